# Optimizing an MI355X kernel written in HIP

```python
import math
import jax, jax.numpy as jnp
from jax import lax
import numpy as np

D_MODEL = 1024
BATCH = 8
SEQ = 4096
DEPTH = 4

H_A = 4
DK_A = 64
DV_A = 128
CONV_A = 4
MLSTM_CHUNK = 64
F_BIAS_INIT = 3.0
H_B = 8
DH_B = 64
R_KV = 128
H_IDX = 4
D_IDX = 64
TOPK_MAX = 256
TOPK_DIV = 4
Q_BLOCK = 128
H_C = 4
DK_C = 64
DV_C = 128
GLA_RANK = 16
GLA_TAU = 16.0
GLA_CHUNK = 64
H_D = 8
DH_D = 64
DIL_PATTERNS = ((128, 1), (512, 4), (2048, 16))
N_BUCKETS = 32
MAX_DIST = 2048
N_REL_HEADS = 8
N_GROUPS = 4
E_PER_GROUP = 4
TOP_K_FINE = 2
EXPERT_FF = 512

EPS = 1e-6
NEG_INF = -1e30
N_AB = (DEPTH + 1) // 2
N_CD = DEPTH // 2
AB_SIZES = (H_A * DK_A, H_A * DK_A, H_A * DV_A, H_A * DV_A, H_A, H_A, H_B * DH_B, R_KV, H_IDX * D_IDX, D_IDX, H_IDX)
CD_SIZES = (H_C * DK_C, H_C * DK_C, H_C * DV_C, GLA_RANK, H_C * DV_C, H_D * DH_D, H_D * DH_D, H_D * DH_D)
W_AB = sum(AB_SIZES)
W_CD = sum(CD_SIZES)
MIX_AB = H_A * DV_A + H_B * DH_B
MIX_CD = H_C * DV_C + H_D * DH_D

kernel_name = "hybrid_mlstm_dsa_gla_dilated_hmoe"


def rmsnorm(x, g):
    xf = x.astype(jnp.float32)
    y = xf * lax.rsqrt(jnp.mean(xf * xf, axis=-1, keepdims=True) + EPS)
    return (y * g.astype(jnp.float32)).astype(x.dtype)


def split_cols(p, sizes):
    offs = np.cumsum((0,) + tuple(sizes))
    return [p[..., int(a):int(b)] for a, b in zip(offs[:-1], offs[1:])]


def heads(a, n):
    return a.reshape(a.shape[0], a.shape[1], n, -1)


def rel_bucket(dist):
    n = jnp.maximum(dist, 0)
    max_exact = N_BUCKETS // 2
    nf = jnp.maximum(n, 1).astype(jnp.float32)
    large = max_exact + (jnp.log(nf / max_exact) / math.log(MAX_DIST / max_exact)
                         * (N_BUCKETS - max_exact)).astype(jnp.int32)
    large = jnp.minimum(large, N_BUCKETS - 1)
    return jnp.where(n < max_exact, n, large)


def causal_dwconv(x, w, b):
    K = w.shape[0]
    L = x.shape[1]
    xp = jnp.pad(x, ((0, 0), (K - 1, 0), (0, 0)))
    return sum(xp[:, j:j + L] * w[j] for j in range(K)) + b


def mlstm_chunkwise(q, k, v, i_pre, f_pre):
    Bn, L, H, DK = q.shape
    DV = v.shape[-1]
    T = MLSTM_CHUNK
    NC = L // T

    def chunks(a):
        return jnp.moveaxis(a.reshape((Bn, NC, T) + a.shape[2:]), 1, 0)

    causal = jnp.tril(jnp.ones((T, T), bool))
    log_f = jax.nn.log_sigmoid(f_pre)

    def step(carry, xs):
        Cm, n, m = carry
        qc, kc, vc, li, lf = xs
        b = jnp.cumsum(lf, axis=1)
        Dm = jnp.where(causal[None, :, :, None],
                       b[:, :, None, :] - b[:, None, :, :] + li[:, None, :, :], NEG_INF)
        g = b + m[:, None, :]
        mt = jnp.maximum(g, Dm.max(axis=2))
        w_intra = jnp.exp(Dm - mt[:, :, None, :])
        w_state = jnp.exp(g - mt)
        s = jnp.einsum('bthk,bshk->btsh', qc, kc) * w_intra
        num = (w_state[..., None] * jnp.einsum('bthk,bhkv->bthv', qc, Cm)
               + jnp.einsum('btsh,bshv->bthv', s, vc))
        den = w_state * jnp.einsum('bthk,bhk->bth', qc, n) + s.sum(axis=2)
        h = num / jnp.maximum(jnp.abs(den), jnp.exp(-mt))[..., None]
        bL = b[:, -1]
        d_end = bL[:, None, :] - b + li
        m_new = jnp.maximum(bL + m, d_end.max(axis=1))
        w_e = jnp.exp(d_end - m_new[:, None, :])
        decay = jnp.exp(bL + m - m_new)
        Cm = decay[..., None, None] * Cm + jnp.einsum('bsh,bshk,bshv->bhkv', w_e, kc, vc)
        n = decay[..., None] * n + jnp.einsum('bsh,bshk->bhk', w_e, kc)
        return (Cm, n, m_new), h

    init = (jnp.zeros((Bn, H, DK, DV), jnp.float32), jnp.zeros((Bn, H, DK), jnp.float32),
            jnp.full((Bn, H), NEG_INF, jnp.float32))
    _, hs = lax.scan(step, init, (chunks(q), chunks(k), chunks(v), chunks(i_pre), chunks(log_f)))
    return jnp.moveaxis(hs, 0, 1).reshape(Bn, L, H, DV)


def gla_chunkwise(q, k, v, log_a):
    Bn, L, H, DK = q.shape
    DV = v.shape[-1]
    T = GLA_CHUNK
    NC = L // T

    def chunks(a):
        return jnp.moveaxis(a.reshape((Bn, NC, T) + a.shape[2:]), 1, 0)

    causal = jnp.tril(jnp.ones((T, T), bool))

    def step(S, xs):
        qc, kc, vc, la = xs
        b = jnp.cumsum(la, axis=1)
        inter = jnp.einsum('bthk,bhkv->bthv', qc * jnp.exp(b), S)
        decay = jnp.exp(jnp.where(causal[None, :, :, None, None], b[:, :, None] - b[:, None, :], NEG_INF))
        A = jnp.einsum('bthk,btshk,bshk->btsh', qc, decay, kc)
        o = inter + jnp.einsum('btsh,bshv->bthv', A, vc)
        bL = b[:, -1]
        S = jnp.exp(bL)[..., None] * S + jnp.einsum('bshk,bshv->bhkv', kc * jnp.exp(bL[:, None] - b), vc)
        return S, o

    _, os_ = lax.scan(step, jnp.zeros((Bn, H, DK, DV), jnp.float32),
                      (chunks(q), chunks(k), chunks(v), chunks(log_a)))
    return jnp.moveaxis(os_, 0, 1).reshape(Bn, L, H, DV)


def dsa_attention(q_abs, c_kv, q_idx, k_idx, w_idx, w_uv, rel_bias):
    Bn, L, H, R = q_abs.shape
    topk = min(TOPK_MAX, L // TOPK_DIV)
    NB = L // Q_BLOCK
    key_pos = jnp.arange(L)
    gather = jax.vmap(lambda tab, idx: tab[idx])

    def block(blk):
        t0 = blk * Q_BLOCK
        qa = lax.dynamic_slice_in_dim(q_abs, t0, Q_BLOCK, axis=1)
        qi = lax.dynamic_slice_in_dim(q_idx, t0, Q_BLOCK, axis=1)
        wi = lax.dynamic_slice_in_dim(w_idx, t0, Q_BLOCK, axis=1)
        pos = t0 + jnp.arange(Q_BLOCK)
        rel = jax.nn.relu(jnp.einsum('bthd,bsd->bths', qi, k_idx))
        score = jnp.einsum('bths,bth->bts', rel, wi).astype(jnp.float32)
        score = jnp.where(key_pos[None, None, :] <= pos[None, :, None], score, -jnp.inf)
        _, idx = lax.top_k(score, topk)
        c_sel = gather(c_kv, idx)
        dist = pos[None, :, None] - idx
        bias = rel_bias[rel_bucket(dist)].transpose(0, 1, 3, 2)
        logits = jnp.einsum('bthr,btkr->bthk', qa, c_sel).astype(jnp.float32) + bias.astype(jnp.float32)
        logits = jnp.where((dist >= 0)[:, :, None, :], logits, NEG_INF)
        p = jax.nn.softmax(logits, axis=-1).astype(c_kv.dtype)
        o_lat = jnp.einsum('bthk,btkr->bthr', p, c_sel)
        return jnp.einsum('bthr,rhd->bthd', o_lat, w_uv)

    out = lax.map(block, jnp.arange(NB))
    return jnp.moveaxis(out, 0, 1).reshape(Bn, L, H, -1)


def dilated_partial(q, k, v, rel_bias, window, dil):
    Bn, L, H, Dh = q.shape
    W = window // dil
    M = L // dil
    nb = -(-M // W)
    Mp = nb * W

    def to_sub(a):
        a = a.reshape(Bn, M, dil, H, Dh).transpose(0, 2, 1, 3, 4)
        a = jnp.pad(a, ((0, 0), (0, 0), (0, Mp - M), (0, 0), (0, 0)))
        return a.reshape(Bn, dil, nb, W, H, Dh)

    def with_prev(a):
        prev = jnp.pad(a[:, :, :-1], ((0, 0), (0, 0), (1, 0), (0, 0), (0, 0), (0, 0)))
        return jnp.concatenate([prev, a], axis=3)

    qs = to_sub(q)
    kc = with_prev(to_sub(k))
    vc = with_prev(to_sub(v))
    tap = jnp.arange(W)[:, None] + W - jnp.arange(2 * W)[None, :]
    tap_ok = (tap >= 0) & (tap <= W)
    blk_ok = (jnp.arange(nb)[:, None] > 0) | (jnp.arange(2 * W)[None, :] >= W)
    mask = tap_ok[None] & blk_ok[:, None, :]
    bias = rel_bias[rel_bucket(jnp.clip(tap, 0, W) * dil)].transpose(2, 0, 1).astype(jnp.float32)
    logits = jnp.einsum('brnqhd,brnkhd->brnhqk', qs, kc).astype(jnp.float32) + bias
    logits = jnp.where(mask[:, None], logits, NEG_INF)
    m = logits.max(axis=-1)
    p = jnp.exp(logits - m[..., None])
    den = p.sum(axis=-1)
    num = jnp.einsum('brnhqk,brnkhd->brnqhd', p, vc.astype(jnp.float32))

    def from_sub(a):
        a = a.reshape((Bn, dil, Mp) + a.shape[4:])[:, :, :M]
        a = jnp.swapaxes(a, 1, 2)
        return a.reshape((Bn, L) + a.shape[3:])

    return from_sub(num), from_sub(jnp.swapaxes(m, 3, 4)), from_sub(jnp.swapaxes(den, 3, 4))


def dilated_mixture(q, k, v, rel_bias):
    parts = [dilated_partial(q, k, v, rel_bias, w, d) for (w, d) in DIL_PATTERNS]
    m_all = jnp.max(jnp.stack([pt[1] for pt in parts]), axis=0)
    num = sum(pt[0] * jnp.exp(pt[1] - m_all)[..., None] for pt in parts)
    den = sum(pt[2] * jnp.exp(pt[1] - m_all) for pt in parts)
    return num / den[..., None]


def mixer_ab(h, w_in, conv_w, conv_b, gate_b, hnorm_g, w_uk, w_uv, rel_bias, w_out):
    Bn, L, _ = h.shape
    p = h @ w_in
    qa, ka, va, oa, ia, fa, qb, ckv, qi, ki, wi = split_cols(p, AB_SIZES)
    qk = jax.nn.silu(causal_dwconv(jnp.concatenate([qa, ka], axis=-1), conv_w, conv_b))
    qa, ka = qk[..., :H_A * DK_A], qk[..., H_A * DK_A:]
    ha = mlstm_chunkwise(heads(qa, H_A).astype(jnp.float32) * DK_A ** -0.5,
                         heads(ka, H_A).astype(jnp.float32),
                         heads(va, H_A).astype(jnp.float32),
                         (ia + gate_b[0]).astype(jnp.float32),
                         (fa + gate_b[1]).astype(jnp.float32))
    ha = rmsnorm(ha.astype(h.dtype), hnorm_g.reshape(H_A, DV_A)).reshape(Bn, L, -1)
    out_a = ha * jax.nn.sigmoid(oa)
    q_abs = jnp.einsum('blhd,rhd->blhr', heads(qb, H_B), w_uk) * DH_B ** -0.5
    out_b = dsa_attention(q_abs, ckv, heads(qi, H_IDX), ki, wi * H_IDX ** -0.5, w_uv, rel_bias)
    y = jnp.concatenate([out_a, out_b.reshape(Bn, L, -1).astype(h.dtype)], axis=-1)
    return y @ w_out


def mixer_cd(h, w_in, w_alpha, b_alpha, hnorm_g, rel_bias, w_out):
    Bn, L, _ = h.shape
    p = h @ w_in
    qc, kc, vc, gc, rc, qd, kd, vd = split_cols(p, CD_SIZES)
    log_a = jax.nn.log_sigmoid((gc @ w_alpha + b_alpha).astype(jnp.float32)) / GLA_TAU
    oc = gla_chunkwise(heads(qc, H_C).astype(jnp.float32) * DK_C ** -0.5,
                       heads(kc, H_C).astype(jnp.float32),
                       heads(vc, H_C).astype(jnp.float32),
                       heads(log_a, H_C))
    oc = rmsnorm(oc.astype(h.dtype), hnorm_g.reshape(H_C, DV_C)).reshape(Bn, L, -1) * jax.nn.silu(rc)
    od = dilated_mixture(heads(qd, H_D) * DH_D ** -0.5, heads(kd, H_D), heads(vd, H_D), rel_bias)
    y = jnp.concatenate([oc, od.reshape(Bn, L, -1).astype(h.dtype)], axis=-1)
    return y @ w_out


def hier_moe(h, w_coarse, b_coarse, w_fine, b_fine, w_gate, w_up, w_down):
    pc = jax.nn.softmax((h @ w_coarse + b_coarse).astype(jnp.float32), axis=-1)
    g_idx = jnp.argmax(pc, axis=-1)
    p_g = jnp.max(pc, axis=-1)
    fine = (jnp.einsum('bld,gde->blge', h, w_fine) + b_fine).astype(jnp.float32)
    fine_sel = jnp.take_along_axis(fine, g_idx[..., None, None], axis=2)[..., 0, :]
    top_v, top_i = lax.top_k(fine_sel, TOP_K_FINE)
    p_e = jax.nn.softmax(top_v, axis=-1)
    w_e = jnp.sum(jax.nn.one_hot(top_i, E_PER_GROUP, dtype=jnp.float32) * p_e[..., None], axis=-2)
    gates = (p_g[..., None, None] * jax.nn.one_hot(g_idx, N_GROUPS, dtype=jnp.float32)[..., None]
             * w_e[..., None, :]).astype(h.dtype)
    y = jnp.zeros_like(h)
    for g in range(N_GROUPS):
        a = jax.nn.silu(jnp.einsum('bld,edf->blef', h, w_gate[g])) * jnp.einsum('bld,edf->blef', h, w_up[g])
        y = y + jnp.einsum('blef,efd->bld', a * gates[:, :, g, :, None], w_down[g])
    return y


def setup_inputs(seed: int = 0) -> dict:
    key = jax.random.key(seed)
    ks = jax.random.split(key, 32)
    f32 = jnp.float32

    def nrm(k, shape, scale):
        return jax.random.normal(k, shape, f32) * scale

    D = D_MODEL
    gate_base = jnp.array([0.0, F_BIAS_INIT], f32)[None, :, None]
    return {
        "x": nrm(ks[0], (BATCH, SEQ, D), 1.0),
        "c": nrm(ks[1], (BATCH, D), 1.0),
        "w_ada": nrm(ks[2], (DEPTH, D, 6 * D), 0.5 * D ** -0.5),
        "b_ada": nrm(ks[3], (DEPTH, 6 * D), 0.02),
        "g_mix": 1.0 + nrm(ks[4], (DEPTH, D), 0.05),
        "g_ffn": 1.0 + nrm(ks[5], (DEPTH, D), 0.05),
        "g_final": 1.0 + nrm(ks[6], (D,), 0.05),
        "rel_bias": nrm(ks[7], (N_BUCKETS, N_REL_HEADS), 0.5),
        "ab_w_in": nrm(ks[8], (N_AB, D, W_AB), D ** -0.5),
        "ab_conv_w": nrm(ks[9], (N_AB, CONV_A, 2 * H_A * DK_A), CONV_A ** -0.5),
        "ab_conv_b": nrm(ks[10], (N_AB, 2 * H_A * DK_A), 0.02),
        "ab_gate_b": gate_base + nrm(ks[11], (N_AB, 2, H_A), 0.1),
        "ab_hnorm_g": 1.0 + nrm(ks[12], (N_AB, H_A * DV_A), 0.05),
        "ab_w_uk": nrm(ks[13], (N_AB, R_KV, H_B, DH_B), R_KV ** -0.5),
        "ab_w_uv": nrm(ks[14], (N_AB, R_KV, H_B, DH_B), R_KV ** -0.5),
        "ab_w_out": nrm(ks[15], (N_AB, MIX_AB, D), MIX_AB ** -0.5),
        "cd_w_in": nrm(ks[16], (N_CD, D, W_CD), D ** -0.5),
        "cd_w_alpha": nrm(ks[17], (N_CD, GLA_RANK, H_C * DK_C), GLA_RANK ** -0.5),
        "cd_b_alpha": nrm(ks[18], (N_CD, H_C * DK_C), 0.1),
        "cd_hnorm_g": 1.0 + nrm(ks[19], (N_CD, H_C * DV_C), 0.05),
        "cd_w_out": nrm(ks[20], (N_CD, MIX_CD, D), MIX_CD ** -0.5),
        "moe_w_coarse": nrm(ks[21], (DEPTH, D, N_GROUPS), D ** -0.5),
        "moe_b_coarse": nrm(ks[22], (DEPTH, N_GROUPS), 0.01),
        "moe_w_fine": nrm(ks[23], (DEPTH, N_GROUPS, D, E_PER_GROUP), D ** -0.5),
        "moe_b_fine": nrm(ks[24], (DEPTH, N_GROUPS, E_PER_GROUP), 0.01),
        "moe_w_gate": nrm(ks[25], (DEPTH, N_GROUPS, E_PER_GROUP, D, EXPERT_FF), D ** -0.5),
        "moe_w_up": nrm(ks[26], (DEPTH, N_GROUPS, E_PER_GROUP, D, EXPERT_FF), D ** -0.5),
        "moe_w_down": nrm(ks[27], (DEPTH, N_GROUPS, E_PER_GROUP, EXPERT_FF, D), EXPERT_FF ** -0.5),
    }


def reference(x, c, w_ada, b_ada, g_mix, g_ffn, g_final, rel_bias,
              ab_w_in, ab_conv_w, ab_conv_b, ab_gate_b, ab_hnorm_g, ab_w_uk, ab_w_uv, ab_w_out,
              cd_w_in, cd_w_alpha, cd_b_alpha, cd_hnorm_g, cd_w_out,
              moe_w_coarse, moe_b_coarse, moe_w_fine, moe_b_fine, moe_w_gate, moe_w_up, moe_w_down):
    mod = jnp.einsum('bd,lde->lbe', jax.nn.silu(c), w_ada) + b_ada[:, None, :]
    for l in range(DEPTH):
        sh_m, sc_m, gt_m, sh_f, sc_f, gt_f = jnp.split(mod[l][:, None, :], 6, axis=-1)
        hm = rmsnorm(x, g_mix[l]) * (1.0 + sc_m) + sh_m
        j = l // 2
        if l % 2 == 0:
            y = mixer_ab(hm, ab_w_in[j], ab_conv_w[j], ab_conv_b[j], ab_gate_b[j], ab_hnorm_g[j],
                         ab_w_uk[j], ab_w_uv[j], rel_bias, ab_w_out[j])
        else:
            y = mixer_cd(hm, cd_w_in[j], cd_w_alpha[j], cd_b_alpha[j], cd_hnorm_g[j], rel_bias, cd_w_out[j])
        x = x + gt_m * y
        hf = rmsnorm(x, g_ffn[l]) * (1.0 + sc_f) + sh_f
        x = x + gt_f * hier_moe(hf, moe_w_coarse[l], moe_b_coarse[l], moe_w_fine[l], moe_b_fine[l],
                                moe_w_gate[l], moe_w_up[l], moe_w_down[l])
    return rmsnorm(x, g_final)
```

```cpp
#include <hip/hip_runtime.h>
#include <cstdio>
#include <cstdint>

#define LAS __attribute__((address_space(3)))
typedef unsigned short bf16_t;
typedef short bf16x8 __attribute__((ext_vector_type(8)));
typedef short bf16x4 __attribute__((ext_vector_type(4)));
typedef float f32x4 __attribute__((ext_vector_type(4)));
typedef float f32x2 __attribute__((ext_vector_type(2)));
typedef unsigned u32x4 __attribute__((ext_vector_type(4)));
typedef unsigned u32x2 __attribute__((ext_vector_type(2)));

constexpr int D = 1024, NB = 8, SEQ = 4096, NTOK = NB * SEQ, DEPTH = 4;
constexpr int W_AB = 2508, W_CD = 3088;
constexpr int NP_AB = 2560, NP_CD = 3072;
constexpr int AB_QA = 0, AB_KA = 256, AB_VA = 512, AB_OA = 1024, AB_QB = 1536, AB_CKV = 2048, AB_QI = 2176, AB_KI = 2432;
constexpr int CD_QC = 0, CD_KC = 256, CD_VC = 512, CD_RC = 1024, CD_QD = 1536, CD_KD = 2048, CD_VD = 2560;
constexpr int MOE_ROWS = 2 * NTOK + 16 * 256;

__device__ __forceinline__ int ltid() { int t = (int)threadIdx.x; asm volatile("" : "+v"(t)); return t; }
__device__ __forceinline__ float bf2f(bf16_t b) { return __uint_as_float(((unsigned)b) << 16); }
__device__ __forceinline__ bf16_t f2bf(float f) { unsigned u = __float_as_uint(f); u += 0x7FFFu + ((u >> 16) & 1u); return (bf16_t)(u >> 16); }
__device__ __forceinline__ unsigned pk2(float lo, float hi) { return (unsigned)f2bf(lo) | ((unsigned)f2bf(hi) << 16); }
__device__ __forceinline__ float wave_sum(float v) {
#pragma unroll
    for (int o = 32; o > 0; o >>= 1) v += __shfl_xor(v, o);
    return v;
}
__device__ __forceinline__ float sigmoidf_(float x) { return 1.0f / (1.0f + __expf(-x)); }
__device__ __forceinline__ float siluf_(float x) { return x / (1.0f + __expf(-x)); }
__device__ __forceinline__ float logsigmoidf_(float x) { return fminf(x, 0.0f) - log1pf(__expf(-fabsf(x))); }

#define XB_TMO      128
#define XB_XCNT(j)  (256  + 64 * (j))
#define XB_XSUB(j)  (1280 + 64 * (j))
#define XB_XGEN(j)  (2304 + 64 * (j))
#define XB_TOP      3328
#define XB_TOPGEN   3392
#define XCD_BAR_WORDS 3456
#define XB_SPIN_CAP (1u << 18)

__device__ __forceinline__ unsigned xb_ld(unsigned* p)              { return __hip_atomic_load(p, __ATOMIC_RELAXED, __HIP_MEMORY_SCOPE_AGENT); }
__device__ __forceinline__ unsigned xb_add(unsigned* p, unsigned v) { return __hip_atomic_fetch_add(p, v, __ATOMIC_RELAXED, __HIP_MEMORY_SCOPE_AGENT); }
__device__ __forceinline__ unsigned xb_xcc_id() { return (unsigned)__builtin_amdgcn_s_getreg((3 << 11) | 20) & 0xFu; }
#define XB_SPIN(cond, bar) do { unsigned _sp = 0; while (cond) { __builtin_amdgcn_s_sleep(1); \
    if ((++_sp & 255u) == 0u) { if (xb_ld(&(bar)[XB_TMO])) break; if (_sp > XB_SPIN_CAP) { atomicAdd(&(bar)[XB_TMO], 1u); break; } } } } while (0)

struct XcdBarrier { unsigned* bar; unsigned x; volatile LAS unsigned* st; };

__device__ __forceinline__ XcdBarrier xcd_barrier_post(unsigned* bar, volatile LAS unsigned* st) {
    XcdBarrier b; b.bar = bar; b.x = xb_xcc_id(); b.st = st;
    if (ltid() == 0) (void)xb_add(&bar[XB_XCNT(b.x)], 1u);
    return b;
}
__device__ __forceinline__ void xcd_barrier_complete(unsigned* bar, unsigned x, unsigned& nloc, unsigned& nx) {
    const unsigned G = gridDim.x * gridDim.y * gridDim.z;
    unsigned sum, cnt, mine, sp = 0u;
    for (;;) {
        sum = 0u; cnt = 0u; mine = 0u;
#pragma unroll
        for (unsigned j = 0; j < 16; ++j) { const unsigned c = xb_ld(&bar[XB_XCNT(j)]); sum += c; cnt += (c > 0u) ? 1u : 0u; mine = (j == x) ? c : mine; }
        if (sum == G) break;
        __builtin_amdgcn_s_sleep(1);
        if ((++sp & 255u) == 0u) { if (xb_ld(&bar[XB_TMO])) break; if (sp > XB_SPIN_CAP) { atomicAdd(&bar[XB_TMO], 1u); break; } }
    }
    nloc = mine > 0u ? mine : 1u; nx = cnt > 0u ? cnt : 1u;
}
__device__ __forceinline__ void xcd_barrier(const XcdBarrier& b) {
    asm volatile("s_waitcnt vmcnt(0)" ::: "memory");
    __syncthreads();
    if (ltid() == 0) {
        unsigned* bar = b.bar;
        __builtin_amdgcn_s_waitcnt(0);
        unsigned nloc = b.st[0], nx = b.st[1];
        if (nloc == 0u) { xcd_barrier_complete(bar, b.x, nloc, nx); b.st[0] = nloc; b.st[1] = nx; }
        const unsigned old = xb_add(&bar[XB_XSUB(b.x)], 1u);
        const unsigned gen = old / nloc;
        if (old + 1u == (gen + 1u) * nloc) {
            __builtin_amdgcn_fence(__ATOMIC_RELEASE, "agent");
            asm volatile("s_waitcnt vmcnt(0)" ::: "memory");
            const unsigned og = xb_add(&bar[XB_TOP], 1u);
            const unsigned tg = og / nx;
            if (og + 1u == (tg + 1u) * nx) xb_add(&bar[XB_TOPGEN], 1u);
            else XB_SPIN(xb_ld(&bar[XB_TOPGEN]) == tg, bar);
            __builtin_amdgcn_fence(__ATOMIC_ACQUIRE, "agent");
            xb_add(&bar[XB_XGEN(b.x)], 1u);
            asm volatile("s_waitcnt vmcnt(0)" ::: "memory");
        } else {
            XB_SPIN(xb_ld(&bar[XB_XGEN(b.x)]) == gen, bar);
            __builtin_amdgcn_fence(__ATOMIC_ACQUIRE, "agent");
            asm volatile("s_waitcnt vmcnt(0)" ::: "memory");
        }
    }
    __syncthreads();
}

namespace pg8 {
constexpr int BM = 256, BK = 64, HALF = 128, HTB = HALF * BK * 2, STAGE_BYTES = 8 * HTB, NXCD = 8, WGM = 8;
__host__ __device__ __forceinline__ int lds_byte(int r, int c) { const int st = (r >> 4) * 2 + (c >> 5), rr = r & 15, cc = c & 31, ob = rr * 64 + cc * 2; return st * 1024 + (ob ^ (((ob >> 9) & 1) << 5)); }
__host__ __device__ __forceinline__ void stage_rc(int b, int& R, int& C) { const int st = b / 1024, sb = b % 1024, swz = sb ^ (((sb >> 9) & 1) << 5); R = (st >> 1) * 16 + swz / 64; C = (st & 1) * 32 + (swz % 64) / 2; }
__host__ __device__ __forceinline__ int perm32(int rho) { const int n = rho >> 4, i = rho & 15; return 8 * (i >> 2) + 4 * n + (i & 3); }

struct Unit { int pm, pn; };
struct Gemm { const bf16_t* A; const bf16_t* Bt; int M, N, K; };

struct StaticOrder {
    int nM, nN, nwg, G, c;
    __host__ __device__ void init(int M, int N, int G_, int c_) { nM = M / BM; nN = N / BM; nwg = nM * nN; G = G_; c = c_; }
    __host__ __device__ bool next(int i, Unit& u) const {
        const long L = (long)i * G + c; if (L >= nwg) return false;
        int wgid = (int)L; { const int q = nwg / NXCD, r = nwg % NXCD, xcd = wgid % NXCD, off = wgid / NXCD; wgid = (xcd < r ? xcd * (q + 1) : r * (q + 1) + (xcd - r) * q) + off; }
        const int nig = WGM * nN, gid = wgid / nig, fm = gid * WGM, gsz = (nM - fm) < WGM ? (nM - fm) : WGM;
        u.pm = fm + ((wgid % nig) % gsz); u.pn = (wgid % nig) / gsz; return true;
    }
    __device__ __forceinline__ void a_ready(const Unit&) const {}
    __device__ __forceinline__ void done(const Unit&) const {}
};
struct MoeOrder {
    const LAS int* tbase;
    int G, c;
    __device__ bool next(int i, Unit& u) const {
        const int L = i * G + c; const int total = tbase[16] * 4; if (L >= total) return false;
        const int pm = L >> 2; int e = 0;
#pragma unroll
        for (int k = 1; k < 16; ++k) e += (pm >= tbase[k]) ? 1 : 0;
        u.pm = pm; u.pn = e * 4 + (L & 3); return true;
    }
    __device__ __forceinline__ void a_ready(const Unit&) const {}
    __device__ __forceinline__ void done(const Unit&) const {}
};

__device__ __forceinline__ unsigned cvt_pk_bf16(float lo, float hi) { unsigned r; asm volatile("v_cvt_pk_bf16_f32 %0, %1, %2" : "=v"(r) : "v"(lo), "v"(hi)); return r; }

template <bool MOE> struct EpiBf16 {
    static constexpr bool PERM = true, AFTER_DRAIN = false;
    bf16_t* O; int ldc;
    __device__ __forceinline__ void operator()(const f32x4 (&acc)[2][2][4][2], const Unit& u, int wr, int wc, int fr, int fq) const {
        const int row0 = u.pm * BM + wr * 64 + fr; const int colt = (MOE ? (u.pn & 3) : u.pn) * BM; const int col0 = colt + wc * 32 + 8 * fq;
#pragma unroll
        for (int ai = 0; ai < 2; ++ai)
#pragma unroll
            for (int m = 0; m < 4; ++m) { bf16_t* rowp = O + (size_t)(row0 + ai * HALF + m * 16) * ldc + col0;
#pragma unroll
                for (int bj = 0; bj < 2; ++bj) { const f32x4 v0 = acc[ai][bj][m][0], v1 = acc[ai][bj][m][1];
                    u32x4 w; w.x = cvt_pk_bf16(v0[0], v0[1]); w.y = cvt_pk_bf16(v0[2], v0[3]); w.z = cvt_pk_bf16(v1[0], v1[1]); w.w = cvt_pk_bf16(v1[2], v1[3]);
                    *(u32x4*)(rowp + bj * HALF) = w; } }
    }
};
struct EpiOutRes {
    static constexpr bool PERM = false, AFTER_DRAIN = false;
    float* X; const float* gate;
    __device__ __forceinline__ void operator()(const f32x4 (&acc)[2][2][4][2], const Unit& u, int wr, int wc, int fr, int fq) const {
        const int row0 = u.pm * BM + wr * 64 + fr, col0 = u.pn * BM + wc * 32 + 4 * fq;
        const float* gp = gate + (size_t)((u.pm * BM) >> 12) * (6 * D) + col0;
        f32x4 gv[2][2];
#pragma unroll
        for (int bj = 0; bj < 2; ++bj)
#pragma unroll
            for (int n = 0; n < 2; ++n) gv[bj][n] = *(const f32x4*)(gp + bj * HALF + n * 16);
#pragma unroll
        for (int ai = 0; ai < 2; ++ai)
#pragma unroll
            for (int m = 0; m < 4; ++m) { float* rowp = X + (size_t)(row0 + ai * HALF + m * 16) * D + col0;
#pragma unroll
                for (int bj = 0; bj < 2; ++bj)
#pragma unroll
                    for (int n = 0; n < 2; ++n) { f32x4* p = (f32x4*)(rowp + bj * HALF + n * 16); *p = *p + gv[bj][n] * acc[ai][bj][m][n]; } }
    }
};
struct EpiMoe1 {
    static constexpr bool PERM = false, AFTER_DRAIN = false;
    bf16_t* H1;
    __device__ __forceinline__ void operator()(const f32x4 (&acc)[2][2][4][2], const Unit& u, int wr, int wc, int fr, int fq) const {
        const int row0 = u.pm * BM + wr * 64 + fr, col0 = (u.pn & 3) * 128 + wc * 16 + 4 * fq;
#pragma unroll
        for (int ai = 0; ai < 2; ++ai)
#pragma unroll
            for (int m = 0; m < 4; ++m) { bf16_t* rowp = H1 + (size_t)(row0 + ai * HALF + m * 16) * 512 + col0;
#pragma unroll
                for (int bj = 0; bj < 2; ++bj) { const f32x4 g = acc[ai][bj][m][0], up = acc[ai][bj][m][1]; float h[4];
#pragma unroll
                    for (int j = 0; j < 4; ++j) h[j] = g[j] / (1.0f + __expf(-g[j])) * up[j];
                    u32x2 w; w.x = cvt_pk_bf16(h[0], h[1]); w.y = cvt_pk_bf16(h[2], h[3]);
                    *(u32x2*)(rowp + bj * 64) = w; } }
    }
};

template <class Epi, class Sched>
__device__ __forceinline__ void gemm_phase(LAS unsigned char* lds, const Gemm g, const Sched& S, const Epi& E) {
    const int tid = ltid(), wid = __builtin_amdgcn_readfirstlane(tid >> 6), lane = tid & 63, wr = wid >> 2, wc = wid & 3, fr = lane & 15, fq = lane >> 4;
    const int K = g.K, nt = K / BK;
    unsigned voffA[2], voffB[2];
#pragma unroll
    for (int i = 0; i < 2; ++i) { int R, C; stage_rc(tid * 16 + i * 8192, R, C); const int Rb = Epi::PERM ? ((R & ~31) + perm32(R & 31)) : R;
        voffA[i] = (unsigned)(R * K + C) * 2u; voffB[i] = (unsigned)(Rb * K + C) * 2u; }
    const size_t kstep = (size_t)(BK * 2);
    const size_t hstep = (size_t)HALF * K * 2;
    const size_t tstep = 2 * hstep;
    const unsigned ldsw = (unsigned)wid * 1024u;
    const int aoff = lds_byte(wr * 64 + fr, fq * 8), boff = lds_byte(wc * 32 + fr, fq * 8);
#define PG8_SA(b, h) (((b) * 2 + (h)) * HTB)
#define PG8_SB(b, h) ((4 + (b) * 2 + (h)) * HTB)
#define PG8_STAGE(bufoff, gbase, voff) do { _Pragma("unroll") for (int _i = 0; _i < 2; ++_i) \
        __builtin_amdgcn_global_load_lds((const unsigned*)((const char*)(gbase) + (voff)[_i]), (LAS unsigned*)(lds + (bufoff) + ldsw + _i * 8192), 16, 0, 0); } while (0)
#define PG8_LDA(dst, b, h) do { _Pragma("unroll") for (int m = 0; m < 4; ++m) _Pragma("unroll") for (int k = 0; k < 2; ++k) dst[m][k] = *(const LAS bf16x8*)(lds + PG8_SA(b, h) + aoff + m * 2048 + k * 1024); } while (0)
#define PG8_LDB(dst, b, h) do { _Pragma("unroll") for (int n = 0; n < 2; ++n) _Pragma("unroll") for (int k = 0; k < 2; ++k) dst[n][k] = *(const LAS bf16x8*)(lds + PG8_SB(b, h) + boff + n * 2048 + k * 1024); } while (0)
#define PG8_MMA(ai, bj, At, Bt) do { __builtin_amdgcn_s_setprio(1); _Pragma("unroll") for (int m = 0; m < 4; ++m) _Pragma("unroll") for (int n = 0; n < 2; ++n) _Pragma("unroll") for (int k = 0; k < 2; ++k) \
        acc[ai][bj][m][n] = __builtin_amdgcn_mfma_f32_16x16x32_bf16(Bt[n][k], At[m][k], acc[ai][bj][m][n], 0, 0, 0); __builtin_amdgcn_s_setprio(0); } while (0)
#define PG8_WAIT_V(n) asm volatile("s_waitcnt vmcnt(" #n ")" ::: "memory")
#define PG8_WAIT_L(n) asm volatile("s_waitcnt lgkmcnt(" #n ")" ::: "memory")
#define PG8_BAR __builtin_amdgcn_s_barrier()
#define PG8_SCHED __builtin_amdgcn_sched_barrier(0)
    Unit cur, nxt; int ui = 0;
    if (!S.next(0, cur)) return;
    f32x4 acc[2][2][4][2];
#pragma unroll
    for (int a = 0; a < 2; ++a)
#pragma unroll
        for (int b = 0; b < 2; ++b)
#pragma unroll
            for (int m = 0; m < 4; ++m)
#pragma unroll
                for (int n = 0; n < 2; ++n) acc[a][b][m][n] = (f32x4){0.f, 0.f, 0.f, 0.f};
    bf16x8 At[4][2], B0[2][2], B1[2][2];
    const char* cA = (const char*)g.A + (size_t)cur.pm * tstep; const char* cB = (const char*)g.Bt + (size_t)cur.pn * tstep;
    S.a_ready(cur);
    PG8_STAGE(PG8_SB(0, 0), cB, voffB); PG8_STAGE(PG8_SA(0, 0), cA, voffA); PG8_STAGE(PG8_SB(0, 1), cB + hstep, voffB); PG8_STAGE(PG8_SA(0, 1), cA + hstep, voffA);
    if (wr == 1) PG8_BAR;
    PG8_WAIT_V(4); PG8_BAR;
    PG8_STAGE(PG8_SB(1, 0), cB + kstep, voffB); PG8_STAGE(PG8_SA(1, 0), cA + kstep, voffA); PG8_STAGE(PG8_SB(1, 1), cB + hstep + kstep, voffB);
    PG8_WAIT_V(6); PG8_BAR;
    for (;;) {
        const bool has_next = S.next(ui + 1, nxt);
        const char* nA = has_next ? (const char*)g.A + (size_t)nxt.pm * tstep : cA; const char* nB = has_next ? (const char*)g.Bt + (size_t)nxt.pn * tstep : cB;
        for (int t = 0; t < nt; t += 2) {
            const bool last = (t == nt - 2);
            const char* a1 = cA + (size_t)(t + 1) * kstep;
            const char* a2 = last ? nA : cA + (size_t)(t + 2) * kstep; const char* b2 = last ? nB : cB + (size_t)(t + 2) * kstep;
            const char* a3 = a2 + kstep; const char* b3 = b2 + kstep;
            if (last && has_next) S.a_ready(nxt);
            PG8_LDB(B0, 0, 0); PG8_SCHED; PG8_LDA(At, 0, 0); PG8_STAGE(PG8_SA(1, 1), a1 + hstep, voffA);
            PG8_WAIT_L(8); PG8_BAR; PG8_WAIT_L(0); PG8_MMA(0, 0, At, B0); PG8_BAR; PG8_SCHED;
            PG8_LDB(B1, 0, 1); PG8_STAGE(PG8_SB(0, 0), b2, voffB);
            PG8_BAR; PG8_WAIT_L(0); PG8_MMA(0, 1, At, B1); PG8_BAR;
            PG8_LDA(At, 0, 1); PG8_STAGE(PG8_SA(0, 0), a2, voffA);
            PG8_BAR; PG8_WAIT_L(0); PG8_MMA(1, 0, At, B0); PG8_BAR; PG8_SCHED;
            PG8_STAGE(PG8_SB(0, 1), b2 + hstep, voffB);
            PG8_WAIT_V(6); PG8_BAR; PG8_MMA(1, 1, At, B1); PG8_BAR;
            PG8_LDB(B0, 1, 0); PG8_SCHED; PG8_LDA(At, 1, 0); PG8_STAGE(PG8_SA(0, 1), a2 + hstep, voffA);
            PG8_WAIT_L(8); PG8_BAR; PG8_WAIT_L(0); PG8_MMA(0, 0, At, B0); PG8_BAR; PG8_SCHED;
            PG8_LDB(B1, 1, 1); PG8_STAGE(PG8_SB(1, 0), b3, voffB);
            PG8_BAR; PG8_WAIT_L(0); PG8_MMA(0, 1, At, B1); PG8_BAR;
            PG8_LDA(At, 1, 1); PG8_STAGE(PG8_SA(1, 0), a3, voffA);
            PG8_BAR; PG8_WAIT_L(0); PG8_MMA(1, 0, At, B0); PG8_BAR; PG8_SCHED;
            PG8_STAGE(PG8_SB(1, 1), b3 + hstep, voffB);
            PG8_WAIT_V(6); PG8_BAR; PG8_MMA(1, 1, At, B1); PG8_BAR;
        }
        E(acc, cur, wr, wc, fr, fq); S.done(cur);
        if (!has_next) break;
#pragma unroll
        for (int a = 0; a < 2; ++a)
#pragma unroll
            for (int b = 0; b < 2; ++b)
#pragma unroll
                for (int m = 0; m < 4; ++m)
#pragma unroll
                    for (int n = 0; n < 2; ++n) acc[a][b][m][n] = (f32x4){0.f, 0.f, 0.f, 0.f};
        cur = nxt; cA = nA; cB = nB; ++ui;
    }
    PG8_WAIT_V(0);
    if (wr == 0) PG8_BAR;
    PG8_BAR;
#undef PG8_SA
#undef PG8_SB
#undef PG8_STAGE
#undef PG8_LDA
#undef PG8_LDB
#undef PG8_MMA
#undef PG8_WAIT_V
#undef PG8_WAIT_L
#undef PG8_BAR
#undef PG8_SCHED
}
}
constexpr size_t MiB = 1024 * 1024;
constexpr size_t WS_CTL  = 0;
constexpr size_t CTL_BYTES = 65536;
constexpr size_t WS_MOD  = WS_CTL + CTL_BYTES;
constexpr size_t WS_BKT  = WS_MOD + 4 * 8 * 6144 * 4;
constexpr size_t WS_SP   = WS_BKT + 4096 * 4;
constexpr size_t WS_RTE  = WS_SP + (size_t)NTOK * 16 * 4;
constexpr size_t WS_RTW  = WS_RTE + (size_t)NTOK * 4;
constexpr size_t WS_POS  = WS_RTW + (size_t)NTOK * 8;
constexpr size_t WS_TC   = WS_POS + (size_t)NTOK * 8;
constexpr size_t WS_WUK  = WS_TC + 256 * 16 * 4;
constexpr size_t WS_WUV  = WS_WUK + 65536 * 2;
constexpr size_t WS_X    = 4 * MiB;
constexpr size_t WS_HBF  = WS_X + 128 * MiB;
constexpr size_t WS_P    = WS_HBF + 64 * MiB;
constexpr size_t WS_YMIX = WS_P + 192 * MiB;
constexpr size_t WS_H1   = WS_YMIX + 64 * MiB;
constexpr size_t WS_WIN  = WS_H1 + 68 * MiB;
constexpr size_t WS_WOUT = WS_WIN + 6 * MiB;
constexpr size_t WS_WGU  = WS_WOUT + 2 * MiB;
constexpr size_t WS_WDN  = WS_WGU + 32 * MiB;
constexpr size_t WS_END  = WS_WDN + 16 * MiB;
static_assert(WS_WUV + 65536 * 2 <= WS_X, "small region overflow");
static_assert((size_t)MOE_ROWS * 512 * 2 <= 68 * MiB, "H1");
static_assert((size_t)MOE_ROWS * 1024 * 2 <= 192 * MiB, "AS");

constexpr int CW_BAR = 0;
constexpr int CW_WQ  = 4096;

constexpr int LDS_TOTAL = 147456;
constexpr int LDS_PERS  = 143360;
constexpr int LP_SLOT = 16, LP_TBASE = 64;

struct Params { const float* in[28]; float* out; unsigned char* ws; };
enum { I_X = 0, I_C, I_WADA, I_BADA, I_GMIX, I_GFFN, I_GFINAL, I_RELB, I_ABWIN, I_ABCONVW, I_ABCONVB, I_ABGATEB, I_ABHNORM, I_ABWUK, I_ABWUV, I_ABWOUT,
       I_CDWIN, I_CDWALPHA, I_CDBALPHA, I_CDHNORM, I_CDWOUT, I_MWC, I_MBC, I_MWF, I_MBF, I_MWG, I_MWU, I_MWD };

#define TID (ltid())
#define NTHR 512

__device__ __forceinline__ void p0_prologue(const Params& p, LAS unsigned char* lds) {
    const int tid = ltid(), G = gridDim.x;
    LAS float* sc = (LAS float*)lds;
    LAS float* red = (LAS float*)(lds + 32768);
    const float* c = p.in[I_C];
    for (int i = tid; i < 8 * 1024; i += NTHR) { const float v = c[i]; sc[i] = v / (1.0f + __expf(-v)); }
    __syncthreads();
    float* mod = (float*)(p.ws + WS_MOD);
    for (int u = blockIdx.x; u < 4 * 48; u += G) {
        const int l = u / 48, e0 = (u % 48) * 128, col = tid & 127, ds = tid >> 7;
        const float* w = p.in[I_WADA] + (size_t)l * D * 6 * D + e0 + col;
        float a[8];
#pragma unroll
        for (int b = 0; b < 8; ++b) a[b] = 0.f;
        for (int d = ds * 256; d < ds * 256 + 256; ++d) { const float wv = w[(size_t)d * 6 * D];
#pragma unroll
            for (int b = 0; b < 8; ++b) a[b] += sc[b * 1024 + d] * wv; }
#pragma unroll
        for (int b = 0; b < 8; ++b) red[(ds * 8 + b) * 128 + col] = a[b];
        __syncthreads();
        for (int i = tid; i < 8 * 128; i += NTHR) { const int b = i >> 7, cc = i & 127;
            const float s = ((red[(0 * 8 + b) * 128 + cc] + red[(1 * 8 + b) * 128 + cc]) + red[(2 * 8 + b) * 128 + cc]) + red[(3 * 8 + b) * 128 + cc];
            mod[((size_t)l * 8 + b) * 6 * D + e0 + cc] = s + p.in[I_BADA][(size_t)l * 6 * D + e0 + cc]; }
        __syncthreads();
    }
    int* bkt = (int*)(p.ws + WS_BKT);
    for (int n = blockIdx.x * NTHR + tid; n < 4096; n += G * NTHR) {
        int v;
        if (n < 16) v = n; else { v = 16 + (int)(log((double)n / 16.0) / log(128.0) * 16.0); if (v > 31) v = 31; }
        bkt[n] = v;
    }
}

template <class SrcF>
__device__ __forceinline__ void prep_tr(LAS unsigned char* lds, const SrcF& src, int K, int Nd, bf16_t* Bt) {
    LAS float* tile = (LAS float*)lds;
    const int tid = ltid(), G = gridDim.x, tnN = Nd / 64, ntile = tnN * (K / 64);
    for (int u = blockIdx.x; u < ntile; u += G) {
        const int tn = u % tnN, tk = u / tnN;
#pragma unroll
        for (int i = 0; i < 8; ++i) { const int kk = (tid >> 6) + 8 * i, nn = tid & 63; tile[kk * 65 + nn] = src(tn * 64 + nn, tk * 64 + kk); }
        __syncthreads();
#pragma unroll
        for (int i = 0; i < 4; ++i) { const int nn = (tid >> 5) + 16 * i, kk = (tid & 31) * 2;
            *(unsigned*)(Bt + (size_t)(tn * 64 + nn) * K + tk * 64 + kk) = pk2(tile[kk * 65 + nn], tile[(kk + 1) * 65 + nn]); }
        __syncthreads();
    }
}
struct SrcShift { const float* W; int ldw, n0, shift, nvalid;
    __device__ __forceinline__ float operator()(int n, int k) const { if (n >= nvalid) return 0.f; return W[(size_t)k * ldw + (n >= n0 ? n + shift : n)]; } };
struct SrcGU { const float* Wg; const float* Wu;
    __device__ __forceinline__ float operator()(int n, int k) const { const int e = n >> 10, r = n & 1023, j = (r >> 5) * 16 + (r & 15); const unsigned long long dlt = (unsigned long long)Wu - (unsigned long long)Wg; const float* W = (const float*)((unsigned long long)Wg + (unsigned long long)((r >> 4) & 1) * dlt); return W[((size_t)e * 1024 + k) * 512 + j]; } };
struct SrcDN { const float* Wd;
    __device__ __forceinline__ float operator()(int n, int k) const { return Wd[((size_t)(n >> 10) * 512 + k) * 1024 + (n & 1023)]; } };

__device__ __forceinline__ void prep_layer(const Params& p, LAS unsigned char* lds, int l) {
    const int j = l >> 1;
    if ((l & 1) == 0) {
        SrcShift s{p.in[I_ABWIN] + (size_t)j * D * W_AB, W_AB, 1536, 8, 2496};
        prep_tr(lds, s, D, NP_AB, (bf16_t*)(p.ws + WS_WIN));
        SrcShift so{p.in[I_ABWOUT] + (size_t)j * D * D, D, 1 << 30, 0, D};
        prep_tr(lds, so, D, D, (bf16_t*)(p.ws + WS_WOUT));
        const float* wuk = p.in[I_ABWUK] + (size_t)j * 65536; const float* wuv = p.in[I_ABWUV] + (size_t)j * 65536;
        bf16_t* ouk = (bf16_t*)(p.ws + WS_WUK); bf16_t* ouv = (bf16_t*)(p.ws + WS_WUV);
        for (int i = blockIdx.x * NTHR + TID; i < 65536; i += gridDim.x * NTHR) {
            ouk[i] = f2bf(wuk[i]);
            const int h = i >> 13, d = (i >> 7) & 63, r = i & 127;
            ouv[i] = f2bf(wuv[((size_t)r * 8 + h) * 64 + d]);
        }
    } else {
        SrcShift s{p.in[I_CDWIN] + (size_t)j * D * W_CD, W_CD, 1024, 16, 3072};
        prep_tr(lds, s, D, NP_CD, (bf16_t*)(p.ws + WS_WIN));
        SrcShift so{p.in[I_CDWOUT] + (size_t)j * D * D, D, 1 << 30, 0, D};
        prep_tr(lds, so, D, D, (bf16_t*)(p.ws + WS_WOUT));
    }
    SrcGU sg{p.in[I_MWG] + (size_t)l * 16 * 1024 * 512, p.in[I_MWU] + (size_t)l * 16 * 1024 * 512};
    prep_tr(lds, sg, 1024, 16 * 1024, (bf16_t*)(p.ws + WS_WGU));
    SrcDN sd{p.in[I_MWD] + (size_t)l * 16 * 512 * 1024};
    prep_tr(lds, sd, 512, 16 * 1024, (bf16_t*)(p.ws + WS_WDN));
}

template <int NC4, class WF>
__device__ __forceinline__ void load_small_w(LAS f32x4* tab, const WF& wf) {
    for (int idx = TID; idx < NC4 * 1024; idx += NTHR) {
        const int c4 = idx >> 10, r = idx & 1023, ij = r >> 6, lane = r & 63, k = 256 * (ij >> 2) + 4 * lane + (ij & 3);
        f32x4 v; v[0] = wf(k, 4 * c4); v[1] = wf(k, 4 * c4 + 1); v[2] = wf(k, 4 * c4 + 2); v[3] = wf(k, 4 * c4 + 3);
        tab[idx] = v;
    }
}
template <int NC4>
__device__ __forceinline__ void small_proj(const LAS f32x4* tab, const f32x4 (&h)[4], int lane, f32x4 (&out)[NC4]) {
#pragma unroll
    for (int c4 = 0; c4 < NC4; ++c4) { f32x4 a = (f32x4){0.f, 0.f, 0.f, 0.f};
#pragma unroll
        for (int i = 0; i < 4; ++i)
#pragma unroll
            for (int j = 0; j < 4; ++j) a += tab[(c4 * 16 + i * 4 + j) * 64 + lane] * h[i][j];
#pragma unroll
        for (int q = 0; q < 4; ++q) a[q] = wave_sum(a[q]);
        out[c4] = a; asm volatile("" ::: "memory"); }
}
struct WfAB { const float* W; __device__ __forceinline__ float operator()(int k, int c) const {
        if (c >= 12) return 0.f; const int col = c < 8 ? 1536 + c : 2504 + (c - 8); return W[(size_t)k * W_AB + col]; } };
struct WfCD { const float* W; __device__ __forceinline__ float operator()(int k, int c) const { return W[(size_t)k * W_CD + 1024 + c]; } };
struct WfRT { const float* Wc; const float* Wf; __device__ __forceinline__ float operator()(int k, int c) const {
        if (c < 4) return Wc[(size_t)k * 4 + c]; const int g = (c - 4) >> 2, e = (c - 4) & 3; return Wf[((size_t)g * D + k) * 4 + e]; } };

__device__ __forceinline__ void phase_norm1(const Params& p, LAS unsigned char* lds, int l) {
    const int tid = ltid(), lane = tid & 63, wave = tid >> 6, G = gridDim.x;
    LAS f32x4* tab = (LAS f32x4*)lds;
    if ((l & 1) == 0) { WfAB wf{p.in[I_ABWIN] + (size_t)(l >> 1) * D * W_AB}; load_small_w<4>(tab, wf); }
    else { WfCD wf{p.in[I_CDWIN] + (size_t)(l >> 1) * D * W_CD}; load_small_w<4>(tab, wf); }
    __syncthreads();
    const float* mod = (const float*)(p.ws + WS_MOD);
    float* X = (float*)(p.ws + WS_X); bf16_t* HBF = (bf16_t*)(p.ws + WS_HBF); float* SP = (float*)(p.ws + WS_SP);
    const bf16_t* YS = (const bf16_t*)(p.ws + WS_P);
    const int* POS = (const int*)(p.ws + WS_POS); const float* RTW = (const float*)(p.ws + WS_RTW);
    for (int grp = blockIdx.x; grp < NTOK / 128; grp += G) {
        const int b = (grp * 128) >> 12;
        const float* mrow = mod + ((size_t)l * 8 + b) * 6 * D;
        f32x4 ca[4], cb[4], gf[4];
#pragma unroll
        for (int i = 0; i < 4; ++i) { const int col = 256 * i + 4 * lane;
            const f32x4 g = *(const f32x4*)(p.in[I_GMIX] + (size_t)l * D + col), sc = *(const f32x4*)(mrow + D + col); ca[i] = g * (sc + 1.0f); cb[i] = *(const f32x4*)(mrow + col);
            gf[i] = (l > 0) ? *(const f32x4*)(mod + ((size_t)(l - 1) * 8 + b) * 6 * D + 5 * D + col) : (f32x4){0.f, 0.f, 0.f, 0.f}; }
        for (int tt = 0; tt < 16; ++tt) {
            const int tok = grp * 128 + wave * 16 + tt;
            f32x4 x[4];
            if (l == 0) {
#pragma unroll
                for (int i = 0; i < 4; ++i) x[i] = *(const f32x4*)(p.in[I_X] + (size_t)tok * D + 256 * i + 4 * lane);
            } else {
                const int p1 = POS[2 * tok], p2 = POS[2 * tok + 1]; const float w1 = RTW[2 * tok], w2 = RTW[2 * tok + 1];
#pragma unroll
                for (int i = 0; i < 4; ++i) { const int col = 256 * i + 4 * lane; x[i] = *(const f32x4*)(X + (size_t)tok * D + col);
                    const u32x2 y1 = *(const u32x2*)(YS + (size_t)p1 * D + col), y2 = *(const u32x2*)(YS + (size_t)p2 * D + col);
                    f32x4 a, c2; a[0] = __uint_as_float(y1.x << 16); a[1] = __uint_as_float(y1.x & 0xffff0000u); a[2] = __uint_as_float(y1.y << 16); a[3] = __uint_as_float(y1.y & 0xffff0000u);
                    c2[0] = __uint_as_float(y2.x << 16); c2[1] = __uint_as_float(y2.x & 0xffff0000u); c2[2] = __uint_as_float(y2.y << 16); c2[3] = __uint_as_float(y2.y & 0xffff0000u);
                    x[i] = x[i] + gf[i] * (a * w1 + c2 * w2); }
            }
            float ss = 0.f;
#pragma unroll
            for (int i = 0; i < 4; ++i) { *(f32x4*)(X + (size_t)tok * D + 256 * i + 4 * lane) = x[i]; ss += (x[i][0] * x[i][0] + x[i][1] * x[i][1]) + (x[i][2] * x[i][2] + x[i][3] * x[i][3]); }
            ss = wave_sum(ss);
            const float rstd = 1.0f / sqrtf(ss * (1.0f / 1024.0f) + 1e-6f);
            f32x4 h[4];
#pragma unroll
            for (int i = 0; i < 4; ++i) { h[i] = x[i] * rstd * ca[i] + cb[i];
                u32x2 w; w.x = pk2(h[i][0], h[i][1]); w.y = pk2(h[i][2], h[i][3]); *(u32x2*)(HBF + (size_t)tok * D + 256 * i + 4 * lane) = w; }
            f32x4 o[4]; small_proj<4>(tab, h, lane, o);
            float v = 0.f;
#pragma unroll
            for (int c = 0; c < 16; ++c) v = (lane == c) ? o[c >> 2][c & 3] : v;
            if (lane < 16) SP[(size_t)tok * 16 + lane] = v;
        }
    }
}

__device__ __forceinline__ void phase_norm2(const Params& p, LAS unsigned char* lds, int l) {
    const int tid = ltid(), lane = tid & 63, wave = tid >> 6, G = gridDim.x;
    LAS f32x4* tab = (LAS f32x4*)lds;
    LAS int* cnts = (LAS int*)(lds + 5 * 16384);
    { WfRT wf{p.in[I_MWC] + (size_t)l * D * 4, p.in[I_MWF] + (size_t)l * 4 * D * 4}; load_small_w<5>(tab, wf); }
    __syncthreads();
    const float* mod = (const float*)(p.ws + WS_MOD);
    const float* X = (const float*)(p.ws + WS_X); bf16_t* HBF = (bf16_t*)(p.ws + WS_HBF);
    int* RTE = (int*)(p.ws + WS_RTE); float* RTW = (float*)(p.ws + WS_RTW); int* TC = (int*)(p.ws + WS_TC);
    float bias[20];
#pragma unroll
    for (int c = 0; c < 4; ++c) bias[c] = p.in[I_MBC][l * 4 + c];
#pragma unroll
    for (int c = 0; c < 16; ++c) bias[4 + c] = p.in[I_MBF][l * 16 + c];
    for (int grp = blockIdx.x; grp < NTOK / 128; grp += G) {
        const int b = (grp * 128) >> 12;
        const float* mrow = mod + ((size_t)l * 8 + b) * 6 * D;
        f32x4 ca[4], cb[4];
#pragma unroll
        for (int i = 0; i < 4; ++i) { const int col = 256 * i + 4 * lane;
            const f32x4 g = *(const f32x4*)(p.in[I_GFFN] + (size_t)l * D + col), sc = *(const f32x4*)(mrow + 4 * D + col); ca[i] = g * (sc + 1.0f); cb[i] = *(const f32x4*)(mrow + 3 * D + col); }
        int cnt = 0;
        for (int tt = 0; tt < 16; ++tt) {
            const int tok = grp * 128 + wave * 16 + tt;
            f32x4 x[4]; float ss = 0.f;
#pragma unroll
            for (int i = 0; i < 4; ++i) { x[i] = *(const f32x4*)(X + (size_t)tok * D + 256 * i + 4 * lane); ss += (x[i][0] * x[i][0] + x[i][1] * x[i][1]) + (x[i][2] * x[i][2] + x[i][3] * x[i][3]); }
            ss = wave_sum(ss);
            const float rstd = 1.0f / sqrtf(ss * (1.0f / 1024.0f) + 1e-6f);
            f32x4 h[4];
#pragma unroll
            for (int i = 0; i < 4; ++i) { h[i] = x[i] * rstd * ca[i] + cb[i];
                u32x2 w; w.x = pk2(h[i][0], h[i][1]); w.y = pk2(h[i][2], h[i][3]); *(u32x2*)(HBF + (size_t)tok * D + 256 * i + 4 * lane) = w; }
            f32x4 o[5]; small_proj<5>(tab, h, lane, o);
            float lc[4];
#pragma unroll
            for (int c = 0; c < 4; ++c) lc[c] = o[0][c] + bias[c];
            int g = 0; float mx = lc[0];
#pragma unroll
            for (int c = 1; c < 4; ++c) if (lc[c] > mx) { mx = lc[c]; g = c; }
            float se = 0.f;
#pragma unroll
            for (int c = 0; c < 4; ++c) se += expf(lc[c] - mx);
            const float pg = 1.0f / se;
            float lf[4];
#pragma unroll
            for (int e = 0; e < 4; ++e) { float v = o[1][e] + bias[4 + e];
                v = (g == 1) ? o[2][e] + bias[8 + e] : v; v = (g == 2) ? o[3][e] + bias[12 + e] : v; v = (g == 3) ? o[4][e] + bias[16 + e] : v; lf[e] = v; }
            int i1 = 0; float v1 = lf[0];
#pragma unroll
            for (int e = 1; e < 4; ++e) if (lf[e] > v1) { v1 = lf[e]; i1 = e; }
            int i2 = -1; float v2 = -3.0e38f;
#pragma unroll
            for (int e = 0; e < 4; ++e) if (e != i1 && lf[e] > v2) { v2 = lf[e]; i2 = e; }
            const float ex = expf(v2 - v1); const float p1 = 1.0f / (1.0f + ex), p2 = ex / (1.0f + ex);
            const int e1 = g * 4 + i1, e2 = g * 4 + i2;
            if (lane == 0) { RTE[tok] = e1 | (e2 << 8); RTW[2 * tok] = pg * p1; RTW[2 * tok + 1] = pg * p2; }
            cnt += (lane == e1 ? 1 : 0) + (lane == e2 ? 1 : 0);
        }
        __syncthreads();
        if (lane < 16) cnts[wave * 16 + lane] = cnt;
        __syncthreads();
        if (tid < 16) { int s = 0;
#pragma unroll
            for (int w = 0; w < 8; ++w) s += cnts[w * 16 + tid];
            TC[grp * 16 + tid] = s; }
    }
}

__device__ __forceinline__ void phase_dispatch(const Params& p, LAS unsigned char* lds, LAS int* tbase) {
    const int tid = ltid(), lane = tid & 63, wave = tid >> 6, G = gridDim.x;
    LAS int* tc = (LAS int*)lds;
    LAS int* tot = (LAS int*)(lds + 16384);
    LAS int* earr = (LAS int*)(lds + 16384 + 256);
    LAS int* parr = (LAS int*)(lds + 16384 + 256 + 1024);
    LAS int* toff = (LAS int*)(lds + 16384 + 256 + 2048);
    const int* TC = (const int*)(p.ws + WS_TC); const int* RTE = (const int*)(p.ws + WS_RTE);
    int* POS = (int*)(p.ws + WS_POS);
    const bf16_t* HBF = (const bf16_t*)(p.ws + WS_HBF); bf16_t* AS = (bf16_t*)(p.ws + WS_P);
    for (int i = tid; i < 256 * 16; i += NTHR) tc[i] = TC[i];
    __syncthreads();
    if (tid < 16) { int s = 0; for (int g = 0; g < 256; ++g) s += tc[g * 16 + tid]; tot[tid] = s; }
    __syncthreads();
    if (tid == 0) { int rb = 0; for (int e = 0; e < 16; ++e) { tot[16 + e] = rb; tbase[e] = rb >> 8; rb += (tot[e] + 255) & ~255; } tbase[16] = rb >> 8; }
    __syncthreads();
    for (int grp = blockIdx.x; grp < NTOK / 128; grp += G) {
        if (tid < 16) { int s = 0; for (int g = 0; g < grp; ++g) s += tc[g * 16 + tid]; toff[tid] = s; }
        if (tid < 256) { const int ee = RTE[grp * 128 + (tid >> 1)]; earr[tid] = (tid & 1) ? ((ee >> 8) & 255) : (ee & 255); }
        __syncthreads();
        if (tid < 256) { const int e = earr[tid]; int rank = 0; for (int j = 0; j < tid; ++j) rank += (earr[j] == e) ? 1 : 0;
            const int pos = tot[16 + e] + toff[e] + rank; parr[tid] = pos; POS[(size_t)(grp * 128) * 2 + tid] = pos; }
        __syncthreads();
        for (int r = 0; r < 32; ++r) { const int i = wave * 32 + r; const int tok = grp * 128 + (i >> 1); const int pos = parr[i];
            const u32x4* s = (const u32x4*)(HBF + (size_t)tok * D); u32x4* d = (u32x4*)(AS + (size_t)pos * D);
            const u32x4 a = s[lane], c2 = s[64 + lane]; d[lane] = a; d[64 + lane] = c2; }
        __syncthreads();
    }
}

__device__ __forceinline__ void phase_final(const Params& p) {
    const int tid = ltid(), lane = tid & 63, wave = tid >> 6, G = gridDim.x;
    const float* mod = (const float*)(p.ws + WS_MOD);
    const float* X = (const float*)(p.ws + WS_X);
    const bf16_t* YS = (const bf16_t*)(p.ws + WS_P);
    const int* POS = (const int*)(p.ws + WS_POS); const float* RTW = (const float*)(p.ws + WS_RTW);
    for (int grp = blockIdx.x; grp < NTOK / 128; grp += G) {
        const int b = (grp * 128) >> 12;
        f32x4 gf[4], gg[4];
#pragma unroll
        for (int i = 0; i < 4; ++i) { const int col = 256 * i + 4 * lane; gf[i] = *(const f32x4*)(mod + ((size_t)3 * 8 + b) * 6 * D + 5 * D + col); gg[i] = *(const f32x4*)(p.in[I_GFINAL] + col); }
        for (int tt = 0; tt < 16; ++tt) {
            const int tok = grp * 128 + wave * 16 + tt;
            const int p1 = POS[2 * tok], p2 = POS[2 * tok + 1]; const float w1 = RTW[2 * tok], w2 = RTW[2 * tok + 1];
            f32x4 x[4]; float ss = 0.f;
#pragma unroll
            for (int i = 0; i < 4; ++i) { const int col = 256 * i + 4 * lane; x[i] = *(const f32x4*)(X + (size_t)tok * D + col);
                const u32x2 y1 = *(const u32x2*)(YS + (size_t)p1 * D + col), y2 = *(const u32x2*)(YS + (size_t)p2 * D + col);
                f32x4 a, c2; a[0] = __uint_as_float(y1.x << 16); a[1] = __uint_as_float(y1.x & 0xffff0000u); a[2] = __uint_as_float(y1.y << 16); a[3] = __uint_as_float(y1.y & 0xffff0000u);
                c2[0] = __uint_as_float(y2.x << 16); c2[1] = __uint_as_float(y2.x & 0xffff0000u); c2[2] = __uint_as_float(y2.y << 16); c2[3] = __uint_as_float(y2.y & 0xffff0000u);
                x[i] = x[i] + gf[i] * (a * w1 + c2 * w2);
                ss += (x[i][0] * x[i][0] + x[i][1] * x[i][1]) + (x[i][2] * x[i][2] + x[i][3] * x[i][3]); }
            ss = wave_sum(ss);
            const float rstd = 1.0f / sqrtf(ss * (1.0f / 1024.0f) + 1e-6f);
#pragma unroll
            for (int i = 0; i < 4; ++i) *(f32x4*)(p.out + (size_t)tok * D + 256 * i + 4 * lane) = x[i] * rstd * gg[i];
        }
    }
}
__device__ __forceinline__ f32x4 mfma16(bf16x8 a, bf16x8 b, f32x4 c) { return __builtin_amdgcn_mfma_f32_16x16x32_bf16(a, b, c, 0, 0, 0); }
__device__ __forceinline__ bf16x8 ldfrag(const LAS unsigned char* base, int row, int stride_bytes, int kk, int g) { return *(const LAS bf16x8*)(base + row * stride_bytes + (kk * 32 + g * 8) * 2); }
__device__ __forceinline__ float scan_add(float v, int lane) {
#pragma unroll
    for (int o = 1; o < 64; o <<= 1) { const float t = __shfl_up(v, o); if (lane >= o) v += t; }
    return v;
}
__device__ __forceinline__ float scan_max(float v, int lane) {
#pragma unroll
    for (int o = 1; o < 64; o <<= 1) { const float t = __shfl_up(v, o); if (lane >= o) v = fmaxf(v, t); }
    return v;
}

constexpr int RS = 144;
__device__ __forceinline__ void unit_mlstm(const Params& p, LAS unsigned char* lds, int j, int b, int h) {
    const int tid = ltid(), lane = tid & 63, wave = __builtin_amdgcn_readfirstlane(tid >> 6), fr = lane & 15, g = lane >> 4;
    LAS unsigned char* QS = lds; LAS unsigned char* KS = lds + 9216; LAS unsigned char* KWT = lds + 18432; LAS unsigned char* VT = lds + 27648;
    LAS unsigned char* CT = lds + 48384; LAS unsigned char* PS = lds + 69120; LAS float* OS = (LAS float*)(lds + 78336); LAS float* GA = (LAS float*)(lds + 116224);
    constexpr int OSS = 148;
    const bf16_t* P = (const bf16_t*)(p.ws + WS_P); const float* SP = (const float*)(p.ws + WS_SP); bf16_t* YMIX = (bf16_t*)(p.ws + WS_YMIX);
    for (int i = tid; i < 144 * 72 / 2; i += NTHR) ((LAS unsigned*)CT)[i] = 0u;
    for (int i = tid; i < 16 * 72; i += NTHR) { const int r = i / 72; ((LAS bf16_t*)VT)[(128 + r) * 72 + (i % 72)] = (r == 0) ? (bf16_t)0x3F80 : (bf16_t)0; }
    const int cch = tid & 127;
    const int ch = (cch < 64) ? h * 64 + cch : 256 + h * 64 + (cch - 64);
    float cw[4]; const float* convw = p.in[I_ABCONVW] + (size_t)j * 4 * 512;
#pragma unroll
    for (int q = 0; q < 4; ++q) cw[q] = convw[q * 512 + ch];
    const float cbias = p.in[I_ABCONVB][j * 512 + ch];
    const float gbi = p.in[I_ABGATEB][j * 8 + h], gbf = p.in[I_ABGATEB][j * 8 + 4 + h];
    const float hg0 = p.in[I_ABHNORM][j * 512 + h * 128 + lane], hg1 = p.in[I_ABHNORM][j * 512 + h * 128 + 64 + lane];
    f32x4 st[5];
#pragma unroll
    for (int i = 0; i < 5; ++i) st[i] = (f32x4){0.f, 0.f, 0.f, 0.f};
    float m_carry = -1e30f;
    __syncthreads();
    for (int ck = 0; ck < 64; ++ck) {
        const int tok0 = b * SEQ + ck * 64;
        if (wave == 0) {
            const int tok = tok0 + lane;
            const float li = SP[(size_t)tok * 16 + h] + gbi; const float lf = logsigmoidf_(SP[(size_t)tok * 16 + 4 + h] + gbf);
            const float bc = scan_add(lf, lane); const float a = li - bc; const float M = fmaxf(m_carry, scan_max(a, lane));
            GA[lane] = a; GA[64 + lane] = M; GA[128 + lane] = __expf(m_carry - M); GA[192 + lane] = __expf(-(bc + M));
            const float bL = __shfl(bc, 63), M63 = __shfl(M, 63);
            m_carry = bL + M63;
        }
        __syncthreads();
        const float M63 = GA[64 + 63], decay = GA[128 + 63];
#pragma unroll 4
        for (int it = 0; it < 16; ++it) { const int t = (tid >> 7) + 4 * it; const int pos = ck * 64 + t;
            float acc = cbias;
#pragma unroll
            for (int q = 0; q < 4; ++q) { const int pp = pos - 3 + q; const float xv = (pp >= 0) ? bf2f(P[(size_t)(b * SEQ + pp) * NP_AB + ch]) : 0.f; acc += cw[q] * xv; }
            const float v = acc / (1.0f + __expf(-acc));
            if (cch < 64) ((LAS bf16_t*)QS)[t * 72 + cch] = f2bf(v * 0.125f);
            else { const int kk = cch - 64; ((LAS bf16_t*)KS)[t * 72 + kk] = f2bf(v); ((LAS bf16_t*)KWT)[kk * 72 + t] = f2bf(v * __expf(GA[t] - M63)); } }
#pragma unroll 4
        for (int it = 0; it < 16; ++it) { const int s = (tid >> 7) + 4 * it, dv = tid & 127; ((LAS bf16_t*)VT)[dv * 72 + s] = P[(size_t)(tok0 + s) * NP_AB + AB_VA + h * 128 + dv]; }
        __syncthreads();
        { const int tq = wave >> 1;
#pragma unroll
          for (int u = 0; u < 2; ++u) { const int ts = (wave & 1) * 2 + u; f32x4 acc = (f32x4){0.f, 0.f, 0.f, 0.f};
            if (ts <= tq) {
#pragma unroll
                for (int kk = 0; kk < 2; ++kk) acc = mfma16(ldfrag(QS, tq * 16 + fr, RS, kk, g), ldfrag(KS, ts * 16 + fr, RS, kk, g), acc);
            }
            const int s = ts * 16 + fr; const float as = GA[s];
#pragma unroll
            for (int r = 0; r < 4; ++r) { const int t = tq * 16 + 4 * g + r; const float pv = (ts <= tq && s <= t) ? acc[r] * __expf(as - GA[64 + t]) : 0.f; ((LAS bf16_t*)PS)[t * 72 + s] = f2bf(pv); } } }
        __syncthreads();
#pragma unroll
        for (int i = 0; i < 5; ++i) { const int id = wave + 8 * i;
            if (id < 36) { const int tq = id / 9, tv = id % 9; f32x4 acc = (f32x4){0.f, 0.f, 0.f, 0.f};
#pragma unroll
                for (int kk = 0; kk < 2; ++kk) acc = mfma16(ldfrag(QS, tq * 16 + fr, RS, kk, g), ldfrag(CT, tv * 16 + fr, RS, kk, g), acc);
#pragma unroll
                for (int r = 0; r < 4; ++r) acc[r] *= GA[128 + tq * 16 + 4 * g + r];
#pragma unroll
                for (int kk = 0; kk < 2; ++kk) acc = mfma16(ldfrag(PS, tq * 16 + fr, RS, kk, g), ldfrag(VT, tv * 16 + fr, RS, kk, g), acc);
#pragma unroll
                for (int r = 0; r < 4; ++r) OS[(tq * 16 + 4 * g + r) * OSS + tv * 16 + fr] = acc[r];
                st[i] = st[i] * decay;
#pragma unroll
                for (int kk = 0; kk < 2; ++kk) st[i] = mfma16(ldfrag(KWT, tq * 16 + fr, RS, kk, g), ldfrag(VT, tv * 16 + fr, RS, kk, g), st[i]);
            } }
        __syncthreads();
#pragma unroll
        for (int i = 0; i < 5; ++i) { const int id = wave + 8 * i;
            if (id < 36) { const int tk = id / 9, tv = id % 9; u32x2 w; w.x = pk2(st[i][0], st[i][1]); w.y = pk2(st[i][2], st[i][3]);
                *(LAS u32x2*)(CT + (tv * 16 + fr) * RS + (tk * 16 + 4 * g) * 2) = w; } }
#pragma unroll 2
        for (int rr = 0; rr < 8; ++rr) { const int t = wave * 8 + rr; const int tok = tok0 + t;
            const float den = OS[t * OSS + 128]; const float dn = fmaxf(fabsf(den), GA[192 + t]);
            const float h0 = OS[t * OSS + lane] / dn, h1 = OS[t * OSS + 64 + lane] / dn;
            const float ss = wave_sum(h0 * h0 + h1 * h1); const float rn = 1.0f / sqrtf(ss * (1.0f / 128.0f) + 1e-6f);
            const float o0 = bf2f(P[(size_t)tok * NP_AB + AB_OA + h * 128 + lane]), o1 = bf2f(P[(size_t)tok * NP_AB + AB_OA + h * 128 + 64 + lane]);
            YMIX[(size_t)tok * D + h * 128 + lane] = f2bf(h0 * rn * hg0 * sigmoidf_(o0));
            YMIX[(size_t)tok * D + h * 128 + 64 + lane] = f2bf(h1 * rn * hg1 * sigmoidf_(o1)); }
        __syncthreads();
    }
}

__device__ __forceinline__ void unit_gla(const Params& p, LAS unsigned char* lds, int j, int b, int h) {
    const int tid = ltid(), lane = tid & 63, wave = __builtin_amdgcn_readfirstlane(tid >> 6), fr = lane & 15, g = lane >> 4;
    LAS unsigned char* QS = lds; LAS unsigned char* KS = lds + 9216; LAS unsigned char* KWT = lds + 18432; LAS unsigned char* VT = lds + 27648;
    LAS unsigned char* ST = lds + 46080; LAS unsigned char* PS = lds + 64512; LAS float* OS = (LAS float*)(lds + 73728); LAS float* BS = (LAS float*)(lds + 107520);
    LAS float* GC = (LAS float*)(lds + 124160); LAS float* WA = (LAS float*)(lds + 128256); LAS float* BA = (LAS float*)(lds + 132352); LAS float* EBL = (LAS float*)(lds + 132608);
    constexpr int OSS = 132, BSS = 65;
    const bf16_t* P = (const bf16_t*)(p.ws + WS_P); const float* SP = (const float*)(p.ws + WS_SP); bf16_t* YMIX = (bf16_t*)(p.ws + WS_YMIX);
    for (int i = tid; i < 128 * 72 / 2; i += NTHR) ((LAS unsigned*)ST)[i] = 0u;
    for (int i = tid; i < 16 * 64; i += NTHR) WA[i] = p.in[I_CDWALPHA][(size_t)j * 16 * 256 + (i >> 6) * 256 + h * 64 + (i & 63)];
    if (tid < 64) BA[tid] = p.in[I_CDBALPHA][j * 256 + h * 64 + tid];
    const float hg0 = p.in[I_CDHNORM][j * 512 + h * 128 + lane], hg1 = p.in[I_CDHNORM][j * 512 + h * 128 + 64 + lane];
    const int cch = tid & 127;
    f32x4 st[4];
#pragma unroll
    for (int i = 0; i < 4; ++i) st[i] = (f32x4){0.f, 0.f, 0.f, 0.f};
    __syncthreads();
    for (int ck = 0; ck < 64; ++ck) {
        const int tok0 = b * SEQ + ck * 64;
        for (int i = tid; i < 64 * 16; i += NTHR) GC[i] = SP[(size_t)tok0 * 16 + i];
        __syncthreads();
        { float gc[16];
#pragma unroll
          for (int r = 0; r < 16; ++r) gc[r] = GC[lane * 16 + r];
#pragma unroll
          for (int i = 0; i < 8; ++i) { const int k = wave * 8 + i; float z = BA[k];
#pragma unroll
            for (int r = 0; r < 16; ++r) z += gc[r] * WA[r * 64 + k];
            const float la = logsigmoidf_(z) * (1.0f / 16.0f); const float bc = scan_add(la, lane);
            BS[lane * BSS + k] = bc;
            if (lane == 63) { EBL[k] = __expf(bc); EBL[64 + k] = bc; } } }
        __syncthreads();
#pragma unroll 4
        for (int it = 0; it < 16; ++it) { const int t = (tid >> 7) + 4 * it; const int tok = tok0 + t;
            if (cch < 64) { const float q = bf2f(P[(size_t)tok * NP_CD + CD_QC + h * 64 + cch]); ((LAS bf16_t*)QS)[t * 72 + cch] = f2bf(q * 0.125f * __expf(BS[t * BSS + cch])); }
            else { const int kk = cch - 64; const float kv = bf2f(P[(size_t)tok * NP_CD + CD_KC + h * 64 + kk]); const float bb = BS[t * BSS + kk];
                ((LAS bf16_t*)KS)[t * 72 + kk] = f2bf(kv * __expf(-bb)); ((LAS bf16_t*)KWT)[kk * 72 + t] = f2bf(kv * __expf(EBL[64 + kk] - bb)); } }
#pragma unroll 4
        for (int it = 0; it < 16; ++it) { const int s = (tid >> 7) + 4 * it, dv = tid & 127; ((LAS bf16_t*)VT)[dv * 72 + s] = P[(size_t)(tok0 + s) * NP_CD + CD_VC + h * 128 + dv]; }
        __syncthreads();
        { const int tq = wave >> 1;
#pragma unroll
          for (int u = 0; u < 2; ++u) { const int ts = (wave & 1) * 2 + u; f32x4 acc = (f32x4){0.f, 0.f, 0.f, 0.f};
            if (ts <= tq) {
#pragma unroll
                for (int kk = 0; kk < 2; ++kk) acc = mfma16(ldfrag(QS, tq * 16 + fr, RS, kk, g), ldfrag(KS, ts * 16 + fr, RS, kk, g), acc);
            }
            const int s = ts * 16 + fr;
#pragma unroll
            for (int r = 0; r < 4; ++r) { const int t = tq * 16 + 4 * g + r; const float pv = (ts <= tq && s <= t) ? acc[r] : 0.f; ((LAS bf16_t*)PS)[t * 72 + s] = f2bf(pv); } } }
        __syncthreads();
#pragma unroll
        for (int i = 0; i < 4; ++i) { const int id = wave + 8 * i; const int tq = id >> 3, tv = id & 7; f32x4 acc = (f32x4){0.f, 0.f, 0.f, 0.f};
#pragma unroll
            for (int kk = 0; kk < 2; ++kk) acc = mfma16(ldfrag(QS, tq * 16 + fr, RS, kk, g), ldfrag(ST, tv * 16 + fr, RS, kk, g), acc);
#pragma unroll
            for (int kk = 0; kk < 2; ++kk) acc = mfma16(ldfrag(PS, tq * 16 + fr, RS, kk, g), ldfrag(VT, tv * 16 + fr, RS, kk, g), acc);
#pragma unroll
            for (int r = 0; r < 4; ++r) OS[(tq * 16 + 4 * g + r) * OSS + tv * 16 + fr] = acc[r];
#pragma unroll
            for (int r = 0; r < 4; ++r) st[i][r] *= EBL[tq * 16 + 4 * g + r];
#pragma unroll
            for (int kk = 0; kk < 2; ++kk) st[i] = mfma16(ldfrag(KWT, tq * 16 + fr, RS, kk, g), ldfrag(VT, tv * 16 + fr, RS, kk, g), st[i]);
        }
        __syncthreads();
#pragma unroll
        for (int i = 0; i < 4; ++i) { const int id = wave + 8 * i; const int tk = id >> 3, tv = id & 7; u32x2 w; w.x = pk2(st[i][0], st[i][1]); w.y = pk2(st[i][2], st[i][3]);
            *(LAS u32x2*)(ST + (tv * 16 + fr) * RS + (tk * 16 + 4 * g) * 2) = w; }
#pragma unroll 2
        for (int rr = 0; rr < 8; ++rr) { const int t = wave * 8 + rr; const int tok = tok0 + t;
            const float h0 = OS[t * OSS + lane], h1 = OS[t * OSS + 64 + lane];
            const float ss = wave_sum(h0 * h0 + h1 * h1); const float rn = 1.0f / sqrtf(ss * (1.0f / 128.0f) + 1e-6f);
            const float r0 = bf2f(P[(size_t)tok * NP_CD + CD_RC + h * 128 + lane]), r1 = bf2f(P[(size_t)tok * NP_CD + CD_RC + h * 128 + 64 + lane]);
            YMIX[(size_t)tok * D + h * 128 + lane] = f2bf(h0 * rn * hg0 * siluf_(r0));
            YMIX[(size_t)tok * D + h * 128 + 64 + lane] = f2bf(h1 * rn * hg1 * siluf_(r1)); }
        __syncthreads();
    }
}
constexpr int L_BKT8 = 134144, L_RELB = 138240;
__device__ __forceinline__ void load_attn_tables(const Params& p, LAS unsigned char* lds) {
    const int* bkt = (const int*)(p.ws + WS_BKT);
    for (int i = TID; i < 4096; i += NTHR) lds[L_BKT8 + i] = (unsigned char)bkt[i];
    if (TID < 256) ((LAS float*)(lds + L_RELB))[TID] = p.in[I_RELB][TID];
}
__device__ __forceinline__ int scan_add_i(int v, int lane) {
#pragma unroll
    for (int o = 1; o < 64; o <<= 1) { const int t = __shfl_up(v, o); if (lane >= o) v += t; }
    return v;
}
__device__ __forceinline__ unsigned keep_lowest(unsigned m, int n) {
    if (n <= 0) return 0u;
    while ((int)__popc(m) > n) m &= ~(1u << (31 - __clz((int)m)));
    return m;
}
__device__ __forceinline__ bf16x4 tr_read(unsigned lds_addr) { bf16x4 r; asm volatile("ds_read_b64_tr_b16 %0, %1\n\ts_waitcnt lgkmcnt(0)" : "=&v"(r) : "v"(lds_addr) : "memory"); return r; }
__device__ __forceinline__ unsigned sortable(float f) { const unsigned u = __float_as_uint(f); return (u & 0x80000000u) ? ~u : (u | 0x80000000u); }

__device__ __forceinline__ void unit_dsa(const Params& p, LAS unsigned char* lds, int b, int ti) {
    const int tid = ltid(), lane = tid & 63, wave = __builtin_amdgcn_readfirstlane(tid >> 6), fr = lane & 15, g = lane >> 4;
    LAS unsigned* HIST = (LAS unsigned*)lds; LAS unsigned char* GBUF = lds;
    LAS unsigned* GTM = (LAS unsigned*)(lds + 69632); LAS unsigned* EQM = (LAS unsigned*)(lds + 77824);
    LAS unsigned short* SEL = (LAS unsigned short*)(lds + 86016); LAS unsigned char* QAB = lds + 94208;
    LAS int* MISC = (LAS int*)(lds + 126976);
    const LAS unsigned char* BKT8 = lds + L_BKT8; const LAS float* RELB = (const LAS float*)(lds + L_RELB);
    const bf16_t* P = (const bf16_t*)(p.ws + WS_P); const float* SP = (const float*)(p.ws + WS_SP); bf16_t* YMIX = (bf16_t*)(p.ws + WS_YMIX);
    const bf16_t* WUK = (const bf16_t*)(p.ws + WS_WUK); const bf16_t* WUV = (const bf16_t*)(p.ws + WS_WUV);
    const int t0 = ti * 16; const size_t rowb = (size_t)b * SEQ;
    for (int i = tid; i < 4096; i += NTHR) ((LAS u32x4*)HIST)[i] = (u32x4){0u, 0u, 0u, 0u};
    { const int h = wave; f32x4 acc[8];
#pragma unroll
      for (int rt = 0; rt < 8; ++rt) acc[rt] = (f32x4){0.f, 0.f, 0.f, 0.f};
#pragma unroll
      for (int kk = 0; kk < 2; ++kk) { const bf16x8 a = *(const bf16x8*)(P + (rowb + t0 + fr) * NP_AB + AB_QB + h * 64 + kk * 32 + g * 8);
#pragma unroll
        for (int rt = 0; rt < 8; ++rt) { const bf16x8 bw = *(const bf16x8*)(WUK + ((size_t)(rt * 16 + fr) * 8 + h) * 64 + kk * 32 + g * 8); acc[rt] = mfma16(a, bw, acc[rt]); } }
#pragma unroll
      for (int rt = 0; rt < 8; ++rt)
#pragma unroll
        for (int r = 0; r < 4; ++r) ((LAS bf16_t*)QAB)[((4 * g + r) * 8 + h) * 128 + rt * 16 + fr] = f2bf(acc[rt][r] * 0.125f); }
    bf16x8 qf[4][2];
#pragma unroll
    for (int hh = 0; hh < 4; ++hh)
#pragma unroll
        for (int kk = 0; kk < 2; ++kk) qf[hh][kk] = *(const bf16x8*)(P + (rowb + t0 + fr) * NP_AB + AB_QI + hh * 64 + kk * 32 + g * 8);
    float wq[4];
#pragma unroll
    for (int hh = 0; hh < 4; ++hh) wq[hh] = SP[(rowb + t0 + fr) * 16 + 8 + hh] * 0.5f;
    const int tq = t0 + fr; const int nkt = ti + 1;
    if (tid < 16) { MISC[tid] = 0; MISC[16 + tid] = 256; MISC[48 + tid] = 0; }
    __syncthreads();
#pragma unroll 1
    for (int pass = 0; pass < 4; ++pass) {
        const unsigned pfx = (unsigned)MISC[fr], tau = (unsigned)MISC[48 + fr];
#pragma unroll 1
        for (int kt = wave; kt < nkt; kt += 8) {
            const bf16x8 k0 = *(const bf16x8*)(P + (rowb + kt * 16 + fr) * NP_AB + AB_KI + g * 8), k1 = *(const bf16x8*)(P + (rowb + kt * 16 + fr) * NP_AB + AB_KI + 32 + g * 8);
            f32x4 sc = (f32x4){0.f, 0.f, 0.f, 0.f};
#pragma unroll
            for (int hh = 0; hh < 4; ++hh) { f32x4 a = (f32x4){0.f, 0.f, 0.f, 0.f}; a = mfma16(k0, qf[hh][0], a); a = mfma16(k1, qf[hh][1], a);
#pragma unroll
                for (int r = 0; r < 4; ++r) sc[r] = fmaf(fmaxf(a[r], 0.f), wq[hh], sc[r]); }
            unsigned gtb = 0u, eqb = 0u;
#pragma unroll
            for (int r = 0; r < 4; ++r) { const int s = kt * 16 + 4 * g + r; const bool valid = s <= tq; const unsigned key = sortable(sc[r]);
                if (pass == 0) { if (valid) { const unsigned bin = key >> 21; __hip_atomic_fetch_add(HIST + fr * 1024 + (bin >> 1), 1u << ((bin & 1u) * 16u), __ATOMIC_RELAXED, __HIP_MEMORY_SCOPE_WORKGROUP); } }
                else if (pass == 1) { if (valid && (key >> 21) == pfx) { const unsigned bin = (key >> 10) & 2047u; __hip_atomic_fetch_add(HIST + fr * 1024 + (bin >> 1), 1u << ((bin & 1u) * 16u), __ATOMIC_RELAXED, __HIP_MEMORY_SCOPE_WORKGROUP); } }
                else if (pass == 2) { if (valid && (key >> 10) == pfx) { const unsigned bin = key & 1023u; __hip_atomic_fetch_add(HIST + fr * 1024 + (bin >> 1), 1u << ((bin & 1u) * 16u), __ATOMIC_RELAXED, __HIP_MEMORY_SCOPE_WORKGROUP); } }
                else { if (valid && key > tau) gtb |= 1u << r; if (valid && key == tau) eqb |= 1u << r; } }
            if (pass == 3) { const int word = kt >> 1, sh = (kt & 1) * 16 + 4 * g;
                if (gtb) __hip_atomic_fetch_or(GTM + fr * 128 + word, gtb << sh, __ATOMIC_RELAXED, __HIP_MEMORY_SCOPE_WORKGROUP);
                if (eqb) __hip_atomic_fetch_or(EQM + fr * 128 + word, eqb << sh, __ATOMIC_RELAXED, __HIP_MEMORY_SCOPE_WORKGROUP); }
        }
        __syncthreads();
        if (pass < 3) {
#pragma unroll 1
            for (int qq = 0; qq < 2; ++qq) { const int q = wave * 2 + qq; const int nq = t0 + q + 1;
                if (nq > 256) {
                    const int R = MISC[16 + q]; const int lo = 2016 - 32 * lane;
                    u32x4 w[4];
#pragma unroll
                    for (int i = 0; i < 4; ++i) w[i] = *(const LAS u32x4*)(HIST + q * 1024 + (lo >> 1) + 4 * i);
                    int sl = 0;
#pragma unroll
                    for (int i = 0; i < 4; ++i)
#pragma unroll
                        for (int c = 0; c < 4; ++c) sl += (int)(w[i][c] & 0xffffu) + (int)(w[i][c] >> 16);
                    const int cum = scan_add_i(sl, lane);
                    const unsigned long long mk = __ballot(cum >= R);
                    const int Ls = mk ? (int)__ffsll((long long)mk) - 1 : 63;
                    int c = cum - sl, fbin = lo, above = c; bool found = false;
#pragma unroll
                    for (int i = 3; i >= 0; --i)
#pragma unroll
                        for (int cc = 3; cc >= 0; --cc) {
                            const int hhi = (int)(w[i][cc] >> 16), hlo = (int)(w[i][cc] & 0xffffu); const int bhi = lo + (4 * i + cc) * 2 + 1;
                            if (!found && c + hhi >= R) { found = true; fbin = bhi; above = c; } c += hhi;
                            if (!found && c + hlo >= R) { found = true; fbin = bhi - 1; above = c; } c += hlo; }
                    const int fb = __shfl(fbin, Ls), ab = __shfl(above, Ls);
                    if (lane == 0) { const unsigned old = (unsigned)MISC[q];
                        if (pass == 0) MISC[q] = fb; else if (pass == 1) MISC[q] = (int)((old << 11) | (unsigned)fb); else MISC[48 + q] = (int)((old << 10) | (unsigned)fb);
                        MISC[16 + q] = R - ab; }
                } else if (lane == 0) { MISC[48 + q] = 0; MISC[16 + q] = 1 << 20; }
            }
            __syncthreads();
            if (pass < 2) { for (int i = tid; i < 4096; i += NTHR) ((LAS u32x4*)HIST)[i] = (u32x4){0u, 0u, 0u, 0u}; }
            else { for (int i = tid; i < 4096; i += NTHR) GTM[i] = 0u; }
            __syncthreads();
        }
    }
#pragma unroll 1
    for (int qq = 0; qq < 2; ++qq) { const int q = wave * 2 + qq; const int R = MISC[16 + q];
        const unsigned g0 = GTM[q * 128 + 2 * lane], g1 = GTM[q * 128 + 2 * lane + 1], e0 = EQM[q * 128 + 2 * lane], e1 = EQM[q * 128 + 2 * lane + 1];
        const int tc = (int)__popc(e0) + (int)__popc(e1); const int tpre = scan_add_i(tc, lane) - tc;
        const unsigned s0 = g0 | keep_lowest(e0, R - tpre), s1 = g1 | keep_lowest(e1, R - tpre - (int)__popc(e0));
        const int c = (int)__popc(s0) + (int)__popc(s1); const int incl = scan_add_i(c, lane); int pos = incl - c;
        unsigned m = s0; while (m) { const int bit = __ffs((int)m) - 1; m &= m - 1u; if (pos < 256) SEL[q * 256 + pos] = (unsigned short)(lane * 64 + bit); ++pos; }
        m = s1; while (m) { const int bit = __ffs((int)m) - 1; m &= m - 1u; if (pos < 256) SEL[q * 256 + pos] = (unsigned short)(lane * 64 + 32 + bit); ++pos; }
        const int total = __shfl(incl, 63);
        if (lane == 0) MISC[32 + q] = total < 256 ? total : 256;
    }
    __syncthreads();
    LAS unsigned char* gb = GBUF + wave * 8704;
    const unsigned gba = (unsigned)(unsigned long long)gb;
#pragma unroll 1
    for (int qq = 0; qq < 2; ++qq) { const int q = wave * 2 + qq; const int count = MISC[32 + q]; const int tpos = t0 + q; const int nch = (count + 31) >> 5;
        bf16x8 qh[4];
#pragma unroll
        for (int kk = 0; kk < 4; ++kk) { const bf16x8 v = *(const LAS bf16x8*)(QAB + ((q * 8 + (fr & 7)) * 128 + kk * 32 + g * 8) * 2); qh[kk] = (fr < 8) ? v : (bf16x8){0, 0, 0, 0, 0, 0, 0, 0}; }
        float m_run = -1e30f, l_part = 0.f; f32x4 ao[8];
#pragma unroll
        for (int rt = 0; rt < 8; ++rt) ao[rt] = (f32x4){0.f, 0.f, 0.f, 0.f};
#pragma unroll 1
        for (int c = 0; c < nch; ++c) {
            u32x4 gv[8];
#pragma unroll
            for (int it = 0; it < 8; ++it) { const int slot = c * 32 + g + 4 * it; const int idx = SEL[q * 256 + (slot < count ? slot : 0)];
                gv[it] = *(const u32x4*)(P + (rowb + idx) * NP_AB + AB_CKV + fr * 8); }
#pragma unroll
            for (int it = 0; it < 8; ++it) *(LAS u32x4*)(gb + (g + 4 * it) * 272 + fr * 16) = gv[it];
            asm volatile("s_waitcnt lgkmcnt(0)" ::: "memory");
            float lg[2][4];
#pragma unroll
            for (int k2 = 0; k2 < 2; ++k2) { f32x4 a = (f32x4){0.f, 0.f, 0.f, 0.f};
#pragma unroll
                for (int kk = 0; kk < 4; ++kk) a = mfma16(*(const LAS bf16x8*)(gb + (k2 * 16 + fr) * 272 + (kk * 32 + g * 8) * 2), qh[kk], a);
#pragma unroll
                for (int r = 0; r < 4; ++r) { const int slot = c * 32 + k2 * 16 + 4 * g + r; const bool valid = slot < count; const int sidx = SEL[q * 256 + (valid ? slot : 0)];
                    const int dist = tpos - sidx; const float bias = RELB[(int)BKT8[dist < 0 ? 0 : dist] * 8 + (fr & 7)];
                    lg[k2][r] = (valid && dist >= 0) ? a[r] + bias : -1e30f; } }
            float ml = fmaxf(fmaxf(fmaxf(lg[0][0], lg[0][1]), fmaxf(lg[0][2], lg[0][3])), fmaxf(fmaxf(lg[1][0], lg[1][1]), fmaxf(lg[1][2], lg[1][3])));
            ml = fmaxf(ml, __shfl_xor(ml, 16)); ml = fmaxf(ml, __shfl_xor(ml, 32));
            const float m_new = fmaxf(m_run, ml); const float alpha = __expf(m_run - m_new);
            float pr[2][4]; float ps = 0.f;
#pragma unroll
            for (int k2 = 0; k2 < 2; ++k2)
#pragma unroll
                for (int r = 0; r < 4; ++r) { pr[k2][r] = __expf(lg[k2][r] - m_new); ps += pr[k2][r]; }
            l_part = l_part * alpha + ps; m_run = m_new;
            bf16x8 pf;
#pragma unroll
            for (int r = 0; r < 4; ++r) { pf[r] = (short)f2bf(pr[0][r]); pf[4 + r] = (short)f2bf(pr[1][r]); }
#pragma unroll
            for (int rt = 0; rt < 8; ++rt) { ao[rt] = ao[rt] * alpha;
                const bf16x4 lo = tr_read(gba + (unsigned)((4 * g + (fr >> 2)) * 272 + (rt * 16 + 4 * (fr & 3)) * 2));
                const bf16x4 hi = tr_read(gba + (unsigned)((16 + 4 * g + (fr >> 2)) * 272 + (rt * 16 + 4 * (fr & 3)) * 2));
                bf16x8 af; af[0] = lo[0]; af[1] = lo[1]; af[2] = lo[2]; af[3] = lo[3]; af[4] = hi[0]; af[5] = hi[1]; af[6] = hi[2]; af[7] = hi[3];
                ao[rt] = mfma16(af, pf, ao[rt]); }
        }
        float l = l_part; l += __shfl_xor(l, 16); l += __shfl_xor(l, 32);
        const float inv = 1.0f / l;
        if (fr < 8) {
#pragma unroll
            for (int rt = 0; rt < 8; ++rt) { u32x2 w; w.x = pk2(ao[rt][0] * inv, ao[rt][1] * inv); w.y = pk2(ao[rt][2] * inv, ao[rt][3] * inv);
                *(LAS u32x2*)(QAB + ((q * 8 + fr) * 128 + rt * 16 + 4 * g) * 2) = w; } }
    }
    __syncthreads();
    { const int h = wave; f32x4 acc[4];
#pragma unroll
      for (int nt = 0; nt < 4; ++nt) acc[nt] = (f32x4){0.f, 0.f, 0.f, 0.f};
#pragma unroll
      for (int kk = 0; kk < 4; ++kk) { const bf16x8 a = *(const LAS bf16x8*)(QAB + ((fr * 8 + h) * 128 + kk * 32 + g * 8) * 2);
#pragma unroll
        for (int nt = 0; nt < 4; ++nt) { const bf16x8 bw = *(const bf16x8*)(WUV + ((size_t)(h * 64 + nt * 16 + fr)) * 128 + kk * 32 + g * 8); acc[nt] = mfma16(a, bw, acc[nt]); } }
#pragma unroll
      for (int nt = 0; nt < 4; ++nt)
#pragma unroll
        for (int r = 0; r < 4; ++r) YMIX[(rowb + t0 + 4 * g + r) * D + 512 + h * 64 + nt * 16 + fr] = f2bf(acc[nt][r]); }
    __syncthreads();
}

__device__ __forceinline__ void unit_dil(const Params& p, LAS unsigned char* lds, int b, int h, int pat, int res, int n) {
    const int tid = ltid(), lane = tid & 63, wave = __builtin_amdgcn_readfirstlane(tid >> 6), fr = lane & 15, g = lane >> 4;
    LAS unsigned char* KS2 = lds; LAS unsigned char* VT2 = lds + 36864;
    const LAS unsigned char* BKT8 = lds + L_BKT8; const LAS float* RELB = (const LAS float*)(lds + L_RELB);
    const bf16_t* P = (const bf16_t*)(p.ws + WS_P);
    const int d = (pat == 0) ? 1 : (pat == 1 ? 4 : 16);
    const size_t rowb = (size_t)b * SEQ;
    bf16_t* OP = (bf16_t*)(p.ws + (pat == 0 ? WS_HBF : (pat == 1 ? WS_HBF + 32 * MiB : WS_H1)));
    float* LSE = (float*)(p.ws + WS_H1 + 32 * MiB) + (size_t)pat * NTOK * 8;
    { const int row = tid >> 1, half = tid & 1; const int jsub = 128 * (n - 1) + row; const bool ok = jsub >= 0;
      const size_t tok = rowb + (size_t)(ok ? jsub : 0) * d + res;
      u32x4 kv[4], vv[4];
#pragma unroll
      for (int q = 0; q < 4; ++q) { kv[q] = *(const u32x4*)(P + tok * NP_CD + CD_KD + h * 64 + half * 32 + q * 8); vv[q] = *(const u32x4*)(P + tok * NP_CD + CD_VD + h * 64 + half * 32 + q * 8); }
#pragma unroll
      for (int q = 0; q < 4; ++q) { if (!ok) { kv[q] = (u32x4){0u, 0u, 0u, 0u}; vv[q] = (u32x4){0u, 0u, 0u, 0u}; }
          *(LAS u32x4*)(KS2 + row * 144 + (half * 32 + q * 8) * 2) = kv[q];
#pragma unroll
          for (int e = 0; e < 4; ++e) { const unsigned w = vv[q][e]; const int dv = half * 32 + q * 8 + 2 * e;
              ((LAS bf16_t*)VT2)[dv * 264 + row] = (bf16_t)(w & 0xffffu); ((LAS bf16_t*)VT2)[(dv + 1) * 264 + row] = (bf16_t)(w >> 16); } } }
    __syncthreads();
    const int qi = 128 * n + 16 * wave + fr; const size_t qtok = rowb + (size_t)qi * d + res;
    bf16x8 qf[2];
#pragma unroll
    for (int kk = 0; kk < 2; ++kk) qf[kk] = *(const bf16x8*)(P + qtok * NP_CD + CD_QD + h * 64 + kk * 32 + g * 8);
    const int ql = 128 + 16 * wave + fr;
    float m_run = -1e30f, l_part = 0.f; f32x4 ao[4];
#pragma unroll
    for (int vt = 0; vt < 4; ++vt) ao[vt] = (f32x4){0.f, 0.f, 0.f, 0.f};
#pragma unroll 1
    for (int c = 0; c < 5; ++c) { const int kl0 = 16 * wave + 32 * c;
        float lg[2][4];
#pragma unroll
        for (int k2 = 0; k2 < 2; ++k2) {
            if (c == 4 && k2 == 1) {
#pragma unroll
                for (int r = 0; r < 4; ++r) lg[k2][r] = -1e30f;
            } else { f32x4 a = (f32x4){0.f, 0.f, 0.f, 0.f};
#pragma unroll
                for (int kk = 0; kk < 2; ++kk) a = mfma16(ldfrag(KS2, kl0 + k2 * 16 + fr, 144, kk, g), qf[kk], a);
#pragma unroll
                for (int r = 0; r < 4; ++r) { const int kl = kl0 + k2 * 16 + 4 * g + r; const int tap = ql - kl; const bool ok = tap >= 0 && tap <= 128 && (n > 0 || kl >= 128);
                    const int tc = ok ? tap : 0; const float bias = RELB[(int)BKT8[tc * d] * 8 + h];
                    lg[k2][r] = ok ? a[r] * 0.125f + bias : -1e30f; } } }
        float ml = fmaxf(fmaxf(fmaxf(lg[0][0], lg[0][1]), fmaxf(lg[0][2], lg[0][3])), fmaxf(fmaxf(lg[1][0], lg[1][1]), fmaxf(lg[1][2], lg[1][3])));
        ml = fmaxf(ml, __shfl_xor(ml, 16)); ml = fmaxf(ml, __shfl_xor(ml, 32));
        const float m_new = fmaxf(m_run, ml); const float alpha = __expf(m_run - m_new);
        float pr[2][4]; float ps = 0.f;
#pragma unroll
        for (int k2 = 0; k2 < 2; ++k2)
#pragma unroll
            for (int r = 0; r < 4; ++r) { pr[k2][r] = (lg[k2][r] > -1e29f) ? __expf(lg[k2][r] - m_new) : 0.f; ps += pr[k2][r]; }
        l_part = l_part * alpha + ps; m_run = m_new;
        bf16x8 pf;
#pragma unroll
        for (int r = 0; r < 4; ++r) { pf[r] = (short)f2bf(pr[0][r]); pf[4 + r] = (short)f2bf(pr[1][r]); }
#pragma unroll
        for (int vt = 0; vt < 4; ++vt) { ao[vt] = ao[vt] * alpha;
            const bf16x4 lo = *(const LAS bf16x4*)(VT2 + (vt * 16 + fr) * 528 + (kl0 + 4 * g) * 2);
            bf16x4 hi = (bf16x4){0, 0, 0, 0};
            if (c < 4) hi = *(const LAS bf16x4*)(VT2 + (vt * 16 + fr) * 528 + (kl0 + 16 + 4 * g) * 2);
            bf16x8 af; af[0] = lo[0]; af[1] = lo[1]; af[2] = lo[2]; af[3] = lo[3]; af[4] = hi[0]; af[5] = hi[1]; af[6] = hi[2]; af[7] = hi[3];
            ao[vt] = mfma16(af, pf, ao[vt]); }
    }
    float l = l_part; l += __shfl_xor(l, 16); l += __shfl_xor(l, 32);
    const float inv = 1.0f / l;
#pragma unroll
    for (int vt = 0; vt < 4; ++vt) { u32x2 w; w.x = pk2(ao[vt][0] * inv, ao[vt][1] * inv); w.y = pk2(ao[vt][2] * inv, ao[vt][3] * inv);
        *(u32x2*)(OP + qtok * 512 + h * 64 + vt * 16 + 4 * g) = w; }
    if (g == 0) LSE[qtok * 8 + h] = m_run + __logf(l);
    __syncthreads();
}

__device__ __forceinline__ void phase_dil_combine(const Params& p) {
    const bf16_t* O0 = (const bf16_t*)(p.ws + WS_HBF); const bf16_t* O1 = (const bf16_t*)(p.ws + WS_HBF + 32 * MiB); const bf16_t* O2 = (const bf16_t*)(p.ws + WS_H1);
    const float* LSE = (const float*)(p.ws + WS_H1 + 32 * MiB); bf16_t* YMIX = (bf16_t*)(p.ws + WS_YMIX);
    for (int idx = blockIdx.x * NTHR + TID; idx < NTOK * 64; idx += gridDim.x * NTHR) {
        const int tok = idx >> 6, h = (idx >> 3) & 7, dg = idx & 7;
        const float l0 = LSE[(size_t)tok * 8 + h], l1 = LSE[(size_t)NTOK * 8 + (size_t)tok * 8 + h], l2 = LSE[(size_t)2 * NTOK * 8 + (size_t)tok * 8 + h];
        const float mx = fmaxf(l0, fmaxf(l1, l2)); const float w0 = __expf(l0 - mx), w1 = __expf(l1 - mx), w2 = __expf(l2 - mx); const float inv = 1.0f / (w0 + w1 + w2);
        const size_t off = (size_t)tok * 512 + h * 64 + dg * 8;
        const u32x4 a = *(const u32x4*)(O0 + off), bq = *(const u32x4*)(O1 + off), c = *(const u32x4*)(O2 + off);
        u32x4 o;
#pragma unroll
        for (int e = 0; e < 4; ++e) {
            const float v0 = (__uint_as_float(a[e] << 16) * w0 + __uint_as_float(bq[e] << 16) * w1 + __uint_as_float(c[e] << 16) * w2) * inv;
            const float v1 = (__uint_as_float(a[e] & 0xffff0000u) * w0 + __uint_as_float(bq[e] & 0xffff0000u) * w1 + __uint_as_float(c[e] & 0xffff0000u) * w2) * inv;
            o[e] = pk2(v0, v1); }
        *(u32x4*)(YMIX + (size_t)tok * D + 512 + h * 64 + dg * 8) = o;
    }
}

__device__ __forceinline__ int grab_unit(unsigned* ctr, LAS int* slot) {
    __syncthreads();
    if (TID == 0) *slot = (int)__hip_atomic_fetch_add(ctr, 1u, __ATOMIC_RELAXED, __HIP_MEMORY_SCOPE_AGENT);
    __syncthreads();
    return *slot;
}
__device__ __forceinline__ void phase_mixer_ab(const Params& p, LAS unsigned char* lds, int j, unsigned* ctr) {
    LAS int* slot = (LAS int*)(lds + LDS_PERS + LP_SLOT);
    load_attn_tables(p, lds);
    for (;;) { const int u = grab_unit(ctr, slot);
        if (u >= 32 + 2048) break;
        if (u < 32) unit_mlstm(p, lds, j, u >> 2, u & 3);
        else { const int k = u - 32; unit_dsa(p, lds, k & 7, 255 - (k >> 3)); } }
}
__device__ __forceinline__ void phase_mixer_cd(const Params& p, LAS unsigned char* lds, int j, unsigned* ctr) {
    LAS int* slot = (LAS int*)(lds + LDS_PERS + LP_SLOT);
    load_attn_tables(p, lds);
    for (;;) { const int u = grab_unit(ctr, slot);
        if (u >= 32 + 6144) break;
        if (u < 32) unit_gla(p, lds, j, u >> 2, u & 3);
        else { const int k = u - 32; const int n32 = k & 31, pat = (k >> 5) % 3, bh = k / 96;
            int res, n; if (pat == 0) { res = 0; n = n32; } else if (pat == 1) { res = n32 >> 3; n = n32 & 7; } else { res = n32 >> 1; n = n32 & 1; }
            unit_dil(p, lds, bh >> 3, bh & 7, pat, res, n); } }
}
__global__ void __launch_bounds__(NTHR, 2) hybrid_fwd(Params p) {
    extern __shared__ __attribute__((aligned(16))) unsigned char lds_raw[];
    LAS unsigned char* lds = (LAS unsigned char*)lds_raw;
    const int tid = TID, G = gridDim.x;
    for (int i = tid; i < (LDS_TOTAL - LDS_PERS) / 4; i += NTHR) ((LAS unsigned*)(lds + LDS_PERS))[i] = 0u;
    __syncthreads();
    unsigned* ctl = (unsigned*)(p.ws + WS_CTL);
    XcdBarrier bar = xcd_barrier_post(ctl + CW_BAR, (volatile LAS unsigned*)(lds + LDS_PERS));
    LAS int* tbase = (LAS int*)(lds + LDS_PERS + LP_TBASE);

    p0_prologue(p, lds);
    __syncthreads();
#pragma unroll 1
    for (int l = 0; l < DEPTH; ++l) {
        const bool is_ab = (l & 1) == 0; const int j = l >> 1;
        prep_layer(p, lds, l);
        if (l == 0) xcd_barrier(bar);
        __syncthreads();
        phase_norm1(p, lds, l);
        xcd_barrier(bar);
        {
            const int N = is_ab ? NP_AB : NP_CD;
            pg8::Gemm gm{(const bf16_t*)(p.ws + WS_HBF), (const bf16_t*)(p.ws + WS_WIN), NTOK, N, D};
            pg8::StaticOrder S; S.init(NTOK, N, G, (int)blockIdx.x);
            pg8::EpiBf16<false> E{(bf16_t*)(p.ws + WS_P), N};
            pg8::gemm_phase(lds, gm, S, E);
        }
        xcd_barrier(bar);
        if (is_ab) phase_mixer_ab(p, lds, j, ctl + CW_WQ + 64 * l);
        else { phase_mixer_cd(p, lds, j, ctl + CW_WQ + 64 * l); xcd_barrier(bar); phase_dil_combine(p); }
        xcd_barrier(bar);
        {
            pg8::Gemm gm{(const bf16_t*)(p.ws + WS_YMIX), (const bf16_t*)(p.ws + WS_WOUT), NTOK, D, D};
            pg8::StaticOrder S; S.init(NTOK, D, G, (int)blockIdx.x);
            pg8::EpiOutRes E{(float*)(p.ws + WS_X), (const float*)(p.ws + WS_MOD) + (size_t)l * 8 * 6 * D + 2 * D};
            pg8::gemm_phase(lds, gm, S, E);
        }
        xcd_barrier(bar);
        phase_norm2(p, lds, l);
        xcd_barrier(bar);
        phase_dispatch(p, lds, tbase);
        xcd_barrier(bar);
        {
            pg8::Gemm gm{(const bf16_t*)(p.ws + WS_P), (const bf16_t*)(p.ws + WS_WGU), MOE_ROWS, 16 * 1024, D};
            pg8::MoeOrder S{tbase, G, (int)blockIdx.x};
            pg8::EpiMoe1 E{(bf16_t*)(p.ws + WS_H1)};
            pg8::gemm_phase(lds, gm, S, E);
        }
        xcd_barrier(bar);
        {
            pg8::Gemm gm{(const bf16_t*)(p.ws + WS_H1), (const bf16_t*)(p.ws + WS_WDN), MOE_ROWS, 16 * 1024, 512};
            pg8::MoeOrder S{tbase, G, (int)blockIdx.x};
            pg8::EpiBf16<true> E{(bf16_t*)(p.ws + WS_P), D};
            pg8::gemm_phase(lds, gm, S, E);
        }
        xcd_barrier(bar);
    }
    phase_final(p);
}

extern "C" void kernel_launch(void* const* d_in, const int* in_sizes, int n_in, void* d_out, int out_size, void* d_ws, size_t ws_size, hipStream_t stream) {
    static int grid = 0;
    if (grid == 0) {
        if (n_in != 28 || ws_size < WS_END) { fprintf(stderr, "kernel_launch: unexpected n_in %d / ws_size %zu (need %zu)\n", n_in, ws_size, (size_t)WS_END); grid = -1; return; }
        int dev = 0, cus = 0, per_cu = 0;
        if (hipGetDevice(&dev) != hipSuccess || hipDeviceGetAttribute(&cus, hipDeviceAttributeMultiprocessorCount, dev) != hipSuccess) { grid = -1; return; }
        if (hipFuncSetAttribute((const void*)hybrid_fwd, hipFuncAttributeMaxDynamicSharedMemorySize, LDS_TOTAL) != hipSuccess) { fprintf(stderr, "kernel_launch: hipFuncSetAttribute failed\n"); grid = -1; return; }
        if (hipOccupancyMaxActiveBlocksPerMultiprocessor(&per_cu, (const void*)hybrid_fwd, NTHR, LDS_TOTAL) != hipSuccess || per_cu < 1) { fprintf(stderr, "kernel_launch: occupancy query says %d\n", per_cu); }
        (void)hipGetLastError();
        grid = cus;
    }
    if (grid < 0) return;
    if (hipMemsetAsync((char*)d_ws + WS_CTL, 0, CTL_BYTES, stream) != hipSuccess) return;
    Params p{};
    for (int i = 0; i < 28; ++i) p.in[i] = (const float*)d_in[i];
    p.out = (float*)d_out; p.ws = (unsigned char*)d_ws;
    hipLaunchKernelGGL(hybrid_fwd, dim3(grid), dim3(NTHR), LDS_TOTAL, stream, p);
}
```

```cpp
#define DBL 0
#include <hip/hip_runtime.h>
#include <cstdio>
#include <cstdint>

#define LAS __attribute__((address_space(3)))
typedef unsigned short bf16_t;
typedef short bf16x8 __attribute__((ext_vector_type(8)));
typedef short bf16x4 __attribute__((ext_vector_type(4)));
typedef float f32x4 __attribute__((ext_vector_type(4)));
typedef float f32x2 __attribute__((ext_vector_type(2)));
typedef unsigned u32x4 __attribute__((ext_vector_type(4)));
typedef unsigned u32x2 __attribute__((ext_vector_type(2)));

constexpr int D = 1024, NB = 8, SEQ = 4096, NTOK = NB * SEQ, DEPTH = 4;
constexpr int W_AB = 2508, W_CD = 3088;
constexpr int NP_AB = 2560, NP_CD = 3072;
constexpr int AB_QA = 0, AB_KA = 256, AB_VA = 512, AB_OA = 1024, AB_QB = 1536, AB_CKV = 2048, AB_QI = 2176, AB_KI = 2432;
constexpr int CD_QC = 0, CD_KC = 256, CD_VC = 512, CD_RC = 1024, CD_QD = 1536, CD_KD = 2048, CD_VD = 2560;
constexpr int MOE_ROWS = 2 * NTOK + 16 * 256;

__device__ __forceinline__ int ltid() { int t = (int)threadIdx.x; asm volatile("" : "+v"(t)); return t; }
__device__ __forceinline__ float bf2f(bf16_t b) { return __uint_as_float(((unsigned)b) << 16); }
__device__ __forceinline__ bf16_t f2bf(float f) { unsigned u = __float_as_uint(f); u += 0x7FFFu + ((u >> 16) & 1u); return (bf16_t)(u >> 16); }
__device__ __forceinline__ unsigned pk2(float lo, float hi) { return (unsigned)f2bf(lo) | ((unsigned)f2bf(hi) << 16); }
__device__ __forceinline__ float wave_sum(float v) {
#pragma unroll
    for (int o = 32; o > 0; o >>= 1) v += __shfl_xor(v, o);
    return v;
}
__device__ __forceinline__ float sigmoidf_(float x) { return 1.0f / (1.0f + __expf(-x)); }
__device__ __forceinline__ float siluf_(float x) { return x / (1.0f + __expf(-x)); }
__device__ __forceinline__ float logsigmoidf_(float x) { return fminf(x, 0.0f) - log1pf(__expf(-fabsf(x))); }

#define XB_TMO      128
#define XB_XCNT(j)  (256  + 64 * (j))
#define XB_XSUB(j)  (1280 + 64 * (j))
#define XB_XGEN(j)  (2304 + 64 * (j))
#define XB_TOP      3328
#define XB_TOPGEN   3392
#define XCD_BAR_WORDS 3456
#define XB_SPIN_CAP (1u << 18)

__device__ __forceinline__ unsigned xb_ld(unsigned* p)              { return __hip_atomic_load(p, __ATOMIC_RELAXED, __HIP_MEMORY_SCOPE_AGENT); }
__device__ __forceinline__ unsigned xb_add(unsigned* p, unsigned v) { return __hip_atomic_fetch_add(p, v, __ATOMIC_RELAXED, __HIP_MEMORY_SCOPE_AGENT); }
__device__ __forceinline__ unsigned xb_xcc_id() { return (unsigned)__builtin_amdgcn_s_getreg((3 << 11) | 20) & 0xFu; }
#define XB_SPIN(cond, bar) do { unsigned _sp = 0; while (cond) { __builtin_amdgcn_s_sleep(1); \
    if ((++_sp & 255u) == 0u) { if (xb_ld(&(bar)[XB_TMO])) break; if (_sp > XB_SPIN_CAP) { atomicAdd(&(bar)[XB_TMO], 1u); break; } } } } while (0)

struct XcdBarrier { unsigned* bar; unsigned x; volatile LAS unsigned* st; };

__device__ __forceinline__ XcdBarrier xcd_barrier_post(unsigned* bar, volatile LAS unsigned* st) {
    XcdBarrier b; b.bar = bar; b.x = xb_xcc_id(); b.st = st;
    if (ltid() == 0) (void)xb_add(&bar[XB_XCNT(b.x)], 1u);
    return b;
}
__device__ __forceinline__ void xcd_barrier_complete(unsigned* bar, unsigned x, unsigned& nloc, unsigned& nx) {
    const unsigned G = gridDim.x * gridDim.y * gridDim.z;
    unsigned sum, cnt, mine, sp = 0u;
    for (;;) {
        sum = 0u; cnt = 0u; mine = 0u;
#pragma unroll
        for (unsigned j = 0; j < 16; ++j) { const unsigned c = xb_ld(&bar[XB_XCNT(j)]); sum += c; cnt += (c > 0u) ? 1u : 0u; mine = (j == x) ? c : mine; }
        if (sum == G) break;
        __builtin_amdgcn_s_sleep(1);
        if ((++sp & 255u) == 0u) { if (xb_ld(&bar[XB_TMO])) break; if (sp > XB_SPIN_CAP) { atomicAdd(&bar[XB_TMO], 1u); break; } }
    }
    nloc = mine > 0u ? mine : 1u; nx = cnt > 0u ? cnt : 1u;
}
__device__ __forceinline__ void xcd_barrier(const XcdBarrier& b) {
    asm volatile("s_waitcnt vmcnt(0)" ::: "memory");
    __syncthreads();
    if (ltid() == 0) {
        unsigned* bar = b.bar;
        __builtin_amdgcn_s_waitcnt(0);
        unsigned nloc = b.st[0], nx = b.st[1];
        if (nloc == 0u) { xcd_barrier_complete(bar, b.x, nloc, nx); b.st[0] = nloc; b.st[1] = nx; }
        const unsigned old = xb_add(&bar[XB_XSUB(b.x)], 1u);
        const unsigned gen = old / nloc;
        if (old + 1u == (gen + 1u) * nloc) {
            __builtin_amdgcn_fence(__ATOMIC_RELEASE, "agent");
            asm volatile("s_waitcnt vmcnt(0)" ::: "memory");
            const unsigned og = xb_add(&bar[XB_TOP], 1u);
            const unsigned tg = og / nx;
            if (og + 1u == (tg + 1u) * nx) xb_add(&bar[XB_TOPGEN], 1u);
            else XB_SPIN(xb_ld(&bar[XB_TOPGEN]) == tg, bar);
            __builtin_amdgcn_fence(__ATOMIC_ACQUIRE, "agent");
            xb_add(&bar[XB_XGEN(b.x)], 1u);
            asm volatile("s_waitcnt vmcnt(0)" ::: "memory");
        } else {
            XB_SPIN(xb_ld(&bar[XB_XGEN(b.x)]) == gen, bar);
            __builtin_amdgcn_fence(__ATOMIC_ACQUIRE, "agent");
            asm volatile("s_waitcnt vmcnt(0)" ::: "memory");
        }
    }
    __syncthreads();
}

namespace pg8 {
constexpr int BM = 256, BK = 64, HALF = 128, HTB = HALF * BK * 2, STAGE_BYTES = 8 * HTB, NXCD = 8, WGM = 8;
__host__ __device__ __forceinline__ int lds_byte(int r, int c) { const int st = (r >> 4) * 2 + (c >> 5), rr = r & 15, cc = c & 31, ob = rr * 64 + cc * 2; return st * 1024 + (ob ^ (((ob >> 9) & 1) << 5)); }
__host__ __device__ __forceinline__ void stage_rc(int b, int& R, int& C) { const int st = b / 1024, sb = b % 1024, swz = sb ^ (((sb >> 9) & 1) << 5); R = (st >> 1) * 16 + swz / 64; C = (st & 1) * 32 + (swz % 64) / 2; }
__host__ __device__ __forceinline__ int perm32(int rho) { const int n = rho >> 4, i = rho & 15; return 8 * (i >> 2) + 4 * n + (i & 3); }

struct Unit { int pm, pn; };
struct Gemm { const bf16_t* A; const bf16_t* Bt; int M, N, K; };

struct StaticOrder {
    int nM, nN, nwg, G, c;
    __host__ __device__ void init(int M, int N, int G_, int c_) { nM = M / BM; nN = N / BM; nwg = nM * nN; G = G_; c = c_; }
    __host__ __device__ bool next(int i, Unit& u) const {
        const long L = (long)i * G + c; if (L >= nwg) return false;
        int wgid = (int)L; { const int q = nwg / NXCD, r = nwg % NXCD, xcd = wgid % NXCD, off = wgid / NXCD; wgid = (xcd < r ? xcd * (q + 1) : r * (q + 1) + (xcd - r) * q) + off; }
        const int nig = WGM * nN, gid = wgid / nig, fm = gid * WGM, gsz = (nM - fm) < WGM ? (nM - fm) : WGM;
        u.pm = fm + ((wgid % nig) % gsz); u.pn = (wgid % nig) / gsz; return true;
    }
    __device__ __forceinline__ void a_ready(const Unit&) const {}
    __device__ __forceinline__ void done(const Unit&) const {}
};
struct MoeOrder {
    const LAS int* tbase;
    int G, c;
    __device__ bool next(int i, Unit& u) const {
        const int L = i * G + c; const int total = tbase[16] * 4; if (L >= total) return false;
        const int pm = L >> 2; int e = 0;
#pragma unroll
        for (int k = 1; k < 16; ++k) e += (pm >= tbase[k]) ? 1 : 0;
        u.pm = pm; u.pn = e * 4 + (L & 3); return true;
    }
    __device__ __forceinline__ void a_ready(const Unit&) const {}
    __device__ __forceinline__ void done(const Unit&) const {}
};

__device__ __forceinline__ unsigned cvt_pk_bf16(float lo, float hi) { unsigned r; asm volatile("v_cvt_pk_bf16_f32 %0, %1, %2" : "=v"(r) : "v"(lo), "v"(hi)); return r; }

template <bool MOE> struct EpiBf16 {
    static constexpr bool PERM = true, AFTER_DRAIN = false;
    bf16_t* O; int ldc;
    __device__ __forceinline__ void operator()(const f32x4 (&acc)[2][2][4][2], const Unit& u, int wr, int wc, int fr, int fq) const {
        const int row0 = u.pm * BM + wr * 64 + fr; const int colt = (MOE ? (u.pn & 3) : u.pn) * BM; const int col0 = colt + wc * 32 + 8 * fq;
#pragma unroll
        for (int ai = 0; ai < 2; ++ai)
#pragma unroll
            for (int m = 0; m < 4; ++m) { bf16_t* rowp = O + (size_t)(row0 + ai * HALF + m * 16) * ldc + col0;
#pragma unroll
                for (int bj = 0; bj < 2; ++bj) { const f32x4 v0 = acc[ai][bj][m][0], v1 = acc[ai][bj][m][1];
                    u32x4 w; w.x = cvt_pk_bf16(v0[0], v0[1]); w.y = cvt_pk_bf16(v0[2], v0[3]); w.z = cvt_pk_bf16(v1[0], v1[1]); w.w = cvt_pk_bf16(v1[2], v1[3]);
                    *(u32x4*)(rowp + bj * HALF) = w; } }
    }
};
struct EpiOutRes {
    static constexpr bool PERM = false, AFTER_DRAIN = false;
    float* X; const float* gate;
    __device__ __forceinline__ void operator()(const f32x4 (&acc)[2][2][4][2], const Unit& u, int wr, int wc, int fr, int fq) const {
        const int row0 = u.pm * BM + wr * 64 + fr, col0 = u.pn * BM + wc * 32 + 4 * fq;
        const float* gp = gate + (size_t)((u.pm * BM) >> 12) * (6 * D) + col0;
        f32x4 gv[2][2];
#pragma unroll
        for (int bj = 0; bj < 2; ++bj)
#pragma unroll
            for (int n = 0; n < 2; ++n) gv[bj][n] = *(const f32x4*)(gp + bj * HALF + n * 16);
#pragma unroll
        for (int ai = 0; ai < 2; ++ai)
#pragma unroll
            for (int m = 0; m < 4; ++m) { float* rowp = X + (size_t)(row0 + ai * HALF + m * 16) * D + col0;
#pragma unroll
                for (int bj = 0; bj < 2; ++bj)
#pragma unroll
                    for (int n = 0; n < 2; ++n) { f32x4* p = (f32x4*)(rowp + bj * HALF + n * 16); *p = *p + gv[bj][n] * acc[ai][bj][m][n]; } }
    }
};
struct EpiMoe1 {
    static constexpr bool PERM = false, AFTER_DRAIN = false;
    bf16_t* H1;
    __device__ __forceinline__ void operator()(const f32x4 (&acc)[2][2][4][2], const Unit& u, int wr, int wc, int fr, int fq) const {
        const int row0 = u.pm * BM + wr * 64 + fr, col0 = (u.pn & 3) * 128 + wc * 16 + 4 * fq;
#pragma unroll
        for (int ai = 0; ai < 2; ++ai)
#pragma unroll
            for (int m = 0; m < 4; ++m) { bf16_t* rowp = H1 + (size_t)(row0 + ai * HALF + m * 16) * 512 + col0;
#pragma unroll
                for (int bj = 0; bj < 2; ++bj) { const f32x4 g = acc[ai][bj][m][0], up = acc[ai][bj][m][1]; float h[4];
#pragma unroll
                    for (int j = 0; j < 4; ++j) h[j] = g[j] / (1.0f + __expf(-g[j])) * up[j];
                    u32x2 w; w.x = cvt_pk_bf16(h[0], h[1]); w.y = cvt_pk_bf16(h[2], h[3]);
                    *(u32x2*)(rowp + bj * 64) = w; } }
    }
};

template <class Epi, class Sched>
__device__ __forceinline__ void gemm_phase(LAS unsigned char* lds, const Gemm g, const Sched& S, const Epi& E) {
    const int tid = ltid(), wid = __builtin_amdgcn_readfirstlane(tid >> 6), lane = tid & 63, wr = wid >> 2, wc = wid & 3, fr = lane & 15, fq = lane >> 4;
    const int K = g.K, nt = K / BK;
    unsigned voffA[2], voffB[2];
#pragma unroll
    for (int i = 0; i < 2; ++i) { int R, C; stage_rc(tid * 16 + i * 8192, R, C); const int Rb = Epi::PERM ? ((R & ~31) + perm32(R & 31)) : R;
        voffA[i] = (unsigned)(R * K + C) * 2u; voffB[i] = (unsigned)(Rb * K + C) * 2u; }
    const size_t kstep = (size_t)(BK * 2);
    const size_t hstep = (size_t)HALF * K * 2;
    const size_t tstep = 2 * hstep;
    const unsigned ldsw = (unsigned)wid * 1024u;
    const int aoff = lds_byte(wr * 64 + fr, fq * 8), boff = lds_byte(wc * 32 + fr, fq * 8);
#define PG8_SA(b, h) (((b) * 2 + (h)) * HTB)
#define PG8_SB(b, h) ((4 + (b) * 2 + (h)) * HTB)
#define PG8_STAGE(bufoff, gbase, voff) do { _Pragma("unroll") for (int _i = 0; _i < 2; ++_i) \
        __builtin_amdgcn_global_load_lds((const unsigned*)((const char*)(gbase) + (voff)[_i]), (LAS unsigned*)(lds + (bufoff) + ldsw + _i * 8192), 16, 0, 0); } while (0)
#define PG8_LDA(dst, b, h) do { _Pragma("unroll") for (int m = 0; m < 4; ++m) _Pragma("unroll") for (int k = 0; k < 2; ++k) dst[m][k] = *(const LAS bf16x8*)(lds + PG8_SA(b, h) + aoff + m * 2048 + k * 1024); } while (0)
#define PG8_LDB(dst, b, h) do { _Pragma("unroll") for (int n = 0; n < 2; ++n) _Pragma("unroll") for (int k = 0; k < 2; ++k) dst[n][k] = *(const LAS bf16x8*)(lds + PG8_SB(b, h) + boff + n * 2048 + k * 1024); } while (0)
#define PG8_MMA(ai, bj, At, Bt) do { __builtin_amdgcn_s_setprio(1); _Pragma("unroll") for (int m = 0; m < 4; ++m) _Pragma("unroll") for (int n = 0; n < 2; ++n) _Pragma("unroll") for (int k = 0; k < 2; ++k) \
        acc[ai][bj][m][n] = __builtin_amdgcn_mfma_f32_16x16x32_bf16(Bt[n][k], At[m][k], acc[ai][bj][m][n], 0, 0, 0); __builtin_amdgcn_s_setprio(0); } while (0)
#define PG8_WAIT_V(n) asm volatile("s_waitcnt vmcnt(" #n ")" ::: "memory")
#define PG8_WAIT_L(n) asm volatile("s_waitcnt lgkmcnt(" #n ")" ::: "memory")
#define PG8_BAR __builtin_amdgcn_s_barrier()
#define PG8_SCHED __builtin_amdgcn_sched_barrier(0)
    Unit cur, nxt; int ui = 0;
    if (!S.next(0, cur)) return;
    f32x4 acc[2][2][4][2];
#pragma unroll
    for (int a = 0; a < 2; ++a)
#pragma unroll
        for (int b = 0; b < 2; ++b)
#pragma unroll
            for (int m = 0; m < 4; ++m)
#pragma unroll
                for (int n = 0; n < 2; ++n) acc[a][b][m][n] = (f32x4){0.f, 0.f, 0.f, 0.f};
    bf16x8 At[4][2], B0[2][2], B1[2][2];
    const char* cA = (const char*)g.A + (size_t)cur.pm * tstep; const char* cB = (const char*)g.Bt + (size_t)cur.pn * tstep;
    S.a_ready(cur);
    PG8_STAGE(PG8_SB(0, 0), cB, voffB); PG8_STAGE(PG8_SA(0, 0), cA, voffA); PG8_STAGE(PG8_SB(0, 1), cB + hstep, voffB); PG8_STAGE(PG8_SA(0, 1), cA + hstep, voffA);
    if (wr == 1) PG8_BAR;
    PG8_WAIT_V(4); PG8_BAR;
    PG8_STAGE(PG8_SB(1, 0), cB + kstep, voffB); PG8_STAGE(PG8_SA(1, 0), cA + kstep, voffA); PG8_STAGE(PG8_SB(1, 1), cB + hstep + kstep, voffB);
    PG8_WAIT_V(6); PG8_BAR;
    for (;;) {
        const bool has_next = S.next(ui + 1, nxt);
        const char* nA = has_next ? (const char*)g.A + (size_t)nxt.pm * tstep : cA; const char* nB = has_next ? (const char*)g.Bt + (size_t)nxt.pn * tstep : cB;
        for (int t = 0; t < nt; t += 2) {
            const bool last = (t == nt - 2);
            const char* a1 = cA + (size_t)(t + 1) * kstep;
            const char* a2 = last ? nA : cA + (size_t)(t + 2) * kstep; const char* b2 = last ? nB : cB + (size_t)(t + 2) * kstep;
            const char* a3 = a2 + kstep; const char* b3 = b2 + kstep;
            if (last && has_next) S.a_ready(nxt);
            PG8_LDB(B0, 0, 0); PG8_SCHED; PG8_LDA(At, 0, 0); PG8_STAGE(PG8_SA(1, 1), a1 + hstep, voffA);
            PG8_WAIT_L(8); PG8_BAR; PG8_WAIT_L(0); PG8_MMA(0, 0, At, B0); PG8_BAR; PG8_SCHED;
            PG8_LDB(B1, 0, 1); PG8_STAGE(PG8_SB(0, 0), b2, voffB);
            PG8_BAR; PG8_WAIT_L(0); PG8_MMA(0, 1, At, B1); PG8_BAR;
            PG8_LDA(At, 0, 1); PG8_STAGE(PG8_SA(0, 0), a2, voffA);
            PG8_BAR; PG8_WAIT_L(0); PG8_MMA(1, 0, At, B0); PG8_BAR; PG8_SCHED;
            PG8_STAGE(PG8_SB(0, 1), b2 + hstep, voffB);
            PG8_WAIT_V(6); PG8_BAR; PG8_MMA(1, 1, At, B1); PG8_BAR;
            PG8_LDB(B0, 1, 0); PG8_SCHED; PG8_LDA(At, 1, 0); PG8_STAGE(PG8_SA(0, 1), a2 + hstep, voffA);
            PG8_WAIT_L(8); PG8_BAR; PG8_WAIT_L(0); PG8_MMA(0, 0, At, B0); PG8_BAR; PG8_SCHED;
            PG8_LDB(B1, 1, 1); PG8_STAGE(PG8_SB(1, 0), b3, voffB);
            PG8_BAR; PG8_WAIT_L(0); PG8_MMA(0, 1, At, B1); PG8_BAR;
            PG8_LDA(At, 1, 1); PG8_STAGE(PG8_SA(1, 0), a3, voffA);
            PG8_BAR; PG8_WAIT_L(0); PG8_MMA(1, 0, At, B0); PG8_BAR; PG8_SCHED;
            PG8_STAGE(PG8_SB(1, 1), b3 + hstep, voffB);
            PG8_WAIT_V(6); PG8_BAR; PG8_MMA(1, 1, At, B1); PG8_BAR;
        }
        E(acc, cur, wr, wc, fr, fq); S.done(cur);
        if (!has_next) break;
#pragma unroll
        for (int a = 0; a < 2; ++a)
#pragma unroll
            for (int b = 0; b < 2; ++b)
#pragma unroll
                for (int m = 0; m < 4; ++m)
#pragma unroll
                    for (int n = 0; n < 2; ++n) acc[a][b][m][n] = (f32x4){0.f, 0.f, 0.f, 0.f};
        cur = nxt; cA = nA; cB = nB; ++ui;
    }
    PG8_WAIT_V(0);
    if (wr == 0) PG8_BAR;
    PG8_BAR;
#undef PG8_SA
#undef PG8_SB
#undef PG8_STAGE
#undef PG8_LDA
#undef PG8_LDB
#undef PG8_MMA
#undef PG8_WAIT_V
#undef PG8_WAIT_L
#undef PG8_BAR
#undef PG8_SCHED
}
}
constexpr size_t MiB = 1024 * 1024;
constexpr size_t WS_CTL  = 0;
constexpr size_t CTL_BYTES = 65536;
constexpr size_t WS_MOD  = WS_CTL + CTL_BYTES;
constexpr size_t WS_BKT  = WS_MOD + 4 * 8 * 6144 * 4;
constexpr size_t WS_SP   = WS_BKT + 4096 * 4;
constexpr size_t WS_RTE  = WS_SP + (size_t)NTOK * 16 * 4;
constexpr size_t WS_RTW  = WS_RTE + (size_t)NTOK * 4;
constexpr size_t WS_POS  = WS_RTW + (size_t)NTOK * 8;
constexpr size_t WS_TC   = WS_POS + (size_t)NTOK * 8;
constexpr size_t WS_WUK  = WS_TC + 256 * 16 * 4;
constexpr size_t WS_WUV  = WS_WUK + 65536 * 2;
constexpr size_t WS_X    = 4 * MiB;
constexpr size_t WS_HBF  = WS_X + 128 * MiB;
constexpr size_t WS_P    = WS_HBF + 64 * MiB;
constexpr size_t WS_YMIX = WS_P + 192 * MiB;
constexpr size_t WS_H1   = WS_YMIX + 64 * MiB;
constexpr size_t WS_WIN  = WS_H1 + 68 * MiB;
constexpr size_t WS_WOUT = WS_WIN + 6 * MiB;
constexpr size_t WS_WGU  = WS_WOUT + 2 * MiB;
constexpr size_t WS_WDN  = WS_WGU + 32 * MiB;
constexpr size_t WS_END  = WS_WDN + 16 * MiB;
static_assert(WS_WUV + 65536 * 2 <= WS_X, "small region overflow");
static_assert((size_t)MOE_ROWS * 512 * 2 <= 68 * MiB, "H1");
static_assert((size_t)MOE_ROWS * 1024 * 2 <= 192 * MiB, "AS");

constexpr int CW_BAR = 0;
constexpr int CW_WQ  = 4096;

constexpr int LDS_TOTAL = 147456;
constexpr int LDS_PERS  = 143360;
constexpr int LP_SLOT = 16, LP_TBASE = 64;

struct Params { const float* in[28]; float* out; unsigned char* ws; };
enum { I_X = 0, I_C, I_WADA, I_BADA, I_GMIX, I_GFFN, I_GFINAL, I_RELB, I_ABWIN, I_ABCONVW, I_ABCONVB, I_ABGATEB, I_ABHNORM, I_ABWUK, I_ABWUV, I_ABWOUT,
       I_CDWIN, I_CDWALPHA, I_CDBALPHA, I_CDHNORM, I_CDWOUT, I_MWC, I_MBC, I_MWF, I_MBF, I_MWG, I_MWU, I_MWD };

#define TID (ltid())
#define NTHR 512

__device__ __forceinline__ void p0_prologue(const Params& p, LAS unsigned char* lds) {
    const int tid = ltid(), G = gridDim.x;
    LAS float* sc = (LAS float*)lds;
    LAS float* red = (LAS float*)(lds + 32768);
    const float* c = p.in[I_C];
    for (int i = tid; i < 8 * 1024; i += NTHR) { const float v = c[i]; sc[i] = v / (1.0f + __expf(-v)); }
    __syncthreads();
    float* mod = (float*)(p.ws + WS_MOD);
    for (int u = blockIdx.x; u < 4 * 48; u += G) {
        const int l = u / 48, e0 = (u % 48) * 128, col = tid & 127, ds = tid >> 7;
        const float* w = p.in[I_WADA] + (size_t)l * D * 6 * D + e0 + col;
        float a[8];
#pragma unroll
        for (int b = 0; b < 8; ++b) a[b] = 0.f;
        for (int d = ds * 256; d < ds * 256 + 256; ++d) { const float wv = w[(size_t)d * 6 * D];
#pragma unroll
            for (int b = 0; b < 8; ++b) a[b] += sc[b * 1024 + d] * wv; }
#pragma unroll
        for (int b = 0; b < 8; ++b) red[(ds * 8 + b) * 128 + col] = a[b];
        __syncthreads();
        for (int i = tid; i < 8 * 128; i += NTHR) { const int b = i >> 7, cc = i & 127;
            const float s = ((red[(0 * 8 + b) * 128 + cc] + red[(1 * 8 + b) * 128 + cc]) + red[(2 * 8 + b) * 128 + cc]) + red[(3 * 8 + b) * 128 + cc];
            mod[((size_t)l * 8 + b) * 6 * D + e0 + cc] = s + p.in[I_BADA][(size_t)l * 6 * D + e0 + cc]; }
        __syncthreads();
    }
    int* bkt = (int*)(p.ws + WS_BKT);
    for (int n = blockIdx.x * NTHR + tid; n < 4096; n += G * NTHR) {
        int v;
        if (n < 16) v = n; else { v = 16 + (int)(log((double)n / 16.0) / log(128.0) * 16.0); if (v > 31) v = 31; }
        bkt[n] = v;
    }
}

template <class SrcF>
__device__ __forceinline__ void prep_tr(LAS unsigned char* lds, const SrcF& src, int K, int Nd, bf16_t* Bt) {
    LAS float* tile = (LAS float*)lds;
    const int tid = ltid(), G = gridDim.x, tnN = Nd / 64, ntile = tnN * (K / 64);
    for (int u = blockIdx.x; u < ntile; u += G) {
        const int tn = u % tnN, tk = u / tnN;
#pragma unroll
        for (int i = 0; i < 8; ++i) { const int kk = (tid >> 6) + 8 * i, nn = tid & 63; tile[kk * 65 + nn] = src(tn * 64 + nn, tk * 64 + kk); }
        __syncthreads();
#pragma unroll
        for (int i = 0; i < 4; ++i) { const int nn = (tid >> 5) + 16 * i, kk = (tid & 31) * 2;
            *(unsigned*)(Bt + (size_t)(tn * 64 + nn) * K + tk * 64 + kk) = pk2(tile[kk * 65 + nn], tile[(kk + 1) * 65 + nn]); }
        __syncthreads();
    }
}
struct SrcShift { const float* W; int ldw, n0, shift, nvalid;
    __device__ __forceinline__ float operator()(int n, int k) const { if (n >= nvalid) return 0.f; return W[(size_t)k * ldw + (n >= n0 ? n + shift : n)]; } };
struct SrcGU { const float* Wg; const float* Wu;
    __device__ __forceinline__ float operator()(int n, int k) const { const int e = n >> 10, r = n & 1023, j = (r >> 5) * 16 + (r & 15); const unsigned long long dlt = (unsigned long long)Wu - (unsigned long long)Wg; const float* W = (const float*)((unsigned long long)Wg + (unsigned long long)((r >> 4) & 1) * dlt); return W[((size_t)e * 1024 + k) * 512 + j]; } };
struct SrcDN { const float* Wd;
    __device__ __forceinline__ float operator()(int n, int k) const { return Wd[((size_t)(n >> 10) * 512 + k) * 1024 + (n & 1023)]; } };

__device__ __forceinline__ void prep_layer(const Params& p, LAS unsigned char* lds, int l) {
    const int j = l >> 1;
    if ((l & 1) == 0) {
        SrcShift s{p.in[I_ABWIN] + (size_t)j * D * W_AB, W_AB, 1536, 8, 2496};
        prep_tr(lds, s, D, NP_AB, (bf16_t*)(p.ws + WS_WIN));
        SrcShift so{p.in[I_ABWOUT] + (size_t)j * D * D, D, 1 << 30, 0, D};
        prep_tr(lds, so, D, D, (bf16_t*)(p.ws + WS_WOUT));
        const float* wuk = p.in[I_ABWUK] + (size_t)j * 65536; const float* wuv = p.in[I_ABWUV] + (size_t)j * 65536;
        bf16_t* ouk = (bf16_t*)(p.ws + WS_WUK); bf16_t* ouv = (bf16_t*)(p.ws + WS_WUV);
        for (int i = blockIdx.x * NTHR + TID; i < 65536; i += gridDim.x * NTHR) {
            ouk[i] = f2bf(wuk[i]);
            const int h = i >> 13, d = (i >> 7) & 63, r = i & 127;
            ouv[i] = f2bf(wuv[((size_t)r * 8 + h) * 64 + d]);
        }
    } else {
        SrcShift s{p.in[I_CDWIN] + (size_t)j * D * W_CD, W_CD, 1024, 16, 3072};
        prep_tr(lds, s, D, NP_CD, (bf16_t*)(p.ws + WS_WIN));
        SrcShift so{p.in[I_CDWOUT] + (size_t)j * D * D, D, 1 << 30, 0, D};
        prep_tr(lds, so, D, D, (bf16_t*)(p.ws + WS_WOUT));
    }
    SrcGU sg{p.in[I_MWG] + (size_t)l * 16 * 1024 * 512, p.in[I_MWU] + (size_t)l * 16 * 1024 * 512};
    prep_tr(lds, sg, 1024, 16 * 1024, (bf16_t*)(p.ws + WS_WGU));
    SrcDN sd{p.in[I_MWD] + (size_t)l * 16 * 512 * 1024};
    prep_tr(lds, sd, 512, 16 * 1024, (bf16_t*)(p.ws + WS_WDN));
}

template <int NC4, class WF>
__device__ __forceinline__ void load_small_w(LAS f32x4* tab, const WF& wf) {
    for (int idx = TID; idx < NC4 * 1024; idx += NTHR) {
        const int c4 = idx >> 10, r = idx & 1023, ij = r >> 6, lane = r & 63, k = 256 * (ij >> 2) + 4 * lane + (ij & 3);
        f32x4 v; v[0] = wf(k, 4 * c4); v[1] = wf(k, 4 * c4 + 1); v[2] = wf(k, 4 * c4 + 2); v[3] = wf(k, 4 * c4 + 3);
        tab[idx] = v;
    }
}
template <int NC4>
__device__ __forceinline__ void small_proj(const LAS f32x4* tab, const f32x4 (&h)[4], int lane, f32x4 (&out)[NC4]) {
#pragma unroll
    for (int c4 = 0; c4 < NC4; ++c4) { f32x4 a = (f32x4){0.f, 0.f, 0.f, 0.f};
#pragma unroll
        for (int i = 0; i < 4; ++i)
#pragma unroll
            for (int j = 0; j < 4; ++j) a += tab[(c4 * 16 + i * 4 + j) * 64 + lane] * h[i][j];
#pragma unroll
        for (int q = 0; q < 4; ++q) a[q] = wave_sum(a[q]);
        out[c4] = a; asm volatile("" ::: "memory"); }
}
struct WfAB { const float* W; __device__ __forceinline__ float operator()(int k, int c) const {
        if (c >= 12) return 0.f; const int col = c < 8 ? 1536 + c : 2504 + (c - 8); return W[(size_t)k * W_AB + col]; } };
struct WfCD { const float* W; __device__ __forceinline__ float operator()(int k, int c) const { return W[(size_t)k * W_CD + 1024 + c]; } };
struct WfRT { const float* Wc; const float* Wf; __device__ __forceinline__ float operator()(int k, int c) const {
        if (c < 4) return Wc[(size_t)k * 4 + c]; const int g = (c - 4) >> 2, e = (c - 4) & 3; return Wf[((size_t)g * D + k) * 4 + e]; } };

__device__ __forceinline__ void phase_norm1(const Params& p, LAS unsigned char* lds, int l) {
    const int tid = ltid(), lane = tid & 63, wave = tid >> 6, G = gridDim.x;
    LAS f32x4* tab = (LAS f32x4*)lds;
    if ((l & 1) == 0) { WfAB wf{p.in[I_ABWIN] + (size_t)(l >> 1) * D * W_AB}; load_small_w<4>(tab, wf); }
    else { WfCD wf{p.in[I_CDWIN] + (size_t)(l >> 1) * D * W_CD}; load_small_w<4>(tab, wf); }
    __syncthreads();
    const float* mod = (const float*)(p.ws + WS_MOD);
    float* X = (float*)(p.ws + WS_X); bf16_t* HBF = (bf16_t*)(p.ws + WS_HBF); float* SP = (float*)(p.ws + WS_SP);
    const bf16_t* YS = (const bf16_t*)(p.ws + WS_P);
    const int* POS = (const int*)(p.ws + WS_POS); const float* RTW = (const float*)(p.ws + WS_RTW);
    for (int grp = blockIdx.x; grp < NTOK / 128; grp += G) {
        const int b = (grp * 128) >> 12;
        const float* mrow = mod + ((size_t)l * 8 + b) * 6 * D;
        f32x4 ca[4], cb[4], gf[4];
#pragma unroll
        for (int i = 0; i < 4; ++i) { const int col = 256 * i + 4 * lane;
            const f32x4 g = *(const f32x4*)(p.in[I_GMIX] + (size_t)l * D + col), sc = *(const f32x4*)(mrow + D + col); ca[i] = g * (sc + 1.0f); cb[i] = *(const f32x4*)(mrow + col);
            gf[i] = (l > 0) ? *(const f32x4*)(mod + ((size_t)(l - 1) * 8 + b) * 6 * D + 5 * D + col) : (f32x4){0.f, 0.f, 0.f, 0.f}; }
        for (int tt = 0; tt < 16; ++tt) {
            const int tok = grp * 128 + wave * 16 + tt;
            f32x4 x[4];
            if (l == 0) {
#pragma unroll
                for (int i = 0; i < 4; ++i) x[i] = *(const f32x4*)(p.in[I_X] + (size_t)tok * D + 256 * i + 4 * lane);
            } else {
                const int p1 = POS[2 * tok], p2 = POS[2 * tok + 1]; const float w1 = RTW[2 * tok], w2 = RTW[2 * tok + 1];
#pragma unroll
                for (int i = 0; i < 4; ++i) { const int col = 256 * i + 4 * lane; x[i] = *(const f32x4*)(X + (size_t)tok * D + col);
                    const u32x2 y1 = *(const u32x2*)(YS + (size_t)p1 * D + col), y2 = *(const u32x2*)(YS + (size_t)p2 * D + col);
                    f32x4 a, c2; a[0] = __uint_as_float(y1.x << 16); a[1] = __uint_as_float(y1.x & 0xffff0000u); a[2] = __uint_as_float(y1.y << 16); a[3] = __uint_as_float(y1.y & 0xffff0000u);
                    c2[0] = __uint_as_float(y2.x << 16); c2[1] = __uint_as_float(y2.x & 0xffff0000u); c2[2] = __uint_as_float(y2.y << 16); c2[3] = __uint_as_float(y2.y & 0xffff0000u);
                    x[i] = x[i] + gf[i] * (a * w1 + c2 * w2); }
            }
            float ss = 0.f;
#pragma unroll
            for (int i = 0; i < 4; ++i) { *(f32x4*)(X + (size_t)tok * D + 256 * i + 4 * lane) = x[i]; ss += (x[i][0] * x[i][0] + x[i][1] * x[i][1]) + (x[i][2] * x[i][2] + x[i][3] * x[i][3]); }
            ss = wave_sum(ss);
            const float rstd = 1.0f / sqrtf(ss * (1.0f / 1024.0f) + 1e-6f);
            f32x4 h[4];
#pragma unroll
            for (int i = 0; i < 4; ++i) { h[i] = x[i] * rstd * ca[i] + cb[i];
                u32x2 w; w.x = pk2(h[i][0], h[i][1]); w.y = pk2(h[i][2], h[i][3]); *(u32x2*)(HBF + (size_t)tok * D + 256 * i + 4 * lane) = w; }
            f32x4 o[4]; small_proj<4>(tab, h, lane, o);
            float v = 0.f;
#pragma unroll
            for (int c = 0; c < 16; ++c) v = (lane == c) ? o[c >> 2][c & 3] : v;
            if (lane < 16) SP[(size_t)tok * 16 + lane] = v;
        }
    }
}

__device__ __forceinline__ void phase_norm2(const Params& p, LAS unsigned char* lds, int l) {
    const int tid = ltid(), lane = tid & 63, wave = tid >> 6, G = gridDim.x;
    LAS f32x4* tab = (LAS f32x4*)lds;
    LAS int* cnts = (LAS int*)(lds + 5 * 16384);
    { WfRT wf{p.in[I_MWC] + (size_t)l * D * 4, p.in[I_MWF] + (size_t)l * 4 * D * 4}; load_small_w<5>(tab, wf); }
    __syncthreads();
    const float* mod = (const float*)(p.ws + WS_MOD);
    const float* X = (const float*)(p.ws + WS_X); bf16_t* HBF = (bf16_t*)(p.ws + WS_HBF);
    int* RTE = (int*)(p.ws + WS_RTE); float* RTW = (float*)(p.ws + WS_RTW); int* TC = (int*)(p.ws + WS_TC);
    float bias[20];
#pragma unroll
    for (int c = 0; c < 4; ++c) bias[c] = p.in[I_MBC][l * 4 + c];
#pragma unroll
    for (int c = 0; c < 16; ++c) bias[4 + c] = p.in[I_MBF][l * 16 + c];
    for (int grp = blockIdx.x; grp < NTOK / 128; grp += G) {
        const int b = (grp * 128) >> 12;
        const float* mrow = mod + ((size_t)l * 8 + b) * 6 * D;
        f32x4 ca[4], cb[4];
#pragma unroll
        for (int i = 0; i < 4; ++i) { const int col = 256 * i + 4 * lane;
            const f32x4 g = *(const f32x4*)(p.in[I_GFFN] + (size_t)l * D + col), sc = *(const f32x4*)(mrow + 4 * D + col); ca[i] = g * (sc + 1.0f); cb[i] = *(const f32x4*)(mrow + 3 * D + col); }
        int cnt = 0;
        for (int tt = 0; tt < 16; ++tt) {
            const int tok = grp * 128 + wave * 16 + tt;
            f32x4 x[4]; float ss = 0.f;
#pragma unroll
            for (int i = 0; i < 4; ++i) { x[i] = *(const f32x4*)(X + (size_t)tok * D + 256 * i + 4 * lane); ss += (x[i][0] * x[i][0] + x[i][1] * x[i][1]) + (x[i][2] * x[i][2] + x[i][3] * x[i][3]); }
            ss = wave_sum(ss);
            const float rstd = 1.0f / sqrtf(ss * (1.0f / 1024.0f) + 1e-6f);
            f32x4 h[4];
#pragma unroll
            for (int i = 0; i < 4; ++i) { h[i] = x[i] * rstd * ca[i] + cb[i];
                u32x2 w; w.x = pk2(h[i][0], h[i][1]); w.y = pk2(h[i][2], h[i][3]); *(u32x2*)(HBF + (size_t)tok * D + 256 * i + 4 * lane) = w; }
            f32x4 o[5]; small_proj<5>(tab, h, lane, o);
            float lc[4];
#pragma unroll
            for (int c = 0; c < 4; ++c) lc[c] = o[0][c] + bias[c];
            int g = 0; float mx = lc[0];
#pragma unroll
            for (int c = 1; c < 4; ++c) if (lc[c] > mx) { mx = lc[c]; g = c; }
            float se = 0.f;
#pragma unroll
            for (int c = 0; c < 4; ++c) se += expf(lc[c] - mx);
            const float pg = 1.0f / se;
            float lf[4];
#pragma unroll
            for (int e = 0; e < 4; ++e) { float v = o[1][e] + bias[4 + e];
                v = (g == 1) ? o[2][e] + bias[8 + e] : v; v = (g == 2) ? o[3][e] + bias[12 + e] : v; v = (g == 3) ? o[4][e] + bias[16 + e] : v; lf[e] = v; }
            int i1 = 0; float v1 = lf[0];
#pragma unroll
            for (int e = 1; e < 4; ++e) if (lf[e] > v1) { v1 = lf[e]; i1 = e; }
            int i2 = -1; float v2 = -3.0e38f;
#pragma unroll
            for (int e = 0; e < 4; ++e) if (e != i1 && lf[e] > v2) { v2 = lf[e]; i2 = e; }
            const float ex = expf(v2 - v1); const float p1 = 1.0f / (1.0f + ex), p2 = ex / (1.0f + ex);
            const int e1 = g * 4 + i1, e2 = g * 4 + i2;
            if (lane == 0) { RTE[tok] = e1 | (e2 << 8); RTW[2 * tok] = pg * p1; RTW[2 * tok + 1] = pg * p2; }
            cnt += (lane == e1 ? 1 : 0) + (lane == e2 ? 1 : 0);
        }
        __syncthreads();
        if (lane < 16) cnts[wave * 16 + lane] = cnt;
        __syncthreads();
        if (tid < 16) { int s = 0;
#pragma unroll
            for (int w = 0; w < 8; ++w) s += cnts[w * 16 + tid];
            TC[grp * 16 + tid] = s; }
    }
}

__device__ __forceinline__ void phase_dispatch(const Params& p, LAS unsigned char* lds, LAS int* tbase) {
    const int tid = ltid(), lane = tid & 63, wave = tid >> 6, G = gridDim.x;
    LAS int* tc = (LAS int*)lds;
    LAS int* tot = (LAS int*)(lds + 16384);
    LAS int* earr = (LAS int*)(lds + 16384 + 256);
    LAS int* parr = (LAS int*)(lds + 16384 + 256 + 1024);
    LAS int* toff = (LAS int*)(lds + 16384 + 256 + 2048);
    const int* TC = (const int*)(p.ws + WS_TC); const int* RTE = (const int*)(p.ws + WS_RTE);
    int* POS = (int*)(p.ws + WS_POS);
    const bf16_t* HBF = (const bf16_t*)(p.ws + WS_HBF); bf16_t* AS = (bf16_t*)(p.ws + WS_P);
    for (int i = tid; i < 256 * 16; i += NTHR) tc[i] = TC[i];
    __syncthreads();
    if (tid < 16) { int s = 0; for (int g = 0; g < 256; ++g) s += tc[g * 16 + tid]; tot[tid] = s; }
    __syncthreads();
    if (tid == 0) { int rb = 0; for (int e = 0; e < 16; ++e) { tot[16 + e] = rb; tbase[e] = rb >> 8; rb += (tot[e] + 255) & ~255; } tbase[16] = rb >> 8; }
    __syncthreads();
    for (int grp = blockIdx.x; grp < NTOK / 128; grp += G) {
        if (tid < 16) { int s = 0; for (int g = 0; g < grp; ++g) s += tc[g * 16 + tid]; toff[tid] = s; }
        if (tid < 256) { const int ee = RTE[grp * 128 + (tid >> 1)]; earr[tid] = (tid & 1) ? ((ee >> 8) & 255) : (ee & 255); }
        __syncthreads();
        if (tid < 256) { const int e = earr[tid]; int rank = 0; for (int j = 0; j < tid; ++j) rank += (earr[j] == e) ? 1 : 0;
            const int pos = tot[16 + e] + toff[e] + rank; parr[tid] = pos; POS[(size_t)(grp * 128) * 2 + tid] = pos; }
        __syncthreads();
        for (int r = 0; r < 32; ++r) { const int i = wave * 32 + r; const int tok = grp * 128 + (i >> 1); const int pos = parr[i];
            const u32x4* s = (const u32x4*)(HBF + (size_t)tok * D); u32x4* d = (u32x4*)(AS + (size_t)pos * D);
            const u32x4 a = s[lane], c2 = s[64 + lane]; d[lane] = a; d[64 + lane] = c2; }
        __syncthreads();
    }
}

__device__ __forceinline__ void phase_final(const Params& p) {
    const int tid = ltid(), lane = tid & 63, wave = tid >> 6, G = gridDim.x;
    const float* mod = (const float*)(p.ws + WS_MOD);
    const float* X = (const float*)(p.ws + WS_X);
    const bf16_t* YS = (const bf16_t*)(p.ws + WS_P);
    const int* POS = (const int*)(p.ws + WS_POS); const float* RTW = (const float*)(p.ws + WS_RTW);
    for (int grp = blockIdx.x; grp < NTOK / 128; grp += G) {
        const int b = (grp * 128) >> 12;
        f32x4 gf[4], gg[4];
#pragma unroll
        for (int i = 0; i < 4; ++i) { const int col = 256 * i + 4 * lane; gf[i] = *(const f32x4*)(mod + ((size_t)3 * 8 + b) * 6 * D + 5 * D + col); gg[i] = *(const f32x4*)(p.in[I_GFINAL] + col); }
        for (int tt = 0; tt < 16; ++tt) {
            const int tok = grp * 128 + wave * 16 + tt;
            const int p1 = POS[2 * tok], p2 = POS[2 * tok + 1]; const float w1 = RTW[2 * tok], w2 = RTW[2 * tok + 1];
            f32x4 x[4]; float ss = 0.f;
#pragma unroll
            for (int i = 0; i < 4; ++i) { const int col = 256 * i + 4 * lane; x[i] = *(const f32x4*)(X + (size_t)tok * D + col);
                const u32x2 y1 = *(const u32x2*)(YS + (size_t)p1 * D + col), y2 = *(const u32x2*)(YS + (size_t)p2 * D + col);
                f32x4 a, c2; a[0] = __uint_as_float(y1.x << 16); a[1] = __uint_as_float(y1.x & 0xffff0000u); a[2] = __uint_as_float(y1.y << 16); a[3] = __uint_as_float(y1.y & 0xffff0000u);
                c2[0] = __uint_as_float(y2.x << 16); c2[1] = __uint_as_float(y2.x & 0xffff0000u); c2[2] = __uint_as_float(y2.y << 16); c2[3] = __uint_as_float(y2.y & 0xffff0000u);
                x[i] = x[i] + gf[i] * (a * w1 + c2 * w2);
                ss += (x[i][0] * x[i][0] + x[i][1] * x[i][1]) + (x[i][2] * x[i][2] + x[i][3] * x[i][3]); }
            ss = wave_sum(ss);
            const float rstd = 1.0f / sqrtf(ss * (1.0f / 1024.0f) + 1e-6f);
#pragma unroll
            for (int i = 0; i < 4; ++i) *(f32x4*)(p.out + (size_t)tok * D + 256 * i + 4 * lane) = x[i] * rstd * gg[i];
        }
    }
}
__device__ __forceinline__ f32x4 mfma16(bf16x8 a, bf16x8 b, f32x4 c) { return __builtin_amdgcn_mfma_f32_16x16x32_bf16(a, b, c, 0, 0, 0); }
__device__ __forceinline__ bf16x8 ldfrag(const LAS unsigned char* base, int row, int stride_bytes, int kk, int g) { return *(const LAS bf16x8*)(base + row * stride_bytes + (kk * 32 + g * 8) * 2); }
__device__ __forceinline__ float scan_add(float v, int lane) {
#pragma unroll
    for (int o = 1; o < 64; o <<= 1) { const float t = __shfl_up(v, o); if (lane >= o) v += t; }
    return v;
}
__device__ __forceinline__ float scan_max(float v, int lane) {
#pragma unroll
    for (int o = 1; o < 64; o <<= 1) { const float t = __shfl_up(v, o); if (lane >= o) v = fmaxf(v, t); }
    return v;
}
__device__ __forceinline__ float bfe(const u32x4& v, int e) { const unsigned w = v[e >> 1]; return __uint_as_float((e & 1) ? (w & 0xffff0000u) : (w << 16)); }
__device__ __forceinline__ bf16_t bfr(const u32x4& v, int e) { const unsigned w = v[e >> 1]; return (bf16_t)((e & 1) ? (w >> 16) : (w & 0xffffu)); }

constexpr int RS = 144;
constexpr size_t WS_CL   = WS_END;
constexpr size_t WS_SCAL = WS_CL + 72 * MiB;
constexpr size_t WS_MC   = WS_SCAL + 512 * 1024;
constexpr size_t WS_END2 = WS_MC + 512 * 1024;
constexpr size_t WS_CTG  = WS_HBF;
constexpr size_t WS_STG  = WS_H1 + 36 * MiB;

__device__ __forceinline__ void unit_mlstm_L(const Params& p, LAS unsigned char* lds, int j, int b, int h, int ck) {
    const int tid = ltid(), lane = tid & 63, wave = __builtin_amdgcn_readfirstlane(tid >> 6), fr = lane & 15, g = lane >> 4;
    LAS unsigned char* KWT = lds; LAS unsigned char* VT = lds + 9216; LAS float* GA = (LAS float*)(lds + 29952);
    const bf16_t* P = (const bf16_t*)(p.ws + WS_P); const float* SP = (const float*)(p.ws + WS_SP);
    float* CL = (float*)(p.ws + WS_CL); float* SCAL = (float*)(p.ws + WS_SCAL);
    const int unit = (b * 4 + h) * 64 + ck; const int tok0 = b * SEQ + ck * 64;
    const int t = tid >> 3, seg = tid & 7, kc0 = 256 + h * 64 + seg * 8, pos = ck * 64 + t;
    u32x4 kin[4], vin[2];
#pragma unroll
    for (int q = 0; q < 4; ++q) { const int pp = pos - 3 + q; kin[q] = (pp >= 0) ? *(const u32x4*)(P + (size_t)(b * SEQ + pp) * NP_AB + kc0) : (u32x4){0u, 0u, 0u, 0u}; }
#pragma unroll
    for (int i = 0; i < 2; ++i) { const int idx = tid + 512 * i; vin[i] = *(const u32x4*)(P + (size_t)(tok0 + (idx >> 4)) * NP_AB + AB_VA + h * 128 + (idx & 15) * 8); }
    if (wave == 0) {
        const int tok = tok0 + lane;
        const float li = SP[(size_t)tok * 16 + h] + p.in[I_ABGATEB][j * 8 + h]; const float lf = logsigmoidf_(SP[(size_t)tok * 16 + 4 + h] + p.in[I_ABGATEB][j * 8 + 4 + h]);
        const float bc = scan_add(lf, lane); const float a = li - bc; const float amax = __shfl(scan_max(a, lane), 63);
        GA[lane] = __expf(a - amax);
        if (lane == 63) { SCAL[unit * 2] = bc; SCAL[unit * 2 + 1] = amax; }
    }
    for (int i = tid; i < 16 * 72; i += NTHR) { const int r = i / 72; ((LAS bf16_t*)VT)[(128 + r) * 72 + (i % 72)] = (r == 0) ? (bf16_t)0x3F80 : (bf16_t)0; }
    __syncthreads();
    { const float* convw = p.in[I_ABCONVW] + (size_t)j * 4 * 512 + kc0; const float* convb = p.in[I_ABCONVB] + j * 512 + kc0; const float we = GA[t];
#pragma unroll
      for (int e = 0; e < 8; ++e) { float acc = convb[e];
#pragma unroll
        for (int q = 0; q < 4; ++q) acc += convw[q * 512 + e] * bfe(kin[q], e);
        const float v = acc / (1.0f + __expf(-acc)); ((LAS bf16_t*)KWT)[(seg * 8 + e) * 72 + t] = f2bf(v * we); } }
#pragma unroll
    for (int i = 0; i < 2; ++i) { const int idx = tid + 512 * i; const int s = idx >> 4, sg = idx & 15;
#pragma unroll
        for (int e = 0; e < 8; ++e) ((LAS bf16_t*)VT)[(sg * 8 + e) * 72 + s] = bfr(vin[i], e); }
    __syncthreads();
#pragma unroll
    for (int i = 0; i < 5; ++i) { const int id = wave + 8 * i;
        if (id < 36) { const int tk = id / 9, tv = id % 9; f32x4 acc = (f32x4){0.f, 0.f, 0.f, 0.f};
#pragma unroll
            for (int kk = 0; kk < 2; ++kk) acc = mfma16(ldfrag(KWT, tk * 16 + fr, RS, kk, g), ldfrag(VT, tv * 16 + fr, RS, kk, g), acc);
#pragma unroll
            for (int r = 0; r < 4; ++r) CL[(size_t)unit * 9216 + (tk * 16 + 4 * g + r) * 144 + tv * 16 + fr] = acc[r]; } }
    __syncthreads();
}

__device__ __forceinline__ void phase_scan_mlstm(const Params& p) {
    const float* CL = (const float*)(p.ws + WS_CL); const float* SCAL = (const float*)(p.ws + WS_SCAL); float* MC = (float*)(p.ws + WS_MC); bf16_t* CTG = (bf16_t*)(p.ws + WS_CTG);
    for (int e = blockIdx.x * NTHR + TID; e < 32 * 9216; e += gridDim.x * NTHR) {
        const int bh = e / 9216, r = e % 9216;
        float C = 0.f, m = -1e30f;
#pragma unroll 1
        for (int c0 = 0; c0 < 64; c0 += 8) { float v[8];
#pragma unroll
            for (int i = 0; i < 8; ++i) v[i] = CL[(size_t)(bh * 64 + c0 + i) * 9216 + r];
#pragma unroll
            for (int i = 0; i < 8; ++i) { const int unit = bh * 64 + c0 + i; const float bL = SCAL[unit * 2], amax = SCAL[unit * 2 + 1];
                CTG[(size_t)unit * 9216 + r] = f2bf(C); if (r == 0) MC[unit] = m;
                const float M = fmaxf(m, amax); C = __expf(m - M) * C + __expf(amax - M) * v[i]; m = bL + M; } }
    }
}

__device__ __forceinline__ void unit_mlstm_O(const Params& p, LAS unsigned char* lds, int j, int b, int h, int ck) {
    const int tid = ltid(), lane = tid & 63, wave = __builtin_amdgcn_readfirstlane(tid >> 6), fr = lane & 15, g = lane >> 4;
    LAS unsigned char* QS = lds; LAS unsigned char* KS = lds + 9216; LAS unsigned char* VT = lds + 18432; LAS unsigned char* CT = lds + 39168; LAS unsigned char* PS = lds + 59904;
    LAS float* OS = (LAS float*)(lds + 69120); LAS float* GA = (LAS float*)(lds + 107008);
    constexpr int OSS = 148;
    const bf16_t* P = (const bf16_t*)(p.ws + WS_P); const float* SP = (const float*)(p.ws + WS_SP); bf16_t* YMIX = (bf16_t*)(p.ws + WS_YMIX);
    const bf16_t* CTG = (const bf16_t*)(p.ws + WS_CTG); const float* MC = (const float*)(p.ws + WS_MC);
    const int unit = (b * 4 + h) * 64 + ck; const int tok0 = b * SEQ + ck * 64;
    const int sg = tid & 15;
    const int ch0 = (sg < 8) ? h * 64 + sg * 8 : 256 + h * 64 + (sg - 8) * 8;
    u32x4 qkin[2][4], vin[2], cin[3], oin[2];
#pragma unroll
    for (int i = 0; i < 2; ++i) { const int tt = (tid + 512 * i) >> 4; const int pos = ck * 64 + tt;
#pragma unroll
        for (int q = 0; q < 4; ++q) { const int pp = pos - 3 + q; qkin[i][q] = (pp >= 0) ? *(const u32x4*)(P + (size_t)(b * SEQ + pp) * NP_AB + ch0) : (u32x4){0u, 0u, 0u, 0u}; }
        vin[i] = *(const u32x4*)(P + (size_t)(tok0 + tt) * NP_AB + AB_VA + h * 128 + sg * 8);
        oin[i] = *(const u32x4*)(P + (size_t)(tok0 + tt) * NP_AB + AB_OA + h * 128 + sg * 8); }
#pragma unroll
    for (int i = 0; i < 3; ++i) { const int idx = tid + 512 * i; cin[i] = (idx < 1152) ? *(const u32x4*)(CTG + (size_t)unit * 9216 + idx * 8) : (u32x4){0u, 0u, 0u, 0u}; }
    if (wave == 0) {
        const int tok = tok0 + lane; const float mc = MC[unit];
        const float li = SP[(size_t)tok * 16 + h] + p.in[I_ABGATEB][j * 8 + h]; const float lf = logsigmoidf_(SP[(size_t)tok * 16 + 4 + h] + p.in[I_ABGATEB][j * 8 + 4 + h]);
        const float bc = scan_add(lf, lane); const float a = li - bc; const float M = fmaxf(mc, scan_max(a, lane));
        GA[lane] = a; GA[64 + lane] = M; GA[128 + lane] = __expf(mc - M); GA[192 + lane] = __expf(-(bc + M));
    }
    for (int i = tid; i < 16 * 72; i += NTHR) { const int r = i / 72; ((LAS bf16_t*)VT)[(128 + r) * 72 + (i % 72)] = (r == 0) ? (bf16_t)0x3F80 : (bf16_t)0; }
    { const float* convw = p.in[I_ABCONVW] + (size_t)j * 4 * 512 + ch0; const float* convb = p.in[I_ABCONVB] + j * 512 + ch0;
      float cw[4][8], cb[8];
#pragma unroll
      for (int e = 0; e < 8; ++e) { cb[e] = convb[e];
#pragma unroll
        for (int q = 0; q < 4; ++q) cw[q][e] = convw[q * 512 + e]; }
      const float qs = (sg < 8) ? 0.125f : 1.0f;
#pragma unroll
      for (int i = 0; i < 2; ++i) { const int tt = (tid + 512 * i) >> 4; float o[8];
#pragma unroll
        for (int e = 0; e < 8; ++e) { float acc = cb[e];
#pragma unroll
            for (int q = 0; q < 4; ++q) acc += cw[q][e] * bfe(qkin[i][q], e);
            o[e] = acc / (1.0f + __expf(-acc)) * qs; }
        u32x4 w; w.x = pk2(o[0], o[1]); w.y = pk2(o[2], o[3]); w.z = pk2(o[4], o[5]); w.w = pk2(o[6], o[7]);
        *(LAS u32x4*)(((sg < 8) ? QS : KS) + tt * RS + (sg & 7) * 16) = w;
#pragma unroll
        for (int e = 0; e < 8; ++e) ((LAS bf16_t*)VT)[(sg * 8 + e) * 72 + tt] = bfr(vin[i], e); } }
#pragma unroll
    for (int i = 0; i < 3; ++i) { const int idx = tid + 512 * i;
        if (idx < 1152) { const int dk = idx / 18, sv = idx % 18;
#pragma unroll
            for (int e = 0; e < 8; ++e) ((LAS bf16_t*)CT)[(sv * 8 + e) * 72 + dk] = bfr(cin[i], e); } }
    __syncthreads();
    { const int tq = wave >> 1;
#pragma unroll
      for (int u = 0; u < 2; ++u) { const int ts = (wave & 1) * 2 + u; f32x4 acc = (f32x4){0.f, 0.f, 0.f, 0.f};
        if (ts <= tq) {
#pragma unroll
            for (int kk = 0; kk < 2; ++kk) acc = mfma16(ldfrag(QS, tq * 16 + fr, RS, kk, g), ldfrag(KS, ts * 16 + fr, RS, kk, g), acc);
        }
        const int s = ts * 16 + fr; const float as = GA[s];
#pragma unroll
        for (int r = 0; r < 4; ++r) { const int t = tq * 16 + 4 * g + r; const float pv = (ts <= tq && s <= t) ? acc[r] * __expf(as - GA[64 + t]) : 0.f; ((LAS bf16_t*)PS)[t * 72 + s] = f2bf(pv); } } }
    __syncthreads();
#pragma unroll
    for (int i = 0; i < 5; ++i) { const int id = wave + 8 * i;
        if (id < 36) { const int tq = id / 9, tv = id % 9; f32x4 acc = (f32x4){0.f, 0.f, 0.f, 0.f};
#pragma unroll
            for (int kk = 0; kk < 2; ++kk) acc = mfma16(ldfrag(QS, tq * 16 + fr, RS, kk, g), ldfrag(CT, tv * 16 + fr, RS, kk, g), acc);
#pragma unroll
            for (int r = 0; r < 4; ++r) acc[r] *= GA[128 + tq * 16 + 4 * g + r];
#pragma unroll
            for (int kk = 0; kk < 2; ++kk) acc = mfma16(ldfrag(PS, tq * 16 + fr, RS, kk, g), ldfrag(VT, tv * 16 + fr, RS, kk, g), acc);
#pragma unroll
            for (int r = 0; r < 4; ++r) OS[(tq * 16 + 4 * g + r) * OSS + tv * 16 + fr] = acc[r]; } }
    __syncthreads();
    { const float* hgp = p.in[I_ABHNORM] + j * 512 + h * 128 + sg * 8;
#pragma unroll
      for (int i = 0; i < 2; ++i) { const int tt = (tid + 512 * i) >> 4;
        const float den = OS[tt * OSS + 128]; const float dn = fmaxf(fabsf(den), GA[192 + tt]); const float idn = 1.0f / dn;
        const f32x4 a0 = *(const LAS f32x4*)(OS + tt * OSS + sg * 8), a1 = *(const LAS f32x4*)(OS + tt * OSS + sg * 8 + 4);
        float hv[8] = {a0[0] * idn, a0[1] * idn, a0[2] * idn, a0[3] * idn, a1[0] * idn, a1[1] * idn, a1[2] * idn, a1[3] * idn};
        float ss = 0.f;
#pragma unroll
        for (int e = 0; e < 8; ++e) ss += hv[e] * hv[e];
        ss += __shfl_xor(ss, 1); ss += __shfl_xor(ss, 2); ss += __shfl_xor(ss, 4); ss += __shfl_xor(ss, 8);
        const float rn = 1.0f / sqrtf(ss * (1.0f / 128.0f) + 1e-6f);
        float y[8];
#pragma unroll
        for (int e = 0; e < 8; ++e) y[e] = hv[e] * rn * hgp[e] * sigmoidf_(bfe(oin[i], e));
        u32x4 w; w.x = pk2(y[0], y[1]); w.y = pk2(y[2], y[3]); w.z = pk2(y[4], y[5]); w.w = pk2(y[6], y[7]);
        *(u32x4*)(YMIX + (size_t)(tok0 + tt) * D + h * 128 + sg * 8) = w; } }
    __syncthreads();
}

__device__ __forceinline__ void gla_cumsum(const Params& p, int j, int h, int tok0, int lane, int wave, LAS float* BS, LAS float* BL, float* scal_unit) {
    const float* SP = (const float*)(p.ws + WS_SP);
    f32x4 gq[4];
#pragma unroll
    for (int r = 0; r < 4; ++r) gq[r] = *(const f32x4*)(SP + (size_t)(tok0 + lane) * 16 + 4 * r);
    const float* wa = p.in[I_CDWALPHA] + (size_t)j * 16 * 256 + h * 64 + wave * 8; const float* ba = p.in[I_CDBALPHA] + j * 256 + h * 64 + wave * 8;
#pragma unroll
    for (int i = 0; i < 8; ++i) { float z = ba[i];
#pragma unroll
        for (int r = 0; r < 16; ++r) z += gq[r >> 2][r & 3] * wa[r * 256 + i];
        const float la = logsigmoidf_(z) * (1.0f / 16.0f); const float bc = scan_add(la, lane);
        BS[lane * 65 + wave * 8 + i] = bc;
        if (lane == 63) { BL[wave * 8 + i] = bc; if (scal_unit) scal_unit[wave * 8 + i] = __expf(bc); } }
}
__device__ __forceinline__ void unit_gla_L(const Params& p, LAS unsigned char* lds, int j, int b, int h, int ck) {
    const int tid = ltid(), lane = tid & 63, wave = __builtin_amdgcn_readfirstlane(tid >> 6), fr = lane & 15, g = lane >> 4;
    LAS unsigned char* KWT = lds; LAS unsigned char* VT = lds + 9216; LAS float* BS = (LAS float*)(lds + 27648); LAS float* BL = (LAS float*)(lds + 44288);
    const bf16_t* P = (const bf16_t*)(p.ws + WS_P); float* CL = (float*)(p.ws + WS_CL); float* SCAL = (float*)(p.ws + WS_SCAL);
    const int unit = (b * 4 + h) * 64 + ck; const int tok0 = b * SEQ + ck * 64;
    const int t = tid >> 3, seg = tid & 7;
    const u32x4 kin = *(const u32x4*)(P + (size_t)(tok0 + t) * NP_CD + CD_KC + h * 64 + seg * 8);
    u32x4 vin[2];
#pragma unroll
    for (int i = 0; i < 2; ++i) { const int idx = tid + 512 * i; vin[i] = *(const u32x4*)(P + (size_t)(tok0 + (idx >> 4)) * NP_CD + CD_VC + h * 128 + (idx & 15) * 8); }
    gla_cumsum(p, j, h, tok0, lane, wave, BS, BL, SCAL + (size_t)unit * 64);
    __syncthreads();
#pragma unroll
    for (int e = 0; e < 8; ++e) { const int kk = seg * 8 + e; ((LAS bf16_t*)KWT)[kk * 72 + t] = f2bf(bfe(kin, e) * __expf(BL[kk] - BS[t * 65 + kk])); }
#pragma unroll
    for (int i = 0; i < 2; ++i) { const int idx = tid + 512 * i; const int s = idx >> 4, sg = idx & 15;
#pragma unroll
        for (int e = 0; e < 8; ++e) ((LAS bf16_t*)VT)[(sg * 8 + e) * 72 + s] = bfr(vin[i], e); }
    __syncthreads();
#pragma unroll
    for (int i = 0; i < 4; ++i) { const int id = wave + 8 * i; const int tk = id >> 3, tv = id & 7; f32x4 acc = (f32x4){0.f, 0.f, 0.f, 0.f};
#pragma unroll
        for (int kk = 0; kk < 2; ++kk) acc = mfma16(ldfrag(KWT, tk * 16 + fr, RS, kk, g), ldfrag(VT, tv * 16 + fr, RS, kk, g), acc);
#pragma unroll
        for (int r = 0; r < 4; ++r) CL[(size_t)unit * 8192 + (tk * 16 + 4 * g + r) * 128 + tv * 16 + fr] = acc[r]; }
    __syncthreads();
}
__device__ __forceinline__ void phase_scan_gla(const Params& p) {
    const float* CL = (const float*)(p.ws + WS_CL); const float* SCAL = (const float*)(p.ws + WS_SCAL); bf16_t* STG = (bf16_t*)(p.ws + WS_STG);
    for (int e = blockIdx.x * NTHR + TID; e < 32 * 8192; e += gridDim.x * NTHR) {
        const int bh = e >> 13, r = e & 8191, dk = r >> 7;
        float S = 0.f;
#pragma unroll 1
        for (int c0 = 0; c0 < 64; c0 += 8) { float v[8], dc[8];
#pragma unroll
            for (int i = 0; i < 8; ++i) { v[i] = CL[(size_t)(bh * 64 + c0 + i) * 8192 + r]; dc[i] = SCAL[(size_t)(bh * 64 + c0 + i) * 64 + dk]; }
#pragma unroll
            for (int i = 0; i < 8; ++i) { STG[(size_t)(bh * 64 + c0 + i) * 8192 + r] = f2bf(S); S = dc[i] * S + v[i]; } }
    }
}
__device__ __forceinline__ void unit_gla_O(const Params& p, LAS unsigned char* lds, int j, int b, int h, int ck) {
    const int tid = ltid(), lane = tid & 63, wave = __builtin_amdgcn_readfirstlane(tid >> 6), fr = lane & 15, g = lane >> 4;
    LAS unsigned char* QS = lds; LAS unsigned char* KS = lds + 9216; LAS unsigned char* VT = lds + 18432; LAS unsigned char* ST = lds + 36864; LAS unsigned char* PS = lds + 55296;
    LAS float* OS = (LAS float*)(lds + 64512); LAS float* BS = (LAS float*)(lds + 98304); LAS float* BL = (LAS float*)(lds + 114944);
    constexpr int OSS = 132;
    const bf16_t* P = (const bf16_t*)(p.ws + WS_P); bf16_t* YMIX = (bf16_t*)(p.ws + WS_YMIX); const bf16_t* STG = (const bf16_t*)(p.ws + WS_STG);
    const int unit = (b * 4 + h) * 64 + ck; const int tok0 = b * SEQ + ck * 64;
    const int sg = tid & 15; const int ch0 = (sg < 8) ? CD_QC + h * 64 + sg * 8 : CD_KC + h * 64 + (sg - 8) * 8;
    u32x4 qkin[2], vin[2], sin_[2], rin[2];
#pragma unroll
    for (int i = 0; i < 2; ++i) { const int idx = tid + 512 * i; const int tt = idx >> 4;
        qkin[i] = *(const u32x4*)(P + (size_t)(tok0 + tt) * NP_CD + ch0);
        vin[i] = *(const u32x4*)(P + (size_t)(tok0 + tt) * NP_CD + CD_VC + h * 128 + sg * 8);
        rin[i] = *(const u32x4*)(P + (size_t)(tok0 + tt) * NP_CD + CD_RC + h * 128 + sg * 8);
        sin_[i] = *(const u32x4*)(STG + (size_t)unit * 8192 + idx * 8); }
    gla_cumsum(p, j, h, tok0, lane, wave, BS, BL, nullptr);
    __syncthreads();
#pragma unroll
    for (int i = 0; i < 2; ++i) { const int idx = tid + 512 * i; const int tt = idx >> 4; float o[8];
#pragma unroll
        for (int e = 0; e < 8; ++e) { const float bb = BS[tt * 65 + (sg & 7) * 8 + e]; o[e] = (sg < 8) ? bfe(qkin[i], e) * 0.125f * __expf(bb) : bfe(qkin[i], e) * __expf(-bb); }
        u32x4 w; w.x = pk2(o[0], o[1]); w.y = pk2(o[2], o[3]); w.z = pk2(o[4], o[5]); w.w = pk2(o[6], o[7]);
        *(LAS u32x4*)(((sg < 8) ? QS : KS) + tt * RS + (sg & 7) * 16) = w;
#pragma unroll
        for (int e = 0; e < 8; ++e) { ((LAS bf16_t*)VT)[(sg * 8 + e) * 72 + tt] = bfr(vin[i], e); ((LAS bf16_t*)ST)[(sg * 8 + e) * 72 + tt] = bfr(sin_[i], e); } }
    __syncthreads();
    { const int tq = wave >> 1;
#pragma unroll
      for (int u = 0; u < 2; ++u) { const int ts = (wave & 1) * 2 + u; f32x4 acc = (f32x4){0.f, 0.f, 0.f, 0.f};
        if (ts <= tq) {
#pragma unroll
            for (int kk = 0; kk < 2; ++kk) acc = mfma16(ldfrag(QS, tq * 16 + fr, RS, kk, g), ldfrag(KS, ts * 16 + fr, RS, kk, g), acc);
        }
        const int s = ts * 16 + fr;
#pragma unroll
        for (int r = 0; r < 4; ++r) { const int t = tq * 16 + 4 * g + r; const float pv = (ts <= tq && s <= t) ? acc[r] : 0.f; ((LAS bf16_t*)PS)[t * 72 + s] = f2bf(pv); } } }
    __syncthreads();
#pragma unroll
    for (int i = 0; i < 4; ++i) { const int id = wave + 8 * i; const int tq = id >> 3, tv = id & 7; f32x4 acc = (f32x4){0.f, 0.f, 0.f, 0.f};
#pragma unroll
        for (int kk = 0; kk < 2; ++kk) acc = mfma16(ldfrag(QS, tq * 16 + fr, RS, kk, g), ldfrag(ST, tv * 16 + fr, RS, kk, g), acc);
#pragma unroll
        for (int kk = 0; kk < 2; ++kk) acc = mfma16(ldfrag(PS, tq * 16 + fr, RS, kk, g), ldfrag(VT, tv * 16 + fr, RS, kk, g), acc);
#pragma unroll
        for (int r = 0; r < 4; ++r) OS[(tq * 16 + 4 * g + r) * OSS + tv * 16 + fr] = acc[r]; }
    __syncthreads();
    { const float* hgp = p.in[I_CDHNORM] + j * 512 + h * 128 + sg * 8;
#pragma unroll
      for (int i = 0; i < 2; ++i) { const int tt = (tid + 512 * i) >> 4;
        const f32x4 a0 = *(const LAS f32x4*)(OS + tt * OSS + sg * 8), a1 = *(const LAS f32x4*)(OS + tt * OSS + sg * 8 + 4);
        float hv[8] = {a0[0], a0[1], a0[2], a0[3], a1[0], a1[1], a1[2], a1[3]};
        float ss = 0.f;
#pragma unroll
        for (int e = 0; e < 8; ++e) ss += hv[e] * hv[e];
        ss += __shfl_xor(ss, 1); ss += __shfl_xor(ss, 2); ss += __shfl_xor(ss, 4); ss += __shfl_xor(ss, 8);
        const float rn = 1.0f / sqrtf(ss * (1.0f / 128.0f) + 1e-6f);
        float y[8];
#pragma unroll
        for (int e = 0; e < 8; ++e) y[e] = hv[e] * rn * hgp[e] * siluf_(bfe(rin[i], e));
        u32x4 w; w.x = pk2(y[0], y[1]); w.y = pk2(y[2], y[3]); w.z = pk2(y[4], y[5]); w.w = pk2(y[6], y[7]);
        *(u32x4*)(YMIX + (size_t)(tok0 + tt) * D + h * 128 + sg * 8) = w; } }
    __syncthreads();
}
constexpr int L_BKT8 = 134144, L_RELB = 138240;
__device__ __forceinline__ void load_attn_tables(const Params& p, LAS unsigned char* lds) {
    const int* bkt = (const int*)(p.ws + WS_BKT);
    for (int i = TID; i < 4096; i += NTHR) lds[L_BKT8 + i] = (unsigned char)bkt[i];
    if (TID < 256) ((LAS float*)(lds + L_RELB))[TID] = p.in[I_RELB][TID];
}
__device__ __forceinline__ int scan_add_i(int v, int lane) {
#pragma unroll
    for (int o = 1; o < 64; o <<= 1) { const int t = __shfl_up(v, o); if (lane >= o) v += t; }
    return v;
}
__device__ __forceinline__ unsigned keep_lowest(unsigned m, int n) {
    if (n <= 0) return 0u;
    while ((int)__popc(m) > n) m &= ~(1u << (31 - __clz((int)m)));
    return m;
}
__device__ __forceinline__ bf16x4 tr_read(unsigned lds_addr) { bf16x4 r; asm volatile("ds_read_b64_tr_b16 %0, %1\n\ts_waitcnt lgkmcnt(0)" : "=&v"(r) : "v"(lds_addr) : "memory"); return r; }
__device__ __forceinline__ unsigned sortable(float f) { const unsigned u = __float_as_uint(f); return (u & 0x80000000u) ? ~u : (u | 0x80000000u); }

__device__ __forceinline__ void unit_dsa(const Params& p, LAS unsigned char* lds, int b, int ti) {
    const int tid = ltid(), lane = tid & 63, wave = __builtin_amdgcn_readfirstlane(tid >> 6), fr = lane & 15, g = lane >> 4;
    LAS unsigned* HIST = (LAS unsigned*)lds; LAS unsigned char* GBUF = lds;
    LAS unsigned* GTM = (LAS unsigned*)(lds + 69632); LAS unsigned* EQM = (LAS unsigned*)(lds + 77824);
    LAS unsigned short* SEL = (LAS unsigned short*)(lds + 86016); LAS unsigned char* QAB = lds + 94208;
    LAS int* MISC = (LAS int*)(lds + 126976);
    const LAS unsigned char* BKT8 = lds + L_BKT8; const LAS float* RELB = (const LAS float*)(lds + L_RELB);
    const bf16_t* P = (const bf16_t*)(p.ws + WS_P); const float* SP = (const float*)(p.ws + WS_SP); bf16_t* YMIX = (bf16_t*)(p.ws + WS_YMIX);
    const bf16_t* WUK = (const bf16_t*)(p.ws + WS_WUK); const bf16_t* WUV = (const bf16_t*)(p.ws + WS_WUV);
    const int t0 = ti * 16; const size_t rowb = (size_t)b * SEQ;
    for (int i = tid; i < 4096; i += NTHR) ((LAS u32x4*)HIST)[i] = (u32x4){0u, 0u, 0u, 0u};
    { const int h = wave; f32x4 acc[8];
#pragma unroll
      for (int rt = 0; rt < 8; ++rt) acc[rt] = (f32x4){0.f, 0.f, 0.f, 0.f};
#pragma unroll
      for (int kk = 0; kk < 2; ++kk) { const bf16x8 a = *(const bf16x8*)(P + (rowb + t0 + fr) * NP_AB + AB_QB + h * 64 + kk * 32 + g * 8);
#pragma unroll
        for (int rt = 0; rt < 8; ++rt) { const bf16x8 bw = *(const bf16x8*)(WUK + ((size_t)(rt * 16 + fr) * 8 + h) * 64 + kk * 32 + g * 8); acc[rt] = mfma16(a, bw, acc[rt]); } }
#pragma unroll
      for (int rt = 0; rt < 8; ++rt)
#pragma unroll
        for (int r = 0; r < 4; ++r) ((LAS bf16_t*)QAB)[((4 * g + r) * 8 + h) * 128 + rt * 16 + fr] = f2bf(acc[rt][r] * 0.125f); }
    bf16x8 qf[4][2];
#pragma unroll
    for (int hh = 0; hh < 4; ++hh)
#pragma unroll
        for (int kk = 0; kk < 2; ++kk) qf[hh][kk] = *(const bf16x8*)(P + (rowb + t0 + fr) * NP_AB + AB_QI + hh * 64 + kk * 32 + g * 8);
    float wq[4];
#pragma unroll
    for (int hh = 0; hh < 4; ++hh) wq[hh] = SP[(rowb + t0 + fr) * 16 + 8 + hh] * 0.5f;
    const int tq = t0 + fr; const int nkt = ti + 1;
    if (tid < 16) { MISC[tid] = 0; MISC[16 + tid] = 256; MISC[48 + tid] = 0; }
    __syncthreads();
#pragma unroll 1
    for (int pass = 0; pass < 4; ++pass) {
        const unsigned pfx = (unsigned)MISC[fr], tau = (unsigned)MISC[48 + fr];
#pragma unroll 1
        for (int kt = wave; kt < nkt; kt += 8) {
            const bf16x8 k0 = *(const bf16x8*)(P + (rowb + kt * 16 + fr) * NP_AB + AB_KI + g * 8), k1 = *(const bf16x8*)(P + (rowb + kt * 16 + fr) * NP_AB + AB_KI + 32 + g * 8);
            f32x4 sc = (f32x4){0.f, 0.f, 0.f, 0.f};
#pragma unroll
            for (int hh = 0; hh < 4; ++hh) { f32x4 a = (f32x4){0.f, 0.f, 0.f, 0.f}; a = mfma16(k0, qf[hh][0], a); a = mfma16(k1, qf[hh][1], a);
#pragma unroll
                for (int r = 0; r < 4; ++r) sc[r] = fmaf(fmaxf(a[r], 0.f), wq[hh], sc[r]); }
            unsigned gtb = 0u, eqb = 0u;
#pragma unroll
            for (int r = 0; r < 4; ++r) { const int s = kt * 16 + 4 * g + r; const bool valid = s <= tq; const unsigned key = sortable(sc[r]);
                if (pass == 0) { if (valid) { const unsigned bin = key >> 21; __hip_atomic_fetch_add(HIST + fr * 1024 + (bin >> 1), 1u << ((bin & 1u) * 16u), __ATOMIC_RELAXED, __HIP_MEMORY_SCOPE_WORKGROUP); } }
                else if (pass == 1) { if (valid && (key >> 21) == pfx) { const unsigned bin = (key >> 10) & 2047u; __hip_atomic_fetch_add(HIST + fr * 1024 + (bin >> 1), 1u << ((bin & 1u) * 16u), __ATOMIC_RELAXED, __HIP_MEMORY_SCOPE_WORKGROUP); } }
                else if (pass == 2) { if (valid && (key >> 10) == pfx) { const unsigned bin = key & 1023u; __hip_atomic_fetch_add(HIST + fr * 1024 + (bin >> 1), 1u << ((bin & 1u) * 16u), __ATOMIC_RELAXED, __HIP_MEMORY_SCOPE_WORKGROUP); } }
                else { if (valid && key > tau) gtb |= 1u << r; if (valid && key == tau) eqb |= 1u << r; } }
            if (pass == 3) { const int word = kt >> 1, sh = (kt & 1) * 16 + 4 * g;
                if (gtb) __hip_atomic_fetch_or(GTM + fr * 128 + word, gtb << sh, __ATOMIC_RELAXED, __HIP_MEMORY_SCOPE_WORKGROUP);
                if (eqb) __hip_atomic_fetch_or(EQM + fr * 128 + word, eqb << sh, __ATOMIC_RELAXED, __HIP_MEMORY_SCOPE_WORKGROUP); }
        }
        __syncthreads();
        if (pass < 3) {
#pragma unroll 1
            for (int qq = 0; qq < 2; ++qq) { const int q = wave * 2 + qq; const int nq = t0 + q + 1;
                if (nq > 256) {
                    const int R = MISC[16 + q]; const int lo = 2016 - 32 * lane;
                    u32x4 w[4];
#pragma unroll
                    for (int i = 0; i < 4; ++i) w[i] = *(const LAS u32x4*)(HIST + q * 1024 + (lo >> 1) + 4 * i);
                    int sl = 0;
#pragma unroll
                    for (int i = 0; i < 4; ++i)
#pragma unroll
                        for (int c = 0; c < 4; ++c) sl += (int)(w[i][c] & 0xffffu) + (int)(w[i][c] >> 16);
                    const int cum = scan_add_i(sl, lane);
                    const unsigned long long mk = __ballot(cum >= R);
                    const int Ls = mk ? (int)__ffsll((long long)mk) - 1 : 63;
                    int c = cum - sl, fbin = lo, above = c; bool found = false;
#pragma unroll
                    for (int i = 3; i >= 0; --i)
#pragma unroll
                        for (int cc = 3; cc >= 0; --cc) {
                            const int hhi = (int)(w[i][cc] >> 16), hlo = (int)(w[i][cc] & 0xffffu); const int bhi = lo + (4 * i + cc) * 2 + 1;
                            if (!found && c + hhi >= R) { found = true; fbin = bhi; above = c; } c += hhi;
                            if (!found && c + hlo >= R) { found = true; fbin = bhi - 1; above = c; } c += hlo; }
                    const int fb = __shfl(fbin, Ls), ab = __shfl(above, Ls);
                    if (lane == 0) { const unsigned old = (unsigned)MISC[q];
                        if (pass == 0) MISC[q] = fb; else if (pass == 1) MISC[q] = (int)((old << 11) | (unsigned)fb); else MISC[48 + q] = (int)((old << 10) | (unsigned)fb);
                        MISC[16 + q] = R - ab; }
                } else if (lane == 0) { MISC[48 + q] = 0; MISC[16 + q] = 1 << 20; }
            }
            __syncthreads();
            if (pass < 2) { for (int i = tid; i < 4096; i += NTHR) ((LAS u32x4*)HIST)[i] = (u32x4){0u, 0u, 0u, 0u}; }
            else { for (int i = tid; i < 4096; i += NTHR) GTM[i] = 0u; }
            __syncthreads();
        }
    }
#pragma unroll 1
    for (int qq = 0; qq < 2; ++qq) { const int q = wave * 2 + qq; const int R = MISC[16 + q];
        const unsigned g0 = GTM[q * 128 + 2 * lane], g1 = GTM[q * 128 + 2 * lane + 1], e0 = EQM[q * 128 + 2 * lane], e1 = EQM[q * 128 + 2 * lane + 1];
        const int tc = (int)__popc(e0) + (int)__popc(e1); const int tpre = scan_add_i(tc, lane) - tc;
        const unsigned s0 = g0 | keep_lowest(e0, R - tpre), s1 = g1 | keep_lowest(e1, R - tpre - (int)__popc(e0));
        const int c = (int)__popc(s0) + (int)__popc(s1); const int incl = scan_add_i(c, lane); int pos = incl - c;
        unsigned m = s0; while (m) { const int bit = __ffs((int)m) - 1; m &= m - 1u; if (pos < 256) SEL[q * 256 + pos] = (unsigned short)(lane * 64 + bit); ++pos; }
        m = s1; while (m) { const int bit = __ffs((int)m) - 1; m &= m - 1u; if (pos < 256) SEL[q * 256 + pos] = (unsigned short)(lane * 64 + 32 + bit); ++pos; }
        const int total = __shfl(incl, 63);
        if (lane == 0) MISC[32 + q] = total < 256 ? total : 256;
    }
    __syncthreads();
    LAS unsigned char* gb = GBUF + wave * 8704;
    const unsigned gba = (unsigned)(unsigned long long)gb;
#pragma unroll 1
    for (int qq = 0; qq < 2; ++qq) { const int q = wave * 2 + qq; const int count = MISC[32 + q]; const int tpos = t0 + q; const int nch = (count + 31) >> 5;
        bf16x8 qh[4];
#pragma unroll
        for (int kk = 0; kk < 4; ++kk) { const bf16x8 v = *(const LAS bf16x8*)(QAB + ((q * 8 + (fr & 7)) * 128 + kk * 32 + g * 8) * 2); qh[kk] = (fr < 8) ? v : (bf16x8){0, 0, 0, 0, 0, 0, 0, 0}; }
        float m_run = -1e30f, l_part = 0.f; f32x4 ao[8];
#pragma unroll
        for (int rt = 0; rt < 8; ++rt) ao[rt] = (f32x4){0.f, 0.f, 0.f, 0.f};
#pragma unroll 1
        for (int c = 0; c < nch; ++c) {
            u32x4 gv[8];
#pragma unroll
            for (int it = 0; it < 8; ++it) { const int slot = c * 32 + g + 4 * it; const int idx = SEL[q * 256 + (slot < count ? slot : 0)];
                gv[it] = *(const u32x4*)(P + (rowb + idx) * NP_AB + AB_CKV + fr * 8); }
#pragma unroll
            for (int it = 0; it < 8; ++it) *(LAS u32x4*)(gb + (g + 4 * it) * 272 + fr * 16) = gv[it];
            asm volatile("s_waitcnt lgkmcnt(0)" ::: "memory");
            float lg[2][4];
#pragma unroll
            for (int k2 = 0; k2 < 2; ++k2) { f32x4 a = (f32x4){0.f, 0.f, 0.f, 0.f};
#pragma unroll
                for (int kk = 0; kk < 4; ++kk) a = mfma16(*(const LAS bf16x8*)(gb + (k2 * 16 + fr) * 272 + (kk * 32 + g * 8) * 2), qh[kk], a);
#pragma unroll
                for (int r = 0; r < 4; ++r) { const int slot = c * 32 + k2 * 16 + 4 * g + r; const bool valid = slot < count; const int sidx = SEL[q * 256 + (valid ? slot : 0)];
                    const int dist = tpos - sidx; const float bias = RELB[(int)BKT8[dist < 0 ? 0 : dist] * 8 + (fr & 7)];
                    lg[k2][r] = (valid && dist >= 0) ? a[r] + bias : -1e30f; } }
            float ml = fmaxf(fmaxf(fmaxf(lg[0][0], lg[0][1]), fmaxf(lg[0][2], lg[0][3])), fmaxf(fmaxf(lg[1][0], lg[1][1]), fmaxf(lg[1][2], lg[1][3])));
            ml = fmaxf(ml, __shfl_xor(ml, 16)); ml = fmaxf(ml, __shfl_xor(ml, 32));
            const float m_new = fmaxf(m_run, ml); const float alpha = __expf(m_run - m_new);
            float pr[2][4]; float ps = 0.f;
#pragma unroll
            for (int k2 = 0; k2 < 2; ++k2)
#pragma unroll
                for (int r = 0; r < 4; ++r) { pr[k2][r] = __expf(lg[k2][r] - m_new); ps += pr[k2][r]; }
            l_part = l_part * alpha + ps; m_run = m_new;
            bf16x8 pf;
#pragma unroll
            for (int r = 0; r < 4; ++r) { pf[r] = (short)f2bf(pr[0][r]); pf[4 + r] = (short)f2bf(pr[1][r]); }
#pragma unroll
            for (int rt = 0; rt < 8; ++rt) { ao[rt] = ao[rt] * alpha;
                const bf16x4 lo = tr_read(gba + (unsigned)((4 * g + (fr >> 2)) * 272 + (rt * 16 + 4 * (fr & 3)) * 2));
                const bf16x4 hi = tr_read(gba + (unsigned)((16 + 4 * g + (fr >> 2)) * 272 + (rt * 16 + 4 * (fr & 3)) * 2));
                bf16x8 af; af[0] = lo[0]; af[1] = lo[1]; af[2] = lo[2]; af[3] = lo[3]; af[4] = hi[0]; af[5] = hi[1]; af[6] = hi[2]; af[7] = hi[3];
                ao[rt] = mfma16(af, pf, ao[rt]); }
        }
        float l = l_part; l += __shfl_xor(l, 16); l += __shfl_xor(l, 32);
        const float inv = 1.0f / l;
        if (fr < 8) {
#pragma unroll
            for (int rt = 0; rt < 8; ++rt) { u32x2 w; w.x = pk2(ao[rt][0] * inv, ao[rt][1] * inv); w.y = pk2(ao[rt][2] * inv, ao[rt][3] * inv);
                *(LAS u32x2*)(QAB + ((q * 8 + fr) * 128 + rt * 16 + 4 * g) * 2) = w; } }
    }
    __syncthreads();
    { const int h = wave; f32x4 acc[4];
#pragma unroll
      for (int nt = 0; nt < 4; ++nt) acc[nt] = (f32x4){0.f, 0.f, 0.f, 0.f};
#pragma unroll
      for (int kk = 0; kk < 4; ++kk) { const bf16x8 a = *(const LAS bf16x8*)(QAB + ((fr * 8 + h) * 128 + kk * 32 + g * 8) * 2);
#pragma unroll
        for (int nt = 0; nt < 4; ++nt) { const bf16x8 bw = *(const bf16x8*)(WUV + ((size_t)(h * 64 + nt * 16 + fr)) * 128 + kk * 32 + g * 8); acc[nt] = mfma16(a, bw, acc[nt]); } }
#pragma unroll
      for (int nt = 0; nt < 4; ++nt)
#pragma unroll
        for (int r = 0; r < 4; ++r) YMIX[(rowb + t0 + 4 * g + r) * D + 512 + h * 64 + nt * 16 + fr] = f2bf(acc[nt][r]); }
    __syncthreads();
}

__device__ __forceinline__ void unit_dil(const Params& p, LAS unsigned char* lds, int b, int h, int pat, int res, int n) {
    const int tid = ltid(), lane = tid & 63, wave = __builtin_amdgcn_readfirstlane(tid >> 6), fr = lane & 15, g = lane >> 4;
    LAS unsigned char* KS2 = lds; LAS unsigned char* VT2 = lds + 36864;
    const LAS unsigned char* BKT8 = lds + L_BKT8; const LAS float* RELB = (const LAS float*)(lds + L_RELB);
    const bf16_t* P = (const bf16_t*)(p.ws + WS_P);
    const int d = (pat == 0) ? 1 : (pat == 1 ? 4 : 16);
    const size_t rowb = (size_t)b * SEQ;
    bf16_t* OP = (bf16_t*)(p.ws + (pat == 0 ? WS_HBF : (pat == 1 ? WS_HBF + 32 * MiB : WS_H1)));
    float* LSE = (float*)(p.ws + WS_H1 + 32 * MiB) + (size_t)pat * NTOK * 8;
    { const int row = tid >> 1, half = tid & 1; const int jsub = 128 * (n - 1) + row; const bool ok = jsub >= 0;
      const size_t tok = rowb + (size_t)(ok ? jsub : 0) * d + res;
      u32x4 kv[4], vv[4];
#pragma unroll
      for (int q = 0; q < 4; ++q) { kv[q] = *(const u32x4*)(P + tok * NP_CD + CD_KD + h * 64 + half * 32 + q * 8); vv[q] = *(const u32x4*)(P + tok * NP_CD + CD_VD + h * 64 + half * 32 + q * 8); }
#pragma unroll
      for (int q = 0; q < 4; ++q) { if (!ok) { kv[q] = (u32x4){0u, 0u, 0u, 0u}; vv[q] = (u32x4){0u, 0u, 0u, 0u}; }
          *(LAS u32x4*)(KS2 + row * 144 + (half * 32 + q * 8) * 2) = kv[q];
#pragma unroll
          for (int e = 0; e < 4; ++e) { const unsigned w = vv[q][e]; const int dv = half * 32 + q * 8 + 2 * e;
              ((LAS bf16_t*)VT2)[dv * 264 + row] = (bf16_t)(w & 0xffffu); ((LAS bf16_t*)VT2)[(dv + 1) * 264 + row] = (bf16_t)(w >> 16); } } }
    __syncthreads();
    const int qi = 128 * n + 16 * wave + fr; const size_t qtok = rowb + (size_t)qi * d + res;
    bf16x8 qf[2];
#pragma unroll
    for (int kk = 0; kk < 2; ++kk) qf[kk] = *(const bf16x8*)(P + qtok * NP_CD + CD_QD + h * 64 + kk * 32 + g * 8);
    const int ql = 128 + 16 * wave + fr;
    float m_run = -1e30f, l_part = 0.f; f32x4 ao[4];
#pragma unroll
    for (int vt = 0; vt < 4; ++vt) ao[vt] = (f32x4){0.f, 0.f, 0.f, 0.f};
#pragma unroll 1
    for (int c = 0; c < 5; ++c) { const int kl0 = 16 * wave + 32 * c;
        float lg[2][4];
#pragma unroll
        for (int k2 = 0; k2 < 2; ++k2) {
            if (c == 4 && k2 == 1) {
#pragma unroll
                for (int r = 0; r < 4; ++r) lg[k2][r] = -1e30f;
            } else { f32x4 a = (f32x4){0.f, 0.f, 0.f, 0.f};
#pragma unroll
                for (int kk = 0; kk < 2; ++kk) a = mfma16(ldfrag(KS2, kl0 + k2 * 16 + fr, 144, kk, g), qf[kk], a);
#pragma unroll
                for (int r = 0; r < 4; ++r) { const int kl = kl0 + k2 * 16 + 4 * g + r; const int tap = ql - kl; const bool ok = tap >= 0 && tap <= 128 && (n > 0 || kl >= 128);
                    const int tc = ok ? tap : 0; const float bias = RELB[(int)BKT8[tc * d] * 8 + h];
                    lg[k2][r] = ok ? a[r] * 0.125f + bias : -1e30f; } } }
        float ml = fmaxf(fmaxf(fmaxf(lg[0][0], lg[0][1]), fmaxf(lg[0][2], lg[0][3])), fmaxf(fmaxf(lg[1][0], lg[1][1]), fmaxf(lg[1][2], lg[1][3])));
        ml = fmaxf(ml, __shfl_xor(ml, 16)); ml = fmaxf(ml, __shfl_xor(ml, 32));
        const float m_new = fmaxf(m_run, ml); const float alpha = __expf(m_run - m_new);
        float pr[2][4]; float ps = 0.f;
#pragma unroll
        for (int k2 = 0; k2 < 2; ++k2)
#pragma unroll
            for (int r = 0; r < 4; ++r) { pr[k2][r] = (lg[k2][r] > -1e29f) ? __expf(lg[k2][r] - m_new) : 0.f; ps += pr[k2][r]; }
        l_part = l_part * alpha + ps; m_run = m_new;
        bf16x8 pf;
#pragma unroll
        for (int r = 0; r < 4; ++r) { pf[r] = (short)f2bf(pr[0][r]); pf[4 + r] = (short)f2bf(pr[1][r]); }
#pragma unroll
        for (int vt = 0; vt < 4; ++vt) { ao[vt] = ao[vt] * alpha;
            const bf16x4 lo = *(const LAS bf16x4*)(VT2 + (vt * 16 + fr) * 528 + (kl0 + 4 * g) * 2);
            bf16x4 hi = (bf16x4){0, 0, 0, 0};
            if (c < 4) hi = *(const LAS bf16x4*)(VT2 + (vt * 16 + fr) * 528 + (kl0 + 16 + 4 * g) * 2);
            bf16x8 af; af[0] = lo[0]; af[1] = lo[1]; af[2] = lo[2]; af[3] = lo[3]; af[4] = hi[0]; af[5] = hi[1]; af[6] = hi[2]; af[7] = hi[3];
            ao[vt] = mfma16(af, pf, ao[vt]); }
    }
    float l = l_part; l += __shfl_xor(l, 16); l += __shfl_xor(l, 32);
    const float inv = 1.0f / l;
#pragma unroll
    for (int vt = 0; vt < 4; ++vt) { u32x2 w; w.x = pk2(ao[vt][0] * inv, ao[vt][1] * inv); w.y = pk2(ao[vt][2] * inv, ao[vt][3] * inv);
        *(u32x2*)(OP + qtok * 512 + h * 64 + vt * 16 + 4 * g) = w; }
    if (g == 0) LSE[qtok * 8 + h] = m_run + __logf(l);
    __syncthreads();
}

__device__ __forceinline__ void phase_dil_combine(const Params& p) {
    const bf16_t* O0 = (const bf16_t*)(p.ws + WS_HBF); const bf16_t* O1 = (const bf16_t*)(p.ws + WS_HBF + 32 * MiB); const bf16_t* O2 = (const bf16_t*)(p.ws + WS_H1);
    const float* LSE = (const float*)(p.ws + WS_H1 + 32 * MiB); bf16_t* YMIX = (bf16_t*)(p.ws + WS_YMIX);
    for (int idx = blockIdx.x * NTHR + TID; idx < NTOK * 64; idx += gridDim.x * NTHR) {
        const int tok = idx >> 6, h = (idx >> 3) & 7, dg = idx & 7;
        const float l0 = LSE[(size_t)tok * 8 + h], l1 = LSE[(size_t)NTOK * 8 + (size_t)tok * 8 + h], l2 = LSE[(size_t)2 * NTOK * 8 + (size_t)tok * 8 + h];
        const float mx = fmaxf(l0, fmaxf(l1, l2)); const float w0 = __expf(l0 - mx), w1 = __expf(l1 - mx), w2 = __expf(l2 - mx); const float inv = 1.0f / (w0 + w1 + w2);
        const size_t off = (size_t)tok * 512 + h * 64 + dg * 8;
        const u32x4 a = *(const u32x4*)(O0 + off), bq = *(const u32x4*)(O1 + off), c = *(const u32x4*)(O2 + off);
        u32x4 o;
#pragma unroll
        for (int e = 0; e < 4; ++e) {
            const float v0 = (__uint_as_float(a[e] << 16) * w0 + __uint_as_float(bq[e] << 16) * w1 + __uint_as_float(c[e] << 16) * w2) * inv;
            const float v1 = (__uint_as_float(a[e] & 0xffff0000u) * w0 + __uint_as_float(bq[e] & 0xffff0000u) * w1 + __uint_as_float(c[e] & 0xffff0000u) * w2) * inv;
            o[e] = pk2(v0, v1); }
        *(u32x4*)(YMIX + (size_t)tok * D + 512 + h * 64 + dg * 8) = o;
    }
}

__device__ __forceinline__ int grab_unit(unsigned* ctr, LAS int* slot) {
    __syncthreads();
    if (TID == 0) *slot = (int)__hip_atomic_fetch_add(ctr, 1u, __ATOMIC_RELAXED, __HIP_MEMORY_SCOPE_AGENT);
    __syncthreads();
    return *slot;
}
__device__ __forceinline__ void phase_rec_L(const Params& p, LAS unsigned char* lds, int j, bool is_ab) {
    for (int u = blockIdx.x; u < 2048; u += gridDim.x) { const int bh = u >> 6, ck = u & 63;
        if (is_ab) unit_mlstm_L(p, lds, j, bh >> 2, bh & 3, ck); else unit_gla_L(p, lds, j, bh >> 2, bh & 3, ck); }
}
__device__ __forceinline__ void phase_mixer_ab(const Params& p, LAS unsigned char* lds, int j, unsigned* ctr, int nrec = 2048) {
    LAS int* slot = (LAS int*)(lds + LDS_PERS + LP_SLOT);
    load_attn_tables(p, lds);
    for (;;) { const int u = grab_unit(ctr, slot);
        if (u >= 2048 + nrec) break;
        if (u < 2048) unit_dsa(p, lds, u & 7, 255 - (u >> 3));
        else { const int k = u - 2048; const int bh = k >> 6; unit_mlstm_O(p, lds, j, bh >> 2, bh & 3, k & 63); } }
}
__device__ __forceinline__ void phase_mixer_cd(const Params& p, LAS unsigned char* lds, int j, unsigned* ctr, int nrec = 2048) {
    LAS int* slot = (LAS int*)(lds + LDS_PERS + LP_SLOT);
    load_attn_tables(p, lds);
    for (;;) { const int u = grab_unit(ctr, slot);
        if (u >= 6144 + nrec) break;
        if (u < 6144) { const int k = u; const int n32 = k & 31, pat = (k >> 5) % 3, bh = k / 96;
            int res, n; if (pat == 0) { res = 0; n = n32; } else if (pat == 1) { res = n32 >> 3; n = n32 & 7; } else { res = n32 >> 1; n = n32 & 1; }
            unit_dil(p, lds, bh >> 3, bh & 7, pat, res, n); }
        else { const int k = u - 6144; const int bh = k >> 6; unit_gla_O(p, lds, j, bh >> 2, bh & 3, k & 63); } }
}
__global__ void __launch_bounds__(NTHR, 2) hybrid_fwd(Params p) {
    extern __shared__ __attribute__((aligned(16))) unsigned char lds_raw[];
    LAS unsigned char* lds = (LAS unsigned char*)lds_raw;
    const int tid = TID, G = gridDim.x;
    for (int i = tid; i < (LDS_TOTAL - LDS_PERS) / 4; i += NTHR) ((LAS unsigned*)(lds + LDS_PERS))[i] = 0u;
    __syncthreads();
    unsigned* ctl = (unsigned*)(p.ws + WS_CTL);
    XcdBarrier bar = xcd_barrier_post(ctl + CW_BAR, (volatile LAS unsigned*)(lds + LDS_PERS));
    LAS int* tbase = (LAS int*)(lds + LDS_PERS + LP_TBASE);

    p0_prologue(p, lds);
    __syncthreads();
#pragma unroll 1
    for (int l = 0; l < DEPTH; ++l) {
        const bool is_ab = (l & 1) == 0; const int j = l >> 1;
        prep_layer(p, lds, l);
#if DBL == 1
        __syncthreads(); prep_layer(p, lds, l);
#endif
        if (l == 0) xcd_barrier(bar);
        __syncthreads();
        phase_norm1(p, lds, l);
        xcd_barrier(bar);
        {
            const int N = is_ab ? NP_AB : NP_CD;
            pg8::Gemm gm{(const bf16_t*)(p.ws + WS_HBF), (const bf16_t*)(p.ws + WS_WIN), NTOK, N, D};
            pg8::StaticOrder S; S.init(NTOK, N, G, (int)blockIdx.x);
            pg8::EpiBf16<false> E{(bf16_t*)(p.ws + WS_P), N};
            pg8::gemm_phase(lds, gm, S, E);
#if DBL == 3
            pg8::gemm_phase(lds, gm, S, E);
#endif
        }
        xcd_barrier(bar);
        phase_rec_L(p, lds, j, is_ab);
#if DBL == 11
        __syncthreads(); phase_rec_L(p, lds, j, is_ab);
#endif
        xcd_barrier(bar);
        if (is_ab) phase_scan_mlstm(p); else phase_scan_gla(p);
#if DBL == 12
        xcd_barrier(bar); if (is_ab) phase_scan_mlstm(p); else phase_scan_gla(p);
#endif
        xcd_barrier(bar);
        if (is_ab) { phase_mixer_ab(p, lds, j, ctl + CW_WQ + 64 * l);
#if DBL == 4
            xcd_barrier(bar); phase_mixer_ab(p, lds, j, ctl + CW_WQ + 64 * (l + 4));
#endif
#if DBL == 9
            xcd_barrier(bar); phase_mixer_ab(p, lds, j, ctl + CW_WQ + 64 * (l + 4), 0);
#endif
        } else { phase_mixer_cd(p, lds, j, ctl + CW_WQ + 64 * l); xcd_barrier(bar); phase_dil_combine(p);
#if DBL == 5
            xcd_barrier(bar); phase_mixer_cd(p, lds, j, ctl + CW_WQ + 64 * (l + 4)); xcd_barrier(bar); phase_dil_combine(p);
#endif
#if DBL == 10
            xcd_barrier(bar); phase_mixer_cd(p, lds, j, ctl + CW_WQ + 64 * (l + 4), 0); xcd_barrier(bar); phase_dil_combine(p);
#endif
        }
        xcd_barrier(bar);
        {
            pg8::Gemm gm{(const bf16_t*)(p.ws + WS_YMIX), (const bf16_t*)(p.ws + WS_WOUT), NTOK, D, D};
            pg8::StaticOrder S; S.init(NTOK, D, G, (int)blockIdx.x);
            pg8::EpiOutRes E{(float*)(p.ws + WS_X), (const float*)(p.ws + WS_MOD) + (size_t)l * 8 * 6 * D + 2 * D};
            pg8::gemm_phase(lds, gm, S, E);
        }
        xcd_barrier(bar);
        phase_norm2(p, lds, l);
#if DBL == 2
        xcd_barrier(bar); phase_norm2(p, lds, l);
#endif
        xcd_barrier(bar);
        phase_dispatch(p, lds, tbase);
#if DBL == 6
        xcd_barrier(bar); phase_dispatch(p, lds, tbase);
#endif
        xcd_barrier(bar);
        {
            pg8::Gemm gm{(const bf16_t*)(p.ws + WS_P), (const bf16_t*)(p.ws + WS_WGU), MOE_ROWS, 16 * 1024, D};
            pg8::MoeOrder S{tbase, G, (int)blockIdx.x};
            pg8::EpiMoe1 E{(bf16_t*)(p.ws + WS_H1)};
            pg8::gemm_phase(lds, gm, S, E);
#if DBL == 7
            pg8::gemm_phase(lds, gm, S, E);
#endif
        }
        xcd_barrier(bar);
        {
            pg8::Gemm gm{(const bf16_t*)(p.ws + WS_H1), (const bf16_t*)(p.ws + WS_WDN), MOE_ROWS, 16 * 1024, 512};
            pg8::MoeOrder S{tbase, G, (int)blockIdx.x};
            pg8::EpiBf16<true> E{(bf16_t*)(p.ws + WS_P), D};
            pg8::gemm_phase(lds, gm, S, E);
#if DBL == 8
            pg8::gemm_phase(lds, gm, S, E);
#endif
        }
        xcd_barrier(bar);
    }
    phase_final(p);
}

extern "C" void kernel_launch(void* const* d_in, const int* in_sizes, int n_in, void* d_out, int out_size, void* d_ws, size_t ws_size, hipStream_t stream) {
    static int grid = 0;
    if (grid == 0) {
        if (n_in != 28 || ws_size < WS_END2) { fprintf(stderr, "kernel_launch: unexpected n_in %d / ws_size %zu (need %zu)\n", n_in, ws_size, (size_t)WS_END2); grid = -1; return; }
        int dev = 0, cus = 0, per_cu = 0;
        if (hipGetDevice(&dev) != hipSuccess || hipDeviceGetAttribute(&cus, hipDeviceAttributeMultiprocessorCount, dev) != hipSuccess) { grid = -1; return; }
        if (hipFuncSetAttribute((const void*)hybrid_fwd, hipFuncAttributeMaxDynamicSharedMemorySize, LDS_TOTAL) != hipSuccess) { fprintf(stderr, "kernel_launch: hipFuncSetAttribute failed\n"); grid = -1; return; }
        if (hipOccupancyMaxActiveBlocksPerMultiprocessor(&per_cu, (const void*)hybrid_fwd, NTHR, LDS_TOTAL) != hipSuccess || per_cu < 1) { fprintf(stderr, "kernel_launch: occupancy query says %d\n", per_cu); }
        (void)hipGetLastError();
        grid = cus;
    }
    if (grid < 0) return;
    if (hipMemsetAsync((char*)d_ws + WS_CTL, 0, CTL_BYTES, stream) != hipSuccess) return;
    Params p{};
    for (int i = 0; i < 28; ++i) p.in[i] = (const float*)d_in[i];
    p.out = (float*)d_out; p.ws = (unsigned char*)d_ws;
    hipLaunchKernelGGL(hybrid_fwd, dim3(grid), dim3(NTHR), LDS_TOTAL, stream, p);
}
```

```cpp
#define DBL 0
#define PROF 0
#include <hip/hip_runtime.h>
#include <cstdio>
#include <cstdint>

#define LAS __attribute__((address_space(3)))
typedef unsigned short bf16_t;
typedef short bf16x8 __attribute__((ext_vector_type(8)));
typedef short bf16x4 __attribute__((ext_vector_type(4)));
typedef float f32x4 __attribute__((ext_vector_type(4)));
typedef float f32x2 __attribute__((ext_vector_type(2)));
typedef unsigned u32x4 __attribute__((ext_vector_type(4)));
typedef unsigned u32x2 __attribute__((ext_vector_type(2)));

constexpr int D = 1024, NB = 8, SEQ = 4096, NTOK = NB * SEQ, DEPTH = 4;
constexpr int W_AB = 2508, W_CD = 3088;
constexpr int NP_AB = 2560, NP_CD = 3072;
constexpr int AB_QA = 0, AB_KA = 256, AB_VA = 512, AB_OA = 1024, AB_QB = 1536, AB_CKV = 2048, AB_QI = 2176, AB_KI = 2432;
constexpr int CD_QC = 0, CD_KC = 256, CD_VC = 512, CD_RC = 1024, CD_QD = 1536, CD_KD = 2048, CD_VD = 2560;
constexpr int MOE_ROWS = 2 * NTOK + 16 * 256;

__device__ __forceinline__ int ltid() { int t = (int)threadIdx.x; asm volatile("" : "+v"(t)); return t; }
__device__ __forceinline__ void gload16(u32x4& dst, const void* ptr) { asm volatile("global_load_dwordx4 %0, %1, off" : "=&v"(dst) : "v"(ptr) : "memory"); }
__device__ __forceinline__ float bf2f(bf16_t b) { return __uint_as_float(((unsigned)b) << 16); }
__device__ __forceinline__ unsigned pk2(float lo, float hi) { unsigned r; asm("v_cvt_pk_bf16_f32 %0, %1, %2" : "=v"(r) : "v"(lo), "v"(hi)); return r; }
__device__ __forceinline__ bf16_t f2bf(float f) { return (bf16_t)(pk2(f, 0.f) & 0xffffu); }
__device__ __forceinline__ float wave_sum(float v) {
#pragma unroll
    for (int o = 32; o > 0; o >>= 1) v += __shfl_xor(v, o);
    return v;
}
__device__ __forceinline__ float sigmoidf_(float x) { return 1.0f / (1.0f + __expf(-x)); }
__device__ __forceinline__ float siluf_(float x) { return x / (1.0f + __expf(-x)); }
__device__ __forceinline__ float logsigmoidf_(float x) { return fminf(x, 0.0f) - log1pf(__expf(-fabsf(x))); }

#define XB_TMO      128
#define XB_XCNT(j)  (256  + 64 * (j))
#define XB_XSUB(j)  (1280 + 64 * (j))
#define XB_XGEN(j)  (2304 + 64 * (j))
#define XB_TOP      3328
#define XB_TOPGEN   3392
#define XCD_BAR_WORDS 3456
#define XB_SPIN_CAP (1u << 18)

__device__ __forceinline__ unsigned xb_ld(unsigned* p)              { return __hip_atomic_load(p, __ATOMIC_RELAXED, __HIP_MEMORY_SCOPE_AGENT); }
__device__ __forceinline__ unsigned xb_add(unsigned* p, unsigned v) { return __hip_atomic_fetch_add(p, v, __ATOMIC_RELAXED, __HIP_MEMORY_SCOPE_AGENT); }
__device__ __forceinline__ unsigned xb_xcc_id() { return (unsigned)__builtin_amdgcn_s_getreg((3 << 11) | 20) & 0xFu; }
#define XB_SPIN(cond, bar) do { unsigned _sp = 0; while (cond) { __builtin_amdgcn_s_sleep(1); \
    if ((++_sp & 255u) == 0u) { if (xb_ld(&(bar)[XB_TMO])) break; if (_sp > XB_SPIN_CAP) { atomicAdd(&(bar)[XB_TMO], 1u); break; } } } } while (0)

struct XcdBarrier { unsigned* bar; unsigned x; volatile LAS unsigned* st; };

__device__ __forceinline__ XcdBarrier xcd_barrier_post(unsigned* bar, volatile LAS unsigned* st) {
    XcdBarrier b; b.bar = bar; b.x = xb_xcc_id(); b.st = st;
    if (ltid() == 0) (void)xb_add(&bar[XB_XCNT(b.x)], 1u);
    return b;
}
__device__ __forceinline__ void xcd_barrier_complete(unsigned* bar, unsigned x, unsigned& nloc, unsigned& nx) {
    const unsigned G = gridDim.x * gridDim.y * gridDim.z;
    unsigned sum, cnt, mine, sp = 0u;
    for (;;) {
        sum = 0u; cnt = 0u; mine = 0u;
#pragma unroll
        for (unsigned j = 0; j < 16; ++j) { const unsigned c = xb_ld(&bar[XB_XCNT(j)]); sum += c; cnt += (c > 0u) ? 1u : 0u; mine = (j == x) ? c : mine; }
        if (sum == G) break;
        __builtin_amdgcn_s_sleep(1);
        if ((++sp & 255u) == 0u) { if (xb_ld(&bar[XB_TMO])) break; if (sp > XB_SPIN_CAP) { atomicAdd(&bar[XB_TMO], 1u); break; } }
    }
    nloc = mine > 0u ? mine : 1u; nx = cnt > 0u ? cnt : 1u;
}
__device__ __forceinline__ void xcd_barrier(const XcdBarrier& b) {
    asm volatile("s_waitcnt vmcnt(0)" ::: "memory");
    __syncthreads();
    if (ltid() == 0) {
        unsigned* bar = b.bar;
        __builtin_amdgcn_s_waitcnt(0);
        unsigned nloc = b.st[0], nx = b.st[1];
        if (nloc == 0u) { xcd_barrier_complete(bar, b.x, nloc, nx); b.st[0] = nloc; b.st[1] = nx; }
        const unsigned old = xb_add(&bar[XB_XSUB(b.x)], 1u);
        const unsigned gen = old / nloc;
        if (old + 1u == (gen + 1u) * nloc) {
            __builtin_amdgcn_fence(__ATOMIC_RELEASE, "agent");
            asm volatile("s_waitcnt vmcnt(0)" ::: "memory");
            const unsigned og = xb_add(&bar[XB_TOP], 1u);
            const unsigned tg = og / nx;
            if (og + 1u == (tg + 1u) * nx) xb_add(&bar[XB_TOPGEN], 1u);
            else XB_SPIN(xb_ld(&bar[XB_TOPGEN]) == tg, bar);
            __builtin_amdgcn_fence(__ATOMIC_ACQUIRE, "agent");
            xb_add(&bar[XB_XGEN(b.x)], 1u);
            asm volatile("s_waitcnt vmcnt(0)" ::: "memory");
        } else {
            XB_SPIN(xb_ld(&bar[XB_XGEN(b.x)]) == gen, bar);
            __builtin_amdgcn_fence(__ATOMIC_ACQUIRE, "agent");
            asm volatile("s_waitcnt vmcnt(0)" ::: "memory");
        }
    }
    __syncthreads();
}

namespace pg8 {
constexpr int BM = 256, BK = 64, HALF = 128, HTB = HALF * BK * 2, STAGE_BYTES = 8 * HTB, NXCD = 8, WGM = 8;
__host__ __device__ __forceinline__ int lds_byte(int r, int c) { const int st = (r >> 4) * 2 + (c >> 5), rr = r & 15, cc = c & 31, ob = rr * 64 + cc * 2; return st * 1024 + (ob ^ (((ob >> 9) & 1) << 5)); }
__host__ __device__ __forceinline__ void stage_rc(int b, int& R, int& C) { const int st = b / 1024, sb = b % 1024, swz = sb ^ (((sb >> 9) & 1) << 5); R = (st >> 1) * 16 + swz / 64; C = (st & 1) * 32 + (swz % 64) / 2; }
__host__ __device__ __forceinline__ int perm32(int rho) { const int n = rho >> 4, i = rho & 15; return 8 * (i >> 2) + 4 * n + (i & 3); }

struct Unit { int pm, pn; };
struct Gemm { const bf16_t* A; const bf16_t* Bt; int M, N, K; };

struct StaticOrder {
    int nM, nN, nwg, G, c;
    __host__ __device__ void init(int M, int N, int G_, int c_) { nM = M / BM; nN = N / BM; nwg = nM * nN; G = G_; c = c_; }
    __host__ __device__ bool next(int i, Unit& u) const {
        const long L = (long)i * G + c; if (L >= nwg) return false;
        int wgid = (int)L; { const int q = nwg / NXCD, r = nwg % NXCD, xcd = wgid % NXCD, off = wgid / NXCD; wgid = (xcd < r ? xcd * (q + 1) : r * (q + 1) + (xcd - r) * q) + off; }
        const int nig = WGM * nN, gid = wgid / nig, fm = gid * WGM, gsz = (nM - fm) < WGM ? (nM - fm) : WGM;
        u.pm = fm + ((wgid % nig) % gsz); u.pn = (wgid % nig) / gsz; return true;
    }
    __device__ __forceinline__ void a_ready(const Unit&) const {}
    __device__ __forceinline__ void done(const Unit&) const {}
};
struct MoeOrder {
    const LAS int* tbase;
    int G, c;
    __device__ bool next(int i, Unit& u) const {
        const int L = i * G + c; const int total = tbase[16] * 4; if (L >= total) return false;
        const int pm = L >> 2; int e = 0;
#pragma unroll
        for (int k = 1; k < 16; ++k) e += (pm >= tbase[k]) ? 1 : 0;
        u.pm = pm; u.pn = e * 4 + (L & 3); return true;
    }
    __device__ __forceinline__ void a_ready(const Unit&) const {}
    __device__ __forceinline__ void done(const Unit&) const {}
};

__device__ __forceinline__ unsigned cvt_pk_bf16(float lo, float hi) { unsigned r; asm volatile("v_cvt_pk_bf16_f32 %0, %1, %2" : "=v"(r) : "v"(lo), "v"(hi)); return r; }

template <bool MOE> struct EpiBf16 {
    static constexpr bool PERM = true, AFTER_DRAIN = false;
    bf16_t* O; int ldc;
    __device__ __forceinline__ void operator()(const f32x4 (&acc)[2][2][4][2], const Unit& u, int wr, int wc, int fr, int fq) const {
        const int row0 = u.pm * BM + wr * 64 + fr; const int colt = (MOE ? (u.pn & 3) : u.pn) * BM; const int col0 = colt + wc * 32 + 8 * fq;
#pragma unroll
        for (int ai = 0; ai < 2; ++ai)
#pragma unroll
            for (int m = 0; m < 4; ++m) { bf16_t* rowp = O + (size_t)(row0 + ai * HALF + m * 16) * ldc + col0;
#pragma unroll
                for (int bj = 0; bj < 2; ++bj) { const f32x4 v0 = acc[ai][bj][m][0], v1 = acc[ai][bj][m][1];
                    u32x4 w; w.x = cvt_pk_bf16(v0[0], v0[1]); w.y = cvt_pk_bf16(v0[2], v0[3]); w.z = cvt_pk_bf16(v1[0], v1[1]); w.w = cvt_pk_bf16(v1[2], v1[3]);
                    *(u32x4*)(rowp + bj * HALF) = w; } }
    }
};
struct EpiOutRes {
    static constexpr bool PERM = false, AFTER_DRAIN = false;
    float* X; const float* gate;
    __device__ __forceinline__ void operator()(const f32x4 (&acc)[2][2][4][2], const Unit& u, int wr, int wc, int fr, int fq) const {
        const int row0 = u.pm * BM + wr * 64 + fr, col0 = u.pn * BM + wc * 32 + 4 * fq;
        const float* gp = gate + (size_t)((u.pm * BM) >> 12) * (6 * D) + col0;
        f32x4 gv[2][2];
#pragma unroll
        for (int bj = 0; bj < 2; ++bj)
#pragma unroll
            for (int n = 0; n < 2; ++n) gv[bj][n] = *(const f32x4*)(gp + bj * HALF + n * 16);
#pragma unroll
        for (int ai = 0; ai < 2; ++ai)
#pragma unroll
            for (int m = 0; m < 4; ++m) { float* rowp = X + (size_t)(row0 + ai * HALF + m * 16) * D + col0;
#pragma unroll
                for (int bj = 0; bj < 2; ++bj)
#pragma unroll
                    for (int n = 0; n < 2; ++n) { f32x4* p = (f32x4*)(rowp + bj * HALF + n * 16); *p = *p + gv[bj][n] * acc[ai][bj][m][n]; } }
    }
};
struct EpiMoe1 {
    static constexpr bool PERM = false, AFTER_DRAIN = false;
    bf16_t* H1;
    __device__ __forceinline__ void operator()(const f32x4 (&acc)[2][2][4][2], const Unit& u, int wr, int wc, int fr, int fq) const {
        const int row0 = u.pm * BM + wr * 64 + fr, col0 = (u.pn & 3) * 128 + wc * 16 + 4 * fq;
#pragma unroll
        for (int ai = 0; ai < 2; ++ai)
#pragma unroll
            for (int m = 0; m < 4; ++m) { bf16_t* rowp = H1 + (size_t)(row0 + ai * HALF + m * 16) * 512 + col0;
#pragma unroll
                for (int bj = 0; bj < 2; ++bj) { const f32x4 g = acc[ai][bj][m][0], up = acc[ai][bj][m][1]; float h[4];
#pragma unroll
                    for (int j = 0; j < 4; ++j) h[j] = g[j] / (1.0f + __expf(-g[j])) * up[j];
                    u32x2 w; w.x = cvt_pk_bf16(h[0], h[1]); w.y = cvt_pk_bf16(h[2], h[3]);
                    *(u32x2*)(rowp + bj * 64) = w; } }
    }
};

template <class Epi, class Sched>
__device__ __forceinline__ void gemm_phase(LAS unsigned char* lds, const Gemm g, const Sched& S, const Epi& E) {
    const int tid = ltid(), wid = __builtin_amdgcn_readfirstlane(tid >> 6), lane = tid & 63, wr = wid >> 2, wc = wid & 3, fr = lane & 15, fq = lane >> 4;
    const int K = g.K, nt = K / BK;
    unsigned voffA[2], voffB[2];
#pragma unroll
    for (int i = 0; i < 2; ++i) { int R, C; stage_rc(tid * 16 + i * 8192, R, C); const int Rb = Epi::PERM ? ((R & ~31) + perm32(R & 31)) : R;
        voffA[i] = (unsigned)(R * K + C) * 2u; voffB[i] = (unsigned)(Rb * K + C) * 2u; }
    const size_t kstep = (size_t)(BK * 2);
    const size_t hstep = (size_t)HALF * K * 2;
    const size_t tstep = 2 * hstep;
    const unsigned ldsw = (unsigned)wid * 1024u;
    const int aoff = lds_byte(wr * 64 + fr, fq * 8), boff = lds_byte(wc * 32 + fr, fq * 8);
#define PG8_SA(b, h) (((b) * 2 + (h)) * HTB)
#define PG8_SB(b, h) ((4 + (b) * 2 + (h)) * HTB)
#define PG8_STAGE(bufoff, gbase, voff) do { _Pragma("unroll") for (int _i = 0; _i < 2; ++_i) \
        __builtin_amdgcn_global_load_lds((const unsigned*)((const char*)(gbase) + (voff)[_i]), (LAS unsigned*)(lds + (bufoff) + ldsw + _i * 8192), 16, 0, 0); } while (0)
#define PG8_LDA(dst, b, h) do { _Pragma("unroll") for (int m = 0; m < 4; ++m) _Pragma("unroll") for (int k = 0; k < 2; ++k) dst[m][k] = *(const LAS bf16x8*)(lds + PG8_SA(b, h) + aoff + m * 2048 + k * 1024); } while (0)
#define PG8_LDB(dst, b, h) do { _Pragma("unroll") for (int n = 0; n < 2; ++n) _Pragma("unroll") for (int k = 0; k < 2; ++k) dst[n][k] = *(const LAS bf16x8*)(lds + PG8_SB(b, h) + boff + n * 2048 + k * 1024); } while (0)
#define PG8_MMA(ai, bj, At, Bt) do { __builtin_amdgcn_s_setprio(1); _Pragma("unroll") for (int m = 0; m < 4; ++m) _Pragma("unroll") for (int n = 0; n < 2; ++n) _Pragma("unroll") for (int k = 0; k < 2; ++k) \
        acc[ai][bj][m][n] = __builtin_amdgcn_mfma_f32_16x16x32_bf16(Bt[n][k], At[m][k], acc[ai][bj][m][n], 0, 0, 0); __builtin_amdgcn_s_setprio(0); } while (0)
#define PG8_WAIT_V(n) asm volatile("s_waitcnt vmcnt(" #n ")" ::: "memory")
#define PG8_WAIT_L(n) asm volatile("s_waitcnt lgkmcnt(" #n ")" ::: "memory")
#define PG8_BAR __builtin_amdgcn_s_barrier()
#define PG8_SCHED __builtin_amdgcn_sched_barrier(0)
    Unit cur, nxt; int ui = 0;
    if (!S.next(0, cur)) return;
    f32x4 acc[2][2][4][2];
#pragma unroll
    for (int a = 0; a < 2; ++a)
#pragma unroll
        for (int b = 0; b < 2; ++b)
#pragma unroll
            for (int m = 0; m < 4; ++m)
#pragma unroll
                for (int n = 0; n < 2; ++n) acc[a][b][m][n] = (f32x4){0.f, 0.f, 0.f, 0.f};
    bf16x8 At[4][2], B0[2][2], B1[2][2];
    const char* cA = (const char*)g.A + (size_t)cur.pm * tstep; const char* cB = (const char*)g.Bt + (size_t)cur.pn * tstep;
    S.a_ready(cur);
    PG8_STAGE(PG8_SB(0, 0), cB, voffB); PG8_STAGE(PG8_SA(0, 0), cA, voffA); PG8_STAGE(PG8_SB(0, 1), cB + hstep, voffB); PG8_STAGE(PG8_SA(0, 1), cA + hstep, voffA);
    if (wr == 1) PG8_BAR;
    PG8_WAIT_V(4); PG8_BAR;
    PG8_STAGE(PG8_SB(1, 0), cB + kstep, voffB); PG8_STAGE(PG8_SA(1, 0), cA + kstep, voffA); PG8_STAGE(PG8_SB(1, 1), cB + hstep + kstep, voffB);
    PG8_WAIT_V(6); PG8_BAR;
    for (;;) {
        const bool has_next = S.next(ui + 1, nxt);
        const char* nA = has_next ? (const char*)g.A + (size_t)nxt.pm * tstep : cA; const char* nB = has_next ? (const char*)g.Bt + (size_t)nxt.pn * tstep : cB;
        for (int t = 0; t < nt; t += 2) {
            const bool last = (t == nt - 2);
            const char* a1 = cA + (size_t)(t + 1) * kstep;
            const char* a2 = last ? nA : cA + (size_t)(t + 2) * kstep; const char* b2 = last ? nB : cB + (size_t)(t + 2) * kstep;
            const char* a3 = a2 + kstep; const char* b3 = b2 + kstep;
            if (last && has_next) S.a_ready(nxt);
            PG8_LDB(B0, 0, 0); PG8_SCHED; PG8_LDA(At, 0, 0); PG8_STAGE(PG8_SA(1, 1), a1 + hstep, voffA);
            PG8_WAIT_L(8); PG8_BAR; PG8_WAIT_L(0); PG8_MMA(0, 0, At, B0); PG8_BAR; PG8_SCHED;
            PG8_LDB(B1, 0, 1); PG8_STAGE(PG8_SB(0, 0), b2, voffB);
            PG8_BAR; PG8_WAIT_L(0); PG8_MMA(0, 1, At, B1); PG8_BAR;
            PG8_LDA(At, 0, 1); PG8_STAGE(PG8_SA(0, 0), a2, voffA);
            PG8_BAR; PG8_WAIT_L(0); PG8_MMA(1, 0, At, B0); PG8_BAR; PG8_SCHED;
            PG8_STAGE(PG8_SB(0, 1), b2 + hstep, voffB);
            PG8_WAIT_V(6); PG8_BAR; PG8_MMA(1, 1, At, B1); PG8_BAR;
            PG8_LDB(B0, 1, 0); PG8_SCHED; PG8_LDA(At, 1, 0); PG8_STAGE(PG8_SA(0, 1), a2 + hstep, voffA);
            PG8_WAIT_L(8); PG8_BAR; PG8_WAIT_L(0); PG8_MMA(0, 0, At, B0); PG8_BAR; PG8_SCHED;
            PG8_LDB(B1, 1, 1); PG8_STAGE(PG8_SB(1, 0), b3, voffB);
            PG8_BAR; PG8_WAIT_L(0); PG8_MMA(0, 1, At, B1); PG8_BAR;
            PG8_LDA(At, 1, 1); PG8_STAGE(PG8_SA(1, 0), a3, voffA);
            PG8_BAR; PG8_WAIT_L(0); PG8_MMA(1, 0, At, B0); PG8_BAR; PG8_SCHED;
            PG8_STAGE(PG8_SB(1, 1), b3 + hstep, voffB);
            PG8_WAIT_V(6); PG8_BAR; PG8_MMA(1, 1, At, B1); PG8_BAR;
        }
        E(acc, cur, wr, wc, fr, fq); S.done(cur);
        if (!has_next) break;
#pragma unroll
        for (int a = 0; a < 2; ++a)
#pragma unroll
            for (int b = 0; b < 2; ++b)
#pragma unroll
                for (int m = 0; m < 4; ++m)
#pragma unroll
                    for (int n = 0; n < 2; ++n) acc[a][b][m][n] = (f32x4){0.f, 0.f, 0.f, 0.f};
        cur = nxt; cA = nA; cB = nB; ++ui;
    }
    PG8_WAIT_V(0);
    if (wr == 0) PG8_BAR;
    PG8_BAR;
#undef PG8_SA
#undef PG8_SB
#undef PG8_STAGE
#undef PG8_LDA
#undef PG8_LDB
#undef PG8_MMA
#undef PG8_WAIT_V
#undef PG8_WAIT_L
#undef PG8_BAR
#undef PG8_SCHED
}
}
constexpr size_t MiB = 1024 * 1024;
constexpr size_t WS_CTL  = 0;
constexpr size_t CTL_BYTES = 65536;
constexpr size_t WS_MOD  = WS_CTL + CTL_BYTES;
constexpr size_t WS_BKT  = WS_MOD + 4 * 8 * 6144 * 4;
constexpr size_t WS_SP   = WS_BKT + 4096 * 4;
constexpr size_t WS_RTE  = WS_SP + (size_t)NTOK * 16 * 4;
constexpr size_t WS_RTW  = WS_RTE + (size_t)NTOK * 4;
constexpr size_t WS_POS  = WS_RTW + (size_t)NTOK * 8;
constexpr size_t WS_TC   = WS_POS + (size_t)NTOK * 8;
constexpr size_t WS_WUK  = WS_TC + 256 * 16 * 4;
constexpr size_t WS_WUV  = WS_WUK + 65536 * 2;
constexpr size_t WS_X    = 4 * MiB;
constexpr size_t WS_HBF  = WS_X + 128 * MiB;
constexpr size_t WS_P    = WS_HBF + 64 * MiB;
constexpr size_t WS_YMIX = WS_P + 192 * MiB;
constexpr size_t WS_H1   = WS_YMIX + 64 * MiB;
constexpr size_t WS_WIN  = WS_H1 + 68 * MiB;
constexpr size_t WS_WOUT = WS_WIN + 6 * MiB;
constexpr size_t WS_WGU  = WS_WOUT + 2 * MiB;
constexpr size_t WS_WDN  = WS_WGU + 32 * MiB;
constexpr size_t WS_END  = WS_WDN + 16 * MiB;
static_assert(WS_WUV + 65536 * 2 <= WS_X, "small region overflow");
static_assert((size_t)MOE_ROWS * 512 * 2 <= 68 * MiB, "H1");
static_assert((size_t)MOE_ROWS * 1024 * 2 <= 192 * MiB, "AS");

constexpr int CW_BAR = 0;
constexpr int CW_WQ  = 4096;

constexpr int LDS_TOTAL = 147456;
constexpr int LDS_PERS  = 143360;
constexpr int LP_SLOT = 16, LP_TBASE = 64;

struct Params { const float* in[28]; float* out; unsigned char* ws; };
enum { I_X = 0, I_C, I_WADA, I_BADA, I_GMIX, I_GFFN, I_GFINAL, I_RELB, I_ABWIN, I_ABCONVW, I_ABCONVB, I_ABGATEB, I_ABHNORM, I_ABWUK, I_ABWUV, I_ABWOUT,
       I_CDWIN, I_CDWALPHA, I_CDBALPHA, I_CDHNORM, I_CDWOUT, I_MWC, I_MBC, I_MWF, I_MBF, I_MWG, I_MWU, I_MWD };

#define TID (ltid())
#define NTHR 512

__device__ __forceinline__ void p0_prologue(const Params& p, LAS unsigned char* lds) {
    const int tid = ltid(), G = gridDim.x;
    LAS float* sc = (LAS float*)lds;
    LAS float* red = (LAS float*)(lds + 32768);
    const float* c = p.in[I_C];
    for (int i = tid; i < 8 * 1024; i += NTHR) { const float v = c[i]; sc[i] = v / (1.0f + __expf(-v)); }
    __syncthreads();
    float* mod = (float*)(p.ws + WS_MOD);
    for (int u = blockIdx.x; u < 4 * 48; u += G) {
        const int l = u / 48, e0 = (u % 48) * 128, col = tid & 127, ds = tid >> 7;
        const float* w = p.in[I_WADA] + (size_t)l * D * 6 * D + e0 + col;
        float a[8];
#pragma unroll
        for (int b = 0; b < 8; ++b) a[b] = 0.f;
        for (int d = ds * 256; d < ds * 256 + 256; ++d) { const float wv = w[(size_t)d * 6 * D];
#pragma unroll
            for (int b = 0; b < 8; ++b) a[b] += sc[b * 1024 + d] * wv; }
#pragma unroll
        for (int b = 0; b < 8; ++b) red[(ds * 8 + b) * 128 + col] = a[b];
        __syncthreads();
        for (int i = tid; i < 8 * 128; i += NTHR) { const int b = i >> 7, cc = i & 127;
            const float s = ((red[(0 * 8 + b) * 128 + cc] + red[(1 * 8 + b) * 128 + cc]) + red[(2 * 8 + b) * 128 + cc]) + red[(3 * 8 + b) * 128 + cc];
            mod[((size_t)l * 8 + b) * 6 * D + e0 + cc] = s + p.in[I_BADA][(size_t)l * 6 * D + e0 + cc]; }
        __syncthreads();
    }
    int* bkt = (int*)(p.ws + WS_BKT);
    for (int n = blockIdx.x * NTHR + tid; n < 4096; n += G * NTHR) {
        int v;
        if (n < 16) v = n; else { v = 16 + (int)(log((double)n / 16.0) / log(128.0) * 16.0); if (v > 31) v = 31; }
        bkt[n] = v;
    }
}

template <class SrcF>
__device__ __forceinline__ void prep_tr(LAS unsigned char* lds, const SrcF& src, int K, int Nd, bf16_t* Bt) {
    LAS float* tile = (LAS float*)lds;
    const int tid = ltid(), G = gridDim.x, tnN = Nd / 64, ntile = tnN * (K / 64);
    for (int u = blockIdx.x; u < ntile; u += G) {
        const int tn = u % tnN, tk = u / tnN;
#pragma unroll
        for (int i = 0; i < 8; ++i) { const int kk = (tid >> 6) + 8 * i, nn = tid & 63; tile[kk * 65 + nn] = src(tn * 64 + nn, tk * 64 + kk); }
        __syncthreads();
#pragma unroll
        for (int i = 0; i < 4; ++i) { const int nn = (tid >> 5) + 16 * i, kk = (tid & 31) * 2;
            *(unsigned*)(Bt + (size_t)(tn * 64 + nn) * K + tk * 64 + kk) = pk2(tile[kk * 65 + nn], tile[(kk + 1) * 65 + nn]); }
        __syncthreads();
    }
}
struct SrcShift { const float* W; int ldw, n0, shift, nvalid;
    __device__ __forceinline__ float operator()(int n, int k) const { if (n >= nvalid) return 0.f; return W[(size_t)k * ldw + (n >= n0 ? n + shift : n)]; } };
struct SrcGU { const float* Wg; const float* Wu;
    __device__ __forceinline__ float operator()(int n, int k) const { const int e = n >> 10, r = n & 1023, j = (r >> 5) * 16 + (r & 15); const unsigned long long dlt = (unsigned long long)Wu - (unsigned long long)Wg; const float* W = (const float*)((unsigned long long)Wg + (unsigned long long)((r >> 4) & 1) * dlt); return W[((size_t)e * 1024 + k) * 512 + j]; } };
struct SrcDN { const float* Wd;
    __device__ __forceinline__ float operator()(int n, int k) const { return Wd[((size_t)(n >> 10) * 512 + k) * 1024 + (n & 1023)]; } };

constexpr size_t WS_TAB = WS_WUV + 65536 * 2;
static_assert(WS_TAB + 13 * 16384 <= WS_X, "small region overflow");
struct WfAB { const float* W; __device__ __forceinline__ float operator()(int k, int c) const {
        if (c >= 12) return 0.f; const int col = c < 8 ? 1536 + c : 2504 + (c - 8); return W[(size_t)k * W_AB + col]; } };
struct WfCD { const float* W; __device__ __forceinline__ float operator()(int k, int c) const { return W[(size_t)k * W_CD + 1024 + c]; } };
struct WfRT { const float* Wc; const float* Wf; __device__ __forceinline__ float operator()(int k, int c) const {
        if (c < 4) return Wc[(size_t)k * 4 + c]; const int g = (c - 4) >> 2, e = (c - 4) & 3; return Wf[((size_t)g * D + k) * 4 + e]; } };
template <class WF>
__device__ __forceinline__ void build_small_tab(f32x4* tab, int nc4, const WF& wf) {
    for (int idx = blockIdx.x * NTHR + TID; idx < nc4 * 1024; idx += gridDim.x * NTHR) {
        const int c4 = idx >> 10, r = idx & 1023, ij = r >> 6, lane = r & 63, k = 512 * (ij >> 3) + 8 * lane + (ij & 7);
        f32x4 v; v[0] = wf(k, 4 * c4); v[1] = wf(k, 4 * c4 + 1); v[2] = wf(k, 4 * c4 + 2); v[3] = wf(k, 4 * c4 + 3);
        tab[idx] = v; }
}
__device__ __forceinline__ void prep_layer(const Params& p, LAS unsigned char* lds, int l) {
    const int j = l >> 1;
    if ((l & 1) == 0) {
        SrcShift s{p.in[I_ABWIN] + (size_t)j * D * W_AB, W_AB, 1536, 8, 2496};
        prep_tr(lds, s, D, NP_AB, (bf16_t*)(p.ws + WS_WIN));
        SrcShift so{p.in[I_ABWOUT] + (size_t)j * D * D, D, 1 << 30, 0, D};
        prep_tr(lds, so, D, D, (bf16_t*)(p.ws + WS_WOUT));
        const float* wuk = p.in[I_ABWUK] + (size_t)j * 65536; const float* wuv = p.in[I_ABWUV] + (size_t)j * 65536;
        bf16_t* ouk = (bf16_t*)(p.ws + WS_WUK); bf16_t* ouv = (bf16_t*)(p.ws + WS_WUV);
        for (int i = blockIdx.x * NTHR + TID; i < 65536; i += gridDim.x * NTHR) {
            ouk[i] = f2bf(wuk[i]);
            const int h = i >> 13, d = (i >> 7) & 63, r = i & 127;
            ouv[i] = f2bf(wuv[((size_t)r * 8 + h) * 64 + d]);
        }
    } else {
        SrcShift s{p.in[I_CDWIN] + (size_t)j * D * W_CD, W_CD, 1024, 16, 3072};
        prep_tr(lds, s, D, NP_CD, (bf16_t*)(p.ws + WS_WIN));
        SrcShift so{p.in[I_CDWOUT] + (size_t)j * D * D, D, 1 << 30, 0, D};
        prep_tr(lds, so, D, D, (bf16_t*)(p.ws + WS_WOUT));
    }
    { f32x4* tabg = (f32x4*)(p.ws + WS_TAB);
      if (l == 0) { WfAB wf{p.in[I_ABWIN]}; build_small_tab(tabg, 4, wf); }
      if (l + 1 < DEPTH) { const int ln = l + 1, jn = ln >> 1;
          if ((ln & 1) == 0) { WfAB wf{p.in[I_ABWIN] + (size_t)jn * D * W_AB}; build_small_tab(tabg + (ln & 1) * 4096, 4, wf); } else { WfCD wf{p.in[I_CDWIN] + (size_t)jn * D * W_CD}; build_small_tab(tabg + (ln & 1) * 4096, 4, wf); } }
      WfRT wr{p.in[I_MWC] + (size_t)l * D * 4, p.in[I_MWF] + (size_t)l * 4 * D * 4}; build_small_tab(tabg + 8 * 1024, 5, wr); }
    SrcGU sg{p.in[I_MWG] + (size_t)l * 16 * 1024 * 512, p.in[I_MWU] + (size_t)l * 16 * 1024 * 512};
    prep_tr(lds, sg, 1024, 16 * 1024, (bf16_t*)(p.ws + WS_WGU));
    SrcDN sd{p.in[I_MWD] + (size_t)l * 16 * 512 * 1024};
    prep_tr(lds, sd, 512, 16 * 1024, (bf16_t*)(p.ws + WS_WDN));
}

__device__ __forceinline__ void copy_tab_to_lds(LAS f32x4* dst, const f32x4* src, int n) { for (int i = TID; i < n; i += NTHR) dst[i] = src[i]; }
template <int NC4>
__device__ __forceinline__ void small_proj(const LAS f32x4* tab, const float (&h)[2][8], int lane, f32x4 (&out)[NC4]) {
#pragma unroll
    for (int c4 = 0; c4 < NC4; ++c4) { f32x4 a = (f32x4){0.f, 0.f, 0.f, 0.f};
#pragma unroll
        for (int i = 0; i < 2; ++i)
#pragma unroll
            for (int j = 0; j < 8; ++j) a += tab[(c4 * 16 + i * 8 + j) * 64 + lane] * h[i][j];
        out[c4] = a; asm volatile("" ::: "memory"); }
}
__device__ __forceinline__ float reduce16(const f32x4 (&a)[4], int lane) {
    const bool b5 = (lane & 32) != 0, b4 = (lane & 16) != 0, b3 = (lane & 8) != 0, b2 = (lane & 4) != 0;
    float w8[8], w4[4], w2[2];
#pragma unroll
    for (int c = 0; c < 8; ++c) { const float lo = a[c >> 2][c & 3], hi = a[(c + 8) >> 2][c & 3]; w8[c] = (b5 ? hi : lo) + __shfl_xor(b5 ? lo : hi, 32); }
#pragma unroll
    for (int c = 0; c < 4; ++c) w4[c] = (b4 ? w8[c + 4] : w8[c]) + __shfl_xor(b4 ? w8[c] : w8[c + 4], 16);
#pragma unroll
    for (int c = 0; c < 2; ++c) w2[c] = (b3 ? w4[c + 2] : w4[c]) + __shfl_xor(b3 ? w4[c] : w4[c + 2], 8);
    float w1 = (b2 ? w2[1] : w2[0]) + __shfl_xor(b2 ? w2[0] : w2[1], 4);
    w1 += __shfl_xor(w1, 2); w1 += __shfl_xor(w1, 1);
    return w1;
}
__device__ __forceinline__ float reduce4(const f32x4& a, int lane) {
    const bool b5 = (lane & 32) != 0, b4 = (lane & 16) != 0;
    const float u0 = (b5 ? a[2] : a[0]) + __shfl_xor(b5 ? a[0] : a[2], 32), u1 = (b5 ? a[3] : a[1]) + __shfl_xor(b5 ? a[1] : a[3], 32);
    float w = (b4 ? u1 : u0) + __shfl_xor(b4 ? u0 : u1, 16);
    w += __shfl_xor(w, 8); w += __shfl_xor(w, 4); w += __shfl_xor(w, 2); w += __shfl_xor(w, 1);
    return w;
}
__device__ __forceinline__ float rdl(float v, int l) { return __int_as_float(__builtin_amdgcn_readlane(__float_as_int(v), l)); }
__device__ __forceinline__ void unpack8(const u32x4& v, float (&o)[8]) {
#pragma unroll
    for (int e = 0; e < 4; ++e) { o[2 * e] = __uint_as_float(v[e] << 16); o[2 * e + 1] = __uint_as_float(v[e] & 0xffff0000u); } }

template <int MODE>
__device__ __forceinline__ void phase_tokens(const Params& p, LAS unsigned char* lds, int l) {
    const int tid = ltid(), lane = tid & 63, wave = tid >> 6, G = gridDim.x;
    LAS f32x4* tab = (LAS f32x4*)lds;
    LAS int* cnts = (LAS int*)(lds + 5 * 16384);
    if (MODE == 1) copy_tab_to_lds(tab, (const f32x4*)(p.ws + WS_TAB) + (l & 1) * 4096, 4 * 1024);
    if (MODE == 2) copy_tab_to_lds(tab, (const f32x4*)(p.ws + WS_TAB) + 8 * 1024, 5 * 1024);
    __syncthreads();
    const float* mod = (const float*)(p.ws + WS_MOD);
    float* X = (float*)(p.ws + WS_X); bf16_t* HBF = (bf16_t*)(p.ws + WS_HBF); float* SP = (float*)(p.ws + WS_SP);
    const bf16_t* YS = (const bf16_t*)(p.ws + WS_P);
    const int* POS = (const int*)(p.ws + WS_POS); float* RTW = (float*)(p.ws + WS_RTW); int* RTE = (int*)(p.ws + WS_RTE); int* TC = (int*)(p.ws + WS_TC);
    const bool comb = (MODE == 3) || (MODE == 1 && l > 0);
    const int lprev = (MODE == 3) ? 3 : l - 1;
    const float* biasc = p.in[I_MBC] + l * 4; const float* biasf = p.in[I_MBF] + l * 16;
    for (int grp = blockIdx.x; grp < NTOK / 128; grp += G) {
        const int b = (grp * 128) >> 12;
        float ca[2][8], cb[2][8], gf[2][8];
#pragma unroll
        for (int i = 0; i < 2; ++i)
#pragma unroll
            for (int j = 0; j < 8; ++j) { const int col = 512 * i + 8 * lane + j;
                if (MODE == 1) { const float* mrow = mod + ((size_t)l * 8 + b) * 6 * D; ca[i][j] = p.in[I_GMIX][(size_t)l * D + col] * (mrow[D + col] + 1.0f); cb[i][j] = mrow[col]; }
                if (MODE == 2) { const float* mrow = mod + ((size_t)l * 8 + b) * 6 * D; ca[i][j] = p.in[I_GFFN][(size_t)l * D + col] * (mrow[4 * D + col] + 1.0f); cb[i][j] = mrow[3 * D + col]; }
                if (MODE == 3) { ca[i][j] = p.in[I_GFINAL][col]; cb[i][j] = 0.f; }
                gf[i][j] = comb ? mod[((size_t)lprev * 8 + b) * 6 * D + 5 * D + col] : 0.f; }
        int pos1v = 0, pos2v = 0; float w1v = 0.f, w2v = 0.f;
        if (comb && lane < 16) { const int tk = grp * 128 + wave * 16 + lane; pos1v = POS[2 * tk]; pos2v = POS[2 * tk + 1]; w1v = RTW[2 * tk]; w2v = RTW[2 * tk + 1]; }
        const float* xsrc = (MODE == 1 && l == 0) ? p.in[I_X] : X;
        LAS unsigned char* mb = lds + ((MODE == 2) ? (5 * 16384 + 1024) : (4 * 16384 + 1024)) + __builtin_amdgcn_readfirstlane(wave) * ((MODE == 2) ? 4096 : 8192);
#define TOK_ISSUE(tt_) do { const int tok_ = grp * 128 + wave * 16 + (tt_); \
            __builtin_amdgcn_global_load_lds((const unsigned*)(xsrc + (size_t)tok_ * D + 8 * lane), (LAS unsigned*)(mb), 16, 0, 0); \
            __builtin_amdgcn_global_load_lds((const unsigned*)(xsrc + (size_t)tok_ * D + 8 * lane + 4), (LAS unsigned*)(mb + 1024), 16, 0, 0); \
            __builtin_amdgcn_global_load_lds((const unsigned*)(xsrc + (size_t)tok_ * D + 512 + 8 * lane), (LAS unsigned*)(mb + 2048), 16, 0, 0); \
            __builtin_amdgcn_global_load_lds((const unsigned*)(xsrc + (size_t)tok_ * D + 512 + 8 * lane + 4), (LAS unsigned*)(mb + 3072), 16, 0, 0); \
            if (comb) { const int q1_ = __builtin_amdgcn_readlane(pos1v, (tt_)), q2_ = __builtin_amdgcn_readlane(pos2v, (tt_)); \
                __builtin_amdgcn_global_load_lds((const unsigned*)(YS + (size_t)q1_ * D + 8 * lane), (LAS unsigned*)(mb + 4096), 16, 0, 0); \
                __builtin_amdgcn_global_load_lds((const unsigned*)(YS + (size_t)q1_ * D + 512 + 8 * lane), (LAS unsigned*)(mb + 5120), 16, 0, 0); \
                __builtin_amdgcn_global_load_lds((const unsigned*)(YS + (size_t)q2_ * D + 8 * lane), (LAS unsigned*)(mb + 6144), 16, 0, 0); \
                __builtin_amdgcn_global_load_lds((const unsigned*)(YS + (size_t)q2_ * D + 512 + 8 * lane), (LAS unsigned*)(mb + 7168), 16, 0, 0); } } while (0)
        TOK_ISSUE(0);
        int cnt = 0;
#pragma unroll 1
        for (int tt = 0; tt < 16; ++tt) {
            const int tok = grp * 128 + wave * 16 + tt;
            asm volatile("s_waitcnt vmcnt(0)" ::: "memory");
            u32x4 xb[4], yb[4];
#pragma unroll
            for (int k4 = 0; k4 < 4; ++k4) xb[k4] = *(const LAS u32x4*)(mb + k4 * 1024 + lane * 16);
            if (comb) {
#pragma unroll
                for (int k4 = 0; k4 < 4; ++k4) yb[k4] = *(const LAS u32x4*)(mb + 4096 + k4 * 1024 + lane * 16);
            }
            asm volatile("s_waitcnt lgkmcnt(0)" ::: "memory");
            float x[2][8];
#pragma unroll
            for (int i = 0; i < 2; ++i)
#pragma unroll
                for (int j = 0; j < 8; ++j) x[i][j] = __uint_as_float(xb[2 * i + (j >> 2)][j & 3]);
            if (comb) { const float w1 = rdl(w1v, tt), w2 = rdl(w2v, tt);
#pragma unroll
                for (int i = 0; i < 2; ++i) { float y1[8], y2[8]; unpack8(yb[i], y1); unpack8(yb[2 + i], y2);
#pragma unroll
                    for (int j = 0; j < 8; ++j) x[i][j] += gf[i][j] * (y1[j] * w1 + y2[j] * w2); } }
            if (tt + 1 < 16) TOK_ISSUE(tt + 1);
            float ss = 0.f;
#pragma unroll
            for (int i = 0; i < 2; ++i)
#pragma unroll
                for (int j = 0; j < 8; ++j) ss += x[i][j] * x[i][j];
            ss = wave_sum(ss);
            const float rstd = 1.0f / sqrtf(ss * (1.0f / 1024.0f) + 1e-6f);
            float h[2][8];
#pragma unroll
            for (int i = 0; i < 2; ++i)
#pragma unroll
                for (int j = 0; j < 8; ++j) h[i][j] = x[i][j] * rstd * ca[i][j] + cb[i][j];
            if (MODE == 1) {
#pragma unroll
                for (int i = 0; i < 2; ++i) { *(f32x4*)(X + (size_t)tok * D + 512 * i + 8 * lane) = (f32x4){x[i][0], x[i][1], x[i][2], x[i][3]}; *(f32x4*)(X + (size_t)tok * D + 512 * i + 8 * lane + 4) = (f32x4){x[i][4], x[i][5], x[i][6], x[i][7]}; }
            }
            if (MODE == 3) {
#pragma unroll
                for (int i = 0; i < 2; ++i) { *(f32x4*)(p.out + (size_t)tok * D + 512 * i + 8 * lane) = (f32x4){h[i][0], h[i][1], h[i][2], h[i][3]}; *(f32x4*)(p.out + (size_t)tok * D + 512 * i + 8 * lane + 4) = (f32x4){h[i][4], h[i][5], h[i][6], h[i][7]}; }
            } else {
#pragma unroll
                for (int i = 0; i < 2; ++i) { u32x4 w; w.x = pk2(h[i][0], h[i][1]); w.y = pk2(h[i][2], h[i][3]); w.z = pk2(h[i][4], h[i][5]); w.w = pk2(h[i][6], h[i][7]); *(u32x4*)(HBF + (size_t)tok * D + 512 * i + 8 * lane) = w; }
            }
            if (MODE == 1) {
                f32x4 o[4]; small_proj<4>(tab, h, lane, o);
                const float v = reduce16(o, lane);
                if ((lane & 3) == 0) SP[(size_t)tok * 16 + (lane >> 2)] = v;
            }
            if (MODE == 2) {
                f32x4 o[5]; small_proj<5>(tab, h, lane, o);
                const float vc = reduce4(o[0], lane);
                const f32x4 of[4] = {o[1], o[2], o[3], o[4]};
                const float vf = reduce16(of, lane);
                float lc[4];
#pragma unroll
                for (int c = 0; c < 4; ++c) lc[c] = rdl(vc, 16 * c) + biasc[c];
                int g = 0; float mx = lc[0];
#pragma unroll
                for (int c = 1; c < 4; ++c) if (lc[c] > mx) { mx = lc[c]; g = c; }
                g = __builtin_amdgcn_readfirstlane(g);
                float se = 0.f;
#pragma unroll
                for (int c = 0; c < 4; ++c) se += expf(lc[c] - mx);
                const float pg = 1.0f / se;
                float lf[4];
#pragma unroll
                for (int e = 0; e < 4; ++e) lf[e] = rdl(vf, 4 * (g * 4 + e)) + biasf[g * 4 + e];
                int i1 = 0; float v1 = lf[0];
#pragma unroll
                for (int e = 1; e < 4; ++e) if (lf[e] > v1) { v1 = lf[e]; i1 = e; }
                int i2 = -1; float v2 = -3.0e38f;
#pragma unroll
                for (int e = 0; e < 4; ++e) if (e != i1 && lf[e] > v2) { v2 = lf[e]; i2 = e; }
                const float ex = expf(v2 - v1); const float p1 = 1.0f / (1.0f + ex), p2 = ex / (1.0f + ex);
                const int e1 = g * 4 + i1, e2 = g * 4 + i2;
                if (lane == 0) { RTE[tok] = e1 | (e2 << 8); RTW[2 * tok] = pg * p1; RTW[2 * tok + 1] = pg * p2; }
                cnt += (lane == e1 ? 1 : 0) + (lane == e2 ? 1 : 0);
            }
        }
#undef TOK_ISSUE
        if (MODE == 2) {
            __syncthreads();
            if (lane < 16) cnts[wave * 16 + lane] = cnt;
            __syncthreads();
            if (tid < 16) { int s = 0;
#pragma unroll
                for (int w = 0; w < 8; ++w) s += cnts[w * 16 + tid];
                TC[grp * 16 + tid] = s; }
        }
    }
}
__device__ __forceinline__ void phase_norm1(const Params& p, LAS unsigned char* lds, int l) { phase_tokens<1>(p, lds, l); }
__device__ __forceinline__ void phase_norm2(const Params& p, LAS unsigned char* lds, int l) { phase_tokens<2>(p, lds, l); }

__device__ __forceinline__ void phase_dispatch(const Params& p, LAS unsigned char* lds, LAS int* tbase) {
    const int tid = ltid(), lane = tid & 63, wave = tid >> 6, G = gridDim.x;
    LAS int* tc = (LAS int*)lds;
    LAS int* tot = (LAS int*)(lds + 16384);
    LAS int* earr = (LAS int*)(lds + 16384 + 256);
    LAS int* parr = (LAS int*)(lds + 16384 + 256 + 1024);
    LAS int* toff = (LAS int*)(lds + 16384 + 256 + 2048);
    const int* TC = (const int*)(p.ws + WS_TC); const int* RTE = (const int*)(p.ws + WS_RTE);
    int* POS = (int*)(p.ws + WS_POS);
    const bf16_t* HBF = (const bf16_t*)(p.ws + WS_HBF); bf16_t* AS = (bf16_t*)(p.ws + WS_P);
    for (int i = tid; i < 256 * 16; i += NTHR) tc[i] = TC[i];
    __syncthreads();
    if (tid < 16) { int s = 0; for (int g = 0; g < 256; ++g) s += tc[g * 16 + tid]; tot[tid] = s; }
    __syncthreads();
    if (tid == 0) { int rb = 0; for (int e = 0; e < 16; ++e) { tot[16 + e] = rb; tbase[e] = rb >> 8; rb += (tot[e] + 255) & ~255; } tbase[16] = rb >> 8; }
    __syncthreads();
    for (int grp = blockIdx.x; grp < NTOK / 128; grp += G) {
        if (tid < 16) { int s = 0; for (int g = 0; g < grp; ++g) s += tc[g * 16 + tid]; toff[tid] = s; }
        if (tid < 256) { const int ee = RTE[grp * 128 + (tid >> 1)]; earr[tid] = (tid & 1) ? ((ee >> 8) & 255) : (ee & 255); }
        __syncthreads();
        if (tid < 256) { const int e = earr[tid]; int rank = 0; for (int j = 0; j < tid; ++j) rank += (earr[j] == e) ? 1 : 0;
            const int pos = tot[16 + e] + toff[e] + rank; parr[tid] = pos; POS[(size_t)(grp * 128) * 2 + tid] = pos; }
        __syncthreads();
        for (int r = 0; r < 32; ++r) { const int i = wave * 32 + r; const int tok = grp * 128 + (i >> 1); const int pos = parr[i];
            const u32x4* s = (const u32x4*)(HBF + (size_t)tok * D); u32x4* d = (u32x4*)(AS + (size_t)pos * D);
            const u32x4 a = s[lane], c2 = s[64 + lane]; d[lane] = a; d[64 + lane] = c2; }
        __syncthreads();
    }
}

__device__ __forceinline__ void phase_final(const Params& p, LAS unsigned char* lds) { phase_tokens<3>(p, lds, 3); }
__device__ __forceinline__ f32x4 mfma16(bf16x8 a, bf16x8 b, f32x4 c) { return __builtin_amdgcn_mfma_f32_16x16x32_bf16(a, b, c, 0, 0, 0); }
__device__ __forceinline__ bf16x8 ldfrag(const LAS unsigned char* base, int row, int stride_bytes, int kk, int g) { return *(const LAS bf16x8*)(base + row * stride_bytes + (kk * 32 + g * 8) * 2); }
__device__ __forceinline__ float scan_add(float v, int lane) {
#pragma unroll
    for (int o = 1; o < 64; o <<= 1) { const float t = __shfl_up(v, o); if (lane >= o) v += t; }
    return v;
}
__device__ __forceinline__ float scan_max(float v, int lane) {
#pragma unroll
    for (int o = 1; o < 64; o <<= 1) { const float t = __shfl_up(v, o); if (lane >= o) v = fmaxf(v, t); }
    return v;
}
__device__ __forceinline__ float bfe(const u32x4& v, int e) { const unsigned w = v[e >> 1]; return __uint_as_float((e & 1) ? (w & 0xffff0000u) : (w << 16)); }
__device__ __forceinline__ bf16_t bfr(const u32x4& v, int e) { const unsigned w = v[e >> 1]; return (bf16_t)((e & 1) ? (w >> 16) : (w & 0xffffu)); }

constexpr int RS = 144;
constexpr size_t WS_CL   = WS_END;
constexpr size_t WS_SCAL = WS_CL + 72 * MiB;
constexpr size_t WS_MC   = WS_SCAL + 512 * 1024;
constexpr size_t WS_END2 = WS_MC + 512 * 1024;
constexpr size_t WS_CTG  = WS_HBF;
constexpr size_t WS_STG  = WS_H1 + 36 * MiB;

__device__ __forceinline__ void unit_mlstm_L(const Params& p, LAS unsigned char* lds, int j, int b, int h, int ck) {
    const int tid = ltid(), lane = tid & 63, wave = __builtin_amdgcn_readfirstlane(tid >> 6), fr = lane & 15, g = lane >> 4;
    LAS unsigned char* KWT = lds; LAS unsigned char* VT = lds + 9216; LAS float* GA = (LAS float*)(lds + 29952);
    const bf16_t* P = (const bf16_t*)(p.ws + WS_P); const float* SP = (const float*)(p.ws + WS_SP);
    float* CL = (float*)(p.ws + WS_CL); float* SCAL = (float*)(p.ws + WS_SCAL);
    const int unit = (b * 4 + h) * 64 + ck; const int tok0 = b * SEQ + ck * 64;
    const int t = tid >> 3, seg = tid & 7, kc0 = 256 + h * 64 + seg * 8, pos = ck * 64 + t;
    u32x4 kin[4], vin[2];
#pragma unroll
    for (int q = 0; q < 4; ++q) { const int pp = pos - 3 + q; kin[q] = (pp >= 0) ? *(const u32x4*)(P + (size_t)(b * SEQ + pp) * NP_AB + kc0) : (u32x4){0u, 0u, 0u, 0u}; }
#pragma unroll
    for (int i = 0; i < 2; ++i) { const int idx = tid + 512 * i; vin[i] = *(const u32x4*)(P + (size_t)(tok0 + (idx >> 4)) * NP_AB + AB_VA + h * 128 + (idx & 15) * 8); }
    if (wave == 0) {
        const int tok = tok0 + lane;
        const float li = SP[(size_t)tok * 16 + h] + p.in[I_ABGATEB][j * 8 + h]; const float lf = logsigmoidf_(SP[(size_t)tok * 16 + 4 + h] + p.in[I_ABGATEB][j * 8 + 4 + h]);
        const float bc = scan_add(lf, lane); const float a = li - bc; const float amax = __shfl(scan_max(a, lane), 63);
        GA[lane] = __expf(a - amax);
        if (lane == 63) { SCAL[unit * 2] = bc; SCAL[unit * 2 + 1] = amax; }
    }
    for (int i = tid; i < 16 * 72; i += NTHR) { const int r = i / 72; ((LAS bf16_t*)VT)[(128 + r) * 72 + (i % 72)] = (r == 0) ? (bf16_t)0x3F80 : (bf16_t)0; }
    __syncthreads();
    { const float* convw = p.in[I_ABCONVW] + (size_t)j * 4 * 512 + kc0; const float* convb = p.in[I_ABCONVB] + j * 512 + kc0; const float we = GA[t];
#pragma unroll
      for (int e = 0; e < 8; ++e) { float acc = convb[e];
#pragma unroll
        for (int q = 0; q < 4; ++q) acc += convw[q * 512 + e] * bfe(kin[q], e);
        const float v = acc / (1.0f + __expf(-acc)); ((LAS bf16_t*)KWT)[(seg * 8 + e) * 72 + t] = f2bf(v * we); } }
#pragma unroll
    for (int i = 0; i < 2; ++i) { const int idx = tid + 512 * i; const int s = idx >> 4, sg = idx & 15;
#pragma unroll
        for (int e = 0; e < 8; ++e) ((LAS bf16_t*)VT)[(sg * 8 + e) * 72 + s] = bfr(vin[i], e); }
    __syncthreads();
#pragma unroll
    for (int i = 0; i < 5; ++i) { const int id = wave + 8 * i;
        if (id < 36) { const int tk = id / 9, tv = id % 9; f32x4 acc = (f32x4){0.f, 0.f, 0.f, 0.f};
#pragma unroll
            for (int kk = 0; kk < 2; ++kk) acc = mfma16(ldfrag(KWT, tk * 16 + fr, RS, kk, g), ldfrag(VT, tv * 16 + fr, RS, kk, g), acc);
#pragma unroll
            for (int r = 0; r < 4; ++r) CL[(size_t)unit * 9216 + (tk * 16 + 4 * g + r) * 144 + tv * 16 + fr] = acc[r]; } }
    __syncthreads();
}

__device__ __forceinline__ void phase_scan_mlstm(const Params& p) {
    const float* CL = (const float*)(p.ws + WS_CL); const float* SCAL = (const float*)(p.ws + WS_SCAL); float* MC = (float*)(p.ws + WS_MC); bf16_t* CTG = (bf16_t*)(p.ws + WS_CTG);
    for (int e = blockIdx.x * NTHR + TID; e < 32 * 9216; e += gridDim.x * NTHR) {
        const int bh = e / 9216, r = e % 9216;
        float C = 0.f, m = -1e30f;
#pragma unroll 1
        for (int c0 = 0; c0 < 64; c0 += 8) { float v[8];
#pragma unroll
            for (int i = 0; i < 8; ++i) v[i] = CL[(size_t)(bh * 64 + c0 + i) * 9216 + r];
#pragma unroll
            for (int i = 0; i < 8; ++i) { const int unit = bh * 64 + c0 + i; const float bL = SCAL[unit * 2], amax = SCAL[unit * 2 + 1];
                CTG[(size_t)unit * 9216 + r] = f2bf(C); if (r == 0) MC[unit] = m;
                const float M = fmaxf(m, amax); C = __expf(m - M) * C + __expf(amax - M) * v[i]; m = bL + M; } }
    }
}

__device__ __forceinline__ void unit_mlstm_O(const Params& p, LAS unsigned char* lds, int j, int b, int h, int ck) {
    const int tid = ltid(), lane = tid & 63, wave = __builtin_amdgcn_readfirstlane(tid >> 6), fr = lane & 15, g = lane >> 4;
    LAS unsigned char* QS = lds; LAS unsigned char* KS = lds + 9216; LAS unsigned char* VT = lds + 18432; LAS unsigned char* CT = lds + 39168; LAS unsigned char* PS = lds + 59904;
    LAS float* OS = (LAS float*)(lds + 69120); LAS float* GA = (LAS float*)(lds + 107008);
    constexpr int OSS = 148;
    const bf16_t* P = (const bf16_t*)(p.ws + WS_P); const float* SP = (const float*)(p.ws + WS_SP); bf16_t* YMIX = (bf16_t*)(p.ws + WS_YMIX);
    const bf16_t* CTG = (const bf16_t*)(p.ws + WS_CTG); const float* MC = (const float*)(p.ws + WS_MC);
    const int unit = (b * 4 + h) * 64 + ck; const int tok0 = b * SEQ + ck * 64;
    const int sg = tid & 15;
    const int ch0 = (sg < 8) ? h * 64 + sg * 8 : 256 + h * 64 + (sg - 8) * 8;
    u32x4 qkin[2][4], vin[2], cin[3], oin[2];
#pragma unroll
    for (int i = 0; i < 2; ++i) { const int tt = (tid + 512 * i) >> 4; const int pos = ck * 64 + tt;
#pragma unroll
        for (int q = 0; q < 4; ++q) { const int pp = pos - 3 + q; qkin[i][q] = (pp >= 0) ? *(const u32x4*)(P + (size_t)(b * SEQ + pp) * NP_AB + ch0) : (u32x4){0u, 0u, 0u, 0u}; }
        vin[i] = *(const u32x4*)(P + (size_t)(tok0 + tt) * NP_AB + AB_VA + h * 128 + sg * 8);
        oin[i] = *(const u32x4*)(P + (size_t)(tok0 + tt) * NP_AB + AB_OA + h * 128 + sg * 8); }
#pragma unroll
    for (int i = 0; i < 3; ++i) { const int idx = tid + 512 * i; cin[i] = (idx < 1152) ? *(const u32x4*)(CTG + (size_t)unit * 9216 + idx * 8) : (u32x4){0u, 0u, 0u, 0u}; }
    if (wave == 0) {
        const int tok = tok0 + lane; const float mc = MC[unit];
        const float li = SP[(size_t)tok * 16 + h] + p.in[I_ABGATEB][j * 8 + h]; const float lf = logsigmoidf_(SP[(size_t)tok * 16 + 4 + h] + p.in[I_ABGATEB][j * 8 + 4 + h]);
        const float bc = scan_add(lf, lane); const float a = li - bc; const float M = fmaxf(mc, scan_max(a, lane));
        GA[lane] = a; GA[64 + lane] = M; GA[128 + lane] = __expf(mc - M); GA[192 + lane] = __expf(-(bc + M));
    }
    for (int i = tid; i < 16 * 72; i += NTHR) { const int r = i / 72; ((LAS bf16_t*)VT)[(128 + r) * 72 + (i % 72)] = (r == 0) ? (bf16_t)0x3F80 : (bf16_t)0; }
    { const float* convw = p.in[I_ABCONVW] + (size_t)j * 4 * 512 + ch0; const float* convb = p.in[I_ABCONVB] + j * 512 + ch0;
      float cw[4][8], cb[8];
#pragma unroll
      for (int e = 0; e < 8; ++e) { cb[e] = convb[e];
#pragma unroll
        for (int q = 0; q < 4; ++q) cw[q][e] = convw[q * 512 + e]; }
      const float qs = (sg < 8) ? 0.125f : 1.0f;
#pragma unroll
      for (int i = 0; i < 2; ++i) { const int tt = (tid + 512 * i) >> 4; float o[8];
#pragma unroll
        for (int e = 0; e < 8; ++e) { float acc = cb[e];
#pragma unroll
            for (int q = 0; q < 4; ++q) acc += cw[q][e] * bfe(qkin[i][q], e);
            o[e] = acc / (1.0f + __expf(-acc)) * qs; }
        u32x4 w; w.x = pk2(o[0], o[1]); w.y = pk2(o[2], o[3]); w.z = pk2(o[4], o[5]); w.w = pk2(o[6], o[7]);
        *(LAS u32x4*)(((sg < 8) ? QS : KS) + tt * RS + (sg & 7) * 16) = w;
#pragma unroll
        for (int e = 0; e < 8; ++e) ((LAS bf16_t*)VT)[(sg * 8 + e) * 72 + tt] = bfr(vin[i], e); } }
#pragma unroll
    for (int i = 0; i < 3; ++i) { const int idx = tid + 512 * i;
        if (idx < 1152) { const int dk = idx / 18, sv = idx % 18;
#pragma unroll
            for (int e = 0; e < 8; ++e) ((LAS bf16_t*)CT)[(sv * 8 + e) * 72 + dk] = bfr(cin[i], e); } }
    __syncthreads();
    { const int tq = wave >> 1;
#pragma unroll
      for (int u = 0; u < 2; ++u) { const int ts = (wave & 1) * 2 + u; f32x4 acc = (f32x4){0.f, 0.f, 0.f, 0.f};
        if (ts <= tq) {
#pragma unroll
            for (int kk = 0; kk < 2; ++kk) acc = mfma16(ldfrag(QS, tq * 16 + fr, RS, kk, g), ldfrag(KS, ts * 16 + fr, RS, kk, g), acc);
        }
        const int s = ts * 16 + fr; const float as = GA[s];
#pragma unroll
        for (int r = 0; r < 4; ++r) { const int t = tq * 16 + 4 * g + r; const float pv = (ts <= tq && s <= t) ? acc[r] * __expf(as - GA[64 + t]) : 0.f; ((LAS bf16_t*)PS)[t * 72 + s] = f2bf(pv); } } }
    __syncthreads();
#pragma unroll
    for (int i = 0; i < 5; ++i) { const int id = wave + 8 * i;
        if (id < 36) { const int tq = id / 9, tv = id % 9; f32x4 acc = (f32x4){0.f, 0.f, 0.f, 0.f};
#pragma unroll
            for (int kk = 0; kk < 2; ++kk) acc = mfma16(ldfrag(QS, tq * 16 + fr, RS, kk, g), ldfrag(CT, tv * 16 + fr, RS, kk, g), acc);
#pragma unroll
            for (int r = 0; r < 4; ++r) acc[r] *= GA[128 + tq * 16 + 4 * g + r];
#pragma unroll
            for (int kk = 0; kk < 2; ++kk) acc = mfma16(ldfrag(PS, tq * 16 + fr, RS, kk, g), ldfrag(VT, tv * 16 + fr, RS, kk, g), acc);
#pragma unroll
            for (int r = 0; r < 4; ++r) OS[(tq * 16 + 4 * g + r) * OSS + tv * 16 + fr] = acc[r]; } }
    __syncthreads();
    { const float* hgp = p.in[I_ABHNORM] + j * 512 + h * 128 + sg * 8;
#pragma unroll
      for (int i = 0; i < 2; ++i) { const int tt = (tid + 512 * i) >> 4;
        const float den = OS[tt * OSS + 128]; const float dn = fmaxf(fabsf(den), GA[192 + tt]); const float idn = 1.0f / dn;
        const f32x4 a0 = *(const LAS f32x4*)(OS + tt * OSS + sg * 8), a1 = *(const LAS f32x4*)(OS + tt * OSS + sg * 8 + 4);
        float hv[8] = {a0[0] * idn, a0[1] * idn, a0[2] * idn, a0[3] * idn, a1[0] * idn, a1[1] * idn, a1[2] * idn, a1[3] * idn};
        float ss = 0.f;
#pragma unroll
        for (int e = 0; e < 8; ++e) ss += hv[e] * hv[e];
        ss += __shfl_xor(ss, 1); ss += __shfl_xor(ss, 2); ss += __shfl_xor(ss, 4); ss += __shfl_xor(ss, 8);
        const float rn = 1.0f / sqrtf(ss * (1.0f / 128.0f) + 1e-6f);
        float y[8];
#pragma unroll
        for (int e = 0; e < 8; ++e) y[e] = hv[e] * rn * hgp[e] * sigmoidf_(bfe(oin[i], e));
        u32x4 w; w.x = pk2(y[0], y[1]); w.y = pk2(y[2], y[3]); w.z = pk2(y[4], y[5]); w.w = pk2(y[6], y[7]);
        *(u32x4*)(YMIX + (size_t)(tok0 + tt) * D + h * 128 + sg * 8) = w; } }
    __syncthreads();
}

__device__ __forceinline__ void gla_cumsum(const Params& p, int j, int h, int tok0, int lane, int wave, LAS float* BS, LAS float* BL, float* scal_unit) {
    const float* SP = (const float*)(p.ws + WS_SP);
    f32x4 gq[4];
#pragma unroll
    for (int r = 0; r < 4; ++r) gq[r] = *(const f32x4*)(SP + (size_t)(tok0 + lane) * 16 + 4 * r);
    const float* wa = p.in[I_CDWALPHA] + (size_t)j * 16 * 256 + h * 64 + wave * 8; const float* ba = p.in[I_CDBALPHA] + j * 256 + h * 64 + wave * 8;
#pragma unroll
    for (int i = 0; i < 8; ++i) { float z = ba[i];
#pragma unroll
        for (int r = 0; r < 16; ++r) z += gq[r >> 2][r & 3] * wa[r * 256 + i];
        const float la = logsigmoidf_(z) * (1.0f / 16.0f); const float bc = scan_add(la, lane);
        BS[lane * 65 + wave * 8 + i] = bc;
        if (lane == 63) { BL[wave * 8 + i] = bc; if (scal_unit) scal_unit[wave * 8 + i] = __expf(bc); } }
}
__device__ __forceinline__ void unit_gla_L(const Params& p, LAS unsigned char* lds, int j, int b, int h, int ck) {
    const int tid = ltid(), lane = tid & 63, wave = __builtin_amdgcn_readfirstlane(tid >> 6), fr = lane & 15, g = lane >> 4;
    LAS unsigned char* KWT = lds; LAS unsigned char* VT = lds + 9216; LAS float* BS = (LAS float*)(lds + 27648); LAS float* BL = (LAS float*)(lds + 44288);
    const bf16_t* P = (const bf16_t*)(p.ws + WS_P); float* CL = (float*)(p.ws + WS_CL); float* SCAL = (float*)(p.ws + WS_SCAL);
    const int unit = (b * 4 + h) * 64 + ck; const int tok0 = b * SEQ + ck * 64;
    const int t = tid >> 3, seg = tid & 7;
    const u32x4 kin = *(const u32x4*)(P + (size_t)(tok0 + t) * NP_CD + CD_KC + h * 64 + seg * 8);
    u32x4 vin[2];
#pragma unroll
    for (int i = 0; i < 2; ++i) { const int idx = tid + 512 * i; vin[i] = *(const u32x4*)(P + (size_t)(tok0 + (idx >> 4)) * NP_CD + CD_VC + h * 128 + (idx & 15) * 8); }
    gla_cumsum(p, j, h, tok0, lane, wave, BS, BL, SCAL + (size_t)unit * 64);
    __syncthreads();
#pragma unroll
    for (int e = 0; e < 8; ++e) { const int kk = seg * 8 + e; ((LAS bf16_t*)KWT)[kk * 72 + t] = f2bf(bfe(kin, e) * __expf(BL[kk] - BS[t * 65 + kk])); }
#pragma unroll
    for (int i = 0; i < 2; ++i) { const int idx = tid + 512 * i; const int s = idx >> 4, sg = idx & 15;
#pragma unroll
        for (int e = 0; e < 8; ++e) ((LAS bf16_t*)VT)[(sg * 8 + e) * 72 + s] = bfr(vin[i], e); }
    __syncthreads();
#pragma unroll
    for (int i = 0; i < 4; ++i) { const int id = wave + 8 * i; const int tk = id >> 3, tv = id & 7; f32x4 acc = (f32x4){0.f, 0.f, 0.f, 0.f};
#pragma unroll
        for (int kk = 0; kk < 2; ++kk) acc = mfma16(ldfrag(KWT, tk * 16 + fr, RS, kk, g), ldfrag(VT, tv * 16 + fr, RS, kk, g), acc);
#pragma unroll
        for (int r = 0; r < 4; ++r) CL[(size_t)unit * 8192 + (tk * 16 + 4 * g + r) * 128 + tv * 16 + fr] = acc[r]; }
    __syncthreads();
}
__device__ __forceinline__ void phase_scan_gla(const Params& p) {
    const float* CL = (const float*)(p.ws + WS_CL); const float* SCAL = (const float*)(p.ws + WS_SCAL); bf16_t* STG = (bf16_t*)(p.ws + WS_STG);
    for (int e = blockIdx.x * NTHR + TID; e < 32 * 8192; e += gridDim.x * NTHR) {
        const int bh = e >> 13, r = e & 8191, dk = r >> 7;
        float S = 0.f;
#pragma unroll 1
        for (int c0 = 0; c0 < 64; c0 += 8) { float v[8], dc[8];
#pragma unroll
            for (int i = 0; i < 8; ++i) { v[i] = CL[(size_t)(bh * 64 + c0 + i) * 8192 + r]; dc[i] = SCAL[(size_t)(bh * 64 + c0 + i) * 64 + dk]; }
#pragma unroll
            for (int i = 0; i < 8; ++i) { STG[(size_t)(bh * 64 + c0 + i) * 8192 + r] = f2bf(S); S = dc[i] * S + v[i]; } }
    }
}
__device__ __forceinline__ void unit_gla_O(const Params& p, LAS unsigned char* lds, int j, int b, int h, int ck) {
    const int tid = ltid(), lane = tid & 63, wave = __builtin_amdgcn_readfirstlane(tid >> 6), fr = lane & 15, g = lane >> 4;
    LAS unsigned char* QS = lds; LAS unsigned char* KS = lds + 9216; LAS unsigned char* VT = lds + 18432; LAS unsigned char* ST = lds + 36864; LAS unsigned char* PS = lds + 55296;
    LAS float* OS = (LAS float*)(lds + 64512); LAS float* BS = (LAS float*)(lds + 98304); LAS float* BL = (LAS float*)(lds + 114944);
    constexpr int OSS = 132;
    const bf16_t* P = (const bf16_t*)(p.ws + WS_P); bf16_t* YMIX = (bf16_t*)(p.ws + WS_YMIX); const bf16_t* STG = (const bf16_t*)(p.ws + WS_STG);
    const int unit = (b * 4 + h) * 64 + ck; const int tok0 = b * SEQ + ck * 64;
    const int sg = tid & 15; const int ch0 = (sg < 8) ? CD_QC + h * 64 + sg * 8 : CD_KC + h * 64 + (sg - 8) * 8;
    u32x4 qkin[2], vin[2], sin_[2], rin[2];
#pragma unroll
    for (int i = 0; i < 2; ++i) { const int idx = tid + 512 * i; const int tt = idx >> 4;
        qkin[i] = *(const u32x4*)(P + (size_t)(tok0 + tt) * NP_CD + ch0);
        vin[i] = *(const u32x4*)(P + (size_t)(tok0 + tt) * NP_CD + CD_VC + h * 128 + sg * 8);
        rin[i] = *(const u32x4*)(P + (size_t)(tok0 + tt) * NP_CD + CD_RC + h * 128 + sg * 8);
        sin_[i] = *(const u32x4*)(STG + (size_t)unit * 8192 + idx * 8); }
    gla_cumsum(p, j, h, tok0, lane, wave, BS, BL, nullptr);
    __syncthreads();
#pragma unroll
    for (int i = 0; i < 2; ++i) { const int idx = tid + 512 * i; const int tt = idx >> 4; float o[8];
#pragma unroll
        for (int e = 0; e < 8; ++e) { const float bb = BS[tt * 65 + (sg & 7) * 8 + e]; o[e] = (sg < 8) ? bfe(qkin[i], e) * 0.125f * __expf(bb) : bfe(qkin[i], e) * __expf(-bb); }
        u32x4 w; w.x = pk2(o[0], o[1]); w.y = pk2(o[2], o[3]); w.z = pk2(o[4], o[5]); w.w = pk2(o[6], o[7]);
        *(LAS u32x4*)(((sg < 8) ? QS : KS) + tt * RS + (sg & 7) * 16) = w;
#pragma unroll
        for (int e = 0; e < 8; ++e) { ((LAS bf16_t*)VT)[(sg * 8 + e) * 72 + tt] = bfr(vin[i], e); ((LAS bf16_t*)ST)[(sg * 8 + e) * 72 + tt] = bfr(sin_[i], e); } }
    __syncthreads();
    { const int tq = wave >> 1;
#pragma unroll
      for (int u = 0; u < 2; ++u) { const int ts = (wave & 1) * 2 + u; f32x4 acc = (f32x4){0.f, 0.f, 0.f, 0.f};
        if (ts <= tq) {
#pragma unroll
            for (int kk = 0; kk < 2; ++kk) acc = mfma16(ldfrag(QS, tq * 16 + fr, RS, kk, g), ldfrag(KS, ts * 16 + fr, RS, kk, g), acc);
        }
        const int s = ts * 16 + fr;
#pragma unroll
        for (int r = 0; r < 4; ++r) { const int t = tq * 16 + 4 * g + r; const float pv = (ts <= tq && s <= t) ? acc[r] : 0.f; ((LAS bf16_t*)PS)[t * 72 + s] = f2bf(pv); } } }
    __syncthreads();
#pragma unroll
    for (int i = 0; i < 4; ++i) { const int id = wave + 8 * i; const int tq = id >> 3, tv = id & 7; f32x4 acc = (f32x4){0.f, 0.f, 0.f, 0.f};
#pragma unroll
        for (int kk = 0; kk < 2; ++kk) acc = mfma16(ldfrag(QS, tq * 16 + fr, RS, kk, g), ldfrag(ST, tv * 16 + fr, RS, kk, g), acc);
#pragma unroll
        for (int kk = 0; kk < 2; ++kk) acc = mfma16(ldfrag(PS, tq * 16 + fr, RS, kk, g), ldfrag(VT, tv * 16 + fr, RS, kk, g), acc);
#pragma unroll
        for (int r = 0; r < 4; ++r) OS[(tq * 16 + 4 * g + r) * OSS + tv * 16 + fr] = acc[r]; }
    __syncthreads();
    { const float* hgp = p.in[I_CDHNORM] + j * 512 + h * 128 + sg * 8;
#pragma unroll
      for (int i = 0; i < 2; ++i) { const int tt = (tid + 512 * i) >> 4;
        const f32x4 a0 = *(const LAS f32x4*)(OS + tt * OSS + sg * 8), a1 = *(const LAS f32x4*)(OS + tt * OSS + sg * 8 + 4);
        float hv[8] = {a0[0], a0[1], a0[2], a0[3], a1[0], a1[1], a1[2], a1[3]};
        float ss = 0.f;
#pragma unroll
        for (int e = 0; e < 8; ++e) ss += hv[e] * hv[e];
        ss += __shfl_xor(ss, 1); ss += __shfl_xor(ss, 2); ss += __shfl_xor(ss, 4); ss += __shfl_xor(ss, 8);
        const float rn = 1.0f / sqrtf(ss * (1.0f / 128.0f) + 1e-6f);
        float y[8];
#pragma unroll
        for (int e = 0; e < 8; ++e) y[e] = hv[e] * rn * hgp[e] * siluf_(bfe(rin[i], e));
        u32x4 w; w.x = pk2(y[0], y[1]); w.y = pk2(y[2], y[3]); w.z = pk2(y[4], y[5]); w.w = pk2(y[6], y[7]);
        *(u32x4*)(YMIX + (size_t)(tok0 + tt) * D + h * 128 + sg * 8) = w; } }
    __syncthreads();
}
#ifndef PROF
#define PROF 0
#endif
constexpr int LP_TACC = 32;
#define TSEC_BEGIN(k) unsigned long long _ts##k = 0; if (PROF == (k) && ltid() == 0) _ts##k = wall_clock64();
#define TSEC_END(k) if (PROF == (k) && ltid() == 0) { *(LAS unsigned long long*)(lds + LDS_PERS + LP_TACC) += wall_clock64() - _ts##k; }
constexpr int L_BKT8 = 134144, L_RELB = 138240;
__device__ __forceinline__ void load_attn_tables(const Params& p, LAS unsigned char* lds) {
    const int* bkt = (const int*)(p.ws + WS_BKT);
    for (int i = TID; i < 4096; i += NTHR) lds[L_BKT8 + i] = (unsigned char)bkt[i];
    if (TID < 256) ((LAS float*)(lds + L_RELB))[TID] = p.in[I_RELB][TID];
}
__device__ __forceinline__ int scan_add_i(int v, int lane) {
#pragma unroll
    for (int o = 1; o < 64; o <<= 1) { const int t = __shfl_up(v, o); if (lane >= o) v += t; }
    return v;
}
__device__ __forceinline__ unsigned keep_lowest(unsigned m, int n) {
    if (n <= 0) return 0u;
    while ((int)__popc(m) > n) m &= ~(1u << (31 - __clz((int)m)));
    return m;
}
__device__ __forceinline__ bf16x4 tr_read(unsigned lds_addr) { bf16x4 r; asm volatile("ds_read_b64_tr_b16 %0, %1\n\ts_waitcnt lgkmcnt(0)" : "=&v"(r) : "v"(lds_addr) : "memory"); return r; }
__device__ __forceinline__ void pf_wait4(u32x4& a, u32x4& b, u32x4& c, u32x4& d) { asm volatile("s_waitcnt vmcnt(0)" : "+v"(a), "+v"(b), "+v"(c), "+v"(d) :: "memory"); }
__device__ __forceinline__ void pf_wait8(u32x4 (&v)[8]) { asm volatile("s_waitcnt vmcnt(0)" : "+v"(v[0]), "+v"(v[1]), "+v"(v[2]), "+v"(v[3]), "+v"(v[4]), "+v"(v[5]), "+v"(v[6]), "+v"(v[7]) :: "memory"); }
__device__ __forceinline__ bf16x8 as_bf16x8(const u32x4& v) { return __builtin_bit_cast(bf16x8, v); }
__device__ __forceinline__ void lds_add_u32(unsigned byte_addr, unsigned v) { asm volatile("ds_add_u32 %0, %1" :: "v"(byte_addr), "v"(v) : "memory"); }
__device__ __forceinline__ void lds_or_b32(unsigned byte_addr, unsigned v) { asm volatile("ds_or_b32 %0, %1" :: "v"(byte_addr), "v"(v) : "memory"); }
__device__ __forceinline__ unsigned sortable(float f) { const int u = __float_as_int(f); return (unsigned)u ^ ((unsigned)(u >> 31) | 0x80000000u); }

template <int PASS>
__device__ __forceinline__ void dsa_score_pass(const bf16_t* P, size_t rowb, int nkt, int wave, int fr, int g, int tq, const bf16x8 (&qf)[4][2], const float (&wq)[4],
                                               unsigned pfx, unsigned tau, unsigned hist_a, unsigned gtm_a, unsigned eqm_a) {
        const bf16_t* kbase = P + rowb * NP_AB + AB_KI + (size_t)fr * NP_AB + g * 8;
        u32x4 c0, c1, c2, c3, n0, n1, n2, n3;
        { const int ka = wave < nkt ? wave : nkt - 1, kb = wave + 8 < nkt ? wave + 8 : nkt - 1;
          gload16(c0, kbase + (size_t)ka * 16 * NP_AB); gload16(c1, kbase + (size_t)ka * 16 * NP_AB + 32); gload16(c2, kbase + (size_t)kb * 16 * NP_AB); gload16(c3, kbase + (size_t)kb * 16 * NP_AB + 32);
          pf_wait4(c0, c1, c2, c3); }
#pragma unroll 1
        for (int kt = wave; kt < nkt; kt += 16) {
            { const int ka = kt + 16 < nkt ? kt + 16 : nkt - 1, kb = kt + 24 < nkt ? kt + 24 : nkt - 1;
              gload16(n0, kbase + (size_t)ka * 16 * NP_AB); gload16(n1, kbase + (size_t)ka * 16 * NP_AB + 32); gload16(n2, kbase + (size_t)kb * 16 * NP_AB); gload16(n3, kbase + (size_t)kb * 16 * NP_AB + 32); }
#pragma unroll
            for (int half = 0; half < 2; ++half) { const int kth = kt + 8 * half;
                if (kth < nkt) {
                    const bf16x8 k0 = as_bf16x8(half ? c2 : c0), k1 = as_bf16x8(half ? c3 : c1);
                    f32x4 sc = (f32x4){0.f, 0.f, 0.f, 0.f};
#pragma unroll
                    for (int hh = 0; hh < 4; ++hh) { f32x4 a = (f32x4){0.f, 0.f, 0.f, 0.f}; a = mfma16(k0, qf[hh][0], a); a = mfma16(k1, qf[hh][1], a);
#pragma unroll
                        for (int r = 0; r < 4; ++r) { const int ai = __float_as_int(a[r]); sc[r] = fmaf(__int_as_float(ai > 0 ? ai : 0), wq[hh], sc[r]); } }
                    unsigned gtb = 0u, eqb = 0u;
#pragma unroll
                    for (int r = 0; r < 4; ++r) { const int s = kth * 16 + 4 * g + r; const bool valid = s <= tq; const unsigned key = sortable(sc[r]);
                        if (PASS == 0) { const unsigned bin = key >> 21; lds_add_u32(hist_a + (bin >> 1) * 4u, valid ? (1u << ((bin & 1u) * 16u)) : 0u); }
                        else if (PASS == 1) { const unsigned bin = (key >> 10) & 2047u; lds_add_u32(hist_a + (bin >> 1) * 4u, (valid && (key >> 21) == pfx) ? (1u << ((bin & 1u) * 16u)) : 0u); }
                        else { gtb |= (valid && (key >> 10) > tau) ? (1u << r) : 0u; eqb |= (valid && (key >> 10) == tau) ? (1u << r) : 0u; } }
                    if (PASS == 2) { const unsigned word = (unsigned)(kth >> 1), sh = (unsigned)((kth & 1) * 16 + 4 * g);
                        lds_or_b32(gtm_a + word * 4u, gtb << sh); lds_or_b32(eqm_a + word * 4u, eqb << sh); }
                } }
            pf_wait4(n0, n1, n2, n3);
            c0 = n0; c1 = n1; c2 = n2; c3 = n3;
        }
}

__device__ __forceinline__ void unit_dsa(const Params& p, LAS unsigned char* lds, int b, int ti) {
    const int tid = ltid(), lane = tid & 63, wave = __builtin_amdgcn_readfirstlane(tid >> 6), fr = lane & 15, g = lane >> 4;
    LAS unsigned* HIST = (LAS unsigned*)lds; LAS unsigned char* GBUF = lds;
    LAS unsigned* GTM = (LAS unsigned*)(lds + 69632); LAS unsigned* EQM = (LAS unsigned*)(lds + 69632 + 8256);
    LAS unsigned short* SEL = (LAS unsigned short*)(lds + 86272); LAS unsigned char* QAB = lds + 94464;
    LAS int* MISC = (LAS int*)(lds + 127232); LAS unsigned char* SELB = lds + 127488;
    const LAS unsigned char* BKT8 = lds + L_BKT8; const LAS float* RELB = (const LAS float*)(lds + L_RELB);
    const bf16_t* P = (const bf16_t*)(p.ws + WS_P); const float* SP = (const float*)(p.ws + WS_SP); bf16_t* YMIX = (bf16_t*)(p.ws + WS_YMIX);
    const bf16_t* WUK = (const bf16_t*)(p.ws + WS_WUK); const bf16_t* WUV = (const bf16_t*)(p.ws + WS_WUV);
    const int t0 = ti * 16; const size_t rowb = (size_t)b * SEQ;
    TSEC_BEGIN(6) TSEC_BEGIN(1)
    for (int i = tid; i < 4100; i += NTHR) ((LAS u32x4*)HIST)[i] = (u32x4){0u, 0u, 0u, 0u};
    { const int h = wave; f32x4 acc[8];
#pragma unroll
      for (int rt = 0; rt < 8; ++rt) acc[rt] = (f32x4){0.f, 0.f, 0.f, 0.f};
#pragma unroll
      for (int kk = 0; kk < 2; ++kk) { const bf16x8 a = *(const bf16x8*)(P + (rowb + t0 + fr) * NP_AB + AB_QB + h * 64 + kk * 32 + g * 8);
#pragma unroll
        for (int rt = 0; rt < 8; ++rt) { const bf16x8 bw = *(const bf16x8*)(WUK + ((size_t)(rt * 16 + fr) * 8 + h) * 64 + kk * 32 + g * 8); acc[rt] = mfma16(a, bw, acc[rt]); } }
#pragma unroll
      for (int rt = 0; rt < 8; ++rt)
#pragma unroll
        for (int r = 0; r < 4; ++r) ((LAS bf16_t*)QAB)[((4 * g + r) * 8 + h) * 128 + rt * 16 + fr] = f2bf(acc[rt][r] * 0.125f); }
    bf16x8 qf[4][2];
#pragma unroll
    for (int hh = 0; hh < 4; ++hh)
#pragma unroll
        for (int kk = 0; kk < 2; ++kk) qf[hh][kk] = *(const bf16x8*)(P + (rowb + t0 + fr) * NP_AB + AB_QI + hh * 64 + kk * 32 + g * 8);
    float wq[4];
#pragma unroll
    for (int hh = 0; hh < 4; ++hh) wq[hh] = SP[(rowb + t0 + fr) * 16 + 8 + hh] * 0.5f;
    const int tq = t0 + fr; const int nkt = ti + 1;
    if (tid < 16) { MISC[tid] = 0; MISC[16 + tid] = (t0 + 16 > 256) ? 256 : (1 << 20); MISC[48 + tid] = 0; }
    for (int i = tid; i < 2 * 16 * 129; i += NTHR) GTM[i] = 0u;
    __syncthreads();
    TSEC_END(1) TSEC_BEGIN(2)
    const unsigned hist_a = (unsigned)(unsigned long long)(HIST + fr * 1025), gtm_a = (unsigned)(unsigned long long)(GTM + fr * 129), eqm_a = (unsigned)(unsigned long long)(EQM + fr * 129);
    const bool need_sel = (t0 + 16) > 256;
#pragma unroll 1
    for (int pass = need_sel ? 0 : 2; pass < 3; ++pass) {
        const unsigned pfx = (unsigned)MISC[fr], tau = (unsigned)MISC[48 + fr];
        TSEC_BEGIN(21)
        if (pass == 0) dsa_score_pass<0>(P, rowb, nkt, wave, fr, g, tq, qf, wq, pfx, tau, hist_a, gtm_a, eqm_a);
        else if (pass == 1) dsa_score_pass<1>(P, rowb, nkt, wave, fr, g, tq, qf, wq, pfx, tau, hist_a, gtm_a, eqm_a);
        else dsa_score_pass<2>(P, rowb, nkt, wave, fr, g, tq, qf, wq, pfx, tau, hist_a, gtm_a, eqm_a);
        asm volatile("s_waitcnt lgkmcnt(0)" ::: "memory");
        __syncthreads();
        TSEC_END(21)
        if (pass < 2) {
            TSEC_BEGIN(22)
#pragma unroll
            for (int qq = 0; qq < 2; ++qq) { const int q = wave * 2 + qq; const int nq = t0 + q + 1;
                if (nq > 256) {
                    const int R = MISC[16 + q]; const int lo = 2016 - 32 * lane;
                    unsigned w[16];
#pragma unroll
                    for (int i = 0; i < 16; ++i) w[i] = HIST[q * 1025 + (lo >> 1) + i];
                    int sl = 0;
#pragma unroll
                    for (int i = 0; i < 16; ++i) sl += (int)(w[i] & 0xffffu) + (int)(w[i] >> 16);
                    const int cum = scan_add_i(sl, lane);
                    const unsigned long long mk = __ballot(cum >= R);
                    const int Ls = mk ? (int)__ffsll((long long)mk) - 1 : 63;
                    const int c0 = cum - sl; int c = c0, nlt = 0, above = c0;
#pragma unroll
                    for (int i = 15; i >= 0; --i) {
                        c += (int)(w[i] >> 16); nlt += (c < R) ? 1 : 0; above = (c < R) ? c : above;
                        c += (int)(w[i] & 0xffffu); nlt += (c < R) ? 1 : 0; above = (c < R) ? c : above; }
                    const int fbin = lo + 31 - nlt;
                    const int fb = __shfl(fbin, Ls), ab = __shfl(above, Ls);
                    if (lane == 0) { const unsigned old = (unsigned)MISC[q];
                        if (pass == 0) MISC[q] = fb; else MISC[48 + q] = (int)((old << 11) | (unsigned)fb);
                        MISC[16 + q] = R - ab; }
                } else if (lane == 0) { MISC[48 + q] = 0; MISC[16 + q] = 1 << 20; }
            }
            __syncthreads();
            if (pass == 0) { for (int i = tid; i < 4100; i += NTHR) ((LAS u32x4*)HIST)[i] = (u32x4){0u, 0u, 0u, 0u}; }
            __syncthreads();
            TSEC_END(22)
        }
    }
    TSEC_END(2) TSEC_BEGIN(3)
#pragma unroll 1
    for (int qq = 0; qq < 2; ++qq) { const int q = wave * 2 + qq; const int R = MISC[16 + q];
        const unsigned g0 = GTM[q * 129 + 2 * lane], g1 = GTM[q * 129 + 2 * lane + 1], e0 = EQM[q * 129 + 2 * lane], e1 = EQM[q * 129 + 2 * lane + 1];
        const int tc = (int)__popc(e0) + (int)__popc(e1); const int tpre = scan_add_i(tc, lane) - tc;
        const unsigned s0 = g0 | keep_lowest(e0, R - tpre), s1 = g1 | keep_lowest(e1, R - tpre - (int)__popc(e0));
        const int c = (int)__popc(s0) + (int)__popc(s1); const int incl = scan_add_i(c, lane); int pos = incl - c;
        unsigned m = s0; while (m) { const int bit = __ffs((int)m) - 1; m &= m - 1u; const int ki = lane * 64 + bit; if (pos < 256) { SEL[q * 256 + pos] = (unsigned short)ki; SELB[q * 256 + pos] = BKT8[t0 + q - ki]; } ++pos; }
        m = s1; while (m) { const int bit = __ffs((int)m) - 1; m &= m - 1u; const int ki = lane * 64 + 32 + bit; if (pos < 256) { SEL[q * 256 + pos] = (unsigned short)ki; SELB[q * 256 + pos] = BKT8[t0 + q - ki]; } ++pos; }
        const int total = __shfl(incl, 63);
        if (lane == 0) MISC[32 + q] = total < 256 ? total : 256;
    }
    __syncthreads();
    TSEC_END(3) TSEC_BEGIN(4)
    LAS unsigned char* gb = GBUF + wave * 8704;
    const unsigned gba = (unsigned)(unsigned long long)gb;
#pragma unroll 1
    for (int qq = 0; qq < 2; ++qq) { const int q = wave * 2 + qq; const int count = MISC[32 + q]; const int tpos = t0 + q; const int nch = (count + 31) >> 5;
        bf16x8 qh[4];
#pragma unroll
        for (int kk = 0; kk < 4; ++kk) { const bf16x8 v = *(const LAS bf16x8*)(QAB + ((q * 8 + (fr & 7)) * 128 + kk * 32 + g * 8) * 2); qh[kk] = (fr < 8) ? v : (bf16x8){0, 0, 0, 0, 0, 0, 0, 0}; }
        float m_run = -1e30f, l_part = 0.f; f32x4 ao[8];
#pragma unroll
        for (int rt = 0; rt < 8; ++rt) ao[rt] = (f32x4){0.f, 0.f, 0.f, 0.f};
        u32x4 gv[8];
#pragma unroll
        for (int it = 0; it < 8; ++it) { const int slot = g + 4 * it; const int idx = SEL[q * 256 + (slot < count ? slot : 0)];
            gload16(gv[it], P + (rowb + idx) * NP_AB + AB_CKV + fr * 8); }
        const unsigned alo = gba + (unsigned)((4 * g + (fr >> 2)) * 272 + (4 * (fr & 3)) * 2), ahi = alo + 16u * 272u;
#pragma unroll 1
        for (int c = 0; c < nch; ++c) {
            TSEC_BEGIN(41)
            pf_wait8(gv);
            TSEC_END(41) TSEC_BEGIN(42)
#pragma unroll
            for (int it = 0; it < 8; ++it) *(LAS u32x4*)(gb + (g + 4 * it) * 272 + fr * 16) = gv[it];
            asm volatile("s_waitcnt lgkmcnt(0)" ::: "memory");
            {
                const int cn = (c + 1 < nch) ? c + 1 : 0;
#pragma unroll
                for (int it = 0; it < 8; ++it) { const int slot = cn * 32 + g + 4 * it; const int idx = SEL[q * 256 + (slot < count ? slot : 0)];
                    gload16(gv[it], P + (rowb + idx) * NP_AB + AB_CKV + fr * 8); } }
            float lg[2][4];
#pragma unroll
            for (int k2 = 0; k2 < 2; ++k2) { f32x4 a = (f32x4){0.f, 0.f, 0.f, 0.f};
#pragma unroll
                for (int kk = 0; kk < 4; ++kk) a = mfma16(*(const LAS bf16x8*)(gb + (k2 * 16 + fr) * 272 + (kk * 32 + g * 8) * 2), qh[kk], a);
                const unsigned bk4 = *(const LAS unsigned*)(SELB + q * 256 + c * 32 + k2 * 16 + 4 * g);
#pragma unroll
                for (int r = 0; r < 4; ++r) { const int slot = c * 32 + k2 * 16 + 4 * g + r; const float bias = RELB[((bk4 >> (8 * r)) & 31u) * 8u + (unsigned)(fr & 7)];
                    lg[k2][r] = (slot < count) ? (a[r] + bias) * 1.44269504f : -1e30f; } }
            float ml = fmaxf(fmaxf(fmaxf(lg[0][0], lg[0][1]), fmaxf(lg[0][2], lg[0][3])), fmaxf(fmaxf(lg[1][0], lg[1][1]), fmaxf(lg[1][2], lg[1][3])));
            ml = fmaxf(ml, __shfl_xor(ml, 16)); ml = fmaxf(ml, __shfl_xor(ml, 32));
            const float m_new = fmaxf(m_run, ml); const float alpha = __builtin_amdgcn_exp2f(m_run - m_new);
            float pr[2][4]; float ps = 0.f;
#pragma unroll
            for (int k2 = 0; k2 < 2; ++k2)
#pragma unroll
                for (int r = 0; r < 4; ++r) { pr[k2][r] = __builtin_amdgcn_exp2f(lg[k2][r] - m_new); ps += pr[k2][r]; }
            l_part = l_part * alpha + ps; m_run = m_new;
            u32x4 pfu; pfu.x = pk2(pr[0][0], pr[0][1]); pfu.y = pk2(pr[0][2], pr[0][3]); pfu.z = pk2(pr[1][0], pr[1][1]); pfu.w = pk2(pr[1][2], pr[1][3]);
            const bf16x8 pf = __builtin_bit_cast(bf16x8, pfu);
            TSEC_END(42) TSEC_BEGIN(43)
            bf16x4 tl[8], th[8];
            asm volatile(
                "ds_read_b64_tr_b16 %0, %16\n\tds_read_b64_tr_b16 %8, %17\n\t"
                "ds_read_b64_tr_b16 %1, %16 offset:32\n\tds_read_b64_tr_b16 %9, %17 offset:32\n\t"
                "ds_read_b64_tr_b16 %2, %16 offset:64\n\tds_read_b64_tr_b16 %10, %17 offset:64\n\t"
                "ds_read_b64_tr_b16 %3, %16 offset:96\n\tds_read_b64_tr_b16 %11, %17 offset:96\n\t"
                "ds_read_b64_tr_b16 %4, %16 offset:128\n\tds_read_b64_tr_b16 %12, %17 offset:128\n\t"
                "ds_read_b64_tr_b16 %5, %16 offset:160\n\tds_read_b64_tr_b16 %13, %17 offset:160\n\t"
                "ds_read_b64_tr_b16 %6, %16 offset:192\n\tds_read_b64_tr_b16 %14, %17 offset:192\n\t"
                "ds_read_b64_tr_b16 %7, %16 offset:224\n\tds_read_b64_tr_b16 %15, %17 offset:224\n\t"
                "s_waitcnt lgkmcnt(0)"
                : "=&v"(tl[0]), "=&v"(tl[1]), "=&v"(tl[2]), "=&v"(tl[3]), "=&v"(tl[4]), "=&v"(tl[5]), "=&v"(tl[6]), "=&v"(tl[7]),
                  "=&v"(th[0]), "=&v"(th[1]), "=&v"(th[2]), "=&v"(th[3]), "=&v"(th[4]), "=&v"(th[5]), "=&v"(th[6]), "=&v"(th[7])
                : "v"(alo), "v"(ahi) : "memory");
#pragma unroll
            for (int rt = 0; rt < 8; ++rt) { ao[rt] = ao[rt] * alpha;
                bf16x8 af; af[0] = tl[rt][0]; af[1] = tl[rt][1]; af[2] = tl[rt][2]; af[3] = tl[rt][3]; af[4] = th[rt][0]; af[5] = th[rt][1]; af[6] = th[rt][2]; af[7] = th[rt][3];
                ao[rt] = mfma16(af, pf, ao[rt]); }
            TSEC_END(43)
        }
        pf_wait8(gv);
        float l = l_part; l += __shfl_xor(l, 16); l += __shfl_xor(l, 32);
        const float inv = 1.0f / l;
        if (fr < 8) {
#pragma unroll
            for (int rt = 0; rt < 8; ++rt) { u32x2 w; w.x = pk2(ao[rt][0] * inv, ao[rt][1] * inv); w.y = pk2(ao[rt][2] * inv, ao[rt][3] * inv);
                *(LAS u32x2*)(QAB + ((q * 8 + fr) * 128 + rt * 16 + 4 * g) * 2) = w; } }
    }
    __syncthreads();
    TSEC_END(4) TSEC_BEGIN(5)
    { const int h = wave; f32x4 acc[4];
#pragma unroll
      for (int nt = 0; nt < 4; ++nt) acc[nt] = (f32x4){0.f, 0.f, 0.f, 0.f};
#pragma unroll
      for (int kk = 0; kk < 4; ++kk) { const bf16x8 a = *(const LAS bf16x8*)(QAB + ((fr * 8 + h) * 128 + kk * 32 + g * 8) * 2);
#pragma unroll
        for (int nt = 0; nt < 4; ++nt) { const bf16x8 bw = *(const bf16x8*)(WUV + ((size_t)(h * 64 + nt * 16 + fr)) * 128 + kk * 32 + g * 8); acc[nt] = mfma16(a, bw, acc[nt]); } }
#pragma unroll
      for (int nt = 0; nt < 4; ++nt)
#pragma unroll
        for (int r = 0; r < 4; ++r) YMIX[(rowb + t0 + 4 * g + r) * D + 512 + h * 64 + nt * 16 + fr] = f2bf(acc[nt][r]); }
    __syncthreads();
    TSEC_END(5) TSEC_END(6)
}

struct DilRegs { u32x4 kv[4], vv[4]; bf16x8 qf[2]; };
__device__ __forceinline__ void dil_issue(const Params& p, int b, int h, int pat, int res, int n, DilRegs& r) {
    const int tid = ltid(), lane = tid & 63, wave = __builtin_amdgcn_readfirstlane(tid >> 6), fr = lane & 15, g = lane >> 4;
    const bf16_t* P = (const bf16_t*)(p.ws + WS_P);
    const int d = (pat == 0) ? 1 : (pat == 1 ? 4 : 16);
    const size_t rowb = (size_t)b * SEQ;
    const int row = tid >> 1, half = tid & 1; const int jsub = 128 * (n - 1) + row; const bool ok = jsub >= 0;
    const size_t tok = rowb + (size_t)(ok ? jsub : 0) * d + res;
#pragma unroll
    for (int q = 0; q < 4; ++q) { r.kv[q] = *(const u32x4*)(P + tok * NP_CD + CD_KD + h * 64 + half * 32 + q * 8); r.vv[q] = *(const u32x4*)(P + tok * NP_CD + CD_VD + h * 64 + half * 32 + q * 8); }
    const int qi = 128 * n + 16 * wave + fr; const size_t qtok = rowb + (size_t)qi * d + res;
#pragma unroll
    for (int kk = 0; kk < 2; ++kk) r.qf[kk] = *(const bf16x8*)(P + qtok * NP_CD + CD_QD + h * 64 + kk * 32 + g * 8);
}
__device__ __forceinline__ void dil_compute(const Params& p, LAS unsigned char* lds, int b, int h, int pat, int res, int n, const DilRegs& rg) {
    const int tid = ltid(), lane = tid & 63, wave = __builtin_amdgcn_readfirstlane(tid >> 6), fr = lane & 15, g = lane >> 4;
    LAS unsigned char* KS2 = lds; LAS unsigned char* VT2 = lds + 36864;
    const LAS unsigned char* BKT8 = lds + L_BKT8; const LAS float* RELB = (const LAS float*)(lds + L_RELB);
    const int d = (pat == 0) ? 1 : (pat == 1 ? 4 : 16);
    const size_t rowb = (size_t)b * SEQ;
    bf16_t* OP = (bf16_t*)(p.ws + (pat == 0 ? WS_HBF : (pat == 1 ? WS_HBF + 32 * MiB : WS_H1)));
    float* LSE = (float*)(p.ws + WS_H1 + 32 * MiB) + (size_t)pat * NTOK * 8;
    { const int row = tid >> 1, half = tid & 1; const bool ok = (128 * (n - 1) + row) >= 0;
#pragma unroll
      for (int q = 0; q < 4; ++q) { const u32x4 kq = ok ? rg.kv[q] : (u32x4){0u, 0u, 0u, 0u}, vq = ok ? rg.vv[q] : (u32x4){0u, 0u, 0u, 0u};
          *(LAS u32x4*)(KS2 + row * 144 + (half * 32 + q * 8) * 2) = kq;
#pragma unroll
          for (int e = 0; e < 4; ++e) { const unsigned w = vq[e]; const int dv = half * 32 + q * 8 + 2 * e;
              ((LAS bf16_t*)VT2)[dv * 264 + row] = (bf16_t)(w & 0xffffu); ((LAS bf16_t*)VT2)[(dv + 1) * 264 + row] = (bf16_t)(w >> 16); } } }
    LAS float* TAPB = (LAS float*)(lds + 70656);
    if (tid < 400) { const int tap = tid - 144; TAPB[tid] = (tap >= 0 && tap <= 128) ? RELB[(int)BKT8[tap * d] * 8 + h] * 1.44269504f : -1e30f; }
    __syncthreads();
    const int qi = 128 * n + 16 * wave + fr; const size_t qtok = rowb + (size_t)qi * d + res;
    const bf16x8 qf[2] = {rg.qf[0], rg.qf[1]};
    const int ql = 128 + 16 * wave + fr;
    float m_run = -1e30f, l_part = 0.f; f32x4 ao[4];
#pragma unroll
    for (int vt = 0; vt < 4; ++vt) ao[vt] = (f32x4){0.f, 0.f, 0.f, 0.f};
#pragma unroll 1
    for (int c = 0; c < 5; ++c) { const int kl0 = 16 * wave + 32 * c;
        float lg[2][4];
#pragma unroll
        for (int k2 = 0; k2 < 2; ++k2) {
            if (c == 4 && k2 == 1) {
#pragma unroll
                for (int r = 0; r < 4; ++r) lg[k2][r] = -1e30f;
            } else { f32x4 a = (f32x4){0.f, 0.f, 0.f, 0.f};
#pragma unroll
                for (int kk = 0; kk < 2; ++kk) a = mfma16(ldfrag(KS2, kl0 + k2 * 16 + fr, 144, kk, g), qf[kk], a);
#pragma unroll
                for (int r = 0; r < 4; ++r) { const int kl = kl0 + k2 * 16 + 4 * g + r; const int tap = ql - kl;
                    float v = fmaf(a[r], 0.125f * 1.44269504f, TAPB[tap + 144]);
                    if (n == 0) v = (kl >= 128) ? v : -1e30f;
                    lg[k2][r] = v; } } }
        float ml = fmaxf(fmaxf(fmaxf(lg[0][0], lg[0][1]), fmaxf(lg[0][2], lg[0][3])), fmaxf(fmaxf(lg[1][0], lg[1][1]), fmaxf(lg[1][2], lg[1][3])));
        ml = fmaxf(ml, __shfl_xor(ml, 16)); ml = fmaxf(ml, __shfl_xor(ml, 32));
        const float m_new = fmaxf(m_run, ml); const float alpha = __builtin_amdgcn_exp2f(m_run - m_new);
        float pr[2][4]; float ps = 0.f;
#pragma unroll
        for (int k2 = 0; k2 < 2; ++k2)
#pragma unroll
            for (int r = 0; r < 4; ++r) { pr[k2][r] = (lg[k2][r] > -1e29f) ? __builtin_amdgcn_exp2f(lg[k2][r] - m_new) : 0.f; ps += pr[k2][r]; }
        l_part = l_part * alpha + ps; m_run = m_new;
        u32x4 pfu; pfu.x = pk2(pr[0][0], pr[0][1]); pfu.y = pk2(pr[0][2], pr[0][3]); pfu.z = pk2(pr[1][0], pr[1][1]); pfu.w = pk2(pr[1][2], pr[1][3]);
        const bf16x8 pf = __builtin_bit_cast(bf16x8, pfu);
#pragma unroll
        for (int vt = 0; vt < 4; ++vt) { ao[vt] = ao[vt] * alpha;
            const bf16x4 lo = *(const LAS bf16x4*)(VT2 + (vt * 16 + fr) * 528 + (kl0 + 4 * g) * 2);
            bf16x4 hi = (bf16x4){0, 0, 0, 0};
            if (c < 4) hi = *(const LAS bf16x4*)(VT2 + (vt * 16 + fr) * 528 + (kl0 + 16 + 4 * g) * 2);
            bf16x8 af; af[0] = lo[0]; af[1] = lo[1]; af[2] = lo[2]; af[3] = lo[3]; af[4] = hi[0]; af[5] = hi[1]; af[6] = hi[2]; af[7] = hi[3];
            ao[vt] = mfma16(af, pf, ao[vt]); }
    }
    float l = l_part; l += __shfl_xor(l, 16); l += __shfl_xor(l, 32);
    const float inv = 1.0f / l;
#pragma unroll
    for (int vt = 0; vt < 4; ++vt) { u32x2 w; w.x = pk2(ao[vt][0] * inv, ao[vt][1] * inv); w.y = pk2(ao[vt][2] * inv, ao[vt][3] * inv);
        *(u32x2*)(OP + qtok * 512 + h * 64 + vt * 16 + 4 * g) = w; }
    if (g == 0) LSE[qtok * 8 + h] = (m_run + __log2f(l)) * 0.69314718f;
    __syncthreads();
}

__device__ __forceinline__ void phase_dil_combine(const Params& p) {
    const bf16_t* O0 = (const bf16_t*)(p.ws + WS_HBF); const bf16_t* O1 = (const bf16_t*)(p.ws + WS_HBF + 32 * MiB); const bf16_t* O2 = (const bf16_t*)(p.ws + WS_H1);
    const float* LSE = (const float*)(p.ws + WS_H1 + 32 * MiB); bf16_t* YMIX = (bf16_t*)(p.ws + WS_YMIX);
    for (int idx = blockIdx.x * NTHR + TID; idx < NTOK * 64; idx += gridDim.x * NTHR) {
        const int tok = idx >> 6, h = (idx >> 3) & 7, dg = idx & 7;
        const float l0 = LSE[(size_t)tok * 8 + h], l1 = LSE[(size_t)NTOK * 8 + (size_t)tok * 8 + h], l2 = LSE[(size_t)2 * NTOK * 8 + (size_t)tok * 8 + h];
        const float mx = fmaxf(l0, fmaxf(l1, l2)); const float w0 = __expf(l0 - mx), w1 = __expf(l1 - mx), w2 = __expf(l2 - mx); const float inv = 1.0f / (w0 + w1 + w2);
        const size_t off = (size_t)tok * 512 + h * 64 + dg * 8;
        const u32x4 a = *(const u32x4*)(O0 + off), bq = *(const u32x4*)(O1 + off), c = *(const u32x4*)(O2 + off);
        u32x4 o;
#pragma unroll
        for (int e = 0; e < 4; ++e) {
            const float v0 = (__uint_as_float(a[e] << 16) * w0 + __uint_as_float(bq[e] << 16) * w1 + __uint_as_float(c[e] << 16) * w2) * inv;
            const float v1 = (__uint_as_float(a[e] & 0xffff0000u) * w0 + __uint_as_float(bq[e] & 0xffff0000u) * w1 + __uint_as_float(c[e] & 0xffff0000u) * w2) * inv;
            o[e] = pk2(v0, v1); }
        *(u32x4*)(YMIX + (size_t)tok * D + 512 + h * 64 + dg * 8) = o;
    }
}

__device__ __forceinline__ int grab_unit(unsigned* ctr, LAS int* slot) {
    __syncthreads();
    if (TID == 0) *slot = (int)__hip_atomic_fetch_add(ctr, 1u, __ATOMIC_RELAXED, __HIP_MEMORY_SCOPE_AGENT);
    __syncthreads();
    return *slot;
}
__device__ __forceinline__ void phase_rec_L(const Params& p, LAS unsigned char* lds, int j, bool is_ab) {
    for (int u = blockIdx.x; u < 2048; u += gridDim.x) { const int bh = u >> 6, ck = u & 63;
        if (is_ab) unit_mlstm_L(p, lds, j, bh >> 2, bh & 3, ck); else unit_gla_L(p, lds, j, bh >> 2, bh & 3, ck); }
}
__device__ __forceinline__ void phase_mixer_ab(const Params& p, LAS unsigned char* lds, int j, unsigned* ctr, int nrec = 2048) {
    LAS int* slot = (LAS int*)(lds + LDS_PERS + LP_SLOT);
    load_attn_tables(p, lds);
    for (;;) { const int u = grab_unit(ctr, slot);
        if (u >= 2048 + nrec) break;
        if (u < 2048) unit_dsa(p, lds, u >> 8, 255 - (u & 255));
        else { const int k = u - 2048; const int bh = k >> 6; TSEC_BEGIN(7) unit_mlstm_O(p, lds, j, bh >> 2, bh & 3, k & 63); TSEC_END(7) } }
}
__device__ __forceinline__ void dil_decode(int k, int& b, int& h, int& pat, int& res, int& n) {
    const int n32 = k & 31, bh = k / 96; pat = (k >> 5) % 3; b = bh >> 3; h = bh & 7;
    if (pat == 0) { res = 0; n = n32; } else if (pat == 1) { res = n32 >> 3; n = n32 & 7; } else { res = n32 >> 1; n = n32 & 1; }
}
__device__ __forceinline__ void phase_mixer_cd(const Params& p, LAS unsigned char* lds, int j, unsigned* ctr, int nrec = 2048) {
    LAS int* slot = (LAS int*)(lds + LDS_PERS + LP_SLOT);
    load_attn_tables(p, lds);
    const int total = 6144 + nrec;
    int u = grab_unit(ctr, slot);
    DilRegs cur, nxt;
    if (u < 6144) { int b, h, pat, res, n; dil_decode(u, b, h, pat, res, n); dil_issue(p, b, h, pat, res, n, cur); }
    while (u < total) {
        const int un = grab_unit(ctr, slot);
        if (u < 6144) { int b, h, pat, res, n; dil_decode(u, b, h, pat, res, n);
            if (un < 6144) { int b2, h2, pat2, res2, n2; dil_decode(un, b2, h2, pat2, res2, n2); dil_issue(p, b2, h2, pat2, res2, n2, nxt); }
            TSEC_BEGIN(8) dil_compute(p, lds, b, h, pat, res, n, cur); TSEC_END(8)
            cur = nxt; }
        else { const int k = u - 6144; const int bh = k >> 6; TSEC_BEGIN(9) unit_gla_O(p, lds, j, bh >> 2, bh & 3, k & 63); TSEC_END(9) }
        u = un;
    }
}
__global__ void __launch_bounds__(NTHR, 2) hybrid_fwd(Params p) {
    extern __shared__ __attribute__((aligned(16))) unsigned char lds_raw[];
    LAS unsigned char* lds = (LAS unsigned char*)lds_raw;
    const int tid = TID, G = gridDim.x;
    for (int i = tid; i < (LDS_TOTAL - LDS_PERS) / 4; i += NTHR) ((LAS unsigned*)(lds + LDS_PERS))[i] = 0u;
    __syncthreads();
    unsigned* ctl = (unsigned*)(p.ws + WS_CTL);
    XcdBarrier bar = xcd_barrier_post(ctl + CW_BAR, (volatile LAS unsigned*)(lds + LDS_PERS));
    LAS int* tbase = (LAS int*)(lds + LDS_PERS + LP_TBASE);

    p0_prologue(p, lds);
    __syncthreads();
#pragma unroll 1
    for (int l = 0; l < DEPTH; ++l) {
        const bool is_ab = (l & 1) == 0; const int j = l >> 1;
        prep_layer(p, lds, l);
#if DBL == 1
        __syncthreads(); prep_layer(p, lds, l);
#endif
        if (l == 0) xcd_barrier(bar);
        __syncthreads();
        phase_norm1(p, lds, l);
        xcd_barrier(bar);
        {
            const int N = is_ab ? NP_AB : NP_CD;
            pg8::Gemm gm{(const bf16_t*)(p.ws + WS_HBF), (const bf16_t*)(p.ws + WS_WIN), NTOK, N, D};
            pg8::StaticOrder S; S.init(NTOK, N, G, (int)blockIdx.x);
            pg8::EpiBf16<false> E{(bf16_t*)(p.ws + WS_P), N};
            pg8::gemm_phase(lds, gm, S, E);
#if DBL == 3
            pg8::gemm_phase(lds, gm, S, E);
#endif
        }
        xcd_barrier(bar);
        phase_rec_L(p, lds, j, is_ab);
#if DBL == 11
        __syncthreads(); phase_rec_L(p, lds, j, is_ab);
#endif
        xcd_barrier(bar);
        if (is_ab) phase_scan_mlstm(p); else phase_scan_gla(p);
#if DBL == 12
        xcd_barrier(bar); if (is_ab) phase_scan_mlstm(p); else phase_scan_gla(p);
#endif
        xcd_barrier(bar);
        if (is_ab) { phase_mixer_ab(p, lds, j, ctl + CW_WQ + 64 * l);
#if DBL == 4
            xcd_barrier(bar); phase_mixer_ab(p, lds, j, ctl + CW_WQ + 64 * (l + 4));
#endif
#if DBL == 9
            xcd_barrier(bar); phase_mixer_ab(p, lds, j, ctl + CW_WQ + 64 * (l + 4), 0);
#endif
        } else { phase_mixer_cd(p, lds, j, ctl + CW_WQ + 64 * l); xcd_barrier(bar); phase_dil_combine(p);
#if DBL == 5
            xcd_barrier(bar); phase_mixer_cd(p, lds, j, ctl + CW_WQ + 64 * (l + 4)); xcd_barrier(bar); phase_dil_combine(p);
#endif
#if DBL == 10
            xcd_barrier(bar); phase_mixer_cd(p, lds, j, ctl + CW_WQ + 64 * (l + 4), 0); xcd_barrier(bar); phase_dil_combine(p);
#endif
        }
        xcd_barrier(bar);
        {
            pg8::Gemm gm{(const bf16_t*)(p.ws + WS_YMIX), (const bf16_t*)(p.ws + WS_WOUT), NTOK, D, D};
            pg8::StaticOrder S; S.init(NTOK, D, G, (int)blockIdx.x);
            pg8::EpiOutRes E{(float*)(p.ws + WS_X), (const float*)(p.ws + WS_MOD) + (size_t)l * 8 * 6 * D + 2 * D};
            pg8::gemm_phase(lds, gm, S, E);
        }
        xcd_barrier(bar);
        phase_norm2(p, lds, l);
#if DBL == 2
        xcd_barrier(bar); phase_norm2(p, lds, l);
#endif
        xcd_barrier(bar);
        phase_dispatch(p, lds, tbase);
#if DBL == 6
        xcd_barrier(bar); phase_dispatch(p, lds, tbase);
#endif
        xcd_barrier(bar);
        {
            pg8::Gemm gm{(const bf16_t*)(p.ws + WS_P), (const bf16_t*)(p.ws + WS_WGU), MOE_ROWS, 16 * 1024, D};
            pg8::MoeOrder S{tbase, G, (int)blockIdx.x};
            pg8::EpiMoe1 E{(bf16_t*)(p.ws + WS_H1)};
            pg8::gemm_phase(lds, gm, S, E);
#if DBL == 7
            pg8::gemm_phase(lds, gm, S, E);
#endif
        }
        xcd_barrier(bar);
        {
            pg8::Gemm gm{(const bf16_t*)(p.ws + WS_H1), (const bf16_t*)(p.ws + WS_WDN), MOE_ROWS, 16 * 1024, 512};
            pg8::MoeOrder S{tbase, G, (int)blockIdx.x};
            pg8::EpiBf16<true> E{(bf16_t*)(p.ws + WS_P), D};
            pg8::gemm_phase(lds, gm, S, E);
#if DBL == 8
            pg8::gemm_phase(lds, gm, S, E);
#endif
        }
        xcd_barrier(bar);
    }
    phase_final(p, lds);
#if PROF
    if (blockIdx.x == 0) { __syncthreads(); const unsigned long long acc = *(LAS unsigned long long*)(lds + LDS_PERS + LP_TACC); const unsigned long long t0 = wall_clock64(); while (wall_clock64() - t0 < acc * 10ull) __builtin_amdgcn_s_sleep(8); }
#endif
}

extern "C" void kernel_launch(void* const* d_in, const int* in_sizes, int n_in, void* d_out, int out_size, void* d_ws, size_t ws_size, hipStream_t stream) {
    static int grid = 0;
    if (grid == 0) {
        if (n_in != 28 || ws_size < WS_END2) { fprintf(stderr, "kernel_launch: unexpected n_in %d / ws_size %zu (need %zu)\n", n_in, ws_size, (size_t)WS_END2); grid = -1; return; }
        int dev = 0, cus = 0, per_cu = 0;
        if (hipGetDevice(&dev) != hipSuccess || hipDeviceGetAttribute(&cus, hipDeviceAttributeMultiprocessorCount, dev) != hipSuccess) { grid = -1; return; }
        if (hipFuncSetAttribute((const void*)hybrid_fwd, hipFuncAttributeMaxDynamicSharedMemorySize, LDS_TOTAL) != hipSuccess) { fprintf(stderr, "kernel_launch: hipFuncSetAttribute failed\n"); grid = -1; return; }
        if (hipOccupancyMaxActiveBlocksPerMultiprocessor(&per_cu, (const void*)hybrid_fwd, NTHR, LDS_TOTAL) != hipSuccess || per_cu < 1) { fprintf(stderr, "kernel_launch: occupancy query says %d\n", per_cu); }
        (void)hipGetLastError();
        grid = cus;
    }
    if (grid < 0) return;
    if (hipMemsetAsync((char*)d_ws + WS_CTL, 0, CTL_BYTES, stream) != hipSuccess) return;
    Params p{};
    for (int i = 0; i < 28; ++i) p.in[i] = (const float*)d_in[i];
    p.out = (float*)d_out; p.ws = (unsigned char*)d_ws;
    hipLaunchKernelGGL(hybrid_fwd, dim3(grid), dim3(NTHR), LDS_TOTAL, stream, p);
}
```

```cpp
#define DBL 0
#define PROF 0
#include <hip/hip_runtime.h>
#include <cstdio>
#include <cstdint>

#define LAS __attribute__((address_space(3)))
typedef unsigned short bf16_t;
typedef short bf16x8 __attribute__((ext_vector_type(8)));
typedef short bf16x4 __attribute__((ext_vector_type(4)));
typedef float f32x4 __attribute__((ext_vector_type(4)));
typedef float f32x2 __attribute__((ext_vector_type(2)));
typedef unsigned u32x4 __attribute__((ext_vector_type(4)));
typedef unsigned u32x2 __attribute__((ext_vector_type(2)));

constexpr int D = 1024, NB = 8, SEQ = 4096, NTOK = NB * SEQ, DEPTH = 4;
constexpr int W_AB = 2508, W_CD = 3088;
constexpr int NP_AB = 2560, NP_CD = 3072;
constexpr int AB_QA = 0, AB_KA = 256, AB_VA = 512, AB_OA = 1024, AB_QB = 1536, AB_CKV = 2048, AB_QI = 2176, AB_KI = 2432;
constexpr int CD_QC = 0, CD_KC = 256, CD_VC = 512, CD_RC = 1024, CD_QD = 1536, CD_KD = 2048, CD_VD = 2560;
constexpr int MOE_ROWS = 2 * NTOK + 16 * 256;

__device__ __forceinline__ int lbid() { int t = (int)blockIdx.x; asm volatile("" : "+s"(t)); return t; }
__device__ __forceinline__ int lgdim() { int t = (int)gridDim.x; asm volatile("" : "+s"(t)); return t; }
#define BID (lbid())
#define GDIM (lgdim())
__device__ __forceinline__ int ltid() { int t = (int)threadIdx.x; asm volatile("" : "+v"(t)); return t; }
__device__ __forceinline__ void gload16(u32x4& dst, const void* ptr) { asm volatile("global_load_dwordx4 %0, %1, off" : "=&v"(dst) : "v"(ptr) : "memory"); }
__device__ __forceinline__ float bf2f(bf16_t b) { return __uint_as_float(((unsigned)b) << 16); }
__device__ __forceinline__ unsigned pk2(float lo, float hi) { unsigned r; asm("v_cvt_pk_bf16_f32 %0, %1, %2" : "=v"(r) : "v"(lo), "v"(hi)); return r; }
__device__ __forceinline__ bf16_t f2bf(float f) { return (bf16_t)(pk2(f, 0.f) & 0xffffu); }
__device__ __forceinline__ float wave_sum(float v) {
#pragma unroll
    for (int o = 32; o > 0; o >>= 1) v += __shfl_xor(v, o);
    return v;
}
__device__ __forceinline__ float sigmoidf_(float x) { return 1.0f / (1.0f + __expf(-x)); }
__device__ __forceinline__ float siluf_(float x) { return x / (1.0f + __expf(-x)); }
__device__ __forceinline__ float logsigmoidf_(float x) { return fminf(x, 0.0f) - log1pf(__expf(-fabsf(x))); }

#define XB_TMO      128
#define XB_XCNT(j)  (256  + 64 * (j))
#define XB_XSUB(j)  (1280 + 64 * (j))
#define XB_XGEN(j)  (2304 + 64 * (j))
#define XB_TOP      3328
#define XB_TOPGEN   3392
#define XCD_BAR_WORDS 3456
#define XB_SPIN_CAP (1u << 18)

__device__ __forceinline__ unsigned xb_ld(unsigned* p)              { return __hip_atomic_load(p, __ATOMIC_RELAXED, __HIP_MEMORY_SCOPE_AGENT); }
__device__ __forceinline__ unsigned xb_add(unsigned* p, unsigned v) { return __hip_atomic_fetch_add(p, v, __ATOMIC_RELAXED, __HIP_MEMORY_SCOPE_AGENT); }
__device__ __forceinline__ unsigned xb_xcc_id() { return (unsigned)__builtin_amdgcn_s_getreg((3 << 11) | 20) & 0xFu; }
#define XB_SPIN(cond, bar) do { unsigned _sp = 0; while (cond) { __builtin_amdgcn_s_sleep(1); \
    if ((++_sp & 255u) == 0u) { if (xb_ld(&(bar)[XB_TMO])) break; if (_sp > XB_SPIN_CAP) { atomicAdd(&(bar)[XB_TMO], 1u); break; } } } } while (0)

struct XcdBarrier { unsigned* bar; unsigned x; volatile LAS unsigned* st; };

__device__ __forceinline__ XcdBarrier xcd_barrier_post(unsigned* bar, volatile LAS unsigned* st) {
    XcdBarrier b; b.bar = bar; b.x = xb_xcc_id(); b.st = st;
    if (ltid() == 0) (void)xb_add(&bar[XB_XCNT(b.x)], 1u);
    return b;
}
__device__ __forceinline__ void xcd_barrier_complete(unsigned* bar, unsigned x, unsigned& nloc, unsigned& nx) {
    const unsigned G = (unsigned)GDIM;
    unsigned sum, cnt, mine, sp = 0u;
    for (;;) {
        sum = 0u; cnt = 0u; mine = 0u;
#pragma unroll
        for (unsigned j = 0; j < 16; ++j) { const unsigned c = xb_ld(&bar[XB_XCNT(j)]); sum += c; cnt += (c > 0u) ? 1u : 0u; mine = (j == x) ? c : mine; }
        if (sum == G) break;
        __builtin_amdgcn_s_sleep(1);
        if ((++sp & 255u) == 0u) { if (xb_ld(&bar[XB_TMO])) break; if (sp > XB_SPIN_CAP) { atomicAdd(&bar[XB_TMO], 1u); break; } }
    }
    nloc = mine > 0u ? mine : 1u; nx = cnt > 0u ? cnt : 1u;
}
__device__ __forceinline__ void xcd_barrier(const XcdBarrier& b) {
    asm volatile("s_waitcnt vmcnt(0)" ::: "memory");
    __syncthreads();
    if (ltid() == 0) {
        unsigned* bar = b.bar;
        __builtin_amdgcn_s_waitcnt(0);
        unsigned nloc = b.st[0], nx = b.st[1];
        if (nloc == 0u) { xcd_barrier_complete(bar, b.x, nloc, nx); b.st[0] = nloc; b.st[1] = nx; }
        const unsigned old = xb_add(&bar[XB_XSUB(b.x)], 1u);
        const unsigned gen = old / nloc;
        if (old + 1u == (gen + 1u) * nloc) {
            __builtin_amdgcn_fence(__ATOMIC_RELEASE, "agent");
            asm volatile("s_waitcnt vmcnt(0)" ::: "memory");
            const unsigned og = xb_add(&bar[XB_TOP], 1u);
            const unsigned tg = og / nx;
            if (og + 1u == (tg + 1u) * nx) xb_add(&bar[XB_TOPGEN], 1u);
            else XB_SPIN(xb_ld(&bar[XB_TOPGEN]) == tg, bar);
            __builtin_amdgcn_fence(__ATOMIC_ACQUIRE, "agent");
            xb_add(&bar[XB_XGEN(b.x)], 1u);
            asm volatile("s_waitcnt vmcnt(0)" ::: "memory");
        } else {
            XB_SPIN(xb_ld(&bar[XB_XGEN(b.x)]) == gen, bar);
            __builtin_amdgcn_fence(__ATOMIC_ACQUIRE, "agent");
            asm volatile("s_waitcnt vmcnt(0)" ::: "memory");
        }
    }
    __syncthreads();
}

namespace pg8 {
constexpr int BM = 256, BK = 64, HALF = 128, HTB = HALF * BK * 2, STAGE_BYTES = 8 * HTB, NXCD = 8, WGM = 8;
__host__ __device__ __forceinline__ int lds_byte(int r, int c) { const int st = (r >> 4) * 2 + (c >> 5), rr = r & 15, cc = c & 31, ob = rr * 64 + cc * 2; return st * 1024 + (ob ^ (((ob >> 9) & 1) << 5)); }
__host__ __device__ __forceinline__ void stage_rc(int b, int& R, int& C) { const int st = b / 1024, sb = b % 1024, swz = sb ^ (((sb >> 9) & 1) << 5); R = (st >> 1) * 16 + swz / 64; C = (st & 1) * 32 + (swz % 64) / 2; }
__host__ __device__ __forceinline__ int perm32(int rho) { const int n = rho >> 4, i = rho & 15; return 8 * (i >> 2) + 4 * n + (i & 3); }

struct Unit { int pm, pn; };
struct Gemm { const bf16_t* A; const bf16_t* Bt; int M, N, K; const int* rowtok; };

struct StaticOrder {
    int nM, nN, nwg, G, c;
    __host__ __device__ void init(int M, int N, int G_, int c_) { nM = M / BM; nN = N / BM; nwg = nM * nN; G = G_; c = c_; }
    __host__ __device__ bool next(int i, Unit& u) const {
        const long L = (long)i * G + c; if (L >= nwg) return false;
        int wgid = (int)L; { const int q = nwg / NXCD, r = nwg % NXCD, xcd = wgid % NXCD, off = wgid / NXCD; wgid = (xcd < r ? xcd * (q + 1) : r * (q + 1) + (xcd - r) * q) + off; }
        const int nig = WGM * nN, gid = wgid / nig, fm = gid * WGM, gsz = (nM - fm) < WGM ? (nM - fm) : WGM;
        u.pm = fm + ((wgid % nig) % gsz); u.pn = (wgid % nig) / gsz; return true;
    }
    __device__ __forceinline__ void a_ready(const Unit&) const {}
    __device__ __forceinline__ void done(const Unit&) const {}
};
struct MoeOrder {
    const LAS int* tbase;
    int G, c;
    __device__ bool next(int i, Unit& u) const {
        const int L = i * G + c; const int total = tbase[16] * 4; if (L >= total) return false;
        const int pm = L >> 2; int e = 0;
#pragma unroll
        for (int k = 1; k < 16; ++k) e += (pm >= tbase[k]) ? 1 : 0;
        u.pm = pm; u.pn = e * 4 + (L & 3); return true;
    }
    __device__ __forceinline__ void a_ready(const Unit&) const {}
    __device__ __forceinline__ void done(const Unit&) const {}
};

__device__ __forceinline__ unsigned cvt_pk_bf16(float lo, float hi) { unsigned r; asm volatile("v_cvt_pk_bf16_f32 %0, %1, %2" : "=v"(r) : "v"(lo), "v"(hi)); return r; }

template <bool MOE> struct EpiBf16 {
    static constexpr bool PERM = true, AFTER_DRAIN = false;
    bf16_t* O; int ldc;
    __device__ __forceinline__ void operator()(const f32x4 (&acc)[2][2][4][2], const Unit& u, int wr, int wc, int fr, int fq) const {
        const int row0 = u.pm * BM + wr * 64 + fr; const int colt = (MOE ? (u.pn & 3) : u.pn) * BM; const int col0 = colt + wc * 32 + 8 * fq;
#pragma unroll
        for (int ai = 0; ai < 2; ++ai)
#pragma unroll
            for (int m = 0; m < 4; ++m) { bf16_t* rowp = O + (size_t)(row0 + ai * HALF + m * 16) * ldc + col0;
#pragma unroll
                for (int bj = 0; bj < 2; ++bj) { const f32x4 v0 = acc[ai][bj][m][0], v1 = acc[ai][bj][m][1];
                    u32x4 w; w.x = cvt_pk_bf16(v0[0], v0[1]); w.y = cvt_pk_bf16(v0[2], v0[3]); w.z = cvt_pk_bf16(v1[0], v1[1]); w.w = cvt_pk_bf16(v1[2], v1[3]);
                    *(u32x4*)(rowp + bj * HALF) = w; } }
    }
};
struct EpiOutRes {
    static constexpr bool PERM = false, AFTER_DRAIN = false;
    float* X; const float* gate;
    __device__ __forceinline__ void operator()(const f32x4 (&acc)[2][2][4][2], const Unit& u, int wr, int wc, int fr, int fq) const {
        const int row0 = u.pm * BM + wr * 64 + fr, col0 = u.pn * BM + wc * 32 + 4 * fq;
        const float* gp = gate + (size_t)((u.pm * BM) >> 12) * (6 * D) + col0;
        f32x4 gv[2][2];
#pragma unroll
        for (int bj = 0; bj < 2; ++bj)
#pragma unroll
            for (int n = 0; n < 2; ++n) gv[bj][n] = *(const f32x4*)(gp + bj * HALF + n * 16);
#pragma unroll
        for (int ai = 0; ai < 2; ++ai)
#pragma unroll
            for (int m = 0; m < 4; ++m) { float* rowp = X + (size_t)(row0 + ai * HALF + m * 16) * D + col0;
#pragma unroll
                for (int bj = 0; bj < 2; ++bj)
#pragma unroll
                    for (int n = 0; n < 2; ++n) { f32x4* p = (f32x4*)(rowp + bj * HALF + n * 16); *p = *p + gv[bj][n] * acc[ai][bj][m][n]; } }
    }
};
struct EpiMoe1 {
    static constexpr bool PERM = false, AFTER_DRAIN = false;
    bf16_t* H1;
    __device__ __forceinline__ void operator()(const f32x4 (&acc)[2][2][4][2], const Unit& u, int wr, int wc, int fr, int fq) const {
        const int row0 = u.pm * BM + wr * 64 + fr, col0 = (u.pn & 3) * 128 + wc * 16 + 4 * fq;
#pragma unroll
        for (int ai = 0; ai < 2; ++ai)
#pragma unroll
            for (int m = 0; m < 4; ++m) { bf16_t* rowp = H1 + (size_t)(row0 + ai * HALF + m * 16) * 512 + col0;
#pragma unroll
                for (int bj = 0; bj < 2; ++bj) { const f32x4 g = acc[ai][bj][m][0], up = acc[ai][bj][m][1]; float h[4];
#pragma unroll
                    for (int j = 0; j < 4; ++j) h[j] = g[j] / (1.0f + __expf(-g[j])) * up[j];
                    u32x2 w; w.x = cvt_pk_bf16(h[0], h[1]); w.y = cvt_pk_bf16(h[2], h[3]);
                    *(u32x2*)(rowp + bj * 64) = w; } }
    }
};

template <class Epi, class Sched, bool GATHER = false>
__device__ __forceinline__ void gemm_phase(LAS unsigned char* lds, const Gemm g, const Sched& S, const Epi& E) {
    const int tid = ltid(), wid = __builtin_amdgcn_readfirstlane(tid >> 6), lane = tid & 63, wr = wid >> 2, wc = wid & 3, fr = lane & 15, fq = lane >> 4;
    const int K = g.K, nt = K / BK;
    unsigned voffA[2], voffB[2];
#pragma unroll
    for (int i = 0; i < 2; ++i) { int R, C; stage_rc(tid * 16 + i * 8192, R, C); const int Rb = Epi::PERM ? ((R & ~31) + perm32(R & 31)) : R;
        voffA[i] = (unsigned)(R * K + C) * 2u; voffB[i] = (unsigned)(Rb * K + C) * 2u; }
    unsigned vc0[2] = {0u, 0u}, vc1[2] = {0u, 0u}, vn0[2] = {0u, 0u}, vn1[2] = {0u, 0u};
#define PG8_GOFF(pm_, v0_, v1_) do { const int _tz = ltid(); _Pragma("unroll") for (int _i = 0; _i < 2; ++_i) { int _R, _C; stage_rc(_tz * 16 + _i * 8192, _R, _C); \
        v0_[_i] = (unsigned)g.rowtok[(pm_) * BM + _R] * (unsigned)(K * 2) + (unsigned)_C * 2u; v1_[_i] = (unsigned)g.rowtok[(pm_) * BM + HALF + _R] * (unsigned)(K * 2) + (unsigned)_C * 2u; } } while (0)
    const size_t kstep = (size_t)(BK * 2);
    const size_t hstep = (size_t)HALF * K * 2;
    const size_t tstep = 2 * hstep;
    const unsigned ldsw = (unsigned)wid * 1024u;
    const int aoff = lds_byte(wr * 64 + fr, fq * 8), boff = lds_byte(wc * 32 + fr, fq * 8);
#define PG8_SA(b, h) (((b) * 2 + (h)) * HTB)
#define PG8_SB(b, h) ((4 + (b) * 2 + (h)) * HTB)
#define PG8_STAGE(bufoff, gbase, voff) do { _Pragma("unroll") for (int _i = 0; _i < 2; ++_i) \
        __builtin_amdgcn_global_load_lds((const unsigned*)((const char*)(gbase) + (voff)[_i]), (LAS unsigned*)(lds + (bufoff) + ldsw + _i * 8192), 16, 0, 0); } while (0)
#define PG8_LDA(dst, b, h) do { _Pragma("unroll") for (int m = 0; m < 4; ++m) _Pragma("unroll") for (int k = 0; k < 2; ++k) dst[m][k] = *(const LAS bf16x8*)(lds + PG8_SA(b, h) + aoff + m * 2048 + k * 1024); } while (0)
#define PG8_LDB(dst, b, h) do { _Pragma("unroll") for (int n = 0; n < 2; ++n) _Pragma("unroll") for (int k = 0; k < 2; ++k) dst[n][k] = *(const LAS bf16x8*)(lds + PG8_SB(b, h) + boff + n * 2048 + k * 1024); } while (0)
#define PG8_MMA(ai, bj, At, Bt) do { __builtin_amdgcn_s_setprio(1); _Pragma("unroll") for (int m = 0; m < 4; ++m) _Pragma("unroll") for (int n = 0; n < 2; ++n) _Pragma("unroll") for (int k = 0; k < 2; ++k) \
        acc[ai][bj][m][n] = __builtin_amdgcn_mfma_f32_16x16x32_bf16(Bt[n][k], At[m][k], acc[ai][bj][m][n], 0, 0, 0); __builtin_amdgcn_s_setprio(0); } while (0)
#define PG8_WAIT_V(n) asm volatile("s_waitcnt vmcnt(" #n ")" ::: "memory")
#define PG8_WAIT_L(n) asm volatile("s_waitcnt lgkmcnt(" #n ")" ::: "memory")
#define PG8_BAR __builtin_amdgcn_s_barrier()
#define PG8_SCHED __builtin_amdgcn_sched_barrier(0)
    Unit cur, nxt; int ui = 0;
    if (!S.next(0, cur)) return;
    f32x4 acc[2][2][4][2];
#pragma unroll
    for (int a = 0; a < 2; ++a)
#pragma unroll
        for (int b = 0; b < 2; ++b)
#pragma unroll
            for (int m = 0; m < 4; ++m)
#pragma unroll
                for (int n = 0; n < 2; ++n) acc[a][b][m][n] = (f32x4){0.f, 0.f, 0.f, 0.f};
    bf16x8 At[4][2], B0[2][2], B1[2][2];
    const char* cA = GATHER ? (const char*)g.A : (const char*)g.A + (size_t)cur.pm * tstep; const char* cB = (const char*)g.Bt + (size_t)cur.pn * tstep;
    S.a_ready(cur);
    if constexpr (GATHER) { PG8_GOFF(cur.pm, vc0, vc1); vn0[0] = vc0[0]; vn0[1] = vc0[1]; vn1[0] = vc1[0]; vn1[1] = vc1[1]; }
    if constexpr (GATHER) { PG8_STAGE(PG8_SB(0, 0), cB, voffB); PG8_STAGE(PG8_SA(0, 0), cA, vc0); PG8_STAGE(PG8_SB(0, 1), cB + hstep, voffB); PG8_STAGE(PG8_SA(0, 1), cA, vc1); }
    else { PG8_STAGE(PG8_SB(0, 0), cB, voffB); PG8_STAGE(PG8_SA(0, 0), cA, voffA); PG8_STAGE(PG8_SB(0, 1), cB + hstep, voffB); PG8_STAGE(PG8_SA(0, 1), cA + hstep, voffA); }
    if (wr == 1) PG8_BAR;
    PG8_WAIT_V(4); PG8_BAR;
    if constexpr (GATHER) { PG8_STAGE(PG8_SB(1, 0), cB + kstep, voffB); PG8_STAGE(PG8_SA(1, 0), cA + kstep, vc0); PG8_STAGE(PG8_SB(1, 1), cB + hstep + kstep, voffB); }
    else { PG8_STAGE(PG8_SB(1, 0), cB + kstep, voffB); PG8_STAGE(PG8_SA(1, 0), cA + kstep, voffA); PG8_STAGE(PG8_SB(1, 1), cB + hstep + kstep, voffB); }
    PG8_WAIT_V(6); PG8_BAR;
    for (;;) {
        const bool has_next = S.next(ui + 1, nxt);
        const char* nA = GATHER ? cA : (has_next ? (const char*)g.A + (size_t)nxt.pm * tstep : cA); const char* nB = has_next ? (const char*)g.Bt + (size_t)nxt.pn * tstep : cB;
        if constexpr (GATHER) { if (has_next) PG8_GOFF(nxt.pm, vn0, vn1); }
        for (int t = 0; t < nt; t += 2) {
            const bool last = (t == nt - 2);
            unsigned s0[2] = {vc0[0], vc0[1]}, s1[2] = {vc1[0], vc1[1]};
            if constexpr (GATHER) { if (last) { asm volatile("" : "+v"(vn0[0]), "+v"(vn0[1]), "+v"(vn1[0]), "+v"(vn1[1])); s0[0] = vn0[0]; s0[1] = vn0[1]; s1[0] = vn1[0]; s1[1] = vn1[1]; } }
            const char* a1 = cA + (size_t)(t + 1) * kstep;
            const char* a2 = last ? nA : cA + (size_t)(t + 2) * kstep; const char* b2 = last ? nB : cB + (size_t)(t + 2) * kstep;
            const char* a3 = a2 + kstep; const char* b3 = b2 + kstep;
            if (last && has_next) S.a_ready(nxt);
            PG8_LDB(B0, 0, 0); PG8_SCHED; PG8_LDA(At, 0, 0); if constexpr (GATHER) PG8_STAGE(PG8_SA(1, 1), a1, vc1); else PG8_STAGE(PG8_SA(1, 1), a1 + hstep, voffA);
            PG8_WAIT_L(8); PG8_BAR; PG8_WAIT_L(0); PG8_MMA(0, 0, At, B0); PG8_BAR; PG8_SCHED;
            PG8_LDB(B1, 0, 1); PG8_STAGE(PG8_SB(0, 0), b2, voffB);
            PG8_BAR; PG8_WAIT_L(0); PG8_MMA(0, 1, At, B1); PG8_BAR;
            PG8_LDA(At, 0, 1); if constexpr (GATHER) PG8_STAGE(PG8_SA(0, 0), a2, s0); else PG8_STAGE(PG8_SA(0, 0), a2, voffA);
            PG8_BAR; PG8_WAIT_L(0); PG8_MMA(1, 0, At, B0); PG8_BAR; PG8_SCHED;
            PG8_STAGE(PG8_SB(0, 1), b2 + hstep, voffB);
            PG8_WAIT_V(6); PG8_BAR; PG8_MMA(1, 1, At, B1); PG8_BAR;
            PG8_LDB(B0, 1, 0); PG8_SCHED; PG8_LDA(At, 1, 0); if constexpr (GATHER) PG8_STAGE(PG8_SA(0, 1), a2, s1); else PG8_STAGE(PG8_SA(0, 1), a2 + hstep, voffA);
            PG8_WAIT_L(8); PG8_BAR; PG8_WAIT_L(0); PG8_MMA(0, 0, At, B0); PG8_BAR; PG8_SCHED;
            PG8_LDB(B1, 1, 1); PG8_STAGE(PG8_SB(1, 0), b3, voffB);
            PG8_BAR; PG8_WAIT_L(0); PG8_MMA(0, 1, At, B1); PG8_BAR;
            PG8_LDA(At, 1, 1); if constexpr (GATHER) PG8_STAGE(PG8_SA(1, 0), a3, s0); else PG8_STAGE(PG8_SA(1, 0), a3, voffA);
            PG8_BAR; PG8_WAIT_L(0); PG8_MMA(1, 0, At, B0); PG8_BAR; PG8_SCHED;
            PG8_STAGE(PG8_SB(1, 1), b3 + hstep, voffB);
            PG8_WAIT_V(6); PG8_BAR; PG8_MMA(1, 1, At, B1); PG8_BAR;
        }
        E(acc, cur, wr, wc, fr, fq); S.done(cur);
        if (!has_next) break;
#pragma unroll
        for (int a = 0; a < 2; ++a)
#pragma unroll
            for (int b = 0; b < 2; ++b)
#pragma unroll
                for (int m = 0; m < 4; ++m)
#pragma unroll
                    for (int n = 0; n < 2; ++n) acc[a][b][m][n] = (f32x4){0.f, 0.f, 0.f, 0.f};
        cur = nxt; cA = nA; cB = nB; ++ui;
        if constexpr (GATHER) { vc0[0] = vn0[0]; vc0[1] = vn0[1]; vc1[0] = vn1[0]; vc1[1] = vn1[1]; }
    }
    PG8_WAIT_V(0);
    if (wr == 0) PG8_BAR;
    PG8_BAR;
#undef PG8_GOFF
#undef PG8_SA
#undef PG8_SB
#undef PG8_STAGE
#undef PG8_LDA
#undef PG8_LDB
#undef PG8_MMA
#undef PG8_WAIT_V
#undef PG8_WAIT_L
#undef PG8_BAR
#undef PG8_SCHED
}
}
constexpr size_t MiB = 1024 * 1024;
constexpr size_t WS_CTL  = 0;
constexpr size_t CTL_BYTES = 65536;
constexpr size_t WS_MOD  = WS_CTL + CTL_BYTES;
constexpr size_t WS_BKT  = WS_MOD + 4 * 8 * 6144 * 4;
constexpr size_t WS_SP   = WS_BKT + 4096 * 4;
constexpr size_t WS_RTE  = WS_SP + (size_t)NTOK * 16 * 4;
constexpr size_t WS_RTW  = WS_RTE + (size_t)NTOK * 4;
constexpr size_t WS_POS  = WS_RTW + (size_t)NTOK * 8;
constexpr size_t WS_TC   = WS_POS + (size_t)NTOK * 8;
constexpr size_t WS_WUK  = WS_TC + 256 * 16 * 4;
constexpr size_t WS_WUV  = WS_WUK + 65536 * 2;
constexpr size_t WS_X    = 4 * MiB;
constexpr size_t WS_HBF  = WS_X + 128 * MiB;
constexpr size_t WS_P    = WS_HBF + 64 * MiB;
constexpr size_t WS_YMIX = WS_P + 192 * MiB;
constexpr size_t WS_H1   = WS_YMIX + 64 * MiB;
constexpr size_t WS_WIN  = WS_H1 + 68 * MiB;
constexpr size_t WS_WOUT = WS_WIN + 6 * MiB;
constexpr size_t WS_WGU  = WS_WOUT + 2 * MiB;
constexpr size_t WS_WDN  = WS_WGU + 32 * MiB;
constexpr size_t WS_END  = WS_WDN + 16 * MiB;
constexpr size_t WS_CL   = WS_END;
constexpr size_t WS_SCAL = WS_CL + 72 * MiB;
constexpr size_t WS_MC   = WS_SCAL + 512 * 1024;
constexpr size_t WS_ROWTOK = WS_MC + 512 * 1024;
constexpr size_t WS_END2 = WS_ROWTOK + 512 * 1024;
constexpr size_t WS_CTG  = WS_HBF;
constexpr size_t WS_STG  = WS_H1 + 36 * MiB;
static_assert(WS_WUV + 65536 * 2 <= WS_X, "small region overflow");
static_assert((size_t)MOE_ROWS * 512 * 2 <= 68 * MiB, "H1");
static_assert((size_t)MOE_ROWS * 1024 * 2 <= 192 * MiB, "AS");

constexpr int CW_BAR = 0;
constexpr int CW_WQ  = 4096;

constexpr int LDS_TOTAL = 147456;
constexpr int LDS_PERS  = 143360;
constexpr int LP_SLOT = 16, LP_TBASE = 64;

struct Params { const float* in[28]; float* out; unsigned char* ws; };
enum { I_X = 0, I_C, I_WADA, I_BADA, I_GMIX, I_GFFN, I_GFINAL, I_RELB, I_ABWIN, I_ABCONVW, I_ABCONVB, I_ABGATEB, I_ABHNORM, I_ABWUK, I_ABWUV, I_ABWOUT,
       I_CDWIN, I_CDWALPHA, I_CDBALPHA, I_CDHNORM, I_CDWOUT, I_MWC, I_MBC, I_MWF, I_MBF, I_MWG, I_MWU, I_MWD };

#define TID (ltid())
#define NTHR 512

__device__ __forceinline__ void p0_prologue(const Params& p, LAS unsigned char* lds) {
    const int tid = ltid(), G = GDIM;
    LAS float* sc = (LAS float*)lds;
    LAS float* red = (LAS float*)(lds + 32768);
    const float* c = p.in[I_C];
    for (int i = tid; i < 8 * 1024; i += NTHR) { const float v = c[i]; sc[i] = v / (1.0f + __expf(-v)); }
    __syncthreads();
    float* mod = (float*)(p.ws + WS_MOD);
    for (int u = BID; u < 4 * 48; u += G) {
        const int l = u / 48, e0 = (u % 48) * 128, col = tid & 127, ds = tid >> 7;
        const float* w = p.in[I_WADA] + (size_t)l * D * 6 * D + e0 + col;
        float a[8];
#pragma unroll
        for (int b = 0; b < 8; ++b) a[b] = 0.f;
        for (int d = ds * 256; d < ds * 256 + 256; ++d) { const float wv = w[(size_t)d * 6 * D];
#pragma unroll
            for (int b = 0; b < 8; ++b) a[b] += sc[b * 1024 + d] * wv; }
#pragma unroll
        for (int b = 0; b < 8; ++b) red[(ds * 8 + b) * 128 + col] = a[b];
        __syncthreads();
        for (int i = tid; i < 8 * 128; i += NTHR) { const int b = i >> 7, cc = i & 127;
            const float s = ((red[(0 * 8 + b) * 128 + cc] + red[(1 * 8 + b) * 128 + cc]) + red[(2 * 8 + b) * 128 + cc]) + red[(3 * 8 + b) * 128 + cc];
            mod[((size_t)l * 8 + b) * 6 * D + e0 + cc] = s + p.in[I_BADA][(size_t)l * 6 * D + e0 + cc]; }
        __syncthreads();
    }
    int* bkt = (int*)(p.ws + WS_BKT);
    for (int n = BID * NTHR + tid; n < 4096; n += G * NTHR) {
        int v;
        if (n < 16) v = n; else { v = 16 + (int)(log((double)n / 16.0) / log(128.0) * 16.0); if (v > 31) v = 31; }
        bkt[n] = v;
    }
}

template <class SrcF>
__device__ __forceinline__ void prep_tr(LAS unsigned char* lds, const SrcF& src, int K, int Nd, bf16_t* Bt) {
    LAS float* tile = (LAS float*)lds;
    const int tid = ltid(), G = GDIM, tnN = Nd / 64, ntile = tnN * (K / 64);
    for (int u = BID; u < ntile; u += G) {
        const int tn = u % tnN, tk = u / tnN;
#pragma unroll
        for (int i = 0; i < 8; ++i) { const int kk = (tid >> 6) + 8 * i, nn = tid & 63; tile[kk * 65 + nn] = src(tn * 64 + nn, tk * 64 + kk); }
        __syncthreads();
#pragma unroll
        for (int i = 0; i < 4; ++i) { const int nn = (tid >> 5) + 16 * i, kk = (tid & 31) * 2;
            *(unsigned*)(Bt + (size_t)(tn * 64 + nn) * K + tk * 64 + kk) = pk2(tile[kk * 65 + nn], tile[(kk + 1) * 65 + nn]); }
        __syncthreads();
    }
}
struct SrcShift { const float* W; int ldw, n0, shift, nvalid;
    __device__ __forceinline__ float operator()(int n, int k) const { if (n >= nvalid) return 0.f; return W[(size_t)k * ldw + (n >= n0 ? n + shift : n)]; } };
struct SrcGU { const float* Wg; const float* Wu;
    __device__ __forceinline__ float operator()(int n, int k) const { const int e = n >> 10, r = n & 1023, j = (r >> 5) * 16 + (r & 15); const unsigned long long dlt = (unsigned long long)Wu - (unsigned long long)Wg; const float* W = (const float*)((unsigned long long)Wg + (unsigned long long)((r >> 4) & 1) * dlt); return W[((size_t)e * 1024 + k) * 512 + j]; } };
struct SrcDN { const float* Wd;
    __device__ __forceinline__ float operator()(int n, int k) const { return Wd[((size_t)(n >> 10) * 512 + k) * 1024 + (n & 1023)]; } };

constexpr size_t WS_TAB = WS_WUV + 65536 * 2;
static_assert(WS_TAB + 13 * 16384 <= WS_X, "small region overflow");
struct WfAB { const float* W; __device__ __forceinline__ float operator()(int k, int c) const {
        if (c >= 12) return 0.f; const int col = c < 8 ? 1536 + c : 2504 + (c - 8); return W[(size_t)k * W_AB + col]; } };
struct WfCD { const float* W; __device__ __forceinline__ float operator()(int k, int c) const { return W[(size_t)k * W_CD + 1024 + c]; } };
struct WfRT { const float* Wc; const float* Wf; __device__ __forceinline__ float operator()(int k, int c) const {
        if (c < 4) return Wc[(size_t)k * 4 + c]; const int g = (c - 4) >> 2, e = (c - 4) & 3; return Wf[((size_t)g * D + k) * 4 + e]; } };
template <class WF>
__device__ __forceinline__ void build_small_tab(f32x4* tab, int nc4, const WF& wf) {
    for (int idx = BID * NTHR + TID; idx < nc4 * 1024; idx += GDIM * NTHR) {
        const int c4 = idx >> 10, r = idx & 1023, ij = r >> 6, lane = r & 63, k = 512 * (ij >> 3) + 8 * lane + (ij & 7);
        f32x4 v; v[0] = wf(k, 4 * c4); v[1] = wf(k, 4 * c4 + 1); v[2] = wf(k, 4 * c4 + 2); v[3] = wf(k, 4 * c4 + 3);
        tab[idx] = v; }
}
__device__ __forceinline__ void prep_layer(const Params& p, LAS unsigned char* lds, int l) {
    const int j = l >> 1;
    if ((l & 1) == 0) {
        SrcShift s{p.in[I_ABWIN] + (size_t)j * D * W_AB, W_AB, 1536, 8, 2496};
        prep_tr(lds, s, D, NP_AB, (bf16_t*)(p.ws + WS_WIN));
        SrcShift so{p.in[I_ABWOUT] + (size_t)j * D * D, D, 1 << 30, 0, D};
        prep_tr(lds, so, D, D, (bf16_t*)(p.ws + WS_WOUT));
        const float* wuk = p.in[I_ABWUK] + (size_t)j * 65536; const float* wuv = p.in[I_ABWUV] + (size_t)j * 65536;
        bf16_t* ouk = (bf16_t*)(p.ws + WS_WUK); bf16_t* ouv = (bf16_t*)(p.ws + WS_WUV);
        for (int i = BID * NTHR + TID; i < 65536; i += GDIM * NTHR) {
            ouk[i] = f2bf(wuk[i]);
            const int h = i >> 13, d = (i >> 7) & 63, r = i & 127;
            ouv[i] = f2bf(wuv[((size_t)r * 8 + h) * 64 + d]);
        }
    } else {
        SrcShift s{p.in[I_CDWIN] + (size_t)j * D * W_CD, W_CD, 1024, 16, 3072};
        prep_tr(lds, s, D, NP_CD, (bf16_t*)(p.ws + WS_WIN));
        SrcShift so{p.in[I_CDWOUT] + (size_t)j * D * D, D, 1 << 30, 0, D};
        prep_tr(lds, so, D, D, (bf16_t*)(p.ws + WS_WOUT));
    }
    { f32x4* tabg = (f32x4*)(p.ws + WS_TAB);
      if (l == 0) { WfAB wf{p.in[I_ABWIN]}; build_small_tab(tabg, 4, wf); }
      if (l + 1 < DEPTH) { const int ln = l + 1, jn = ln >> 1;
          if ((ln & 1) == 0) { WfAB wf{p.in[I_ABWIN] + (size_t)jn * D * W_AB}; build_small_tab(tabg + (ln & 1) * 4096, 4, wf); } else { WfCD wf{p.in[I_CDWIN] + (size_t)jn * D * W_CD}; build_small_tab(tabg + (ln & 1) * 4096, 4, wf); } }
      WfRT wr{p.in[I_MWC] + (size_t)l * D * 4, p.in[I_MWF] + (size_t)l * 4 * D * 4}; build_small_tab(tabg + 8 * 1024, 5, wr); }
    SrcGU sg{p.in[I_MWG] + (size_t)l * 16 * 1024 * 512, p.in[I_MWU] + (size_t)l * 16 * 1024 * 512};
    prep_tr(lds, sg, 1024, 16 * 1024, (bf16_t*)(p.ws + WS_WGU));
    SrcDN sd{p.in[I_MWD] + (size_t)l * 16 * 512 * 1024};
    prep_tr(lds, sd, 512, 16 * 1024, (bf16_t*)(p.ws + WS_WDN));
}

__device__ __forceinline__ void copy_tab_to_lds(LAS f32x4* dst, const f32x4* src, int n) { for (int i = TID; i < n; i += NTHR) dst[i] = src[i]; }
template <int NC4>
__device__ __forceinline__ void small_proj(const LAS f32x4* tab, const float (&h)[2][8], int lane, f32x4 (&out)[NC4]) {
#pragma unroll
    for (int c4 = 0; c4 < NC4; ++c4) { f32x4 a = (f32x4){0.f, 0.f, 0.f, 0.f};
#pragma unroll
        for (int i = 0; i < 2; ++i)
#pragma unroll
            for (int j = 0; j < 8; ++j) a += tab[(c4 * 16 + i * 8 + j) * 64 + lane] * h[i][j];
        out[c4] = a; asm volatile("" ::: "memory"); }
}
__device__ __forceinline__ float reduce16(const f32x4 (&a)[4], int lane) {
    const bool b5 = (lane & 32) != 0, b4 = (lane & 16) != 0, b3 = (lane & 8) != 0, b2 = (lane & 4) != 0;
    float w8[8], w4[4], w2[2];
#pragma unroll
    for (int c = 0; c < 8; ++c) { const float lo = a[c >> 2][c & 3], hi = a[(c + 8) >> 2][c & 3]; w8[c] = (b5 ? hi : lo) + __shfl_xor(b5 ? lo : hi, 32); }
#pragma unroll
    for (int c = 0; c < 4; ++c) w4[c] = (b4 ? w8[c + 4] : w8[c]) + __shfl_xor(b4 ? w8[c] : w8[c + 4], 16);
#pragma unroll
    for (int c = 0; c < 2; ++c) w2[c] = (b3 ? w4[c + 2] : w4[c]) + __shfl_xor(b3 ? w4[c] : w4[c + 2], 8);
    float w1 = (b2 ? w2[1] : w2[0]) + __shfl_xor(b2 ? w2[0] : w2[1], 4);
    w1 += __shfl_xor(w1, 2); w1 += __shfl_xor(w1, 1);
    return w1;
}
__device__ __forceinline__ float reduce4(const f32x4& a, int lane) {
    const bool b5 = (lane & 32) != 0, b4 = (lane & 16) != 0;
    const float u0 = (b5 ? a[2] : a[0]) + __shfl_xor(b5 ? a[0] : a[2], 32), u1 = (b5 ? a[3] : a[1]) + __shfl_xor(b5 ? a[1] : a[3], 32);
    float w = (b4 ? u1 : u0) + __shfl_xor(b4 ? u0 : u1, 16);
    w += __shfl_xor(w, 8); w += __shfl_xor(w, 4); w += __shfl_xor(w, 2); w += __shfl_xor(w, 1);
    return w;
}
__device__ __forceinline__ float rdl(float v, int l) { return __int_as_float(__builtin_amdgcn_readlane(__float_as_int(v), l)); }
__device__ __forceinline__ void unpack8(const u32x4& v, float (&o)[8]) {
#pragma unroll
    for (int e = 0; e < 4; ++e) { o[2 * e] = __uint_as_float(v[e] << 16); o[2 * e + 1] = __uint_as_float(v[e] & 0xffff0000u); } }

template <int MODE>
__device__ __forceinline__ void phase_tokens(const Params& p, LAS unsigned char* lds, int l) {
    const int tid = ltid(), lane = tid & 63, wave = tid >> 6, G = GDIM;
    LAS f32x4* tab = (LAS f32x4*)lds;
    LAS int* cnts = (LAS int*)(lds + 5 * 16384);
    if (MODE == 1) copy_tab_to_lds(tab, (const f32x4*)(p.ws + WS_TAB) + (l & 1) * 4096, 4 * 1024);
    if (MODE == 2) copy_tab_to_lds(tab, (const f32x4*)(p.ws + WS_TAB) + 8 * 1024, 5 * 1024);
    __syncthreads();
    const float* mod = (const float*)(p.ws + WS_MOD);
    float* X = (float*)(p.ws + WS_X); bf16_t* HBF = (bf16_t*)(p.ws + WS_HBF); float* SP = (float*)(p.ws + WS_SP);
    const bf16_t* YS = (const bf16_t*)(p.ws + WS_P);
    const int* POS = (const int*)(p.ws + WS_POS); float* RTW = (float*)(p.ws + WS_RTW); int* RTE = (int*)(p.ws + WS_RTE); int* TC = (int*)(p.ws + WS_TC);
    const bool comb = (MODE == 3) || (MODE == 1 && l > 0);
    const int lprev = (MODE == 3) ? 3 : l - 1;
    const float* biasc = p.in[I_MBC] + l * 4; const float* biasf = p.in[I_MBF] + l * 16;
    for (int grp = BID; grp < NTOK / 128; grp += G) {
        const int b = (grp * 128) >> 12;
        float ca[2][8], cb[2][8], gf[2][8];
#pragma unroll
        for (int i = 0; i < 2; ++i)
#pragma unroll
            for (int j = 0; j < 8; ++j) { const int col = 512 * i + 8 * lane + j;
                if (MODE == 1) { const float* mrow = mod + ((size_t)l * 8 + b) * 6 * D; ca[i][j] = p.in[I_GMIX][(size_t)l * D + col] * (mrow[D + col] + 1.0f); cb[i][j] = mrow[col]; }
                if (MODE == 2) { const float* mrow = mod + ((size_t)l * 8 + b) * 6 * D; ca[i][j] = p.in[I_GFFN][(size_t)l * D + col] * (mrow[4 * D + col] + 1.0f); cb[i][j] = mrow[3 * D + col]; }
                if (MODE == 3) { ca[i][j] = p.in[I_GFINAL][col]; cb[i][j] = 0.f; }
                gf[i][j] = comb ? mod[((size_t)lprev * 8 + b) * 6 * D + 5 * D + col] : 0.f; }
        int pos1v = 0, pos2v = 0; float w1v = 0.f, w2v = 0.f;
        if (comb && lane < 16) { const int tk = grp * 128 + wave * 16 + lane; pos1v = POS[2 * tk]; pos2v = POS[2 * tk + 1]; w1v = RTW[2 * tk]; w2v = RTW[2 * tk + 1]; }
        const float* xsrc = (MODE == 1 && l == 0) ? p.in[I_X] : X;
        LAS unsigned char* mb = lds + ((MODE == 2) ? (5 * 16384 + 1024) : (4 * 16384 + 1024)) + __builtin_amdgcn_readfirstlane(wave) * ((MODE == 2) ? 4096 : 8192);
#define TOK_ISSUE(tt_) do { const int tok_ = grp * 128 + wave * 16 + (tt_); \
            __builtin_amdgcn_global_load_lds((const unsigned*)(xsrc + (size_t)tok_ * D + 8 * lane), (LAS unsigned*)(mb), 16, 0, 0); \
            __builtin_amdgcn_global_load_lds((const unsigned*)(xsrc + (size_t)tok_ * D + 8 * lane + 4), (LAS unsigned*)(mb + 1024), 16, 0, 0); \
            __builtin_amdgcn_global_load_lds((const unsigned*)(xsrc + (size_t)tok_ * D + 512 + 8 * lane), (LAS unsigned*)(mb + 2048), 16, 0, 0); \
            __builtin_amdgcn_global_load_lds((const unsigned*)(xsrc + (size_t)tok_ * D + 512 + 8 * lane + 4), (LAS unsigned*)(mb + 3072), 16, 0, 0); \
            if (comb) { const int q1_ = __builtin_amdgcn_readlane(pos1v, (tt_)), q2_ = __builtin_amdgcn_readlane(pos2v, (tt_)); \
                __builtin_amdgcn_global_load_lds((const unsigned*)(YS + (size_t)q1_ * D + 8 * lane), (LAS unsigned*)(mb + 4096), 16, 0, 0); \
                __builtin_amdgcn_global_load_lds((const unsigned*)(YS + (size_t)q1_ * D + 512 + 8 * lane), (LAS unsigned*)(mb + 5120), 16, 0, 0); \
                __builtin_amdgcn_global_load_lds((const unsigned*)(YS + (size_t)q2_ * D + 8 * lane), (LAS unsigned*)(mb + 6144), 16, 0, 0); \
                __builtin_amdgcn_global_load_lds((const unsigned*)(YS + (size_t)q2_ * D + 512 + 8 * lane), (LAS unsigned*)(mb + 7168), 16, 0, 0); } } while (0)
        TOK_ISSUE(0);
        int cnt = 0;
#pragma unroll 1
        for (int tt = 0; tt < 16; ++tt) {
            const int tok = grp * 128 + wave * 16 + tt;
            asm volatile("s_waitcnt vmcnt(0)" ::: "memory");
            u32x4 xb[4], yb[4];
#pragma unroll
            for (int k4 = 0; k4 < 4; ++k4) xb[k4] = *(const LAS u32x4*)(mb + k4 * 1024 + lane * 16);
            if (comb) {
#pragma unroll
                for (int k4 = 0; k4 < 4; ++k4) yb[k4] = *(const LAS u32x4*)(mb + 4096 + k4 * 1024 + lane * 16);
            }
            asm volatile("s_waitcnt lgkmcnt(0)" ::: "memory");
            float x[2][8];
#pragma unroll
            for (int i = 0; i < 2; ++i)
#pragma unroll
                for (int j = 0; j < 8; ++j) x[i][j] = __uint_as_float(xb[2 * i + (j >> 2)][j & 3]);
            if (comb) { const float w1 = rdl(w1v, tt), w2 = rdl(w2v, tt);
#pragma unroll
                for (int i = 0; i < 2; ++i) { float y1[8], y2[8]; unpack8(yb[i], y1); unpack8(yb[2 + i], y2);
#pragma unroll
                    for (int j = 0; j < 8; ++j) x[i][j] += gf[i][j] * (y1[j] * w1 + y2[j] * w2); } }
            if (tt + 1 < 16) TOK_ISSUE(tt + 1);
            float ss = 0.f;
#pragma unroll
            for (int i = 0; i < 2; ++i)
#pragma unroll
                for (int j = 0; j < 8; ++j) ss += x[i][j] * x[i][j];
            ss = wave_sum(ss);
            const float rstd = 1.0f / sqrtf(ss * (1.0f / 1024.0f) + 1e-6f);
            float h[2][8];
#pragma unroll
            for (int i = 0; i < 2; ++i)
#pragma unroll
                for (int j = 0; j < 8; ++j) h[i][j] = x[i][j] * rstd * ca[i][j] + cb[i][j];
            if (MODE == 1) {
#pragma unroll
                for (int i = 0; i < 2; ++i) { *(f32x4*)(X + (size_t)tok * D + 512 * i + 8 * lane) = (f32x4){x[i][0], x[i][1], x[i][2], x[i][3]}; *(f32x4*)(X + (size_t)tok * D + 512 * i + 8 * lane + 4) = (f32x4){x[i][4], x[i][5], x[i][6], x[i][7]}; }
            }
            if (MODE == 3) {
#pragma unroll
                for (int i = 0; i < 2; ++i) { *(f32x4*)(p.out + (size_t)tok * D + 512 * i + 8 * lane) = (f32x4){h[i][0], h[i][1], h[i][2], h[i][3]}; *(f32x4*)(p.out + (size_t)tok * D + 512 * i + 8 * lane + 4) = (f32x4){h[i][4], h[i][5], h[i][6], h[i][7]}; }
            } else {
#pragma unroll
                for (int i = 0; i < 2; ++i) { u32x4 w; w.x = pk2(h[i][0], h[i][1]); w.y = pk2(h[i][2], h[i][3]); w.z = pk2(h[i][4], h[i][5]); w.w = pk2(h[i][6], h[i][7]); *(u32x4*)(HBF + (size_t)tok * D + 512 * i + 8 * lane) = w; }
            }
            if (MODE == 1) {
                f32x4 o[4]; o[3] = (f32x4){0.f, 0.f, 0.f, 0.f};
                if ((l & 1) == 0) { f32x4 o3[3]; small_proj<3>(tab, h, lane, o3); o[0] = o3[0]; o[1] = o3[1]; o[2] = o3[2]; }
                else small_proj<4>(tab, h, lane, o);
                const float v = reduce16(o, lane);
                if ((lane & 3) == 0) SP[(size_t)tok * 16 + (lane >> 2)] = v;
            }
            if (MODE == 2) {
                f32x4 oc = (f32x4){0.f, 0.f, 0.f, 0.f};
#pragma unroll
                for (int i = 0; i < 2; ++i)
#pragma unroll
                    for (int jj = 0; jj < 8; ++jj) oc += tab[(i * 8 + jj) * 64 + lane] * h[i][jj];
                const float vc = reduce4(oc, lane);
                float lc[4];
#pragma unroll
                for (int c = 0; c < 4; ++c) lc[c] = rdl(vc, 16 * c) + biasc[c];
                int g = 0; float mx = lc[0];
#pragma unroll
                for (int c = 1; c < 4; ++c) if (lc[c] > mx) { mx = lc[c]; g = c; }
                g = __builtin_amdgcn_readfirstlane(g);
                float se = 0.f;
#pragma unroll
                for (int c = 0; c < 4; ++c) se += expf(lc[c] - mx);
                const float pg = 1.0f / se;
                f32x4 of = (f32x4){0.f, 0.f, 0.f, 0.f};
                const LAS f32x4* tabf = tab + (1 + g) * 1024;
#pragma unroll
                for (int i = 0; i < 2; ++i)
#pragma unroll
                    for (int jj = 0; jj < 8; ++jj) of += tabf[(i * 8 + jj) * 64 + lane] * h[i][jj];
                const float vf = reduce4(of, lane);
                float lf[4];
#pragma unroll
                for (int e = 0; e < 4; ++e) lf[e] = rdl(vf, 16 * e) + biasf[g * 4 + e];
                int i1 = 0; float v1 = lf[0];
#pragma unroll
                for (int e = 1; e < 4; ++e) if (lf[e] > v1) { v1 = lf[e]; i1 = e; }
                int i2 = -1; float v2 = -3.0e38f;
#pragma unroll
                for (int e = 0; e < 4; ++e) if (e != i1 && lf[e] > v2) { v2 = lf[e]; i2 = e; }
                const float ex = expf(v2 - v1); const float p1 = 1.0f / (1.0f + ex), p2 = ex / (1.0f + ex);
                const int e1 = g * 4 + i1, e2 = g * 4 + i2;
                if (lane == 0) { RTE[tok] = e1 | (e2 << 8); RTW[2 * tok] = pg * p1; RTW[2 * tok + 1] = pg * p2; }
                cnt += (lane == e1 ? 1 : 0) + (lane == e2 ? 1 : 0);
            }
        }
#undef TOK_ISSUE
        if (MODE == 2) {
            __syncthreads();
            if (lane < 16) cnts[wave * 16 + lane] = cnt;
            __syncthreads();
            if (tid < 16) { int s = 0;
#pragma unroll
                for (int w = 0; w < 8; ++w) s += cnts[w * 16 + tid];
                TC[grp * 16 + tid] = s; }
        }
    }
}
__device__ __forceinline__ void phase_norm1(const Params& p, LAS unsigned char* lds, int l) { phase_tokens<1>(p, lds, l); }
__device__ __forceinline__ void phase_norm2(const Params& p, LAS unsigned char* lds, int l) { phase_tokens<2>(p, lds, l); }

__device__ __forceinline__ void phase_dispatch(const Params& p, LAS unsigned char* lds, LAS int* tbase) {
    const int tid = ltid(), lane = tid & 63, wave = tid >> 6, G = GDIM;
    LAS int* tc = (LAS int*)lds;
    LAS int* tot = (LAS int*)(lds + 16384);
    LAS int* earr = (LAS int*)(lds + 16384 + 256);
    LAS int* parr = (LAS int*)(lds + 16384 + 256 + 1024);
    LAS int* toff = (LAS int*)(lds + 16384 + 256 + 2048);
    const int* TC = (const int*)(p.ws + WS_TC); const int* RTE = (const int*)(p.ws + WS_RTE);
    int* POS = (int*)(p.ws + WS_POS);
    int* ROWTOK = (int*)(p.ws + WS_ROWTOK);
    for (int i = tid; i < 256 * 16; i += NTHR) tc[i] = TC[i];
    __syncthreads();
    if (tid < 16) { int s = 0; for (int g = 0; g < 256; ++g) s += tc[g * 16 + tid]; tot[tid] = s; }
    __syncthreads();
    if (tid == 0) { int rb = 0; for (int e = 0; e < 16; ++e) { tot[16 + e] = rb; tbase[e] = rb >> 8; rb += (tot[e] + 255) & ~255; } tbase[16] = rb >> 8; }
    __syncthreads();
    for (int e = 0; e < 16; ++e) { const int lo_ = tot[16 + e] + tot[e], hi_ = tot[16 + e] + ((tot[e] + 255) & ~255); for (int r = lo_ + tid; r < hi_; r += NTHR) ROWTOK[r] = 0; }
    for (int grp = BID; grp < NTOK / 128; grp += G) {
        if (tid < 16) { int s = 0; for (int g = 0; g < grp; ++g) s += tc[g * 16 + tid]; toff[tid] = s; }
        if (tid < 256) { const int ee = RTE[grp * 128 + (tid >> 1)]; earr[tid] = (tid & 1) ? ((ee >> 8) & 255) : (ee & 255); }
        __syncthreads();
        if (tid < 256) { const int e = earr[tid]; int rank = 0; for (int j = 0; j < tid; ++j) rank += (earr[j] == e) ? 1 : 0;
            const int pos = tot[16 + e] + toff[e] + rank; parr[tid] = pos; POS[(size_t)(grp * 128) * 2 + tid] = pos; }
        __syncthreads();
        if (tid < 256) ROWTOK[parr[tid]] = grp * 128 + (tid >> 1);
        __syncthreads();
    }
}

__device__ __forceinline__ void phase_final(const Params& p, LAS unsigned char* lds) { phase_tokens<3>(p, lds, 3); }
#ifndef PROF
#define PROF 0
#endif
constexpr int LP_TACC = 32;
#define TSEC_BEGIN(k) unsigned long long _ts##k = 0; if (PROF == (k) && ltid() == 0) _ts##k = wall_clock64();
#define TSEC_END(k) if (PROF == (k) && ltid() == 0) { *(LAS unsigned long long*)(lds + LDS_PERS + LP_TACC) += wall_clock64() - _ts##k; }
__device__ __forceinline__ f32x4 mfma16(bf16x8 a, bf16x8 b, f32x4 c) { return __builtin_amdgcn_mfma_f32_16x16x32_bf16(a, b, c, 0, 0, 0); }
__device__ __forceinline__ bf16x8 ldfrag(const LAS unsigned char* base, int row, int stride_bytes, int kk, int g) { return *(const LAS bf16x8*)(base + row * stride_bytes + (kk * 32 + g * 8) * 2); }
__device__ __forceinline__ float scan_add(float v, int lane) {
#pragma unroll
    for (int o = 1; o < 64; o <<= 1) { const float t = __shfl_up(v, o); if (lane >= o) v += t; }
    return v;
}
__device__ __forceinline__ float scan_max(float v, int lane) {
#pragma unroll
    for (int o = 1; o < 64; o <<= 1) { const float t = __shfl_up(v, o); if (lane >= o) v = fmaxf(v, t); }
    return v;
}
__device__ __forceinline__ float bfe(const u32x4& v, int e) { const unsigned w = v[e >> 1]; return __uint_as_float((e & 1) ? (w & 0xffff0000u) : (w << 16)); }
__device__ __forceinline__ bf16_t bfr(const u32x4& v, int e) { const unsigned w = v[e >> 1]; return (bf16_t)((e & 1) ? (w >> 16) : (w & 0xffffu)); }

constexpr int RS = 144;

__device__ __forceinline__ void unit_mlstm_L(const Params& p, LAS unsigned char* lds, int j, int b, int h, int ck) {
    const int tid = ltid(), lane = tid & 63, wave = __builtin_amdgcn_readfirstlane(tid >> 6), fr = lane & 15, g = lane >> 4;
    LAS unsigned char* KWT = lds; LAS unsigned char* VT = lds + 9216; LAS float* GA = (LAS float*)(lds + 29952);
    const bf16_t* P = (const bf16_t*)(p.ws + WS_P); const float* SP = (const float*)(p.ws + WS_SP);
    float* CL = (float*)(p.ws + WS_CL); float* SCAL = (float*)(p.ws + WS_SCAL);
    const int unit = (b * 4 + h) * 64 + ck; const int tok0 = b * SEQ + ck * 64;
    const int t = tid >> 3, seg = tid & 7, kc0 = 256 + h * 64 + seg * 8, pos = ck * 64 + t;
    TSEC_BEGIN(31) TSEC_BEGIN(32)
    u32x4 kin[4], vin[2];
#pragma unroll
    for (int q = 0; q < 4; ++q) { const int pp = pos - 3 + q; kin[q] = (pp >= 0) ? *(const u32x4*)(P + (size_t)(b * SEQ + pp) * NP_AB + kc0) : (u32x4){0u, 0u, 0u, 0u}; }
#pragma unroll
    for (int i = 0; i < 2; ++i) { const int idx = tid + 512 * i; vin[i] = *(const u32x4*)(P + (size_t)(tok0 + (idx >> 4)) * NP_AB + AB_VA + h * 128 + (idx & 15) * 8); }
    float we;
    {
        const int tok = tok0 + lane;
        const float li = SP[(size_t)tok * 16 + h] + p.in[I_ABGATEB][j * 8 + h]; const float lf = logsigmoidf_(SP[(size_t)tok * 16 + 4 + h] + p.in[I_ABGATEB][j * 8 + 4 + h]);
        const float bc = scan_add(lf, lane); const float a = li - bc; const float amax = __shfl(scan_max(a, lane), 63);
        we = __shfl(__expf(a - amax), t & 63);
        if (wave == 0 && lane == 63) { SCAL[unit * 2] = bc; SCAL[unit * 2 + 1] = amax; }
    }
    for (int i = tid; i < 16 * 72; i += NTHR) { const int r = i / 72; ((LAS bf16_t*)VT)[(128 + r) * 72 + (i % 72)] = (r == 0) ? (bf16_t)0x3F80 : (bf16_t)0; }
    { const float* convw = p.in[I_ABCONVW] + (size_t)j * 4 * 512 + kc0; const float* convb = p.in[I_ABCONVB] + j * 512 + kc0;
#pragma unroll
      for (int e = 0; e < 8; ++e) { float acc = convb[e];
#pragma unroll
        for (int q = 0; q < 4; ++q) acc += convw[q * 512 + e] * bfe(kin[q], e);
        const float v = acc / (1.0f + __expf(-acc)); ((LAS bf16_t*)KWT)[(seg * 8 + e) * 72 + t] = f2bf(v * we); } }
#pragma unroll
    for (int i = 0; i < 2; ++i) { const int idx = tid + 512 * i; const int s = idx >> 4, sg = idx & 15;
#pragma unroll
        for (int e = 0; e < 8; ++e) ((LAS bf16_t*)VT)[(sg * 8 + e) * 72 + s] = bfr(vin[i], e); }
    __syncthreads();
    TSEC_END(32) TSEC_BEGIN(33)
#pragma unroll
    for (int i = 0; i < 5; ++i) { const int id = wave + 8 * i;
        if (id < 36) { const int tk = id / 9, tv = id % 9; f32x4 acc = (f32x4){0.f, 0.f, 0.f, 0.f};
#pragma unroll
            for (int kk = 0; kk < 2; ++kk) acc = mfma16(ldfrag(KWT, tk * 16 + fr, RS, kk, g), ldfrag(VT, tv * 16 + fr, RS, kk, g), acc);
#pragma unroll
            for (int r = 0; r < 4; ++r) CL[(size_t)unit * 9216 + (tk * 16 + 4 * g + r) * 144 + tv * 16 + fr] = acc[r]; } }
    __syncthreads();
    TSEC_END(33) TSEC_END(31)
}

__device__ __forceinline__ void phase_scan_mlstm(const Params& p) {
    const float* CL = (const float*)(p.ws + WS_CL); const float* SCAL = (const float*)(p.ws + WS_SCAL); float* MC = (float*)(p.ws + WS_MC); bf16_t* CTG = (bf16_t*)(p.ws + WS_CTG);
    for (int e = BID * NTHR + TID; e < 32 * 9216; e += GDIM * NTHR) {
        const int bh = e / 9216, r = e % 9216;
        float C = 0.f, m = -1e30f;
#pragma unroll 1
        for (int c0 = 0; c0 < 64; c0 += 8) { float v[8];
#pragma unroll
            for (int i = 0; i < 8; ++i) v[i] = CL[(size_t)(bh * 64 + c0 + i) * 9216 + r];
#pragma unroll
            for (int i = 0; i < 8; ++i) { const int unit = bh * 64 + c0 + i; const float bL = SCAL[unit * 2], amax = SCAL[unit * 2 + 1];
                CTG[(size_t)unit * 9216 + r] = f2bf(C); if (r == 0) MC[unit] = m;
                const float M = fmaxf(m, amax); C = __expf(m - M) * C + __expf(amax - M) * v[i]; m = bL + M; } }
    }
}

__device__ __forceinline__ void unit_mlstm_O(const Params& p, LAS unsigned char* lds, int j, int b, int h, int ck) {
    const int tid = ltid(), lane = tid & 63, wave = __builtin_amdgcn_readfirstlane(tid >> 6), fr = lane & 15, g = lane >> 4;
    LAS unsigned char* QS = lds; LAS unsigned char* KS = lds + 9216; LAS unsigned char* VT = lds + 18432; LAS unsigned char* CT = lds + 39168; LAS unsigned char* PS = lds + 59904;
    LAS float* OS = (LAS float*)(lds + 69120); LAS float* GA = (LAS float*)(lds + 107008);
    constexpr int OSS = 148;
    const bf16_t* P = (const bf16_t*)(p.ws + WS_P); const float* SP = (const float*)(p.ws + WS_SP); bf16_t* YMIX = (bf16_t*)(p.ws + WS_YMIX);
    const bf16_t* CTG = (const bf16_t*)(p.ws + WS_CTG); const float* MC = (const float*)(p.ws + WS_MC);
    const int unit = (b * 4 + h) * 64 + ck; const int tok0 = b * SEQ + ck * 64;
    const int sg = tid & 15;
    const int ch0 = (sg < 8) ? h * 64 + sg * 8 : 256 + h * 64 + (sg - 8) * 8;
    u32x4 qkin[2][4], vin[2], cin[3], oin[2];
#pragma unroll
    for (int i = 0; i < 2; ++i) { const int tt = (tid + 512 * i) >> 4; const int pos = ck * 64 + tt;
#pragma unroll
        for (int q = 0; q < 4; ++q) { const int pp = pos - 3 + q; qkin[i][q] = (pp >= 0) ? *(const u32x4*)(P + (size_t)(b * SEQ + pp) * NP_AB + ch0) : (u32x4){0u, 0u, 0u, 0u}; }
        vin[i] = *(const u32x4*)(P + (size_t)(tok0 + tt) * NP_AB + AB_VA + h * 128 + sg * 8);
        oin[i] = *(const u32x4*)(P + (size_t)(tok0 + tt) * NP_AB + AB_OA + h * 128 + sg * 8); }
#pragma unroll
    for (int i = 0; i < 3; ++i) { const int idx = tid + 512 * i; cin[i] = (idx < 1152) ? *(const u32x4*)(CTG + (size_t)unit * 9216 + idx * 8) : (u32x4){0u, 0u, 0u, 0u}; }
    {
        const int tok = tok0 + lane; const float mc = MC[unit];
        const float li = SP[(size_t)tok * 16 + h] + p.in[I_ABGATEB][j * 8 + h]; const float lf = logsigmoidf_(SP[(size_t)tok * 16 + 4 + h] + p.in[I_ABGATEB][j * 8 + 4 + h]);
        const float bc = scan_add(lf, lane); const float a = li - bc; const float M = fmaxf(mc, scan_max(a, lane));
        GA[lane] = a; GA[64 + lane] = M; GA[128 + lane] = __expf(mc - M); GA[192 + lane] = __expf(-(bc + M));
    }
    for (int i = tid; i < 16 * 72; i += NTHR) { const int r = i / 72; ((LAS bf16_t*)VT)[(128 + r) * 72 + (i % 72)] = (r == 0) ? (bf16_t)0x3F80 : (bf16_t)0; }
    { const float* convw = p.in[I_ABCONVW] + (size_t)j * 4 * 512 + ch0; const float* convb = p.in[I_ABCONVB] + j * 512 + ch0;
      float cw[4][8], cb[8];
#pragma unroll
      for (int e = 0; e < 8; ++e) { cb[e] = convb[e];
#pragma unroll
        for (int q = 0; q < 4; ++q) cw[q][e] = convw[q * 512 + e]; }
      const float qs = (sg < 8) ? 0.125f : 1.0f;
#pragma unroll
      for (int i = 0; i < 2; ++i) { const int tt = (tid + 512 * i) >> 4; float o[8];
#pragma unroll
        for (int e = 0; e < 8; ++e) { float acc = cb[e];
#pragma unroll
            for (int q = 0; q < 4; ++q) acc += cw[q][e] * bfe(qkin[i][q], e);
            o[e] = acc / (1.0f + __expf(-acc)) * qs; }
        u32x4 w; w.x = pk2(o[0], o[1]); w.y = pk2(o[2], o[3]); w.z = pk2(o[4], o[5]); w.w = pk2(o[6], o[7]);
        *(LAS u32x4*)(((sg < 8) ? QS : KS) + tt * RS + (sg & 7) * 16) = w;
#pragma unroll
        for (int e = 0; e < 8; ++e) ((LAS bf16_t*)VT)[(sg * 8 + e) * 72 + tt] = bfr(vin[i], e); } }
#pragma unroll
    for (int i = 0; i < 3; ++i) { const int idx = tid + 512 * i;
        if (idx < 1152) { const int dk = idx / 18, sv = idx % 18;
#pragma unroll
            for (int e = 0; e < 8; ++e) ((LAS bf16_t*)CT)[(sv * 8 + e) * 72 + dk] = bfr(cin[i], e); } }
    __syncthreads();
    { const int tq = wave >> 1;
#pragma unroll
      for (int u = 0; u < 2; ++u) { const int ts = (wave & 1) * 2 + u; f32x4 acc = (f32x4){0.f, 0.f, 0.f, 0.f};
        if (ts <= tq) {
#pragma unroll
            for (int kk = 0; kk < 2; ++kk) acc = mfma16(ldfrag(QS, tq * 16 + fr, RS, kk, g), ldfrag(KS, ts * 16 + fr, RS, kk, g), acc);
        }
        const int s = ts * 16 + fr; const float as = GA[s];
#pragma unroll
        for (int r = 0; r < 4; ++r) { const int t = tq * 16 + 4 * g + r; const float pv = (ts <= tq && s <= t) ? acc[r] * __expf(as - GA[64 + t]) : 0.f; ((LAS bf16_t*)PS)[t * 72 + s] = f2bf(pv); } } }
    __syncthreads();
#pragma unroll
    for (int i = 0; i < 5; ++i) { const int id = wave + 8 * i;
        if (id < 36) { const int tq = id / 9, tv = id % 9; f32x4 acc = (f32x4){0.f, 0.f, 0.f, 0.f};
#pragma unroll
            for (int kk = 0; kk < 2; ++kk) acc = mfma16(ldfrag(QS, tq * 16 + fr, RS, kk, g), ldfrag(CT, tv * 16 + fr, RS, kk, g), acc);
#pragma unroll
            for (int r = 0; r < 4; ++r) acc[r] *= GA[128 + tq * 16 + 4 * g + r];
#pragma unroll
            for (int kk = 0; kk < 2; ++kk) acc = mfma16(ldfrag(PS, tq * 16 + fr, RS, kk, g), ldfrag(VT, tv * 16 + fr, RS, kk, g), acc);
#pragma unroll
            for (int r = 0; r < 4; ++r) OS[(tq * 16 + 4 * g + r) * OSS + tv * 16 + fr] = acc[r]; } }
    __syncthreads();
    { const float* hgp = p.in[I_ABHNORM] + j * 512 + h * 128 + sg * 8;
#pragma unroll
      for (int i = 0; i < 2; ++i) { const int tt = (tid + 512 * i) >> 4;
        const float den = OS[tt * OSS + 128]; const float dn = fmaxf(fabsf(den), GA[192 + tt]); const float idn = 1.0f / dn;
        const f32x4 a0 = *(const LAS f32x4*)(OS + tt * OSS + sg * 8), a1 = *(const LAS f32x4*)(OS + tt * OSS + sg * 8 + 4);
        float hv[8] = {a0[0] * idn, a0[1] * idn, a0[2] * idn, a0[3] * idn, a1[0] * idn, a1[1] * idn, a1[2] * idn, a1[3] * idn};
        float ss = 0.f;
#pragma unroll
        for (int e = 0; e < 8; ++e) ss += hv[e] * hv[e];
        ss += __shfl_xor(ss, 1); ss += __shfl_xor(ss, 2); ss += __shfl_xor(ss, 4); ss += __shfl_xor(ss, 8);
        const float rn = 1.0f / sqrtf(ss * (1.0f / 128.0f) + 1e-6f);
        float y[8];
#pragma unroll
        for (int e = 0; e < 8; ++e) y[e] = hv[e] * rn * hgp[e] * sigmoidf_(bfe(oin[i], e));
        u32x4 w; w.x = pk2(y[0], y[1]); w.y = pk2(y[2], y[3]); w.z = pk2(y[4], y[5]); w.w = pk2(y[6], y[7]);
        *(u32x4*)(YMIX + (size_t)(tok0 + tt) * D + h * 128 + sg * 8) = w; } }
    __syncthreads();
}

__device__ __forceinline__ void gla_cumsum(const Params& p, int j, int h, int tok0, int lane, int wave, LAS float* BS, LAS float* BL, float* scal_unit) {
    const float* SP = (const float*)(p.ws + WS_SP);
    f32x4 gq[4];
#pragma unroll
    for (int r = 0; r < 4; ++r) gq[r] = *(const f32x4*)(SP + (size_t)(tok0 + lane) * 16 + 4 * r);
    const float* wa = p.in[I_CDWALPHA] + (size_t)j * 16 * 256 + h * 64 + wave * 8; const float* ba = p.in[I_CDBALPHA] + j * 256 + h * 64 + wave * 8;
#pragma unroll
    for (int i = 0; i < 8; ++i) { float z = ba[i];
#pragma unroll
        for (int r = 0; r < 16; ++r) z += gq[r >> 2][r & 3] * wa[r * 256 + i];
        const float la = logsigmoidf_(z) * (1.0f / 16.0f); const float bc = scan_add(la, lane);
        BS[lane * 65 + wave * 8 + i] = bc;
        if (lane == 63) { BL[wave * 8 + i] = bc; if (scal_unit) scal_unit[wave * 8 + i] = __expf(bc); } }
}
__device__ __forceinline__ void unit_gla_L(const Params& p, LAS unsigned char* lds, int j, int b, int h, int ck) {
    const int tid = ltid(), lane = tid & 63, wave = __builtin_amdgcn_readfirstlane(tid >> 6), fr = lane & 15, g = lane >> 4;
    LAS unsigned char* KWT = lds; LAS unsigned char* VT = lds + 9216; LAS float* BS = (LAS float*)(lds + 27648); LAS float* BL = (LAS float*)(lds + 44288);
    const bf16_t* P = (const bf16_t*)(p.ws + WS_P); float* CL = (float*)(p.ws + WS_CL); float* SCAL = (float*)(p.ws + WS_SCAL);
    const int unit = (b * 4 + h) * 64 + ck; const int tok0 = b * SEQ + ck * 64;
    const int t = tid >> 3, seg = tid & 7;
    const u32x4 kin = *(const u32x4*)(P + (size_t)(tok0 + t) * NP_CD + CD_KC + h * 64 + seg * 8);
    u32x4 vin[2];
#pragma unroll
    for (int i = 0; i < 2; ++i) { const int idx = tid + 512 * i; vin[i] = *(const u32x4*)(P + (size_t)(tok0 + (idx >> 4)) * NP_CD + CD_VC + h * 128 + (idx & 15) * 8); }
    gla_cumsum(p, j, h, tok0, lane, wave, BS, BL, SCAL + (size_t)unit * 64);
    __syncthreads();
#pragma unroll
    for (int e = 0; e < 8; ++e) { const int kk = seg * 8 + e; ((LAS bf16_t*)KWT)[kk * 72 + t] = f2bf(bfe(kin, e) * __expf(BL[kk] - BS[t * 65 + kk])); }
#pragma unroll
    for (int i = 0; i < 2; ++i) { const int idx = tid + 512 * i; const int s = idx >> 4, sg = idx & 15;
#pragma unroll
        for (int e = 0; e < 8; ++e) ((LAS bf16_t*)VT)[(sg * 8 + e) * 72 + s] = bfr(vin[i], e); }
    __syncthreads();
#pragma unroll
    for (int i = 0; i < 4; ++i) { const int id = wave + 8 * i; const int tk = id >> 3, tv = id & 7; f32x4 acc = (f32x4){0.f, 0.f, 0.f, 0.f};
#pragma unroll
        for (int kk = 0; kk < 2; ++kk) acc = mfma16(ldfrag(KWT, tk * 16 + fr, RS, kk, g), ldfrag(VT, tv * 16 + fr, RS, kk, g), acc);
#pragma unroll
        for (int r = 0; r < 4; ++r) CL[(size_t)unit * 8192 + (tk * 16 + 4 * g + r) * 128 + tv * 16 + fr] = acc[r]; }
    __syncthreads();
}
__device__ __forceinline__ void phase_scan_gla(const Params& p) {
    const float* CL = (const float*)(p.ws + WS_CL); const float* SCAL = (const float*)(p.ws + WS_SCAL); bf16_t* STG = (bf16_t*)(p.ws + WS_STG);
    for (int e = BID * NTHR + TID; e < 32 * 8192; e += GDIM * NTHR) {
        const int bh = e >> 13, r = e & 8191, dk = r >> 7;
        float S = 0.f;
#pragma unroll 1
        for (int c0 = 0; c0 < 64; c0 += 8) { float v[8], dc[8];
#pragma unroll
            for (int i = 0; i < 8; ++i) { v[i] = CL[(size_t)(bh * 64 + c0 + i) * 8192 + r]; dc[i] = SCAL[(size_t)(bh * 64 + c0 + i) * 64 + dk]; }
#pragma unroll
            for (int i = 0; i < 8; ++i) { STG[(size_t)(bh * 64 + c0 + i) * 8192 + r] = f2bf(S); S = dc[i] * S + v[i]; } }
    }
}
__device__ __forceinline__ void unit_gla_O(const Params& p, LAS unsigned char* lds, int j, int b, int h, int ck) {
    const int tid = ltid(), lane = tid & 63, wave = __builtin_amdgcn_readfirstlane(tid >> 6), fr = lane & 15, g = lane >> 4;
    LAS unsigned char* QS = lds; LAS unsigned char* KS = lds + 9216; LAS unsigned char* VT = lds + 18432; LAS unsigned char* ST = lds + 36864; LAS unsigned char* PS = lds + 55296;
    LAS float* OS = (LAS float*)(lds + 64512); LAS float* BS = (LAS float*)(lds + 98304); LAS float* BL = (LAS float*)(lds + 114944);
    constexpr int OSS = 132;
    const bf16_t* P = (const bf16_t*)(p.ws + WS_P); bf16_t* YMIX = (bf16_t*)(p.ws + WS_YMIX); const bf16_t* STG = (const bf16_t*)(p.ws + WS_STG);
    const int unit = (b * 4 + h) * 64 + ck; const int tok0 = b * SEQ + ck * 64;
    const int sg = tid & 15; const int ch0 = (sg < 8) ? CD_QC + h * 64 + sg * 8 : CD_KC + h * 64 + (sg - 8) * 8;
    u32x4 qkin[2], vin[2], sin_[2], rin[2];
#pragma unroll
    for (int i = 0; i < 2; ++i) { const int idx = tid + 512 * i; const int tt = idx >> 4;
        qkin[i] = *(const u32x4*)(P + (size_t)(tok0 + tt) * NP_CD + ch0);
        vin[i] = *(const u32x4*)(P + (size_t)(tok0 + tt) * NP_CD + CD_VC + h * 128 + sg * 8);
        rin[i] = *(const u32x4*)(P + (size_t)(tok0 + tt) * NP_CD + CD_RC + h * 128 + sg * 8);
        sin_[i] = *(const u32x4*)(STG + (size_t)unit * 8192 + idx * 8); }
    gla_cumsum(p, j, h, tok0, lane, wave, BS, BL, nullptr);
    __syncthreads();
#pragma unroll
    for (int i = 0; i < 2; ++i) { const int idx = tid + 512 * i; const int tt = idx >> 4; float o[8];
#pragma unroll
        for (int e = 0; e < 8; ++e) { const float bb = BS[tt * 65 + (sg & 7) * 8 + e]; o[e] = (sg < 8) ? bfe(qkin[i], e) * 0.125f * __expf(bb) : bfe(qkin[i], e) * __expf(-bb); }
        u32x4 w; w.x = pk2(o[0], o[1]); w.y = pk2(o[2], o[3]); w.z = pk2(o[4], o[5]); w.w = pk2(o[6], o[7]);
        *(LAS u32x4*)(((sg < 8) ? QS : KS) + tt * RS + (sg & 7) * 16) = w;
#pragma unroll
        for (int e = 0; e < 8; ++e) { ((LAS bf16_t*)VT)[(sg * 8 + e) * 72 + tt] = bfr(vin[i], e); ((LAS bf16_t*)ST)[(sg * 8 + e) * 72 + tt] = bfr(sin_[i], e); } }
    __syncthreads();
    { const int tq = wave >> 1;
#pragma unroll
      for (int u = 0; u < 2; ++u) { const int ts = (wave & 1) * 2 + u; f32x4 acc = (f32x4){0.f, 0.f, 0.f, 0.f};
        if (ts <= tq) {
#pragma unroll
            for (int kk = 0; kk < 2; ++kk) acc = mfma16(ldfrag(QS, tq * 16 + fr, RS, kk, g), ldfrag(KS, ts * 16 + fr, RS, kk, g), acc);
        }
        const int s = ts * 16 + fr;
#pragma unroll
        for (int r = 0; r < 4; ++r) { const int t = tq * 16 + 4 * g + r; const float pv = (ts <= tq && s <= t) ? acc[r] : 0.f; ((LAS bf16_t*)PS)[t * 72 + s] = f2bf(pv); } } }
    __syncthreads();
#pragma unroll
    for (int i = 0; i < 4; ++i) { const int id = wave + 8 * i; const int tq = id >> 3, tv = id & 7; f32x4 acc = (f32x4){0.f, 0.f, 0.f, 0.f};
#pragma unroll
        for (int kk = 0; kk < 2; ++kk) acc = mfma16(ldfrag(QS, tq * 16 + fr, RS, kk, g), ldfrag(ST, tv * 16 + fr, RS, kk, g), acc);
#pragma unroll
        for (int kk = 0; kk < 2; ++kk) acc = mfma16(ldfrag(PS, tq * 16 + fr, RS, kk, g), ldfrag(VT, tv * 16 + fr, RS, kk, g), acc);
#pragma unroll
        for (int r = 0; r < 4; ++r) OS[(tq * 16 + 4 * g + r) * OSS + tv * 16 + fr] = acc[r]; }
    __syncthreads();
    { const float* hgp = p.in[I_CDHNORM] + j * 512 + h * 128 + sg * 8;
#pragma unroll
      for (int i = 0; i < 2; ++i) { const int tt = (tid + 512 * i) >> 4;
        const f32x4 a0 = *(const LAS f32x4*)(OS + tt * OSS + sg * 8), a1 = *(const LAS f32x4*)(OS + tt * OSS + sg * 8 + 4);
        float hv[8] = {a0[0], a0[1], a0[2], a0[3], a1[0], a1[1], a1[2], a1[3]};
        float ss = 0.f;
#pragma unroll
        for (int e = 0; e < 8; ++e) ss += hv[e] * hv[e];
        ss += __shfl_xor(ss, 1); ss += __shfl_xor(ss, 2); ss += __shfl_xor(ss, 4); ss += __shfl_xor(ss, 8);
        const float rn = 1.0f / sqrtf(ss * (1.0f / 128.0f) + 1e-6f);
        float y[8];
#pragma unroll
        for (int e = 0; e < 8; ++e) y[e] = hv[e] * rn * hgp[e] * siluf_(bfe(rin[i], e));
        u32x4 w; w.x = pk2(y[0], y[1]); w.y = pk2(y[2], y[3]); w.z = pk2(y[4], y[5]); w.w = pk2(y[6], y[7]);
        *(u32x4*)(YMIX + (size_t)(tok0 + tt) * D + h * 128 + sg * 8) = w; } }
    __syncthreads();
}
constexpr int L_BKT8 = 134144, L_RELB = 138240;
__device__ __forceinline__ void load_attn_tables(const Params& p, LAS unsigned char* lds) {
    const int* bkt = (const int*)(p.ws + WS_BKT);
    for (int i = TID; i < 4096; i += NTHR) lds[L_BKT8 + i] = (unsigned char)bkt[i];
    if (TID < 256) ((LAS float*)(lds + L_RELB))[TID] = p.in[I_RELB][TID];
}
__device__ __forceinline__ int scan_add_i(int v, int lane) {
#pragma unroll
    for (int o = 1; o < 64; o <<= 1) { const int t = __shfl_up(v, o); if (lane >= o) v += t; }
    return v;
}
__device__ __forceinline__ unsigned keep_lowest(unsigned m, int n) {
    if (n <= 0) return 0u;
    while ((int)__popc(m) > n) m &= ~(1u << (31 - __clz((int)m)));
    return m;
}
__device__ __forceinline__ bf16x4 tr_read(unsigned lds_addr) { bf16x4 r; asm volatile("ds_read_b64_tr_b16 %0, %1\n\ts_waitcnt lgkmcnt(0)" : "=&v"(r) : "v"(lds_addr) : "memory"); return r; }
__device__ __forceinline__ void pf_wait4(u32x4& a, u32x4& b, u32x4& c, u32x4& d) { asm volatile("s_waitcnt vmcnt(0)" : "+v"(a), "+v"(b), "+v"(c), "+v"(d) :: "memory"); }
__device__ __forceinline__ void pf_wait8(u32x4 (&v)[8]) { asm volatile("s_waitcnt vmcnt(0)" : "+v"(v[0]), "+v"(v[1]), "+v"(v[2]), "+v"(v[3]), "+v"(v[4]), "+v"(v[5]), "+v"(v[6]), "+v"(v[7]) :: "memory"); }
__device__ __forceinline__ bf16x8 as_bf16x8(const u32x4& v) { return __builtin_bit_cast(bf16x8, v); }
__device__ __forceinline__ void lds_add_u32(unsigned byte_addr, unsigned v) { asm volatile("ds_add_u32 %0, %1" :: "v"(byte_addr), "v"(v) : "memory"); }
__device__ __forceinline__ void lds_or_b32(unsigned byte_addr, unsigned v) { asm volatile("ds_or_b32 %0, %1" :: "v"(byte_addr), "v"(v) : "memory"); }
__device__ __forceinline__ unsigned sortable(float f) { const int u = __float_as_int(f); return (unsigned)u ^ ((unsigned)(u >> 31) | 0x80000000u); }

template <int PASS>
__device__ __forceinline__ void dsa_score_pass(const bf16_t* P, size_t rowb, int nkt, int wave, int fr, int g, int tq, const bf16x8 (&qf)[4][2], const float (&wq)[4],
                                               unsigned pfx, unsigned tau, unsigned hist_a, unsigned gtm_a, unsigned eqm_a) {
        const bf16_t* kbase = P + rowb * NP_AB + AB_KI + (size_t)fr * NP_AB + g * 8;
        u32x4 c0, c1, c2, c3, n0, n1, n2, n3;
        { const int ka = wave < nkt ? wave : nkt - 1, kb = wave + 8 < nkt ? wave + 8 : nkt - 1;
          gload16(c0, kbase + (size_t)ka * 16 * NP_AB); gload16(c1, kbase + (size_t)ka * 16 * NP_AB + 32); gload16(c2, kbase + (size_t)kb * 16 * NP_AB); gload16(c3, kbase + (size_t)kb * 16 * NP_AB + 32);
          pf_wait4(c0, c1, c2, c3); }
#pragma unroll 1
        for (int kt = wave; kt < nkt; kt += 16) {
            { const int ka = kt + 16 < nkt ? kt + 16 : nkt - 1, kb = kt + 24 < nkt ? kt + 24 : nkt - 1;
              gload16(n0, kbase + (size_t)ka * 16 * NP_AB); gload16(n1, kbase + (size_t)ka * 16 * NP_AB + 32); gload16(n2, kbase + (size_t)kb * 16 * NP_AB); gload16(n3, kbase + (size_t)kb * 16 * NP_AB + 32); }
#pragma unroll
            for (int half = 0; half < 2; ++half) { const int kth = kt + 8 * half;
                if (kth < nkt) {
                    const bf16x8 k0 = as_bf16x8(half ? c2 : c0), k1 = as_bf16x8(half ? c3 : c1);
                    f32x4 sc = (f32x4){0.f, 0.f, 0.f, 0.f};
#pragma unroll
                    for (int hh = 0; hh < 4; ++hh) { f32x4 a = (f32x4){0.f, 0.f, 0.f, 0.f}; a = mfma16(k0, qf[hh][0], a); a = mfma16(k1, qf[hh][1], a);
#pragma unroll
                        for (int r = 0; r < 4; ++r) { const int ai = __float_as_int(a[r]); sc[r] = fmaf(__int_as_float(ai > 0 ? ai : 0), wq[hh], sc[r]); } }
                    unsigned gtb = 0u, eqb = 0u;
#pragma unroll
                    for (int r = 0; r < 4; ++r) { const int s = kth * 16 + 4 * g + r; const bool valid = s <= tq; const unsigned key = sortable(sc[r]);
                        if (PASS == 0) { const unsigned bin = key >> 21; lds_add_u32(hist_a + (bin >> 1) * 4u, valid ? (1u << ((bin & 1u) * 16u)) : 0u); }
                        else if (PASS == 1) { const unsigned bin = (key >> 10) & 2047u; lds_add_u32(hist_a + (bin >> 1) * 4u, (valid && (key >> 21) == pfx) ? (1u << ((bin & 1u) * 16u)) : 0u); }
                        else { gtb |= (valid && (key >> 10) > tau) ? (1u << r) : 0u; eqb |= (valid && (key >> 10) == tau) ? (1u << r) : 0u; } }
                    if (PASS == 2) { const unsigned word = (unsigned)(kth >> 1), sh = (unsigned)((kth & 1) * 16 + 4 * g);
                        lds_or_b32(gtm_a + word * 4u, gtb << sh); lds_or_b32(eqm_a + word * 4u, eqb << sh); }
                } }
            pf_wait4(n0, n1, n2, n3);
            c0 = n0; c1 = n1; c2 = n2; c3 = n3;
        }
}

__device__ __forceinline__ void unit_dsa(const Params& p, LAS unsigned char* lds, int b, int ti) {
    const int tid = ltid(), lane = tid & 63, wave = __builtin_amdgcn_readfirstlane(tid >> 6), fr = lane & 15, g = lane >> 4;
    LAS unsigned* HIST = (LAS unsigned*)lds; LAS unsigned char* GBUF = lds;
    LAS unsigned* GTM = (LAS unsigned*)(lds + 69632); LAS unsigned* EQM = (LAS unsigned*)(lds + 69632 + 8256);
    LAS unsigned short* SEL = (LAS unsigned short*)(lds + 86272); LAS unsigned char* QAB = lds + 94464;
    LAS int* MISC = (LAS int*)(lds + 127232); LAS unsigned char* SELB = lds + 127488;
    const LAS unsigned char* BKT8 = lds + L_BKT8; const LAS float* RELB = (const LAS float*)(lds + L_RELB);
    const bf16_t* P = (const bf16_t*)(p.ws + WS_P); const float* SP = (const float*)(p.ws + WS_SP); bf16_t* YMIX = (bf16_t*)(p.ws + WS_YMIX);
    const bf16_t* WUK = (const bf16_t*)(p.ws + WS_WUK); const bf16_t* WUV = (const bf16_t*)(p.ws + WS_WUV);
    const int t0 = ti * 16; const size_t rowb = (size_t)b * SEQ;
    TSEC_BEGIN(6) TSEC_BEGIN(1)
    for (int i = tid; i < 4100; i += NTHR) ((LAS u32x4*)HIST)[i] = (u32x4){0u, 0u, 0u, 0u};
    { const int h = wave; f32x4 acc[8];
#pragma unroll
      for (int rt = 0; rt < 8; ++rt) acc[rt] = (f32x4){0.f, 0.f, 0.f, 0.f};
#pragma unroll
      for (int kk = 0; kk < 2; ++kk) { const bf16x8 a = *(const bf16x8*)(P + (rowb + t0 + fr) * NP_AB + AB_QB + h * 64 + kk * 32 + g * 8);
#pragma unroll
        for (int rt = 0; rt < 8; ++rt) { const bf16x8 bw = *(const bf16x8*)(WUK + ((size_t)(rt * 16 + fr) * 8 + h) * 64 + kk * 32 + g * 8); acc[rt] = mfma16(a, bw, acc[rt]); } }
#pragma unroll
      for (int rt = 0; rt < 8; ++rt)
#pragma unroll
        for (int r = 0; r < 4; ++r) ((LAS bf16_t*)QAB)[((4 * g + r) * 8 + h) * 128 + rt * 16 + fr] = f2bf(acc[rt][r] * 0.125f); }
    bf16x8 qf[4][2];
#pragma unroll
    for (int hh = 0; hh < 4; ++hh)
#pragma unroll
        for (int kk = 0; kk < 2; ++kk) qf[hh][kk] = *(const bf16x8*)(P + (rowb + t0 + fr) * NP_AB + AB_QI + hh * 64 + kk * 32 + g * 8);
    float wq[4];
#pragma unroll
    for (int hh = 0; hh < 4; ++hh) wq[hh] = SP[(rowb + t0 + fr) * 16 + 8 + hh] * 0.5f;
    const int tq = t0 + fr; const int nkt = ti + 1;
    if (tid < 16) { MISC[tid] = 0; MISC[16 + tid] = (t0 + 16 > 256) ? 256 : (1 << 20); MISC[48 + tid] = 0; }
    for (int i = tid; i < 2 * 16 * 129; i += NTHR) GTM[i] = 0u;
    __syncthreads();
    TSEC_END(1) TSEC_BEGIN(2)
    const unsigned hist_a = (unsigned)(unsigned long long)(HIST + fr * 1025), gtm_a = (unsigned)(unsigned long long)(GTM + fr * 129), eqm_a = (unsigned)(unsigned long long)(EQM + fr * 129);
    const bool need_sel = (t0 + 16) > 256;
#pragma unroll 1
    for (int pass = need_sel ? 0 : 2; pass < 3; ++pass) {
        const unsigned pfx = (unsigned)MISC[fr], tau = (unsigned)MISC[48 + fr];
        TSEC_BEGIN(21)
        if (pass == 0) dsa_score_pass<0>(P, rowb, nkt, wave, fr, g, tq, qf, wq, pfx, tau, hist_a, gtm_a, eqm_a);
        else if (pass == 1) dsa_score_pass<1>(P, rowb, nkt, wave, fr, g, tq, qf, wq, pfx, tau, hist_a, gtm_a, eqm_a);
        else dsa_score_pass<2>(P, rowb, nkt, wave, fr, g, tq, qf, wq, pfx, tau, hist_a, gtm_a, eqm_a);
        asm volatile("s_waitcnt lgkmcnt(0)" ::: "memory");
        __syncthreads();
        TSEC_END(21)
        if (pass < 2) {
            TSEC_BEGIN(22)
#pragma unroll
            for (int qq = 0; qq < 2; ++qq) { const int q = wave * 2 + qq; const int nq = t0 + q + 1;
                if (nq > 256) {
                    const int R = MISC[16 + q]; const int lo = 2016 - 32 * lane;
                    unsigned w[16];
#pragma unroll
                    for (int i = 0; i < 16; ++i) w[i] = HIST[q * 1025 + (lo >> 1) + i];
                    int sl = 0;
#pragma unroll
                    for (int i = 0; i < 16; ++i) sl += (int)(w[i] & 0xffffu) + (int)(w[i] >> 16);
                    const int cum = scan_add_i(sl, lane);
                    const unsigned long long mk = __ballot(cum >= R);
                    const int Ls = mk ? (int)__ffsll((long long)mk) - 1 : 63;
                    const int c0 = cum - sl; int c = c0, nlt = 0, above = c0;
#pragma unroll
                    for (int i = 15; i >= 0; --i) {
                        c += (int)(w[i] >> 16); nlt += (c < R) ? 1 : 0; above = (c < R) ? c : above;
                        c += (int)(w[i] & 0xffffu); nlt += (c < R) ? 1 : 0; above = (c < R) ? c : above; }
                    const int fbin = lo + 31 - nlt;
                    const int fb = __shfl(fbin, Ls), ab = __shfl(above, Ls);
                    if (lane == 0) { const unsigned old = (unsigned)MISC[q];
                        if (pass == 0) MISC[q] = fb; else MISC[48 + q] = (int)((old << 11) | (unsigned)fb);
                        MISC[16 + q] = R - ab; }
                } else if (lane == 0) { MISC[48 + q] = 0; MISC[16 + q] = 1 << 20; }
            }
            __syncthreads();
            if (pass == 0) { for (int i = tid; i < 4100; i += NTHR) ((LAS u32x4*)HIST)[i] = (u32x4){0u, 0u, 0u, 0u}; }
            __syncthreads();
            TSEC_END(22)
        }
    }
    TSEC_END(2) TSEC_BEGIN(3)
#pragma unroll 1
    for (int qq = 0; qq < 2; ++qq) { const int q = wave * 2 + qq; const int R = MISC[16 + q];
        const unsigned g0 = GTM[q * 129 + 2 * lane], g1 = GTM[q * 129 + 2 * lane + 1], e0 = EQM[q * 129 + 2 * lane], e1 = EQM[q * 129 + 2 * lane + 1];
        const int tc = (int)__popc(e0) + (int)__popc(e1); const int tpre = scan_add_i(tc, lane) - tc;
        const unsigned s0 = g0 | keep_lowest(e0, R - tpre), s1 = g1 | keep_lowest(e1, R - tpre - (int)__popc(e0));
        const int c = (int)__popc(s0) + (int)__popc(s1); const int incl = scan_add_i(c, lane); int pos = incl - c;
        unsigned m = s0; while (m) { const int bit = __ffs((int)m) - 1; m &= m - 1u; const int ki = lane * 64 + bit; if (pos < 256) { SEL[q * 256 + pos] = (unsigned short)ki; SELB[q * 256 + pos] = BKT8[t0 + q - ki]; } ++pos; }
        m = s1; while (m) { const int bit = __ffs((int)m) - 1; m &= m - 1u; const int ki = lane * 64 + 32 + bit; if (pos < 256) { SEL[q * 256 + pos] = (unsigned short)ki; SELB[q * 256 + pos] = BKT8[t0 + q - ki]; } ++pos; }
        const int total = __shfl(incl, 63);
        if (lane == 0) MISC[32 + q] = total < 256 ? total : 256;
    }
    __syncthreads();
    TSEC_END(3) TSEC_BEGIN(4)
    LAS unsigned char* gb = GBUF + wave * 8704;
    const unsigned gba = (unsigned)(unsigned long long)gb;
#pragma unroll 1
    for (int qq = 0; qq < 2; ++qq) { const int q = wave * 2 + qq; const int count = MISC[32 + q]; const int tpos = t0 + q; const int nch = (count + 31) >> 5;
        bf16x8 qh[4];
#pragma unroll
        for (int kk = 0; kk < 4; ++kk) { const bf16x8 v = *(const LAS bf16x8*)(QAB + ((q * 8 + (fr & 7)) * 128 + kk * 32 + g * 8) * 2); qh[kk] = (fr < 8) ? v : (bf16x8){0, 0, 0, 0, 0, 0, 0, 0}; }
        float m_run = -1e30f, l_part = 0.f; f32x4 ao[8];
#pragma unroll
        for (int rt = 0; rt < 8; ++rt) ao[rt] = (f32x4){0.f, 0.f, 0.f, 0.f};
        u32x4 gv[8];
#pragma unroll
        for (int it = 0; it < 8; ++it) { const int slot = g + 4 * it; const int idx = SEL[q * 256 + (slot < count ? slot : 0)];
            gload16(gv[it], P + (rowb + idx) * NP_AB + AB_CKV + fr * 8); }
        const unsigned alo = gba + (unsigned)((4 * g + (fr >> 2)) * 272 + (4 * (fr & 3)) * 2), ahi = alo + 16u * 272u;
#pragma unroll 1
        for (int c = 0; c < nch; ++c) {
            TSEC_BEGIN(41)
            pf_wait8(gv);
            TSEC_END(41) TSEC_BEGIN(42)
#pragma unroll
            for (int it = 0; it < 8; ++it) *(LAS u32x4*)(gb + (g + 4 * it) * 272 + fr * 16) = gv[it];
            asm volatile("s_waitcnt lgkmcnt(0)" ::: "memory");
            {
                const int cn = (c + 1 < nch) ? c + 1 : 0;
#pragma unroll
                for (int it = 0; it < 8; ++it) { const int slot = cn * 32 + g + 4 * it; const int idx = SEL[q * 256 + (slot < count ? slot : 0)];
                    gload16(gv[it], P + (rowb + idx) * NP_AB + AB_CKV + fr * 8); } }
            float lg[2][4];
#pragma unroll
            for (int k2 = 0; k2 < 2; ++k2) { f32x4 a = (f32x4){0.f, 0.f, 0.f, 0.f};
#pragma unroll
                for (int kk = 0; kk < 4; ++kk) a = mfma16(*(const LAS bf16x8*)(gb + (k2 * 16 + fr) * 272 + (kk * 32 + g * 8) * 2), qh[kk], a);
                const unsigned bk4 = *(const LAS unsigned*)(SELB + q * 256 + c * 32 + k2 * 16 + 4 * g);
#pragma unroll
                for (int r = 0; r < 4; ++r) { const int slot = c * 32 + k2 * 16 + 4 * g + r; const float bias = RELB[((bk4 >> (8 * r)) & 31u) * 8u + (unsigned)(fr & 7)];
                    lg[k2][r] = (slot < count) ? (a[r] + bias) * 1.44269504f : -1e30f; } }
            float ml = fmaxf(fmaxf(fmaxf(lg[0][0], lg[0][1]), fmaxf(lg[0][2], lg[0][3])), fmaxf(fmaxf(lg[1][0], lg[1][1]), fmaxf(lg[1][2], lg[1][3])));
            ml = fmaxf(ml, __shfl_xor(ml, 16)); ml = fmaxf(ml, __shfl_xor(ml, 32));
            const float m_new = fmaxf(m_run, ml); const float alpha = __builtin_amdgcn_exp2f(m_run - m_new);
            float pr[2][4]; float ps = 0.f;
#pragma unroll
            for (int k2 = 0; k2 < 2; ++k2)
#pragma unroll
                for (int r = 0; r < 4; ++r) { pr[k2][r] = __builtin_amdgcn_exp2f(lg[k2][r] - m_new); ps += pr[k2][r]; }
            l_part = l_part * alpha + ps; m_run = m_new;
            u32x4 pfu; pfu.x = pk2(pr[0][0], pr[0][1]); pfu.y = pk2(pr[0][2], pr[0][3]); pfu.z = pk2(pr[1][0], pr[1][1]); pfu.w = pk2(pr[1][2], pr[1][3]);
            const bf16x8 pf = __builtin_bit_cast(bf16x8, pfu);
            TSEC_END(42) TSEC_BEGIN(43)
            bf16x4 tl[8], th[8];
            asm volatile(
                "ds_read_b64_tr_b16 %0, %16\n\tds_read_b64_tr_b16 %8, %17\n\t"
                "ds_read_b64_tr_b16 %1, %16 offset:32\n\tds_read_b64_tr_b16 %9, %17 offset:32\n\t"
                "ds_read_b64_tr_b16 %2, %16 offset:64\n\tds_read_b64_tr_b16 %10, %17 offset:64\n\t"
                "ds_read_b64_tr_b16 %3, %16 offset:96\n\tds_read_b64_tr_b16 %11, %17 offset:96\n\t"
                "ds_read_b64_tr_b16 %4, %16 offset:128\n\tds_read_b64_tr_b16 %12, %17 offset:128\n\t"
                "ds_read_b64_tr_b16 %5, %16 offset:160\n\tds_read_b64_tr_b16 %13, %17 offset:160\n\t"
                "ds_read_b64_tr_b16 %6, %16 offset:192\n\tds_read_b64_tr_b16 %14, %17 offset:192\n\t"
                "ds_read_b64_tr_b16 %7, %16 offset:224\n\tds_read_b64_tr_b16 %15, %17 offset:224\n\t"
                "s_waitcnt lgkmcnt(0)"
                : "=&v"(tl[0]), "=&v"(tl[1]), "=&v"(tl[2]), "=&v"(tl[3]), "=&v"(tl[4]), "=&v"(tl[5]), "=&v"(tl[6]), "=&v"(tl[7]),
                  "=&v"(th[0]), "=&v"(th[1]), "=&v"(th[2]), "=&v"(th[3]), "=&v"(th[4]), "=&v"(th[5]), "=&v"(th[6]), "=&v"(th[7])
                : "v"(alo), "v"(ahi) : "memory");
#pragma unroll
            for (int rt = 0; rt < 8; ++rt) { ao[rt] = ao[rt] * alpha;
                bf16x8 af; af[0] = tl[rt][0]; af[1] = tl[rt][1]; af[2] = tl[rt][2]; af[3] = tl[rt][3]; af[4] = th[rt][0]; af[5] = th[rt][1]; af[6] = th[rt][2]; af[7] = th[rt][3];
                ao[rt] = mfma16(af, pf, ao[rt]); }
            TSEC_END(43)
        }
        pf_wait8(gv);
        float l = l_part; l += __shfl_xor(l, 16); l += __shfl_xor(l, 32);
        const float inv = 1.0f / l;
        if (fr < 8) {
#pragma unroll
            for (int rt = 0; rt < 8; ++rt) { u32x2 w; w.x = pk2(ao[rt][0] * inv, ao[rt][1] * inv); w.y = pk2(ao[rt][2] * inv, ao[rt][3] * inv);
                *(LAS u32x2*)(QAB + ((q * 8 + fr) * 128 + rt * 16 + 4 * g) * 2) = w; } }
    }
    __syncthreads();
    TSEC_END(4) TSEC_BEGIN(5)
    { const int h = wave; f32x4 acc[4];
#pragma unroll
      for (int nt = 0; nt < 4; ++nt) acc[nt] = (f32x4){0.f, 0.f, 0.f, 0.f};
#pragma unroll
      for (int kk = 0; kk < 4; ++kk) { const bf16x8 a = *(const LAS bf16x8*)(QAB + ((fr * 8 + h) * 128 + kk * 32 + g * 8) * 2);
#pragma unroll
        for (int nt = 0; nt < 4; ++nt) { const bf16x8 bw = *(const bf16x8*)(WUV + ((size_t)(h * 64 + nt * 16 + fr)) * 128 + kk * 32 + g * 8); acc[nt] = mfma16(a, bw, acc[nt]); } }
#pragma unroll
      for (int nt = 0; nt < 4; ++nt)
#pragma unroll
        for (int r = 0; r < 4; ++r) YMIX[(rowb + t0 + 4 * g + r) * D + 512 + h * 64 + nt * 16 + fr] = f2bf(acc[nt][r]); }
    __syncthreads();
    TSEC_END(5) TSEC_END(6)
}

struct DilRegs { u32x4 kv[4], vv[4]; bf16x8 qf[2]; };
__device__ __forceinline__ void dil_issue(const Params& p, int b, int h, int pat, int res, int n, DilRegs& r) {
    const int tid = ltid(), lane = tid & 63, wave = __builtin_amdgcn_readfirstlane(tid >> 6), fr = lane & 15, g = lane >> 4;
    const bf16_t* P = (const bf16_t*)(p.ws + WS_P);
    const int d = (pat == 0) ? 1 : (pat == 1 ? 4 : 16);
    const size_t rowb = (size_t)b * SEQ;
    const int row = tid >> 1, half = tid & 1; const int jsub = 128 * (n - 1) + row; const bool ok = jsub >= 0;
    const size_t tok = rowb + (size_t)(ok ? jsub : 0) * d + res;
#pragma unroll
    for (int q = 0; q < 4; ++q) { r.kv[q] = *(const u32x4*)(P + tok * NP_CD + CD_KD + h * 64 + half * 32 + q * 8); r.vv[q] = *(const u32x4*)(P + tok * NP_CD + CD_VD + h * 64 + half * 32 + q * 8); }
    const int qi = 128 * n + 16 * wave + fr; const size_t qtok = rowb + (size_t)qi * d + res;
#pragma unroll
    for (int kk = 0; kk < 2; ++kk) r.qf[kk] = *(const bf16x8*)(P + qtok * NP_CD + CD_QD + h * 64 + kk * 32 + g * 8);
}
__device__ __forceinline__ void dil_compute(const Params& p, LAS unsigned char* lds, int b, int h, int pat, int res, int n, const DilRegs& rg) {
    const int tid = ltid(), lane = tid & 63, wave = __builtin_amdgcn_readfirstlane(tid >> 6), fr = lane & 15, g = lane >> 4;
    LAS unsigned char* KS2 = lds; LAS unsigned char* VT2 = lds + 36864;
    const LAS unsigned char* BKT8 = lds + L_BKT8; const LAS float* RELB = (const LAS float*)(lds + L_RELB);
    const int d = (pat == 0) ? 1 : (pat == 1 ? 4 : 16);
    const size_t rowb = (size_t)b * SEQ;
    bf16_t* OP = (bf16_t*)(p.ws + (pat == 0 ? WS_HBF : (pat == 1 ? WS_HBF + 32 * MiB : WS_H1)));
    float* LSE = (float*)(p.ws + WS_H1 + 32 * MiB) + (size_t)pat * NTOK * 8;
    { const int row = tid >> 1, half = tid & 1; const bool ok = (128 * (n - 1) + row) >= 0;
#pragma unroll
      for (int q = 0; q < 4; ++q) { const u32x4 kq = ok ? rg.kv[q] : (u32x4){0u, 0u, 0u, 0u}, vq = ok ? rg.vv[q] : (u32x4){0u, 0u, 0u, 0u};
          *(LAS u32x4*)(KS2 + row * 144 + (half * 32 + q * 8) * 2) = kq;
#pragma unroll
          for (int e = 0; e < 4; ++e) { const unsigned w = vq[e]; const int dv = half * 32 + q * 8 + 2 * e;
              ((LAS bf16_t*)VT2)[dv * 264 + row] = (bf16_t)(w & 0xffffu); ((LAS bf16_t*)VT2)[(dv + 1) * 264 + row] = (bf16_t)(w >> 16); } } }
    LAS float* TAPB = (LAS float*)(lds + 70656);
    if (tid < 400) { const int tap = tid - 144; TAPB[tid] = (tap >= 0 && tap <= 128) ? RELB[(int)BKT8[tap * d] * 8 + h] * 1.44269504f : -1e30f; }
    __syncthreads();
    const int qi = 128 * n + 16 * wave + fr; const size_t qtok = rowb + (size_t)qi * d + res;
    const bf16x8 qf[2] = {rg.qf[0], rg.qf[1]};
    const int ql = 128 + 16 * wave + fr;
    float m_run = -1e30f, l_part = 0.f; f32x4 ao[4];
#pragma unroll
    for (int vt = 0; vt < 4; ++vt) ao[vt] = (f32x4){0.f, 0.f, 0.f, 0.f};
#pragma unroll 1
    for (int c = 0; c < 5; ++c) { const int kl0 = 16 * wave + 32 * c;
        float lg[2][4];
#pragma unroll
        for (int k2 = 0; k2 < 2; ++k2) {
            if (c == 4 && k2 == 1) {
#pragma unroll
                for (int r = 0; r < 4; ++r) lg[k2][r] = -1e30f;
            } else { f32x4 a = (f32x4){0.f, 0.f, 0.f, 0.f};
#pragma unroll
                for (int kk = 0; kk < 2; ++kk) a = mfma16(ldfrag(KS2, kl0 + k2 * 16 + fr, 144, kk, g), qf[kk], a);
#pragma unroll
                for (int r = 0; r < 4; ++r) { const int kl = kl0 + k2 * 16 + 4 * g + r; const int tap = ql - kl;
                    float v = fmaf(a[r], 0.125f * 1.44269504f, TAPB[tap + 144]);
                    if (n == 0) v = (kl >= 128) ? v : -1e30f;
                    lg[k2][r] = v; } } }
        float ml = fmaxf(fmaxf(fmaxf(lg[0][0], lg[0][1]), fmaxf(lg[0][2], lg[0][3])), fmaxf(fmaxf(lg[1][0], lg[1][1]), fmaxf(lg[1][2], lg[1][3])));
        ml = fmaxf(ml, __shfl_xor(ml, 16)); ml = fmaxf(ml, __shfl_xor(ml, 32));
        const float m_new = fmaxf(m_run, ml); const float alpha = __builtin_amdgcn_exp2f(m_run - m_new);
        float pr[2][4]; float ps = 0.f;
#pragma unroll
        for (int k2 = 0; k2 < 2; ++k2)
#pragma unroll
            for (int r = 0; r < 4; ++r) { pr[k2][r] = (lg[k2][r] > -1e29f) ? __builtin_amdgcn_exp2f(lg[k2][r] - m_new) : 0.f; ps += pr[k2][r]; }
        l_part = l_part * alpha + ps; m_run = m_new;
        u32x4 pfu; pfu.x = pk2(pr[0][0], pr[0][1]); pfu.y = pk2(pr[0][2], pr[0][3]); pfu.z = pk2(pr[1][0], pr[1][1]); pfu.w = pk2(pr[1][2], pr[1][3]);
        const bf16x8 pf = __builtin_bit_cast(bf16x8, pfu);
#pragma unroll
        for (int vt = 0; vt < 4; ++vt) { ao[vt] = ao[vt] * alpha;
            const bf16x4 lo = *(const LAS bf16x4*)(VT2 + (vt * 16 + fr) * 528 + (kl0 + 4 * g) * 2);
            bf16x4 hi = (bf16x4){0, 0, 0, 0};
            if (c < 4) hi = *(const LAS bf16x4*)(VT2 + (vt * 16 + fr) * 528 + (kl0 + 16 + 4 * g) * 2);
            bf16x8 af; af[0] = lo[0]; af[1] = lo[1]; af[2] = lo[2]; af[3] = lo[3]; af[4] = hi[0]; af[5] = hi[1]; af[6] = hi[2]; af[7] = hi[3];
            ao[vt] = mfma16(af, pf, ao[vt]); }
    }
    float l = l_part; l += __shfl_xor(l, 16); l += __shfl_xor(l, 32);
    const float inv = 1.0f / l;
#pragma unroll
    for (int vt = 0; vt < 4; ++vt) { u32x2 w; w.x = pk2(ao[vt][0] * inv, ao[vt][1] * inv); w.y = pk2(ao[vt][2] * inv, ao[vt][3] * inv);
        *(u32x2*)(OP + qtok * 512 + h * 64 + vt * 16 + 4 * g) = w; }
    if (g == 0) LSE[qtok * 8 + h] = (m_run + __log2f(l)) * 0.69314718f;
    __syncthreads();
}

__device__ __forceinline__ void phase_dil_combine(const Params& p) {
    const bf16_t* O0 = (const bf16_t*)(p.ws + WS_HBF); const bf16_t* O1 = (const bf16_t*)(p.ws + WS_HBF + 32 * MiB); const bf16_t* O2 = (const bf16_t*)(p.ws + WS_H1);
    const float* LSE = (const float*)(p.ws + WS_H1 + 32 * MiB); bf16_t* YMIX = (bf16_t*)(p.ws + WS_YMIX);
    for (int idx = BID * NTHR + TID; idx < NTOK * 64; idx += GDIM * NTHR) {
        const int tok = idx >> 6, h = (idx >> 3) & 7, dg = idx & 7;
        const float l0 = LSE[(size_t)tok * 8 + h], l1 = LSE[(size_t)NTOK * 8 + (size_t)tok * 8 + h], l2 = LSE[(size_t)2 * NTOK * 8 + (size_t)tok * 8 + h];
        const float mx = fmaxf(l0, fmaxf(l1, l2)); const float w0 = __expf(l0 - mx), w1 = __expf(l1 - mx), w2 = __expf(l2 - mx); const float inv = 1.0f / (w0 + w1 + w2);
        const size_t off = (size_t)tok * 512 + h * 64 + dg * 8;
        const u32x4 a = *(const u32x4*)(O0 + off), bq = *(const u32x4*)(O1 + off), c = *(const u32x4*)(O2 + off);
        u32x4 o;
#pragma unroll
        for (int e = 0; e < 4; ++e) {
            const float v0 = (__uint_as_float(a[e] << 16) * w0 + __uint_as_float(bq[e] << 16) * w1 + __uint_as_float(c[e] << 16) * w2) * inv;
            const float v1 = (__uint_as_float(a[e] & 0xffff0000u) * w0 + __uint_as_float(bq[e] & 0xffff0000u) * w1 + __uint_as_float(c[e] & 0xffff0000u) * w2) * inv;
            o[e] = pk2(v0, v1); }
        *(u32x4*)(YMIX + (size_t)tok * D + 512 + h * 64 + dg * 8) = o;
    }
}

__device__ __forceinline__ int grab_unit(unsigned* ctr, LAS int* slot) {
    __syncthreads();
    if (TID == 0) *slot = (int)__hip_atomic_fetch_add(ctr, 1u, __ATOMIC_RELAXED, __HIP_MEMORY_SCOPE_AGENT);
    __syncthreads();
    return *slot;
}
__device__ __forceinline__ void phase_rec_L(const Params& p, LAS unsigned char* lds, int j, bool is_ab) {
    for (int u = BID; u < 2048; u += GDIM) { const int bh = u >> 6, ck = u & 63;
        if (is_ab) unit_mlstm_L(p, lds, j, bh >> 2, bh & 3, ck); else unit_gla_L(p, lds, j, bh >> 2, bh & 3, ck); }
}
__device__ __forceinline__ void phase_mixer_ab(const Params& p, LAS unsigned char* lds, int j, unsigned* ctr, int nrec = 2048) {
    LAS int* slot = (LAS int*)(lds + LDS_PERS + LP_SLOT);
    load_attn_tables(p, lds);
    for (;;) { const int u = grab_unit(ctr, slot);
        if (u >= 2048 + nrec) break;
        if (u < 2048) unit_dsa(p, lds, u >> 8, 255 - (u & 255));
        else { const int k = u - 2048; const int bh = k >> 6; TSEC_BEGIN(7) unit_mlstm_O(p, lds, j, bh >> 2, bh & 3, k & 63); TSEC_END(7) } }
}
__device__ __forceinline__ void dil_decode(int k, int& b, int& h, int& pat, int& res, int& n) {
    const int n32 = k & 31, bh = k / 96; pat = (k >> 5) % 3; b = bh >> 3; h = bh & 7;
    if (pat == 0) { res = 0; n = n32; } else if (pat == 1) { res = n32 >> 3; n = n32 & 7; } else { res = n32 >> 1; n = n32 & 1; }
}
__device__ __forceinline__ void phase_mixer_cd(const Params& p, LAS unsigned char* lds, int j, unsigned* ctr, int nrec = 2048) {
    LAS int* slot = (LAS int*)(lds + LDS_PERS + LP_SLOT);
    load_attn_tables(p, lds);
    const int total = 6144 + nrec;
    int u = grab_unit(ctr, slot);
    DilRegs cur, nxt;
    if (u < 6144) { int b, h, pat, res, n; dil_decode(u, b, h, pat, res, n); dil_issue(p, b, h, pat, res, n, cur); }
    while (u < total) {
        const int un = grab_unit(ctr, slot);
        if (u < 6144) { int b, h, pat, res, n; dil_decode(u, b, h, pat, res, n);
            if (un < 6144) { int b2, h2, pat2, res2, n2; dil_decode(un, b2, h2, pat2, res2, n2); dil_issue(p, b2, h2, pat2, res2, n2, nxt); }
            TSEC_BEGIN(8) dil_compute(p, lds, b, h, pat, res, n, cur); TSEC_END(8)
            cur = nxt; }
        else { const int k = u - 6144; const int bh = k >> 6; TSEC_BEGIN(9) unit_gla_O(p, lds, j, bh >> 2, bh & 3, k & 63); TSEC_END(9) }
        u = un;
    }
}
typedef const __attribute__((address_space(4))) Params* KernargP;
__device__ __forceinline__ const Params& lparams() { KernargP k = (KernargP)__builtin_amdgcn_kernarg_segment_ptr(); asm volatile("" : "+s"(k)); return *(const Params*)k; }
#define PP (lparams())
__device__ __forceinline__ LAS unsigned char* llds(LAS unsigned char* q) { asm volatile("" : "+s"(q)); return q; }
#define LL (llds(lds))
__global__ void __launch_bounds__(NTHR, 2) hybrid_fwd(Params p) {
    extern __shared__ __attribute__((aligned(16))) unsigned char lds_raw[];
    LAS unsigned char* lds = (LAS unsigned char*)lds_raw;
    const int tid = TID, G = GDIM;
    for (int i = tid; i < (LDS_TOTAL - LDS_PERS) / 4; i += NTHR) ((LAS unsigned*)(lds + LDS_PERS))[i] = 0u;
    __syncthreads();
    unsigned* ctl = (unsigned*)(PP.ws + WS_CTL);
    XcdBarrier bar = xcd_barrier_post(ctl + CW_BAR, (volatile LAS unsigned*)(lds + LDS_PERS));
    LAS int* tbase = (LAS int*)(lds + LDS_PERS + LP_TBASE);

    p0_prologue(PP, LL);
    __syncthreads();
#pragma unroll 1
    for (int l = 0; l < DEPTH; ++l) {
        const bool is_ab = (l & 1) == 0; const int j = l >> 1;
        prep_layer(PP, LL, l);
#if DBL == 1
        __syncthreads(); prep_layer(PP, LL, l);
#endif
        if (l == 0) xcd_barrier(bar);
        __syncthreads();
        phase_norm1(PP, LL, l);
        xcd_barrier(bar);
        {
            const int N = is_ab ? NP_AB : NP_CD;
            pg8::Gemm gm{(const bf16_t*)(PP.ws + WS_HBF), (const bf16_t*)(PP.ws + WS_WIN), NTOK, N, D};
            pg8::StaticOrder S; S.init(NTOK, N, G, BID);
            pg8::EpiBf16<false> E{(bf16_t*)(PP.ws + WS_P), N};
            pg8::gemm_phase(LL, gm, S, E);
#if DBL == 3
            pg8::gemm_phase(LL, gm, S, E);
#endif
        }
        xcd_barrier(bar);
        phase_rec_L(PP, LL, j, is_ab);
#if DBL == 11
        __syncthreads(); phase_rec_L(PP, LL, j, is_ab);
#endif
        xcd_barrier(bar);
        if (is_ab) phase_scan_mlstm(PP); else phase_scan_gla(PP);
#if DBL == 12
        xcd_barrier(bar); if (is_ab) phase_scan_mlstm(PP); else phase_scan_gla(PP);
#endif
        xcd_barrier(bar);
        if (is_ab) { phase_mixer_ab(PP, LL, j, ctl + CW_WQ + 64 * l);
#if DBL == 4
            xcd_barrier(bar); phase_mixer_ab(PP, LL, j, ctl + CW_WQ + 64 * (l + 4));
#endif
#if DBL == 9
            xcd_barrier(bar); phase_mixer_ab(PP, LL, j, ctl + CW_WQ + 64 * (l + 4), 0);
#endif
        } else { phase_mixer_cd(PP, LL, j, ctl + CW_WQ + 64 * l); xcd_barrier(bar); phase_dil_combine(PP);
#if DBL == 5
            xcd_barrier(bar); phase_mixer_cd(PP, LL, j, ctl + CW_WQ + 64 * (l + 4)); xcd_barrier(bar); phase_dil_combine(PP);
#endif
#if DBL == 10
            xcd_barrier(bar); phase_mixer_cd(PP, LL, j, ctl + CW_WQ + 64 * (l + 4), 0); xcd_barrier(bar); phase_dil_combine(PP);
#endif
        }
        xcd_barrier(bar);
        {
            pg8::Gemm gm{(const bf16_t*)(PP.ws + WS_YMIX), (const bf16_t*)(PP.ws + WS_WOUT), NTOK, D, D};
            pg8::StaticOrder S; S.init(NTOK, D, G, BID);
            pg8::EpiOutRes E{(float*)(PP.ws + WS_X), (const float*)(PP.ws + WS_MOD) + (size_t)l * 8 * 6 * D + 2 * D};
            pg8::gemm_phase(LL, gm, S, E);
        }
        xcd_barrier(bar);
        phase_norm2(PP, LL, l);
#if DBL == 2
        xcd_barrier(bar); phase_norm2(PP, LL, l);
#endif
        xcd_barrier(bar);
        phase_dispatch(PP, LL, tbase);
#if DBL == 6
        xcd_barrier(bar); phase_dispatch(PP, LL, tbase);
#endif
        xcd_barrier(bar);
        {
            pg8::Gemm gm{(const bf16_t*)(PP.ws + WS_HBF), (const bf16_t*)(PP.ws + WS_WGU), MOE_ROWS, 16 * 1024, D, (const int*)(PP.ws + WS_ROWTOK)};
            pg8::MoeOrder S{tbase, G, BID};
            pg8::EpiMoe1 E{(bf16_t*)(PP.ws + WS_H1)};
            pg8::gemm_phase<pg8::EpiMoe1, pg8::MoeOrder, true>(LL, gm, S, E);
#if DBL == 7
            pg8::gemm_phase<pg8::EpiMoe1, pg8::MoeOrder, true>(LL, gm, S, E);
#endif
        }
        xcd_barrier(bar);
        {
            pg8::Gemm gm{(const bf16_t*)(PP.ws + WS_H1), (const bf16_t*)(PP.ws + WS_WDN), MOE_ROWS, 16 * 1024, 512};
            pg8::MoeOrder S{tbase, G, BID};
            pg8::EpiBf16<true> E{(bf16_t*)(PP.ws + WS_P), D};
            pg8::gemm_phase(LL, gm, S, E);
#if DBL == 8
            pg8::gemm_phase(LL, gm, S, E);
#endif
        }
        xcd_barrier(bar);
    }
    phase_final(PP, LL);
#if PROF
    if (BID == 0) { __syncthreads(); const unsigned long long acc = *(LAS unsigned long long*)(lds + LDS_PERS + LP_TACC); const unsigned long long t0 = wall_clock64(); while (wall_clock64() - t0 < acc * 10ull) __builtin_amdgcn_s_sleep(8); }
#endif
}

extern "C" void kernel_launch(void* const* d_in, const int* in_sizes, int n_in, void* d_out, int out_size, void* d_ws, size_t ws_size, hipStream_t stream) {
    static int grid = 0;
    if (grid == 0) {
        if (n_in != 28 || ws_size < WS_END2) { fprintf(stderr, "kernel_launch: unexpected n_in %d / ws_size %zu (need %zu)\n", n_in, ws_size, (size_t)WS_END2); grid = -1; return; }
        int dev = 0, cus = 0, per_cu = 0;
        if (hipGetDevice(&dev) != hipSuccess || hipDeviceGetAttribute(&cus, hipDeviceAttributeMultiprocessorCount, dev) != hipSuccess) { grid = -1; return; }
        if (hipFuncSetAttribute((const void*)hybrid_fwd, hipFuncAttributeMaxDynamicSharedMemorySize, LDS_TOTAL) != hipSuccess) { fprintf(stderr, "kernel_launch: hipFuncSetAttribute failed\n"); grid = -1; return; }
        if (hipOccupancyMaxActiveBlocksPerMultiprocessor(&per_cu, (const void*)hybrid_fwd, NTHR, LDS_TOTAL) != hipSuccess || per_cu < 1) { fprintf(stderr, "kernel_launch: occupancy query says %d\n", per_cu); }
        (void)hipGetLastError();
        grid = cus;
    }
    if (grid < 0) return;
    if (hipMemsetAsync((char*)d_ws + WS_CTL, 0, CTL_BYTES, stream) != hipSuccess) return;
    Params p{};
    for (int i = 0; i < 28; ++i) p.in[i] = (const float*)d_in[i];
    p.out = (float*)d_out; p.ws = (unsigned char*)d_ws;
    hipLaunchKernelGGL(hybrid_fwd, dim3(grid), dim3(NTHR), LDS_TOTAL, stream, p);
}
```

```cpp
#define DBL 0
#define PROF 0
#define PERTURB 0
#include <hip/hip_runtime.h>
#include <cstdio>
#include <cstdint>

#define LAS __attribute__((address_space(3)))
typedef unsigned short bf16_t;
typedef short bf16x8 __attribute__((ext_vector_type(8)));
typedef short bf16x4 __attribute__((ext_vector_type(4)));
typedef float f32x4 __attribute__((ext_vector_type(4)));
typedef float f32x2 __attribute__((ext_vector_type(2)));
typedef unsigned u32x4 __attribute__((ext_vector_type(4)));
typedef unsigned u32x2 __attribute__((ext_vector_type(2)));

constexpr int D = 1024, NB = 8, SEQ = 4096, NTOK = NB * SEQ, DEPTH = 4;
constexpr int W_AB = 2508, W_CD = 3088;
constexpr int NP_AB = 2560, NP_CD = 3072;
constexpr int AB_QA = 0, AB_KA = 256, AB_VA = 512, AB_OA = 1024, AB_QB = 1536, AB_CKV = 2048, AB_QI = 2176, AB_KI = 2432;
constexpr int CD_QC = 0, CD_KC = 256, CD_VC = 512, CD_RC = 1024, CD_QD = 1536, CD_KD = 2048, CD_VD = 2560;
constexpr int MOE_ROWS = 2 * NTOK + 16 * 256;

__device__ __forceinline__ int lbid() { int t = (int)blockIdx.x; asm volatile("" : "+s"(t)); return t; }
__device__ __forceinline__ int lgdim() { int t = (int)gridDim.x; asm volatile("" : "+s"(t)); return t; }
#define BID (lbid())
#define GDIM (lgdim())
__device__ __forceinline__ int ltid() { int t = (int)threadIdx.x; asm volatile("" : "+v"(t)); return t; }
__device__ __forceinline__ void gload16(u32x4& dst, const void* ptr) { asm volatile("global_load_dwordx4 %0, %1, off" : "=&v"(dst) : "v"(ptr) : "memory"); }
__device__ __forceinline__ float bf2f(bf16_t b) { return __uint_as_float(((unsigned)b) << 16); }
__device__ __forceinline__ unsigned pk2(float lo, float hi) { unsigned r; asm("v_cvt_pk_bf16_f32 %0, %1, %2" : "=v"(r) : "v"(lo), "v"(hi)); return r; }
__device__ __forceinline__ bf16_t f2bf(float f) { return (bf16_t)(pk2(f, 0.f) & 0xffffu); }
__device__ __forceinline__ float wave_sum(float v) {
#pragma unroll
    for (int o = 32; o > 0; o >>= 1) v += __shfl_xor(v, o);
    return v;
}
__device__ __forceinline__ float sigmoidf_(float x) { return 1.0f / (1.0f + __expf(-x)); }
__device__ __forceinline__ float siluf_(float x) { return x / (1.0f + __expf(-x)); }
__device__ __forceinline__ float logsigmoidf_(float x) { return fminf(x, 0.0f) - log1pf(__expf(-fabsf(x))); }

#define XB_TMO      128
#define XB_XCNT(j)  (256  + 64 * (j))
#define XB_XSUB(j)  (1280 + 64 * (j))
#define XB_XGEN(j)  (2304 + 64 * (j))
#define XB_TOP      3328
#define XB_TOPGEN   3392
#define XCD_BAR_WORDS 3456
#define XB_SPIN_CAP (1u << 18)

__device__ __forceinline__ unsigned xb_ld(unsigned* p)              { return __hip_atomic_load(p, __ATOMIC_RELAXED, __HIP_MEMORY_SCOPE_AGENT); }
__device__ __forceinline__ unsigned xb_add(unsigned* p, unsigned v) { return __hip_atomic_fetch_add(p, v, __ATOMIC_RELAXED, __HIP_MEMORY_SCOPE_AGENT); }
__device__ __forceinline__ unsigned xb_xcc_id() { return (unsigned)__builtin_amdgcn_s_getreg((3 << 11) | 20) & 0xFu; }
#define XB_SPIN(cond, bar) do { unsigned _sp = 0; while (cond) { __builtin_amdgcn_s_sleep(1); \
    if ((++_sp & 255u) == 0u) { if (xb_ld(&(bar)[XB_TMO])) break; if (_sp > XB_SPIN_CAP) { atomicAdd(&(bar)[XB_TMO], 1u); break; } } } } while (0)

struct XcdBarrier { unsigned* bar; unsigned x; volatile LAS unsigned* st; };

__device__ __forceinline__ XcdBarrier xcd_barrier_post(unsigned* bar, volatile LAS unsigned* st) {
    XcdBarrier b; b.bar = bar; b.x = xb_xcc_id(); b.st = st;
    if (ltid() == 0) (void)xb_add(&bar[XB_XCNT(b.x)], 1u);
    return b;
}
__device__ __forceinline__ void xcd_barrier_complete(unsigned* bar, unsigned x, unsigned& nloc, unsigned& nx) {
    const unsigned G = (unsigned)GDIM;
    unsigned sum, cnt, mine, sp = 0u;
    for (;;) {
        sum = 0u; cnt = 0u; mine = 0u;
#pragma unroll
        for (unsigned j = 0; j < 16; ++j) { const unsigned c = xb_ld(&bar[XB_XCNT(j)]); sum += c; cnt += (c > 0u) ? 1u : 0u; mine = (j == x) ? c : mine; }
        if (sum == G) break;
        __builtin_amdgcn_s_sleep(1);
        if ((++sp & 255u) == 0u) { if (xb_ld(&bar[XB_TMO])) break; if (sp > XB_SPIN_CAP) { atomicAdd(&bar[XB_TMO], 1u); break; } }
    }
    nloc = mine > 0u ? mine : 1u; nx = cnt > 0u ? cnt : 1u;
}
__device__ __forceinline__ void xcd_barrier1(const XcdBarrier& b) {
    asm volatile("s_waitcnt vmcnt(0)" ::: "memory");
    __syncthreads();
    if (ltid() == 0) {
        unsigned* bar = b.bar;
        __builtin_amdgcn_s_waitcnt(0);
        unsigned nloc = b.st[0], nx = b.st[1];
        if (nloc == 0u) { xcd_barrier_complete(bar, b.x, nloc, nx); b.st[0] = nloc; b.st[1] = nx; }
        const unsigned old = xb_add(&bar[XB_XSUB(b.x)], 1u);
        const unsigned gen = old / nloc;
        if (old + 1u == (gen + 1u) * nloc) {
            __builtin_amdgcn_fence(__ATOMIC_RELEASE, "agent");
            asm volatile("s_waitcnt vmcnt(0)" ::: "memory");
            const unsigned og = xb_add(&bar[XB_TOP], 1u);
            const unsigned tg = og / nx;
            if (og + 1u == (tg + 1u) * nx) xb_add(&bar[XB_TOPGEN], 1u);
            else XB_SPIN(xb_ld(&bar[XB_TOPGEN]) == tg, bar);
            __builtin_amdgcn_fence(__ATOMIC_ACQUIRE, "agent");
            xb_add(&bar[XB_XGEN(b.x)], 1u);
            asm volatile("s_waitcnt vmcnt(0)" ::: "memory");
        } else {
            XB_SPIN(xb_ld(&bar[XB_XGEN(b.x)]) == gen, bar);
            __builtin_amdgcn_fence(__ATOMIC_ACQUIRE, "agent");
            asm volatile("s_waitcnt vmcnt(0)" ::: "memory");
        }
    }
    __syncthreads();
}

#ifndef DBL
#define DBL 0
#endif
__device__ __forceinline__ void xcd_barrier(const XcdBarrier& b) { xcd_barrier1(b);
#if DBL == 20
    xcd_barrier1(b);
#endif
}

namespace pg8 {
constexpr int BM = 256, BK = 64, HALF = 128, HTB = HALF * BK * 2, STAGE_BYTES = 8 * HTB, NXCD = 8, WGM = 8;
__host__ __device__ __forceinline__ int lds_byte(int r, int c) { const int st = (r >> 4) * 2 + (c >> 5), rr = r & 15, cc = c & 31, ob = rr * 64 + cc * 2; return st * 1024 + (ob ^ (((ob >> 9) & 1) << 5)); }
__host__ __device__ __forceinline__ void stage_rc(int b, int& R, int& C) { const int st = b / 1024, sb = b % 1024, swz = sb ^ (((sb >> 9) & 1) << 5); R = (st >> 1) * 16 + swz / 64; C = (st & 1) * 32 + (swz % 64) / 2; }
__host__ __device__ __forceinline__ int perm32(int rho) { const int n = rho >> 4, i = rho & 15; return 8 * (i >> 2) + 4 * n + (i & 3); }

struct Unit { int pm, pn; };
struct Gemm { const bf16_t* A; const bf16_t* Bt; int M, N, K; const int* rowtok; };

struct StaticOrder {
    int nM, nN, nwg, G, c;
    __host__ __device__ void init(int M, int N, int G_, int c_) { nM = M / BM; nN = N / BM; nwg = nM * nN; G = G_; c = c_; }
    __host__ __device__ bool next(int i, Unit& u) const {
        const long L = (long)i * G + c; if (L >= nwg) return false;
        int wgid = (int)L; { const int q = nwg / NXCD, r = nwg % NXCD, xcd = wgid % NXCD, off = wgid / NXCD; wgid = (xcd < r ? xcd * (q + 1) : r * (q + 1) + (xcd - r) * q) + off; }
        const int nig = WGM * nN, gid = wgid / nig, fm = gid * WGM, gsz = (nM - fm) < WGM ? (nM - fm) : WGM;
        u.pm = fm + ((wgid % nig) % gsz); u.pn = (wgid % nig) / gsz; return true;
    }
    __device__ __forceinline__ void a_ready(const Unit&) const {}
    __device__ __forceinline__ void done(const Unit&) const {}
};
struct MoeOrder {
    const LAS int* tbase;
    int G, c;
    __device__ bool next(int i, Unit& u) const {
        const int L = i * G + c; const int total = tbase[16] * 4; if (L >= total) return false;
        const int pm = L >> 2; int e = 0;
#pragma unroll
        for (int k = 1; k < 16; ++k) e += (pm >= tbase[k]) ? 1 : 0;
        u.pm = pm; u.pn = e * 4 + (L & 3); return true;
    }
    __device__ __forceinline__ void a_ready(const Unit&) const {}
    __device__ __forceinline__ void done(const Unit&) const {}
};

__device__ __forceinline__ unsigned cvt_pk_bf16(float lo, float hi) { unsigned r; asm volatile("v_cvt_pk_bf16_f32 %0, %1, %2" : "=v"(r) : "v"(lo), "v"(hi)); return r; }

template <bool MOE> struct EpiBf16 {
    static constexpr bool PERM = true, AFTER_DRAIN = false;
    bf16_t* O; int ldc;
    bf16_t* kic; bf16_t* ckc;
    __device__ __forceinline__ void operator()(const f32x4 (&acc)[2][2][4][2], const Unit& u, int wr, int wc, int fr, int fq) const {
        const int row0 = u.pm * BM + wr * 64 + fr; const int colt = (MOE ? (u.pn & 3) : u.pn) * BM; const int col0 = colt + wc * 32 + 8 * fq;
#pragma unroll
        for (int ai = 0; ai < 2; ++ai)
#pragma unroll
            for (int m = 0; m < 4; ++m) { bf16_t* rowp = O + (size_t)(row0 + ai * HALF + m * 16) * ldc + col0;
#pragma unroll
                for (int bj = 0; bj < 2; ++bj) { const f32x4 v0 = acc[ai][bj][m][0], v1 = acc[ai][bj][m][1];
                    u32x4 w; w.x = cvt_pk_bf16(v0[0], v0[1]); w.y = cvt_pk_bf16(v0[2], v0[3]); w.z = cvt_pk_bf16(v1[0], v1[1]); w.w = cvt_pk_bf16(v1[2], v1[3]);
                    *(u32x4*)(rowp + bj * HALF) = w;
                    if (!MOE) { const size_t row = (size_t)(row0 + ai * HALF + m * 16);
                        if (kic && u.pn == 9 && bj == 1 && wc < 2) *(u32x4*)(kic + row * 64 + wc * 32 + 8 * fq) = w;
                        if (ckc && u.pn == 8 && bj == 0) *(u32x4*)(ckc + row * 128 + wc * 32 + 8 * fq) = w; } } }
    }
};
struct EpiOutRes {
    static constexpr bool PERM = false, AFTER_DRAIN = false;
    float* X; const float* gate;
    __device__ __forceinline__ void operator()(const f32x4 (&acc)[2][2][4][2], const Unit& u, int wr, int wc, int fr, int fq) const {
        const int row0 = u.pm * BM + wr * 64 + fr, col0 = u.pn * BM + wc * 32 + 4 * fq;
        const float* gp = gate + (size_t)((u.pm * BM) >> 12) * (6 * D) + col0;
        f32x4 gv[2][2];
#pragma unroll
        for (int bj = 0; bj < 2; ++bj)
#pragma unroll
            for (int n = 0; n < 2; ++n) gv[bj][n] = *(const f32x4*)(gp + bj * HALF + n * 16);
#pragma unroll
        for (int ai = 0; ai < 2; ++ai)
#pragma unroll
            for (int m = 0; m < 4; ++m) { float* rowp = X + (size_t)(row0 + ai * HALF + m * 16) * D + col0;
#pragma unroll
                for (int bj = 0; bj < 2; ++bj)
#pragma unroll
                    for (int n = 0; n < 2; ++n) { f32x4* p = (f32x4*)(rowp + bj * HALF + n * 16); *p = *p + gv[bj][n] * acc[ai][bj][m][n]; } }
    }
};
struct EpiMoe1 {
    static constexpr bool PERM = false, AFTER_DRAIN = false;
    bf16_t* H1;
    __device__ __forceinline__ void operator()(const f32x4 (&acc)[2][2][4][2], const Unit& u, int wr, int wc, int fr, int fq) const {
        const int row0 = u.pm * BM + wr * 64 + fr, col0 = (u.pn & 3) * 128 + wc * 16 + 4 * fq;
#pragma unroll
        for (int ai = 0; ai < 2; ++ai)
#pragma unroll
            for (int m = 0; m < 4; ++m) { bf16_t* rowp = H1 + (size_t)(row0 + ai * HALF + m * 16) * 512 + col0;
#pragma unroll
                for (int bj = 0; bj < 2; ++bj) { const f32x4 g = acc[ai][bj][m][0], up = acc[ai][bj][m][1]; float h[4];
#pragma unroll
                    for (int j = 0; j < 4; ++j) h[j] = g[j] / (1.0f + __expf(-g[j])) * up[j];
                    u32x2 w; w.x = cvt_pk_bf16(h[0], h[1]); w.y = cvt_pk_bf16(h[2], h[3]);
                    *(u32x2*)(rowp + bj * 64) = w; } }
    }
};

template <class Epi, class Sched, bool GATHER = false>
__device__ __forceinline__ void gemm_phase(LAS unsigned char* lds, const Gemm g, const Sched& S, const Epi& E) {
    const int tid = ltid(), wid = __builtin_amdgcn_readfirstlane(tid >> 6), lane = tid & 63, wr = wid >> 2, wc = wid & 3, fr = lane & 15, fq = lane >> 4;
    const int K = g.K, nt = K / BK;
    unsigned voffA[2], voffB[2];
#pragma unroll
    for (int i = 0; i < 2; ++i) { int R, C; stage_rc(tid * 16 + i * 8192, R, C); const int Rb = Epi::PERM ? ((R & ~31) + perm32(R & 31)) : R;
        voffA[i] = (unsigned)(R * K + C) * 2u; voffB[i] = (unsigned)(Rb * K + C) * 2u; }
    unsigned vc0[2] = {0u, 0u}, vc1[2] = {0u, 0u}, vn0[2] = {0u, 0u}, vn1[2] = {0u, 0u};
#define PG8_GOFF(pm_, v0_, v1_) do { const int _tz = ltid(); _Pragma("unroll") for (int _i = 0; _i < 2; ++_i) { int _R, _C; stage_rc(_tz * 16 + _i * 8192, _R, _C); \
        v0_[_i] = (unsigned)g.rowtok[(pm_) * BM + _R] * (unsigned)(K * 2) + (unsigned)_C * 2u; v1_[_i] = (unsigned)g.rowtok[(pm_) * BM + HALF + _R] * (unsigned)(K * 2) + (unsigned)_C * 2u; } } while (0)
    const size_t kstep = (size_t)(BK * 2);
    const size_t hstep = (size_t)HALF * K * 2;
    const size_t tstep = 2 * hstep;
    const unsigned ldsw = (unsigned)wid * 1024u;
    const int aoff = lds_byte(wr * 64 + fr, fq * 8), boff = lds_byte(wc * 32 + fr, fq * 8);
#define PG8_SA(b, h) (((b) * 2 + (h)) * HTB)
#define PG8_SB(b, h) ((4 + (b) * 2 + (h)) * HTB)
#define PG8_STAGE(bufoff, gbase, voff) do { _Pragma("unroll") for (int _i = 0; _i < 2; ++_i) \
        __builtin_amdgcn_global_load_lds((const unsigned*)((const char*)(gbase) + (voff)[_i]), (LAS unsigned*)(lds + (bufoff) + ldsw + _i * 8192), 16, 0, 0); } while (0)
#define PG8_LDA(dst, b, h) do { _Pragma("unroll") for (int m = 0; m < 4; ++m) _Pragma("unroll") for (int k = 0; k < 2; ++k) dst[m][k] = *(const LAS bf16x8*)(lds + PG8_SA(b, h) + aoff + m * 2048 + k * 1024); } while (0)
#define PG8_LDB(dst, b, h) do { _Pragma("unroll") for (int n = 0; n < 2; ++n) _Pragma("unroll") for (int k = 0; k < 2; ++k) dst[n][k] = *(const LAS bf16x8*)(lds + PG8_SB(b, h) + boff + n * 2048 + k * 1024); } while (0)
#define PG8_MMA(ai, bj, At, Bt) do { __builtin_amdgcn_s_setprio(1); _Pragma("unroll") for (int m = 0; m < 4; ++m) _Pragma("unroll") for (int n = 0; n < 2; ++n) _Pragma("unroll") for (int k = 0; k < 2; ++k) \
        acc[ai][bj][m][n] = __builtin_amdgcn_mfma_f32_16x16x32_bf16(Bt[n][k], At[m][k], acc[ai][bj][m][n], 0, 0, 0); __builtin_amdgcn_s_setprio(0); } while (0)
#define PG8_WAIT_V(n) asm volatile("s_waitcnt vmcnt(" #n ")" ::: "memory")
#define PG8_WAIT_L(n) asm volatile("s_waitcnt lgkmcnt(" #n ")" ::: "memory")
#define PG8_BAR __builtin_amdgcn_s_barrier()
#define PG8_SCHED __builtin_amdgcn_sched_barrier(0)
    Unit cur, nxt; int ui = 0;
    if (!S.next(0, cur)) return;
    f32x4 acc[2][2][4][2];
#pragma unroll
    for (int a = 0; a < 2; ++a)
#pragma unroll
        for (int b = 0; b < 2; ++b)
#pragma unroll
            for (int m = 0; m < 4; ++m)
#pragma unroll
                for (int n = 0; n < 2; ++n) acc[a][b][m][n] = (f32x4){0.f, 0.f, 0.f, 0.f};
    bf16x8 At[4][2], B0[2][2], B1[2][2];
    const char* cA = GATHER ? (const char*)g.A : (const char*)g.A + (size_t)cur.pm * tstep; const char* cB = (const char*)g.Bt + (size_t)cur.pn * tstep;
    S.a_ready(cur);
    if constexpr (GATHER) { PG8_GOFF(cur.pm, vc0, vc1); vn0[0] = vc0[0]; vn0[1] = vc0[1]; vn1[0] = vc1[0]; vn1[1] = vc1[1]; }
    if constexpr (GATHER) { PG8_STAGE(PG8_SB(0, 0), cB, voffB); PG8_STAGE(PG8_SA(0, 0), cA, vc0); PG8_STAGE(PG8_SB(0, 1), cB + hstep, voffB); PG8_STAGE(PG8_SA(0, 1), cA, vc1); }
    else { PG8_STAGE(PG8_SB(0, 0), cB, voffB); PG8_STAGE(PG8_SA(0, 0), cA, voffA); PG8_STAGE(PG8_SB(0, 1), cB + hstep, voffB); PG8_STAGE(PG8_SA(0, 1), cA + hstep, voffA); }
    if (wr == 1) PG8_BAR;
    PG8_WAIT_V(4); PG8_BAR;
    if constexpr (GATHER) { PG8_STAGE(PG8_SB(1, 0), cB + kstep, voffB); PG8_STAGE(PG8_SA(1, 0), cA + kstep, vc0); PG8_STAGE(PG8_SB(1, 1), cB + hstep + kstep, voffB); }
    else { PG8_STAGE(PG8_SB(1, 0), cB + kstep, voffB); PG8_STAGE(PG8_SA(1, 0), cA + kstep, voffA); PG8_STAGE(PG8_SB(1, 1), cB + hstep + kstep, voffB); }
    PG8_WAIT_V(6); PG8_BAR;
    for (;;) {
        const bool has_next = S.next(ui + 1, nxt);
        const char* nA = GATHER ? cA : (has_next ? (const char*)g.A + (size_t)nxt.pm * tstep : cA); const char* nB = has_next ? (const char*)g.Bt + (size_t)nxt.pn * tstep : cB;
        if constexpr (GATHER) { if (has_next) PG8_GOFF(nxt.pm, vn0, vn1); }
        for (int t = 0; t < nt; t += 2) {
            const bool last = (t == nt - 2);
            unsigned s0[2] = {vc0[0], vc0[1]}, s1[2] = {vc1[0], vc1[1]};
            if constexpr (GATHER) { if (last) { asm volatile("" : "+v"(vn0[0]), "+v"(vn0[1]), "+v"(vn1[0]), "+v"(vn1[1])); s0[0] = vn0[0]; s0[1] = vn0[1]; s1[0] = vn1[0]; s1[1] = vn1[1]; } }
            const char* a1 = cA + (size_t)(t + 1) * kstep;
            const char* a2 = last ? nA : cA + (size_t)(t + 2) * kstep; const char* b2 = last ? nB : cB + (size_t)(t + 2) * kstep;
            const char* a3 = a2 + kstep; const char* b3 = b2 + kstep;
            if (last && has_next) S.a_ready(nxt);
            PG8_LDB(B0, 0, 0); PG8_SCHED; PG8_LDA(At, 0, 0); if constexpr (GATHER) PG8_STAGE(PG8_SA(1, 1), a1, vc1); else PG8_STAGE(PG8_SA(1, 1), a1 + hstep, voffA);
            PG8_WAIT_L(8); PG8_BAR; PG8_WAIT_L(0); PG8_MMA(0, 0, At, B0); PG8_BAR; PG8_SCHED;
            PG8_LDB(B1, 0, 1); PG8_STAGE(PG8_SB(0, 0), b2, voffB);
            PG8_BAR; PG8_WAIT_L(0); PG8_MMA(0, 1, At, B1); PG8_BAR;
            PG8_LDA(At, 0, 1); if constexpr (GATHER) PG8_STAGE(PG8_SA(0, 0), a2, s0); else PG8_STAGE(PG8_SA(0, 0), a2, voffA);
            PG8_BAR; PG8_WAIT_L(0); PG8_MMA(1, 0, At, B0); PG8_BAR; PG8_SCHED;
            PG8_STAGE(PG8_SB(0, 1), b2 + hstep, voffB);
            PG8_WAIT_V(6); PG8_BAR; PG8_MMA(1, 1, At, B1); PG8_BAR;
            PG8_LDB(B0, 1, 0); PG8_SCHED; PG8_LDA(At, 1, 0); if constexpr (GATHER) PG8_STAGE(PG8_SA(0, 1), a2, s1); else PG8_STAGE(PG8_SA(0, 1), a2 + hstep, voffA);
            PG8_WAIT_L(8); PG8_BAR; PG8_WAIT_L(0); PG8_MMA(0, 0, At, B0); PG8_BAR; PG8_SCHED;
            PG8_LDB(B1, 1, 1); PG8_STAGE(PG8_SB(1, 0), b3, voffB);
            PG8_BAR; PG8_WAIT_L(0); PG8_MMA(0, 1, At, B1); PG8_BAR;
            PG8_LDA(At, 1, 1); if constexpr (GATHER) PG8_STAGE(PG8_SA(1, 0), a3, s0); else PG8_STAGE(PG8_SA(1, 0), a3, voffA);
            PG8_BAR; PG8_WAIT_L(0); PG8_MMA(1, 0, At, B0); PG8_BAR; PG8_SCHED;
            PG8_STAGE(PG8_SB(1, 1), b3 + hstep, voffB);
            PG8_WAIT_V(6); PG8_BAR; PG8_MMA(1, 1, At, B1); PG8_BAR;
        }
        E(acc, cur, wr, wc, fr, fq); S.done(cur);
        if (!has_next) break;
#pragma unroll
        for (int a = 0; a < 2; ++a)
#pragma unroll
            for (int b = 0; b < 2; ++b)
#pragma unroll
                for (int m = 0; m < 4; ++m)
#pragma unroll
                    for (int n = 0; n < 2; ++n) acc[a][b][m][n] = (f32x4){0.f, 0.f, 0.f, 0.f};
        cur = nxt; cA = nA; cB = nB; ++ui;
        if constexpr (GATHER) { vc0[0] = vn0[0]; vc0[1] = vn0[1]; vc1[0] = vn1[0]; vc1[1] = vn1[1]; }
    }
    PG8_WAIT_V(0);
    if (wr == 0) PG8_BAR;
    PG8_BAR;
#undef PG8_GOFF
#undef PG8_SA
#undef PG8_SB
#undef PG8_STAGE
#undef PG8_LDA
#undef PG8_LDB
#undef PG8_MMA
#undef PG8_WAIT_V
#undef PG8_WAIT_L
#undef PG8_BAR
#undef PG8_SCHED
}
}
constexpr size_t MiB = 1024 * 1024;
constexpr size_t WS_CTL  = 0;
constexpr size_t CTL_BYTES = 65536;
constexpr size_t WS_MOD  = WS_CTL + CTL_BYTES;
constexpr size_t WS_BKT  = WS_MOD + 4 * 8 * 6144 * 4;
constexpr size_t WS_SP   = WS_BKT + 4096 * 4;
constexpr size_t WS_RTE  = WS_SP + (size_t)NTOK * 16 * 4;
constexpr size_t WS_RTW  = WS_RTE + (size_t)NTOK * 4;
constexpr size_t WS_POS  = WS_RTW + (size_t)NTOK * 8;
constexpr size_t WS_TC   = WS_POS + (size_t)NTOK * 8;
constexpr size_t WS_WUK  = WS_TC + 256 * 16 * 4;
constexpr size_t WS_WUV  = WS_WUK + 65536 * 2;
constexpr size_t WS_X    = 4 * MiB;
constexpr size_t WS_HBF  = WS_X + 128 * MiB;
constexpr size_t WS_P    = WS_HBF + 64 * MiB;
constexpr size_t WS_YMIX = WS_P + 192 * MiB;
constexpr size_t WS_H1   = WS_YMIX + 64 * MiB;
constexpr size_t WS_WIN  = WS_H1 + 68 * MiB;
constexpr size_t WS_WOUT = WS_WIN + 6 * MiB;
constexpr size_t WS_WGU  = WS_WOUT + 2 * MiB;
constexpr size_t WS_WDN  = WS_WGU + 32 * MiB;
constexpr size_t WS_END  = WS_WDN + 16 * MiB;
constexpr size_t WS_CL   = WS_END;
constexpr size_t WS_SCAL = WS_CL + 72 * MiB;
constexpr size_t WS_MC   = WS_SCAL + 512 * 1024;
constexpr size_t WS_KIC  = WS_MC + 1024 * 1024;
constexpr size_t WS_CKC  = WS_KIC + 4 * MiB;
constexpr size_t WS_ROWTOK = WS_MC + 512 * 1024;
constexpr size_t WS_END2 = WS_CKC + 8 * MiB;
constexpr size_t WS_CTG  = WS_HBF;
constexpr size_t WS_STG  = WS_H1 + 36 * MiB;
static_assert(WS_WUV + 65536 * 2 <= WS_X, "small region overflow");
static_assert((size_t)MOE_ROWS * 512 * 2 <= 68 * MiB, "H1");
static_assert((size_t)MOE_ROWS * 1024 * 2 <= 192 * MiB, "AS");

constexpr int CW_BAR = 0;
constexpr int CW_WQ  = 4096;

constexpr int LDS_TOTAL = 147456;
constexpr int LDS_PERS  = 143360;
constexpr int LP_SLOT = 16, LP_TBASE = 64;

struct Params { const float* in[28]; float* out; unsigned char* ws; };
enum { I_X = 0, I_C, I_WADA, I_BADA, I_GMIX, I_GFFN, I_GFINAL, I_RELB, I_ABWIN, I_ABCONVW, I_ABCONVB, I_ABGATEB, I_ABHNORM, I_ABWUK, I_ABWUV, I_ABWOUT,
       I_CDWIN, I_CDWALPHA, I_CDBALPHA, I_CDHNORM, I_CDWOUT, I_MWC, I_MBC, I_MWF, I_MBF, I_MWG, I_MWU, I_MWD };

#define TID (ltid())
#define NTHR 512

__device__ __forceinline__ void p0_prologue(const Params& p, LAS unsigned char* lds) {
    const int tid = ltid(), G = GDIM;
    LAS float* sc = (LAS float*)lds;
    LAS float* red = (LAS float*)(lds + 32768);
    const float* c = p.in[I_C];
    for (int i = tid; i < 8 * 1024; i += NTHR) { const float v = c[i]; sc[i] = v / (1.0f + __expf(-v)); }
    __syncthreads();
    float* mod = (float*)(p.ws + WS_MOD);
    for (int u = BID; u < 4 * 48; u += G) {
        const int l = u / 48, e0 = (u % 48) * 128, col = tid & 127, ds = tid >> 7;
        const float* w = p.in[I_WADA] + (size_t)l * D * 6 * D + e0 + col;
        float a[8];
#pragma unroll
        for (int b = 0; b < 8; ++b) a[b] = 0.f;
        for (int d = ds * 256; d < ds * 256 + 256; ++d) { const float wv = w[(size_t)d * 6 * D];
#pragma unroll
            for (int b = 0; b < 8; ++b) a[b] += sc[b * 1024 + d] * wv; }
#pragma unroll
        for (int b = 0; b < 8; ++b) red[(ds * 8 + b) * 128 + col] = a[b];
        __syncthreads();
        for (int i = tid; i < 8 * 128; i += NTHR) { const int b = i >> 7, cc = i & 127;
            const float s = ((red[(0 * 8 + b) * 128 + cc] + red[(1 * 8 + b) * 128 + cc]) + red[(2 * 8 + b) * 128 + cc]) + red[(3 * 8 + b) * 128 + cc];
            mod[((size_t)l * 8 + b) * 6 * D + e0 + cc] = s + p.in[I_BADA][(size_t)l * 6 * D + e0 + cc]; }
        __syncthreads();
    }
    int* bkt = (int*)(p.ws + WS_BKT);
    for (int n = BID * NTHR + tid; n < 4096; n += G * NTHR) {
        int v;
        if (n < 16) v = n; else { v = 16 + (int)(log((double)n / 16.0) / log(128.0) * 16.0); if (v > 31) v = 31; }
        bkt[n] = v;
    }
}

template <class SrcF>
__device__ __forceinline__ void prep_tr(LAS unsigned char* lds, const SrcF& src, int K, int Nd, bf16_t* Bt) {
    LAS float* tile = (LAS float*)lds;
    const int tid = TID, G = GDIM, tnN = Nd / 64, ntile = tnN * (K / 64);
    for (int u = BID; u < ntile; u += G) {
        const int tn = u % tnN, tk = u / tnN;
#pragma unroll
        for (int i = 0; i < 8; ++i) { const int kk = (tid >> 6) + 8 * i, nn = tid & 63; tile[kk * 65 + nn] = src(tn * 64 + nn, tk * 64 + kk); }
        __syncthreads();
#pragma unroll
        for (int i = 0; i < 4; ++i) { const int nn = (tid >> 5) + 16 * i, kk = (tid & 31) * 2;
            *(unsigned*)(Bt + (size_t)(tn * 64 + nn) * K + tk * 64 + kk) = pk2(tile[kk * 65 + nn], tile[(kk + 1) * 65 + nn]); }
        __syncthreads();
    }
}
struct SrcShift { const float* W; int ldw, n0, shift, nvalid;
    __device__ __forceinline__ float operator()(int n, int k) const { if (n >= nvalid) return 0.f; return W[(size_t)k * ldw + (n >= n0 ? n + shift : n)]; } };
struct SrcGU { const float* Wg; const float* Wu;
    __device__ __forceinline__ float operator()(int n, int k) const { const int e = n >> 10, r = n & 1023, j = (r >> 5) * 16 + (r & 15); const unsigned long long dlt = (unsigned long long)Wu - (unsigned long long)Wg; const float* W = (const float*)((unsigned long long)Wg + (unsigned long long)((r >> 4) & 1) * dlt); return W[((size_t)e * 1024 + k) * 512 + j]; } };
struct SrcDN { const float* Wd;
    __device__ __forceinline__ float operator()(int n, int k) const { return Wd[((size_t)(n >> 10) * 512 + k) * 1024 + (n & 1023)]; } };

constexpr size_t WS_TAB = WS_WUV + 65536 * 2;
static_assert(WS_TAB + 13 * 16384 <= WS_X, "small region overflow");
struct WfAB { const float* W; __device__ __forceinline__ float operator()(int k, int c) const {
        if (c >= 12) return 0.f; const int col = c < 8 ? 1536 + c : 2504 + (c - 8); return W[(size_t)k * W_AB + col]; } };
struct WfCD { const float* W; __device__ __forceinline__ float operator()(int k, int c) const { return W[(size_t)k * W_CD + 1024 + c]; } };
struct WfRT { const float* Wc; const float* Wf; __device__ __forceinline__ float operator()(int k, int c) const {
        if (c < 4) return Wc[(size_t)k * 4 + c]; const int g = (c - 4) >> 2, e = (c - 4) & 3; return Wf[((size_t)g * D + k) * 4 + e]; } };
template <class WF>
__device__ __forceinline__ void build_small_tab(f32x4* tab, int nc4, const WF& wf) {
    for (int idx = BID * NTHR + TID; idx < nc4 * 1024; idx += GDIM * NTHR) {
        const int c4 = idx >> 10, r = idx & 1023, ij = r >> 6, lane = r & 63, k = 512 * (ij >> 3) + 8 * lane + (ij & 7);
        f32x4 v; v[0] = wf(k, 4 * c4); v[1] = wf(k, 4 * c4 + 1); v[2] = wf(k, 4 * c4 + 2); v[3] = wf(k, 4 * c4 + 3);
        tab[idx] = v; }
}
__device__ __forceinline__ void prep_layer(const Params& p, LAS unsigned char* lds, int l) {
    const int j = l >> 1;
    if ((l & 1) == 0) {
        SrcShift s{p.in[I_ABWIN] + (size_t)j * D * W_AB, W_AB, 1536, 8, 2496};
        prep_tr(lds, s, D, NP_AB, (bf16_t*)(p.ws + WS_WIN));
        SrcShift so{p.in[I_ABWOUT] + (size_t)j * D * D, D, 1 << 30, 0, D};
        prep_tr(lds, so, D, D, (bf16_t*)(p.ws + WS_WOUT));
        const float* wuk = p.in[I_ABWUK] + (size_t)j * 65536; const float* wuv = p.in[I_ABWUV] + (size_t)j * 65536;
        bf16_t* ouk = (bf16_t*)(p.ws + WS_WUK); bf16_t* ouv = (bf16_t*)(p.ws + WS_WUV);
        for (int i = BID * NTHR + TID; i < 65536; i += GDIM * NTHR) {
            ouk[i] = f2bf(wuk[i]);
            const int h = i >> 13, d = (i >> 7) & 63, r = i & 127;
            ouv[i] = f2bf(wuv[((size_t)r * 8 + h) * 64 + d]);
        }
    } else {
        SrcShift s{p.in[I_CDWIN] + (size_t)j * D * W_CD, W_CD, 1024, 16, 3072};
        prep_tr(lds, s, D, NP_CD, (bf16_t*)(p.ws + WS_WIN));
        SrcShift so{p.in[I_CDWOUT] + (size_t)j * D * D, D, 1 << 30, 0, D};
        prep_tr(lds, so, D, D, (bf16_t*)(p.ws + WS_WOUT));
    }
    { f32x4* tabg = (f32x4*)(p.ws + WS_TAB);
      if (l == 0) { WfAB wf{p.in[I_ABWIN]}; build_small_tab(tabg, 4, wf); }
      if (l + 1 < DEPTH) { const int ln = l + 1, jn = ln >> 1;
          if ((ln & 1) == 0) { WfAB wf{p.in[I_ABWIN] + (size_t)jn * D * W_AB}; build_small_tab(tabg + (ln & 1) * 4096, 4, wf); } else { WfCD wf{p.in[I_CDWIN] + (size_t)jn * D * W_CD}; build_small_tab(tabg + (ln & 1) * 4096, 4, wf); } }
      WfRT wr{p.in[I_MWC] + (size_t)l * D * 4, p.in[I_MWF] + (size_t)l * 4 * D * 4}; build_small_tab(tabg + 8 * 1024, 5, wr); }
    SrcGU sg{p.in[I_MWG] + (size_t)l * 16 * 1024 * 512, p.in[I_MWU] + (size_t)l * 16 * 1024 * 512};
    prep_tr(lds, sg, 1024, 16 * 1024, (bf16_t*)(p.ws + WS_WGU));
    SrcDN sd{p.in[I_MWD] + (size_t)l * 16 * 512 * 1024};
    prep_tr(lds, sd, 512, 16 * 1024, (bf16_t*)(p.ws + WS_WDN));
}

__device__ __forceinline__ void copy_tab_to_lds(LAS f32x4* dst, const f32x4* src, int n) { for (int i = TID; i < n; i += NTHR) dst[i] = src[i]; }
template <int NC4>
__device__ __forceinline__ void small_proj(const LAS f32x4* tab, const float (&h)[2][8], int lane, f32x4 (&out)[NC4]) {
#pragma unroll
    for (int c4 = 0; c4 < NC4; ++c4) { f32x4 a = (f32x4){0.f, 0.f, 0.f, 0.f};
#pragma unroll
        for (int i = 0; i < 2; ++i)
#pragma unroll
            for (int j = 0; j < 8; ++j) a += tab[(c4 * 16 + i * 8 + j) * 64 + lane] * h[i][j];
        out[c4] = a; asm volatile("" ::: "memory"); }
}
__device__ __forceinline__ float reduce16(const f32x4 (&a)[4], int lane) {
    const bool b5 = (lane & 32) != 0, b4 = (lane & 16) != 0, b3 = (lane & 8) != 0, b2 = (lane & 4) != 0;
    float w8[8], w4[4], w2[2];
#pragma unroll
    for (int c = 0; c < 8; ++c) { const float lo = a[c >> 2][c & 3], hi = a[(c + 8) >> 2][c & 3]; w8[c] = (b5 ? hi : lo) + __shfl_xor(b5 ? lo : hi, 32); }
#pragma unroll
    for (int c = 0; c < 4; ++c) w4[c] = (b4 ? w8[c + 4] : w8[c]) + __shfl_xor(b4 ? w8[c] : w8[c + 4], 16);
#pragma unroll
    for (int c = 0; c < 2; ++c) w2[c] = (b3 ? w4[c + 2] : w4[c]) + __shfl_xor(b3 ? w4[c] : w4[c + 2], 8);
    float w1 = (b2 ? w2[1] : w2[0]) + __shfl_xor(b2 ? w2[0] : w2[1], 4);
    w1 += __shfl_xor(w1, 2); w1 += __shfl_xor(w1, 1);
    return w1;
}
__device__ __forceinline__ float reduce4(const f32x4& a, int lane) {
    const bool b5 = (lane & 32) != 0, b4 = (lane & 16) != 0;
    const float u0 = (b5 ? a[2] : a[0]) + __shfl_xor(b5 ? a[0] : a[2], 32), u1 = (b5 ? a[3] : a[1]) + __shfl_xor(b5 ? a[1] : a[3], 32);
    float w = (b4 ? u1 : u0) + __shfl_xor(b4 ? u0 : u1, 16);
    w += __shfl_xor(w, 8); w += __shfl_xor(w, 4); w += __shfl_xor(w, 2); w += __shfl_xor(w, 1);
    return w;
}
__device__ __forceinline__ float rdl(float v, int l) { return __int_as_float(__builtin_amdgcn_readlane(__float_as_int(v), l)); }
__device__ __forceinline__ void unpack8(const u32x4& v, float (&o)[8]) {
#pragma unroll
    for (int e = 0; e < 4; ++e) { o[2 * e] = __uint_as_float(v[e] << 16); o[2 * e + 1] = __uint_as_float(v[e] & 0xffff0000u); } }

template <int MODE>
__device__ __forceinline__ void phase_tokens(const Params& p, LAS unsigned char* lds, int l) {
    const int tid = ltid(), lane = tid & 63, wave = tid >> 6, G = GDIM;
    LAS f32x4* tab = (LAS f32x4*)lds;
    LAS int* cnts = (LAS int*)(lds + 5 * 16384);
    if (MODE == 1) copy_tab_to_lds(tab, (const f32x4*)(p.ws + WS_TAB) + (l & 1) * 4096, 4 * 1024);
    if (MODE == 2) copy_tab_to_lds(tab, (const f32x4*)(p.ws + WS_TAB) + 8 * 1024, 5 * 1024);
    __syncthreads();
    const float* mod = (const float*)(p.ws + WS_MOD);
    float* X = (float*)(p.ws + WS_X); bf16_t* HBF = (bf16_t*)(p.ws + WS_HBF); float* SP = (float*)(p.ws + WS_SP);
    const bf16_t* YS = (const bf16_t*)(p.ws + WS_P);
    const int* POS = (const int*)(p.ws + WS_POS); float* RTW = (float*)(p.ws + WS_RTW); int* RTE = (int*)(p.ws + WS_RTE); int* TC = (int*)(p.ws + WS_TC);
    const bool comb = (MODE == 3) || (MODE == 1 && l > 0);
    const int lprev = (MODE == 3) ? 3 : l - 1;
    const float* biasc = p.in[I_MBC] + l * 4; const float* biasf = p.in[I_MBF] + l * 16;
    for (int grp = BID; grp < NTOK / 128; grp += G) {
        const int b = (grp * 128) >> 12;
        float ca[2][8], cb[2][8], gf[2][8];
#pragma unroll
        for (int i = 0; i < 2; ++i)
#pragma unroll
            for (int j = 0; j < 8; ++j) { const int col = 512 * i + 8 * lane + j;
                if (MODE == 1) { const float* mrow = mod + ((size_t)l * 8 + b) * 6 * D; ca[i][j] = p.in[I_GMIX][(size_t)l * D + col] * (mrow[D + col] + 1.0f); cb[i][j] = mrow[col]; }
                if (MODE == 2) { const float* mrow = mod + ((size_t)l * 8 + b) * 6 * D; ca[i][j] = p.in[I_GFFN][(size_t)l * D + col] * (mrow[4 * D + col] + 1.0f); cb[i][j] = mrow[3 * D + col]; }
                if (MODE == 3) { ca[i][j] = p.in[I_GFINAL][col]; cb[i][j] = 0.f; }
                gf[i][j] = comb ? mod[((size_t)lprev * 8 + b) * 6 * D + 5 * D + col] : 0.f; }
        int pos1v = 0, pos2v = 0; float w1v = 0.f, w2v = 0.f;
        if (comb && lane < 16) { const int tk = grp * 128 + wave * 16 + lane; pos1v = POS[2 * tk]; pos2v = POS[2 * tk + 1]; w1v = RTW[2 * tk]; w2v = RTW[2 * tk + 1]; }
        const float* xsrc = (MODE == 1 && l == 0) ? p.in[I_X] : X;
        LAS unsigned char* mb = lds + ((MODE == 2) ? (5 * 16384 + 1024) : (4 * 16384 + 1024)) + __builtin_amdgcn_readfirstlane(wave) * ((MODE == 2) ? 4096 : 8192);
#define TOK_ISSUE(tt_) do { const int tok_ = grp * 128 + wave * 16 + (tt_); \
            __builtin_amdgcn_global_load_lds((const unsigned*)(xsrc + (size_t)tok_ * D + 8 * lane), (LAS unsigned*)(mb), 16, 0, 0); \
            __builtin_amdgcn_global_load_lds((const unsigned*)(xsrc + (size_t)tok_ * D + 8 * lane + 4), (LAS unsigned*)(mb + 1024), 16, 0, 0); \
            __builtin_amdgcn_global_load_lds((const unsigned*)(xsrc + (size_t)tok_ * D + 512 + 8 * lane), (LAS unsigned*)(mb + 2048), 16, 0, 0); \
            __builtin_amdgcn_global_load_lds((const unsigned*)(xsrc + (size_t)tok_ * D + 512 + 8 * lane + 4), (LAS unsigned*)(mb + 3072), 16, 0, 0); \
            if (comb) { const int q1_ = __builtin_amdgcn_readlane(pos1v, (tt_)), q2_ = __builtin_amdgcn_readlane(pos2v, (tt_)); \
                __builtin_amdgcn_global_load_lds((const unsigned*)(YS + (size_t)q1_ * D + 8 * lane), (LAS unsigned*)(mb + 4096), 16, 0, 0); \
                __builtin_amdgcn_global_load_lds((const unsigned*)(YS + (size_t)q1_ * D + 512 + 8 * lane), (LAS unsigned*)(mb + 5120), 16, 0, 0); \
                __builtin_amdgcn_global_load_lds((const unsigned*)(YS + (size_t)q2_ * D + 8 * lane), (LAS unsigned*)(mb + 6144), 16, 0, 0); \
                __builtin_amdgcn_global_load_lds((const unsigned*)(YS + (size_t)q2_ * D + 512 + 8 * lane), (LAS unsigned*)(mb + 7168), 16, 0, 0); } } while (0)
        TOK_ISSUE(0);
        int cnt = 0;
#pragma unroll 1
        for (int tt = 0; tt < 16; ++tt) {
            const int tok = grp * 128 + wave * 16 + tt;
            asm volatile("s_waitcnt vmcnt(0)" ::: "memory");
            u32x4 xb[4], yb[4];
#pragma unroll
            for (int k4 = 0; k4 < 4; ++k4) xb[k4] = *(const LAS u32x4*)(mb + k4 * 1024 + lane * 16);
            if (comb) {
#pragma unroll
                for (int k4 = 0; k4 < 4; ++k4) yb[k4] = *(const LAS u32x4*)(mb + 4096 + k4 * 1024 + lane * 16);
            }
            asm volatile("s_waitcnt lgkmcnt(0)" ::: "memory");
            float x[2][8];
#pragma unroll
            for (int i = 0; i < 2; ++i)
#pragma unroll
                for (int j = 0; j < 8; ++j) x[i][j] = __uint_as_float(xb[2 * i + (j >> 2)][j & 3]);
            if (comb) { const float w1 = rdl(w1v, tt), w2 = rdl(w2v, tt);
#pragma unroll
                for (int i = 0; i < 2; ++i) { float y1[8], y2[8]; unpack8(yb[i], y1); unpack8(yb[2 + i], y2);
#pragma unroll
                    for (int j = 0; j < 8; ++j) x[i][j] += gf[i][j] * (y1[j] * w1 + y2[j] * w2); } }
            if (tt + 1 < 16) TOK_ISSUE(tt + 1);
            float ss = 0.f;
#pragma unroll
            for (int i = 0; i < 2; ++i)
#pragma unroll
                for (int j = 0; j < 8; ++j) ss += x[i][j] * x[i][j];
            ss = wave_sum(ss);
            const float rstd = 1.0f / sqrtf(ss * (1.0f / 1024.0f) + 1e-6f);
            float h[2][8];
#pragma unroll
            for (int i = 0; i < 2; ++i)
#pragma unroll
                for (int j = 0; j < 8; ++j) h[i][j] = x[i][j] * rstd * ca[i][j] + cb[i][j];
            if (MODE == 1) {
#pragma unroll
                for (int i = 0; i < 2; ++i) { *(f32x4*)(X + (size_t)tok * D + 512 * i + 8 * lane) = (f32x4){x[i][0], x[i][1], x[i][2], x[i][3]}; *(f32x4*)(X + (size_t)tok * D + 512 * i + 8 * lane + 4) = (f32x4){x[i][4], x[i][5], x[i][6], x[i][7]}; }
            }
            if (MODE == 3) {
#pragma unroll
                for (int i = 0; i < 2; ++i) { *(f32x4*)(p.out + (size_t)tok * D + 512 * i + 8 * lane) = (f32x4){h[i][0], h[i][1], h[i][2], h[i][3]}; *(f32x4*)(p.out + (size_t)tok * D + 512 * i + 8 * lane + 4) = (f32x4){h[i][4], h[i][5], h[i][6], h[i][7]}; }
            } else {
#pragma unroll
                for (int i = 0; i < 2; ++i) { u32x4 w; w.x = pk2(h[i][0], h[i][1]); w.y = pk2(h[i][2], h[i][3]); w.z = pk2(h[i][4], h[i][5]); w.w = pk2(h[i][6], h[i][7]); *(u32x4*)(HBF + (size_t)tok * D + 512 * i + 8 * lane) = w; }
            }
            if (MODE == 1) {
                f32x4 o[4]; o[3] = (f32x4){0.f, 0.f, 0.f, 0.f};
                if ((l & 1) == 0) { f32x4 o3[3]; small_proj<3>(tab, h, lane, o3); o[0] = o3[0]; o[1] = o3[1]; o[2] = o3[2]; }
                else small_proj<4>(tab, h, lane, o);
                const float v = reduce16(o, lane);
                if ((lane & 3) == 0) SP[(size_t)tok * 16 + (lane >> 2)] = v;
            }
            if (MODE == 2) {
                f32x4 oc = (f32x4){0.f, 0.f, 0.f, 0.f};
#pragma unroll
                for (int i = 0; i < 2; ++i)
#pragma unroll
                    for (int jj = 0; jj < 8; ++jj) oc += tab[(i * 8 + jj) * 64 + lane] * h[i][jj];
                const float vc = reduce4(oc, lane);
                float lc[4];
#pragma unroll
                for (int c = 0; c < 4; ++c) lc[c] = rdl(vc, 16 * c) + biasc[c];
                int g = 0; float mx = lc[0];
#pragma unroll
                for (int c = 1; c < 4; ++c) if (lc[c] > mx) { mx = lc[c]; g = c; }
                g = __builtin_amdgcn_readfirstlane(g);
                float se = 0.f;
#pragma unroll
                for (int c = 0; c < 4; ++c) se += expf(lc[c] - mx);
                const float pg = 1.0f / se;
                f32x4 of = (f32x4){0.f, 0.f, 0.f, 0.f};
                const LAS f32x4* tabf = tab + (1 + g) * 1024;
#pragma unroll
                for (int i = 0; i < 2; ++i)
#pragma unroll
                    for (int jj = 0; jj < 8; ++jj) of += tabf[(i * 8 + jj) * 64 + lane] * h[i][jj];
                const float vf = reduce4(of, lane);
                float lf[4];
#pragma unroll
                for (int e = 0; e < 4; ++e) lf[e] = rdl(vf, 16 * e) + biasf[g * 4 + e];
                int i1 = 0; float v1 = lf[0];
#pragma unroll
                for (int e = 1; e < 4; ++e) if (lf[e] > v1) { v1 = lf[e]; i1 = e; }
                int i2 = -1; float v2 = -3.0e38f;
#pragma unroll
                for (int e = 0; e < 4; ++e) if (e != i1 && lf[e] > v2) { v2 = lf[e]; i2 = e; }
                const float ex = expf(v2 - v1); const float p1 = 1.0f / (1.0f + ex), p2 = ex / (1.0f + ex);
                const int e1 = g * 4 + i1, e2 = g * 4 + i2;
                if (lane == 0) { RTE[tok] = e1 | (e2 << 8); RTW[2 * tok] = pg * p1; RTW[2 * tok + 1] = pg * p2; }
                cnt += (lane == e1 ? 1 : 0) + (lane == e2 ? 1 : 0);
            }
        }
#undef TOK_ISSUE
        if (MODE == 2) {
            __syncthreads();
            if (lane < 16) cnts[wave * 16 + lane] = cnt;
            __syncthreads();
            if (tid < 16) { int s = 0;
#pragma unroll
                for (int w = 0; w < 8; ++w) s += cnts[w * 16 + tid];
                TC[grp * 16 + tid] = s; }
        }
    }
}
__device__ __forceinline__ void phase_norm1(const Params& p, LAS unsigned char* lds, int l) { phase_tokens<1>(p, lds, l); }
__device__ __forceinline__ void phase_norm2(const Params& p, LAS unsigned char* lds, int l) { phase_tokens<2>(p, lds, l); }

__device__ __forceinline__ void phase_dispatch(const Params& p, LAS unsigned char* lds, LAS int* tbase) {
    const int tid = ltid(), lane = tid & 63, wave = tid >> 6, G = GDIM;
    LAS int* tc = (LAS int*)lds;
    LAS int* part = (LAS int*)(lds + 16384);
    LAS int* tot = (LAS int*)(lds + 16384 + 4096);
    LAS int* toff = (LAS int*)(lds + 16384 + 4096 + 128);
    LAS int* wcnt = (LAS int*)(lds + 16384 + 4096 + 256);
    const int* TC = (const int*)(p.ws + WS_TC); const int* RTE = (const int*)(p.ws + WS_RTE);
    int* POS = (int*)(p.ws + WS_POS);
    int* ROWTOK = (int*)(p.ws + WS_ROWTOK);
    for (int i = tid; i < 256 * 16; i += NTHR) tc[i] = TC[i];
    __syncthreads();
    { const int e = tid & 15, c8 = tid >> 4; int sa = 0;
#pragma unroll
      for (int q = 0; q < 8; ++q) sa += tc[(c8 * 8 + q) * 16 + e];
      part[c8 * 16 + e] = sa; }
    __syncthreads();
    if (tid < 16) { int sa = 0;
#pragma unroll
        for (int c8 = 0; c8 < 32; ++c8) sa += part[c8 * 16 + tid];
        tot[tid] = sa; }
    __syncthreads();
    if (tid == 0) { int rb = 0; for (int e = 0; e < 16; ++e) { tot[16 + e] = rb; tbase[e] = rb >> 8; rb += (tot[e] + 255) & ~255; } tbase[16] = rb >> 8; }
    __syncthreads();
    for (int grp = BID; grp < NTOK / 128; grp += G) {
        { const int e = tid & 15, c8 = tid >> 4; int sb = 0;
#pragma unroll
          for (int q = 0; q < 8; ++q) { const int gq = c8 * 8 + q; sb += (gq < grp) ? tc[gq * 16 + e] : 0; }
          part[512 + c8 * 16 + e] = sb; }
        int e_me = 0, rank_l = 0;
        if (tid < 256) { const int ee = RTE[grp * 128 + (tid >> 1)]; e_me = (tid & 1) ? ((ee >> 8) & 255) : (ee & 255); }
        if (wave < 4) {
            const unsigned long long lt = (lane == 0) ? 0ull : (~0ull >> (64 - lane));
#pragma unroll
            for (int e = 0; e < 16; ++e) { const unsigned long long m = __ballot(e_me == e); if (e_me == e) rank_l = __popcll(m & lt); if (lane == 0) wcnt[wave * 16 + e] = __popcll(m); }
        }
        __syncthreads();
        if (tid < 16) { int sb = 0;
#pragma unroll
            for (int c8 = 0; c8 < 32; ++c8) sb += part[512 + c8 * 16 + tid];
            toff[tid] = sb; }
        __syncthreads();
        if (tid < 256) { int rank = rank_l;
#pragma unroll
            for (int w = 0; w < 3; ++w) rank += (w < wave) ? wcnt[w * 16 + e_me] : 0;
            const int pos = tot[16 + e_me] + toff[e_me] + rank; POS[(size_t)(grp * 128) * 2 + tid] = pos; ROWTOK[pos] = grp * 128 + (tid >> 1); }
        __syncthreads();
    }
    for (int e = 0; e < 16; ++e) { const int lo_ = tot[16 + e] + tot[e], hi_ = tot[16 + e] + ((tot[e] + 255) & ~255); for (int r = lo_ + tid; r < hi_; r += NTHR) ROWTOK[r] = 0; }
}

__device__ __forceinline__ void phase_final(const Params& p, LAS unsigned char* lds) { phase_tokens<3>(p, lds, 3); }
#ifndef PROF
#define PROF 0
#endif
constexpr int LP_TACC = 32;
#define TSEC_BEGIN(k) unsigned long long _ts##k = 0; if (PROF == (k) && ltid() == 0) _ts##k = wall_clock64();
#define TSEC_END(k) if (PROF == (k) && ltid() == 0) { *(LAS unsigned long long*)(lds + LDS_PERS + LP_TACC) += wall_clock64() - _ts##k; }
__device__ __forceinline__ f32x4 mfma16(bf16x8 a, bf16x8 b, f32x4 c) { return __builtin_amdgcn_mfma_f32_16x16x32_bf16(a, b, c, 0, 0, 0); }
__device__ __forceinline__ bf16x8 ldfrag(const LAS unsigned char* base, int row, int stride_bytes, int kk, int g) { return *(const LAS bf16x8*)(base + row * stride_bytes + (kk * 32 + g * 8) * 2); }
__device__ __forceinline__ float scan_add(float v, int lane) {
#pragma unroll
    for (int o = 1; o < 64; o <<= 1) { const float t = __shfl_up(v, o); if (lane >= o) v += t; }
    return v;
}
__device__ __forceinline__ float scan_max(float v, int lane) {
#pragma unroll
    for (int o = 1; o < 64; o <<= 1) { const float t = __shfl_up(v, o); if (lane >= o) v = fmaxf(v, t); }
    return v;
}
__device__ __forceinline__ float bfe(const u32x4& v, int e) { const unsigned w = v[e >> 1]; return __uint_as_float((e & 1) ? (w & 0xffff0000u) : (w << 16)); }
__device__ __forceinline__ bf16_t bfr(const u32x4& v, int e) { const unsigned w = v[e >> 1]; return (bf16_t)((e & 1) ? (w >> 16) : (w & 0xffffu)); }

constexpr int RS = 144;

__device__ __forceinline__ void unit_mlstm_L(const Params& p, LAS unsigned char* lds, int j, int b, int h, int ck) {
    const int tid = ltid(), lane = tid & 63, wave = __builtin_amdgcn_readfirstlane(tid >> 6), fr = lane & 15, g = lane >> 4;
    LAS unsigned char* KWT = lds; LAS unsigned char* VT = lds + 9216; LAS float* GA = (LAS float*)(lds + 29952);
    const bf16_t* P = (const bf16_t*)(p.ws + WS_P); const float* SP = (const float*)(p.ws + WS_SP);
    float* CL = (float*)(p.ws + WS_CL); float* SCAL = (float*)(p.ws + WS_SCAL);
    const int unit = (b * 4 + h) * 64 + ck; const int tok0 = b * SEQ + ck * 64;
    const int t = tid >> 3, seg = tid & 7, kc0 = 256 + h * 64 + seg * 8, pos = ck * 64 + t;
    TSEC_BEGIN(31) TSEC_BEGIN(32)
    u32x4 kin[4], vin[2];
#pragma unroll
    for (int q = 0; q < 4; ++q) { const int pp = pos - 3 + q; kin[q] = (pp >= 0) ? *(const u32x4*)(P + (size_t)(b * SEQ + pp) * NP_AB + kc0) : (u32x4){0u, 0u, 0u, 0u}; }
#pragma unroll
    for (int i = 0; i < 2; ++i) { const int idx = tid + 512 * i; vin[i] = *(const u32x4*)(P + (size_t)(tok0 + (idx >> 4)) * NP_AB + AB_VA + h * 128 + (idx & 15) * 8); }
    float we;
    {
        const int tok = tok0 + lane;
        const float li = SP[(size_t)tok * 16 + h] + p.in[I_ABGATEB][j * 8 + h]; const float lf = logsigmoidf_(SP[(size_t)tok * 16 + 4 + h] + p.in[I_ABGATEB][j * 8 + 4 + h]);
        const float bc = scan_add(lf, lane); const float a = li - bc; const float amax = __shfl(scan_max(a, lane), 63);
        we = __shfl(__expf(a - amax), t & 63);
        if (wave == 0 && lane == 63) { SCAL[unit * 2] = bc; SCAL[unit * 2 + 1] = amax; }
    }
    for (int i = tid; i < 16 * 72; i += NTHR) { const int r = i / 72; ((LAS bf16_t*)VT)[(128 + r) * 72 + (i % 72)] = (r == 0) ? (bf16_t)0x3F80 : (bf16_t)0; }
    { const float* convw = p.in[I_ABCONVW] + (size_t)j * 4 * 512 + kc0; const float* convb = p.in[I_ABCONVB] + j * 512 + kc0;
#pragma unroll
      for (int e = 0; e < 8; ++e) { float acc = convb[e];
#pragma unroll
        for (int q = 0; q < 4; ++q) acc += convw[q * 512 + e] * bfe(kin[q], e);
        const float v = acc / (1.0f + __expf(-acc)); ((LAS bf16_t*)KWT)[(seg * 8 + e) * 72 + t] = f2bf(v * we); } }
#pragma unroll
    for (int i = 0; i < 2; ++i) { const int idx = tid + 512 * i; const int s = idx >> 4, sg = idx & 15;
#pragma unroll
        for (int e = 0; e < 8; ++e) ((LAS bf16_t*)VT)[(sg * 8 + e) * 72 + s] = bfr(vin[i], e); }
    __syncthreads();
    TSEC_END(32) TSEC_BEGIN(33)
#pragma unroll
    for (int i = 0; i < 5; ++i) { const int id = wave + 8 * i;
        if (id < 36) { const int tk = id / 9, tv = id % 9; f32x4 acc = (f32x4){0.f, 0.f, 0.f, 0.f};
#pragma unroll
            for (int kk = 0; kk < 2; ++kk) acc = mfma16(ldfrag(KWT, tk * 16 + fr, RS, kk, g), ldfrag(VT, tv * 16 + fr, RS, kk, g), acc);
#pragma unroll
            for (int r = 0; r < 4; ++r) CL[(size_t)unit * 9216 + (tk * 16 + 4 * g + r) * 144 + tv * 16 + fr] = acc[r]; } }
    __syncthreads();
    TSEC_END(33) TSEC_END(31)
}

__device__ __forceinline__ void phase_scan_mlstm(const Params& p) {
    const float* CL = (const float*)(p.ws + WS_CL); const float* SCAL = (const float*)(p.ws + WS_SCAL); float* MC = (float*)(p.ws + WS_MC); bf16_t* CTG = (bf16_t*)(p.ws + WS_CTG);
    for (int e = BID * NTHR + TID; e < 32 * 9216; e += GDIM * NTHR) {
        const int bh = e / 9216, r = e % 9216;
        float C = 0.f, m = -1e30f;
#pragma unroll 1
        for (int c0 = 0; c0 < 64; c0 += 8) { float v[8];
#pragma unroll
            for (int i = 0; i < 8; ++i) v[i] = CL[(size_t)(bh * 64 + c0 + i) * 9216 + r];
#pragma unroll
            for (int i = 0; i < 8; ++i) { const int unit = bh * 64 + c0 + i; const float bL = SCAL[unit * 2], amax = SCAL[unit * 2 + 1];
                CTG[(size_t)unit * 9216 + r] = f2bf(C); if (r == 0) MC[unit] = m;
                const float M = fmaxf(m, amax); C = __expf(m - M) * C + __expf(amax - M) * v[i]; m = bL + M; } }
    }
}

struct MlstmOIn { u32x4 qkin[2][4], vin[2], cin[3], oin[2]; float sp_i, sp_f, mc; };
__device__ __forceinline__ void mlstm_O_issue(const Params& p, int b, int h, int ck, MlstmOIn& r) {
    const int tid = ltid(), lane = tid & 63;
    const bf16_t* P = (const bf16_t*)(p.ws + WS_P); const float* SP = (const float*)(p.ws + WS_SP);
    const bf16_t* CTG = (const bf16_t*)(p.ws + WS_CTG); const float* MC = (const float*)(p.ws + WS_MC);
    const int unit = (b * 4 + h) * 64 + ck; const int tok0 = b * SEQ + ck * 64;
    const int sg = tid & 15; const int ch0 = (sg < 8) ? h * 64 + sg * 8 : 256 + h * 64 + (sg - 8) * 8;
#pragma unroll
    for (int i = 0; i < 2; ++i) { const int tt = (tid + 512 * i) >> 4; const int pos = ck * 64 + tt;
#pragma unroll
        for (int q = 0; q < 4; ++q) { const int pp = pos - 3 + q; r.qkin[i][q] = (pp >= 0) ? *(const u32x4*)(P + (size_t)(b * SEQ + pp) * NP_AB + ch0) : (u32x4){0u, 0u, 0u, 0u}; }
        r.vin[i] = *(const u32x4*)(P + (size_t)(tok0 + tt) * NP_AB + AB_VA + h * 128 + sg * 8);
        r.oin[i] = *(const u32x4*)(P + (size_t)(tok0 + tt) * NP_AB + AB_OA + h * 128 + sg * 8); }
#pragma unroll
    for (int i = 0; i < 3; ++i) { const int idx = tid + 512 * i; r.cin[i] = (idx < 1152) ? *(const u32x4*)(CTG + (size_t)unit * 9216 + idx * 8) : (u32x4){0u, 0u, 0u, 0u}; }
    r.sp_i = SP[(size_t)(tok0 + lane) * 16 + h]; r.sp_f = SP[(size_t)(tok0 + lane) * 16 + 4 + h]; r.mc = MC[unit];
}
__device__ __forceinline__ void mlstm_O_compute(const Params& p, LAS unsigned char* lds, int j, int b, int h, int ck, const MlstmOIn& rg) {
    const int tid = ltid(), lane = tid & 63, wave = __builtin_amdgcn_readfirstlane(tid >> 6), fr = lane & 15, g = lane >> 4;
    LAS unsigned char* QS = lds; LAS unsigned char* KS = lds + 9216; LAS unsigned char* VT = lds + 18432; LAS unsigned char* CT = lds + 39168; LAS unsigned char* PS = lds + 59904;
    LAS float* OS = (LAS float*)(lds + 69120); LAS float* GA = (LAS float*)(lds + 107008);
    constexpr int OSS = 148;
    bf16_t* YMIX = (bf16_t*)(p.ws + WS_YMIX);
    const int tok0 = b * SEQ + ck * 64;
    const int sg = tid & 15;
    const int ch0 = (sg < 8) ? h * 64 + sg * 8 : 256 + h * 64 + (sg - 8) * 8;
    const u32x4 (&qkin)[2][4] = rg.qkin; const u32x4 (&vin)[2] = rg.vin; const u32x4 (&cin)[3] = rg.cin; const u32x4 (&oin)[2] = rg.oin;
    {
        const float mc = rg.mc;
        const float li = rg.sp_i + p.in[I_ABGATEB][j * 8 + h]; const float lf = logsigmoidf_(rg.sp_f + p.in[I_ABGATEB][j * 8 + 4 + h]);
        const float bc = scan_add(lf, lane); const float a = li - bc; const float M = fmaxf(mc, scan_max(a, lane));
        GA[lane] = a; GA[64 + lane] = M; GA[128 + lane] = __expf(mc - M); GA[192 + lane] = __expf(-(bc + M));
    }
    for (int i = tid; i < 16 * 72; i += NTHR) { const int r = i / 72; ((LAS bf16_t*)VT)[(128 + r) * 72 + (i % 72)] = (r == 0) ? (bf16_t)0x3F80 : (bf16_t)0; }
    { const float* convw = p.in[I_ABCONVW] + (size_t)j * 4 * 512 + ch0; const float* convb = p.in[I_ABCONVB] + j * 512 + ch0;
      float cw[4][8], cb[8];
#pragma unroll
      for (int e = 0; e < 8; ++e) { cb[e] = convb[e];
#pragma unroll
        for (int q = 0; q < 4; ++q) cw[q][e] = convw[q * 512 + e]; }
      const float qs = (sg < 8) ? 0.125f : 1.0f;
#pragma unroll
      for (int i = 0; i < 2; ++i) { const int tt = (tid + 512 * i) >> 4; float o[8];
#pragma unroll
        for (int e = 0; e < 8; ++e) { float acc = cb[e];
#pragma unroll
            for (int q = 0; q < 4; ++q) acc += cw[q][e] * bfe(qkin[i][q], e);
            o[e] = acc / (1.0f + __expf(-acc)) * qs; }
        u32x4 w; w.x = pk2(o[0], o[1]); w.y = pk2(o[2], o[3]); w.z = pk2(o[4], o[5]); w.w = pk2(o[6], o[7]);
        *(LAS u32x4*)(((sg < 8) ? QS : KS) + tt * RS + (sg & 7) * 16) = w;
#pragma unroll
        for (int e = 0; e < 8; ++e) ((LAS bf16_t*)VT)[(sg * 8 + e) * 72 + tt] = bfr(vin[i], e); } }
#pragma unroll
    for (int i = 0; i < 3; ++i) { const int idx = tid + 512 * i;
        if (idx < 1152) { const int dk = idx / 18, sv = idx % 18;
#pragma unroll
            for (int e = 0; e < 8; ++e) ((LAS bf16_t*)CT)[(sv * 8 + e) * 72 + dk] = bfr(cin[i], e); } }
    __syncthreads();
    { const int tq = wave >> 1;
#pragma unroll
      for (int u = 0; u < 2; ++u) { const int ts = (wave & 1) * 2 + u; f32x4 acc = (f32x4){0.f, 0.f, 0.f, 0.f};
        if (ts <= tq) {
#pragma unroll
            for (int kk = 0; kk < 2; ++kk) acc = mfma16(ldfrag(QS, tq * 16 + fr, RS, kk, g), ldfrag(KS, ts * 16 + fr, RS, kk, g), acc);
        }
        const int s = ts * 16 + fr; const float as = GA[s];
#pragma unroll
        for (int r = 0; r < 4; ++r) { const int t = tq * 16 + 4 * g + r; const float pv = (ts <= tq && s <= t) ? acc[r] * __expf(as - GA[64 + t]) : 0.f; ((LAS bf16_t*)PS)[t * 72 + s] = f2bf(pv); } } }
    __syncthreads();
#pragma unroll
    for (int i = 0; i < 5; ++i) { const int id = wave + 8 * i;
        if (id < 36) { const int tq = id / 9, tv = id % 9; f32x4 acc = (f32x4){0.f, 0.f, 0.f, 0.f};
#pragma unroll
            for (int kk = 0; kk < 2; ++kk) acc = mfma16(ldfrag(QS, tq * 16 + fr, RS, kk, g), ldfrag(CT, tv * 16 + fr, RS, kk, g), acc);
#pragma unroll
            for (int r = 0; r < 4; ++r) acc[r] *= GA[128 + tq * 16 + 4 * g + r];
#pragma unroll
            for (int kk = 0; kk < 2; ++kk) acc = mfma16(ldfrag(PS, tq * 16 + fr, RS, kk, g), ldfrag(VT, tv * 16 + fr, RS, kk, g), acc);
#pragma unroll
            for (int r = 0; r < 4; ++r) OS[(tq * 16 + 4 * g + r) * OSS + tv * 16 + fr] = acc[r]; } }
    __syncthreads();
    { const float* hgp = p.in[I_ABHNORM] + j * 512 + h * 128 + sg * 8;
#pragma unroll
      for (int i = 0; i < 2; ++i) { const int tt = (tid + 512 * i) >> 4;
        const float den = OS[tt * OSS + 128]; const float dn = fmaxf(fabsf(den), GA[192 + tt]); const float idn = 1.0f / dn;
        const f32x4 a0 = *(const LAS f32x4*)(OS + tt * OSS + sg * 8), a1 = *(const LAS f32x4*)(OS + tt * OSS + sg * 8 + 4);
        float hv[8] = {a0[0] * idn, a0[1] * idn, a0[2] * idn, a0[3] * idn, a1[0] * idn, a1[1] * idn, a1[2] * idn, a1[3] * idn};
        float ss = 0.f;
#pragma unroll
        for (int e = 0; e < 8; ++e) ss += hv[e] * hv[e];
        ss += __shfl_xor(ss, 1); ss += __shfl_xor(ss, 2); ss += __shfl_xor(ss, 4); ss += __shfl_xor(ss, 8);
        const float rn = 1.0f / sqrtf(ss * (1.0f / 128.0f) + 1e-6f);
        float y[8];
#pragma unroll
        for (int e = 0; e < 8; ++e) y[e] = hv[e] * rn * hgp[e] * sigmoidf_(bfe(oin[i], e));
        u32x4 w; w.x = pk2(y[0], y[1]); w.y = pk2(y[2], y[3]); w.z = pk2(y[4], y[5]); w.w = pk2(y[6], y[7]);
        *(u32x4*)(YMIX + (size_t)(tok0 + tt) * D + h * 128 + sg * 8) = w; } }
    __syncthreads();
}

__device__ __forceinline__ void unit_mlstm_O(const Params& p, LAS unsigned char* lds, int j, int b, int h, int ck) { MlstmOIn r; mlstm_O_issue(p, b, h, ck, r); mlstm_O_compute(p, lds, j, b, h, ck, r); }

__device__ __forceinline__ void gla_cumsum(const Params& p, int j, int h, int tok0, int lane, int wave, LAS float* BS, LAS float* BL, float* scal_unit) {
    const float* SP = (const float*)(p.ws + WS_SP);
    f32x4 gq[4];
#pragma unroll
    for (int r = 0; r < 4; ++r) gq[r] = *(const f32x4*)(SP + (size_t)(tok0 + lane) * 16 + 4 * r);
    const float* wa = p.in[I_CDWALPHA] + (size_t)j * 16 * 256 + h * 64 + wave * 8; const float* ba = p.in[I_CDBALPHA] + j * 256 + h * 64 + wave * 8;
#pragma unroll
    for (int i = 0; i < 8; ++i) { float z = ba[i];
#pragma unroll
        for (int r = 0; r < 16; ++r) z += gq[r >> 2][r & 3] * wa[r * 256 + i];
        const float la = logsigmoidf_(z) * (1.0f / 16.0f); const float bc = scan_add(la, lane);
        BS[lane * 65 + wave * 8 + i] = bc;
        if (lane == 63) { BL[wave * 8 + i] = bc; if (scal_unit) scal_unit[wave * 8 + i] = __expf(bc); } }
}
__device__ __forceinline__ void unit_gla_L(const Params& p, LAS unsigned char* lds, int j, int b, int h, int ck) {
    const int tid = ltid(), lane = tid & 63, wave = __builtin_amdgcn_readfirstlane(tid >> 6), fr = lane & 15, g = lane >> 4;
    LAS unsigned char* KWT = lds; LAS unsigned char* VT = lds + 9216; LAS float* BS = (LAS float*)(lds + 27648); LAS float* BL = (LAS float*)(lds + 44288);
    const bf16_t* P = (const bf16_t*)(p.ws + WS_P); float* CL = (float*)(p.ws + WS_CL); float* SCAL = (float*)(p.ws + WS_SCAL);
    const int unit = (b * 4 + h) * 64 + ck; const int tok0 = b * SEQ + ck * 64;
    const int t = tid >> 3, seg = tid & 7;
    const u32x4 kin = *(const u32x4*)(P + (size_t)(tok0 + t) * NP_CD + CD_KC + h * 64 + seg * 8);
    u32x4 vin[2];
#pragma unroll
    for (int i = 0; i < 2; ++i) { const int idx = tid + 512 * i; vin[i] = *(const u32x4*)(P + (size_t)(tok0 + (idx >> 4)) * NP_CD + CD_VC + h * 128 + (idx & 15) * 8); }
    gla_cumsum(p, j, h, tok0, lane, wave, BS, BL, SCAL + (size_t)unit * 64);
    __syncthreads();
#pragma unroll
    for (int e = 0; e < 8; ++e) { const int kk = seg * 8 + e; ((LAS bf16_t*)KWT)[kk * 72 + t] = f2bf(bfe(kin, e) * __expf(BL[kk] - BS[t * 65 + kk])); }
#pragma unroll
    for (int i = 0; i < 2; ++i) { const int idx = tid + 512 * i; const int s = idx >> 4, sg = idx & 15;
#pragma unroll
        for (int e = 0; e < 8; ++e) ((LAS bf16_t*)VT)[(sg * 8 + e) * 72 + s] = bfr(vin[i], e); }
    __syncthreads();
#pragma unroll
    for (int i = 0; i < 4; ++i) { const int id = wave + 8 * i; const int tk = id >> 3, tv = id & 7; f32x4 acc = (f32x4){0.f, 0.f, 0.f, 0.f};
#pragma unroll
        for (int kk = 0; kk < 2; ++kk) acc = mfma16(ldfrag(KWT, tk * 16 + fr, RS, kk, g), ldfrag(VT, tv * 16 + fr, RS, kk, g), acc);
#pragma unroll
        for (int r = 0; r < 4; ++r) CL[(size_t)unit * 8192 + (tk * 16 + 4 * g + r) * 128 + tv * 16 + fr] = acc[r]; }
    __syncthreads();
}
__device__ __forceinline__ void phase_scan_gla(const Params& p) {
    const float* CL = (const float*)(p.ws + WS_CL); const float* SCAL = (const float*)(p.ws + WS_SCAL); bf16_t* STG = (bf16_t*)(p.ws + WS_STG);
    for (int e = BID * NTHR + TID; e < 32 * 8192; e += GDIM * NTHR) {
        const int bh = e >> 13, r = e & 8191, dk = r >> 7;
        float S = 0.f;
#pragma unroll 1
        for (int c0 = 0; c0 < 64; c0 += 8) { float v[8], dc[8];
#pragma unroll
            for (int i = 0; i < 8; ++i) { v[i] = CL[(size_t)(bh * 64 + c0 + i) * 8192 + r]; dc[i] = SCAL[(size_t)(bh * 64 + c0 + i) * 64 + dk]; }
#pragma unroll
            for (int i = 0; i < 8; ++i) { STG[(size_t)(bh * 64 + c0 + i) * 8192 + r] = f2bf(S); S = dc[i] * S + v[i]; } }
    }
}
__device__ __forceinline__ void unit_gla_O(const Params& p, LAS unsigned char* lds, int j, int b, int h, int ck) {
    const int tid = ltid(), lane = tid & 63, wave = __builtin_amdgcn_readfirstlane(tid >> 6), fr = lane & 15, g = lane >> 4;
    LAS unsigned char* QS = lds; LAS unsigned char* KS = lds + 9216; LAS unsigned char* VT = lds + 18432; LAS unsigned char* ST = lds + 36864; LAS unsigned char* PS = lds + 55296;
    LAS float* OS = (LAS float*)(lds + 64512); LAS float* BS = (LAS float*)(lds + 98304); LAS float* BL = (LAS float*)(lds + 114944);
    constexpr int OSS = 132;
    const bf16_t* P = (const bf16_t*)(p.ws + WS_P); bf16_t* YMIX = (bf16_t*)(p.ws + WS_YMIX); const bf16_t* STG = (const bf16_t*)(p.ws + WS_STG);
    const int unit = (b * 4 + h) * 64 + ck; const int tok0 = b * SEQ + ck * 64;
    const int sg = tid & 15; const int ch0 = (sg < 8) ? CD_QC + h * 64 + sg * 8 : CD_KC + h * 64 + (sg - 8) * 8;
    u32x4 qkin[2], vin[2], sin_[2], rin[2];
#pragma unroll
    for (int i = 0; i < 2; ++i) { const int idx = tid + 512 * i; const int tt = idx >> 4;
        qkin[i] = *(const u32x4*)(P + (size_t)(tok0 + tt) * NP_CD + ch0);
        vin[i] = *(const u32x4*)(P + (size_t)(tok0 + tt) * NP_CD + CD_VC + h * 128 + sg * 8);
        rin[i] = *(const u32x4*)(P + (size_t)(tok0 + tt) * NP_CD + CD_RC + h * 128 + sg * 8);
        sin_[i] = *(const u32x4*)(STG + (size_t)unit * 8192 + idx * 8); }
    gla_cumsum(p, j, h, tok0, lane, wave, BS, BL, nullptr);
    __syncthreads();
#pragma unroll
    for (int i = 0; i < 2; ++i) { const int idx = tid + 512 * i; const int tt = idx >> 4; float o[8];
#pragma unroll
        for (int e = 0; e < 8; ++e) { const float bb = BS[tt * 65 + (sg & 7) * 8 + e]; o[e] = (sg < 8) ? bfe(qkin[i], e) * 0.125f * __expf(bb) : bfe(qkin[i], e) * __expf(-bb); }
        u32x4 w; w.x = pk2(o[0], o[1]); w.y = pk2(o[2], o[3]); w.z = pk2(o[4], o[5]); w.w = pk2(o[6], o[7]);
        *(LAS u32x4*)(((sg < 8) ? QS : KS) + tt * RS + (sg & 7) * 16) = w;
#pragma unroll
        for (int e = 0; e < 8; ++e) { ((LAS bf16_t*)VT)[(sg * 8 + e) * 72 + tt] = bfr(vin[i], e); ((LAS bf16_t*)ST)[(sg * 8 + e) * 72 + tt] = bfr(sin_[i], e); } }
    __syncthreads();
    { const int tq = wave >> 1;
#pragma unroll
      for (int u = 0; u < 2; ++u) { const int ts = (wave & 1) * 2 + u; f32x4 acc = (f32x4){0.f, 0.f, 0.f, 0.f};
        if (ts <= tq) {
#pragma unroll
            for (int kk = 0; kk < 2; ++kk) acc = mfma16(ldfrag(QS, tq * 16 + fr, RS, kk, g), ldfrag(KS, ts * 16 + fr, RS, kk, g), acc);
        }
        const int s = ts * 16 + fr;
#pragma unroll
        for (int r = 0; r < 4; ++r) { const int t = tq * 16 + 4 * g + r; const float pv = (ts <= tq && s <= t) ? acc[r] : 0.f; ((LAS bf16_t*)PS)[t * 72 + s] = f2bf(pv); } } }
    __syncthreads();
#pragma unroll
    for (int i = 0; i < 4; ++i) { const int id = wave + 8 * i; const int tq = id >> 3, tv = id & 7; f32x4 acc = (f32x4){0.f, 0.f, 0.f, 0.f};
#pragma unroll
        for (int kk = 0; kk < 2; ++kk) acc = mfma16(ldfrag(QS, tq * 16 + fr, RS, kk, g), ldfrag(ST, tv * 16 + fr, RS, kk, g), acc);
#pragma unroll
        for (int kk = 0; kk < 2; ++kk) acc = mfma16(ldfrag(PS, tq * 16 + fr, RS, kk, g), ldfrag(VT, tv * 16 + fr, RS, kk, g), acc);
#pragma unroll
        for (int r = 0; r < 4; ++r) OS[(tq * 16 + 4 * g + r) * OSS + tv * 16 + fr] = acc[r]; }
    __syncthreads();
    { const float* hgp = p.in[I_CDHNORM] + j * 512 + h * 128 + sg * 8;
#pragma unroll
      for (int i = 0; i < 2; ++i) { const int tt = (tid + 512 * i) >> 4;
        const f32x4 a0 = *(const LAS f32x4*)(OS + tt * OSS + sg * 8), a1 = *(const LAS f32x4*)(OS + tt * OSS + sg * 8 + 4);
        float hv[8] = {a0[0], a0[1], a0[2], a0[3], a1[0], a1[1], a1[2], a1[3]};
        float ss = 0.f;
#pragma unroll
        for (int e = 0; e < 8; ++e) ss += hv[e] * hv[e];
        ss += __shfl_xor(ss, 1); ss += __shfl_xor(ss, 2); ss += __shfl_xor(ss, 4); ss += __shfl_xor(ss, 8);
        const float rn = 1.0f / sqrtf(ss * (1.0f / 128.0f) + 1e-6f);
        float y[8];
#pragma unroll
        for (int e = 0; e < 8; ++e) y[e] = hv[e] * rn * hgp[e] * siluf_(bfe(rin[i], e));
        u32x4 w; w.x = pk2(y[0], y[1]); w.y = pk2(y[2], y[3]); w.z = pk2(y[4], y[5]); w.w = pk2(y[6], y[7]);
        *(u32x4*)(YMIX + (size_t)(tok0 + tt) * D + h * 128 + sg * 8) = w; } }
    __syncthreads();
}
constexpr int L_BKT8 = 134144, L_RELB = 138240;
__device__ __forceinline__ void load_attn_tables(const Params& p, LAS unsigned char* lds) {
    const int* bkt = (const int*)(p.ws + WS_BKT);
    for (int i = TID; i < 4096; i += NTHR) lds[L_BKT8 + i] = (unsigned char)bkt[i];
    if (TID < 256) ((LAS float*)(lds + L_RELB))[TID] = p.in[I_RELB][TID];
}
__device__ __forceinline__ int scan_add_i(int v, int lane) {
#pragma unroll
    for (int o = 1; o < 64; o <<= 1) { const int t = __shfl_up(v, o); if (lane >= o) v += t; }
    return v;
}
__device__ __forceinline__ unsigned keep_lowest(unsigned m, int n) {
    if (n <= 0) return 0u;
    while ((int)__popc(m) > n) m &= ~(1u << (31 - __clz((int)m)));
    return m;
}
__device__ __forceinline__ bf16x4 tr_read(unsigned lds_addr) { bf16x4 r; asm volatile("ds_read_b64_tr_b16 %0, %1\n\ts_waitcnt lgkmcnt(0)" : "=&v"(r) : "v"(lds_addr) : "memory"); return r; }
__device__ __forceinline__ void pf_wait4(u32x4& a, u32x4& b, u32x4& c, u32x4& d) { asm volatile("s_waitcnt vmcnt(0)" : "+v"(a), "+v"(b), "+v"(c), "+v"(d) :: "memory"); }
__device__ __forceinline__ void pf_wait8(u32x4 (&v)[8]) { asm volatile("s_waitcnt vmcnt(0)" : "+v"(v[0]), "+v"(v[1]), "+v"(v[2]), "+v"(v[3]), "+v"(v[4]), "+v"(v[5]), "+v"(v[6]), "+v"(v[7]) :: "memory"); }
__device__ __forceinline__ bf16x8 as_bf16x8(const u32x4& v) { return __builtin_bit_cast(bf16x8, v); }
__device__ __forceinline__ void lds_add_u32(unsigned byte_addr, unsigned v) { asm volatile("ds_add_u32 %0, %1" :: "v"(byte_addr), "v"(v) : "memory"); }
__device__ __forceinline__ void lds_or_b32(unsigned byte_addr, unsigned v) { asm volatile("ds_or_b32 %0, %1" :: "v"(byte_addr), "v"(v) : "memory"); }
__device__ __forceinline__ unsigned sortable(float f) { const int u = __float_as_int(f); return (unsigned)u ^ ((unsigned)(u >> 31) | 0x80000000u); }

template <int PASS>
__device__ __forceinline__ void dsa_score_pass(const bf16_t* KIC, size_t rowb, int nkt, int wave, int fr, int g, int tq, const bf16x8 (&qf)[4][2], const float (&wq)[4],
                                               unsigned pfx, unsigned tau, unsigned hist_a, unsigned gtm_a, unsigned eqm_a) {
        const bf16_t* kbase = KIC + (rowb + fr) * 64 + g * 8;
        u32x4 c0, c1, c2, c3, n0, n1, n2, n3;
        { const int ka = wave < nkt ? wave : nkt - 1, kb = wave + 8 < nkt ? wave + 8 : nkt - 1;
          gload16(c0, kbase + (size_t)ka * 16 * 64); gload16(c1, kbase + (size_t)ka * 16 * 64 + 32); gload16(c2, kbase + (size_t)kb * 16 * 64); gload16(c3, kbase + (size_t)kb * 16 * 64 + 32);
          pf_wait4(c0, c1, c2, c3); }
#pragma unroll 1
        for (int kt = wave; kt < nkt; kt += 16) {
            { const int ka = kt + 16 < nkt ? kt + 16 : nkt - 1, kb = kt + 24 < nkt ? kt + 24 : nkt - 1;
              gload16(n0, kbase + (size_t)ka * 16 * 64); gload16(n1, kbase + (size_t)ka * 16 * 64 + 32); gload16(n2, kbase + (size_t)kb * 16 * 64); gload16(n3, kbase + (size_t)kb * 16 * 64 + 32); }
            f32x4 a[2][4];
#pragma unroll
            for (int half = 0; half < 2; ++half) { const bf16x8 k0 = as_bf16x8(half ? c2 : c0), k1 = as_bf16x8(half ? c3 : c1);
#pragma unroll
                for (int hh = 0; hh < 4; ++hh) { f32x4 z = (f32x4){0.f, 0.f, 0.f, 0.f}; z = mfma16(k0, qf[hh][0], z); a[half][hh] = mfma16(k1, qf[hh][1], z); } }
#pragma unroll
            for (int half = 0; half < 2; ++half) { const int kth = kt + 8 * half; const bool live = kth < nkt;
                f32x4 sc = (f32x4){0.f, 0.f, 0.f, 0.f};
#pragma unroll
                for (int hh = 0; hh < 4; ++hh)
#pragma unroll
                    for (int r = 0; r < 4; ++r) { const int ai = __float_as_int(a[half][hh][r]); sc[r] = fmaf(__int_as_float(ai > 0 ? ai : 0), wq[hh], sc[r]); }
                unsigned gtb = 0u, eqb = 0u;
#pragma unroll
                for (int r = 0; r < 4; ++r) { const int s = kth * 16 + 4 * g + r; const bool valid = live && s <= tq; const unsigned key = sortable(sc[r]);
                    if (PASS == 0) { const unsigned bin = key >> 21; lds_add_u32(hist_a + (bin >> 1) * 4u, valid ? (1u << ((bin & 1u) * 16u)) : 0u); }
                    else if (PASS == 1) { const unsigned bin = (key >> 10) & 2047u; lds_add_u32(hist_a + (bin >> 1) * 4u, (valid && (key >> 21) == pfx) ? (1u << ((bin & 1u) * 16u)) : 0u); }
                    else { gtb |= (valid && (key >> 10) > tau) ? (1u << r) : 0u; eqb |= (valid && (key >> 10) == tau) ? (1u << r) : 0u; } }
                if (PASS == 2) { const unsigned word = (unsigned)(kth >> 1), sh = (unsigned)((kth & 1) * 16 + 4 * g);
                    lds_or_b32(gtm_a + word * 4u, gtb << sh); lds_or_b32(eqm_a + word * 4u, eqb << sh); }
            }
            pf_wait4(n0, n1, n2, n3);
            c0 = n0; c1 = n1; c2 = n2; c3 = n3;
        }
}

__device__ __forceinline__ void unit_dsa(const Params& p, LAS unsigned char* lds, int b, int ti) {
    const int tid = ltid(), lane = tid & 63, wave = __builtin_amdgcn_readfirstlane(tid >> 6), fr = lane & 15, g = lane >> 4;
    LAS unsigned* HIST = (LAS unsigned*)lds; LAS unsigned char* GBUF = lds;
    LAS unsigned* GTM = (LAS unsigned*)(lds + 69632); LAS unsigned* EQM = (LAS unsigned*)(lds + 69632 + 8256);
    LAS unsigned short* SEL = (LAS unsigned short*)(lds + 86272); LAS unsigned char* QAB = lds + 94464;
    LAS int* MISC = (LAS int*)(lds + 127232); LAS unsigned char* SELB = lds + 127488;
    const LAS unsigned char* BKT8 = lds + L_BKT8; const LAS float* RELB = (const LAS float*)(lds + L_RELB);
    const bf16_t* P = (const bf16_t*)(p.ws + WS_P); const float* SP = (const float*)(p.ws + WS_SP); bf16_t* YMIX = (bf16_t*)(p.ws + WS_YMIX);
    const bf16_t* WUK = (const bf16_t*)(p.ws + WS_WUK); const bf16_t* WUV = (const bf16_t*)(p.ws + WS_WUV);
    const bf16_t* KIC = (const bf16_t*)(p.ws + WS_KIC); const bf16_t* CKC = (const bf16_t*)(p.ws + WS_CKC);
    const int t0 = ti * 16; const size_t rowb = (size_t)b * SEQ;
    TSEC_BEGIN(6) TSEC_BEGIN(1)
    for (int i = tid; i < 4100; i += NTHR) ((LAS u32x4*)HIST)[i] = (u32x4){0u, 0u, 0u, 0u};
    { const int h = wave; f32x4 acc[8];
#pragma unroll
      for (int rt = 0; rt < 8; ++rt) acc[rt] = (f32x4){0.f, 0.f, 0.f, 0.f};
#pragma unroll
      for (int kk = 0; kk < 2; ++kk) { const bf16x8 a = *(const bf16x8*)(P + (rowb + t0 + fr) * NP_AB + AB_QB + h * 64 + kk * 32 + g * 8);
#pragma unroll
        for (int rt = 0; rt < 8; ++rt) { const bf16x8 bw = *(const bf16x8*)(WUK + ((size_t)(rt * 16 + fr) * 8 + h) * 64 + kk * 32 + g * 8); acc[rt] = mfma16(a, bw, acc[rt]); } }
#pragma unroll
      for (int rt = 0; rt < 8; ++rt)
#pragma unroll
        for (int r = 0; r < 4; ++r) ((LAS bf16_t*)QAB)[((4 * g + r) * 8 + h) * 128 + rt * 16 + fr] = f2bf(acc[rt][r] * 0.125f); }
    bf16x8 qf[4][2];
#pragma unroll
    for (int hh = 0; hh < 4; ++hh)
#pragma unroll
        for (int kk = 0; kk < 2; ++kk) qf[hh][kk] = *(const bf16x8*)(P + (rowb + t0 + fr) * NP_AB + AB_QI + hh * 64 + kk * 32 + g * 8);
    float wq[4];
#pragma unroll
    for (int hh = 0; hh < 4; ++hh) wq[hh] = SP[(rowb + t0 + fr) * 16 + 8 + hh] * 0.5f;
    const int tq = t0 + fr; const int nkt = ti + 1;
    if (tid < 16) { MISC[tid] = 0; MISC[16 + tid] = (t0 + 16 > 256) ? 256 : (1 << 20); MISC[48 + tid] = 0; }
    for (int i = tid; i < 2 * 16 * 129; i += NTHR) GTM[i] = 0u;
    __syncthreads();
    TSEC_END(1) TSEC_BEGIN(2)
    const unsigned hist_a = (unsigned)(unsigned long long)(HIST + fr * 1025), gtm_a = (unsigned)(unsigned long long)(GTM + fr * 129), eqm_a = (unsigned)(unsigned long long)(EQM + fr * 129);
    const bool need_sel = (t0 + 16) > 256;
#pragma unroll 1
    for (int pass = need_sel ? 0 : 2; pass < 3; ++pass) {
        const unsigned pfx = (unsigned)MISC[fr], tau = (unsigned)MISC[48 + fr];
        TSEC_BEGIN(21)
#if defined(PERTURB) && PERTURB == 7
        if (pass == 0) dsa_score_pass<0>(KIC, rowb, nkt < 8 ? nkt : 8, wave, fr, g, -1, qf, wq, pfx, tau, hist_a, gtm_a, eqm_a);
#endif
#if defined(PERTURB) && PERTURB == 8
        __syncthreads(); __syncthreads();
#endif
#if defined(PERTURB) && PERTURB == 6
        if (pass == 0) dsa_score_pass<0>(KIC, rowb, (nkt + 1) >> 1, wave, fr, g, -1, qf, wq, pfx, tau, hist_a, gtm_a, eqm_a);
#endif
#if defined(PERTURB) && PERTURB == 4
        if (pass == 0) dsa_score_pass<0>(KIC, rowb, nkt, wave, fr, g, -1, qf, wq, pfx, tau, hist_a, gtm_a, eqm_a);
#endif
        if (pass == 0) dsa_score_pass<0>(KIC, rowb, nkt, wave, fr, g, tq, qf, wq, pfx, tau, hist_a, gtm_a, eqm_a);
        else if (pass == 1) dsa_score_pass<1>(KIC, rowb, nkt, wave, fr, g, tq, qf, wq, pfx, tau, hist_a, gtm_a, eqm_a);
        else dsa_score_pass<2>(KIC, rowb, nkt, wave, fr, g, tq, qf, wq, pfx, tau, hist_a, gtm_a, eqm_a);
        asm volatile("s_waitcnt lgkmcnt(0)" ::: "memory");
        __syncthreads();
        TSEC_END(21)
        if (pass < 2) {
            TSEC_BEGIN(22)
#pragma unroll
            for (int qq = 0; qq < 2; ++qq) { const int q = wave * 2 + qq; const int nq = t0 + q + 1;
                if (nq > 256) {
                    const int R = MISC[16 + q]; const int lo = 2016 - 32 * lane;
                    unsigned w[16];
#pragma unroll
                    for (int i = 0; i < 16; ++i) w[i] = HIST[q * 1025 + (lo >> 1) + i];
                    int sl = 0;
#pragma unroll
                    for (int i = 0; i < 16; ++i) sl += (int)(w[i] & 0xffffu) + (int)(w[i] >> 16);
                    const int cum = scan_add_i(sl, lane);
                    const unsigned long long mk = __ballot(cum >= R);
                    const int Ls = mk ? (int)__ffsll((long long)mk) - 1 : 63;
                    const int c0 = cum - sl; int c = c0, nlt = 0, above = c0;
#pragma unroll
                    for (int i = 15; i >= 0; --i) {
                        c += (int)(w[i] >> 16); nlt += (c < R) ? 1 : 0; above = (c < R) ? c : above;
                        c += (int)(w[i] & 0xffffu); nlt += (c < R) ? 1 : 0; above = (c < R) ? c : above; }
                    const int fbin = lo + 31 - nlt;
                    const int fb = __shfl(fbin, Ls), ab = __shfl(above, Ls);
                    if (lane == 0) { const unsigned old = (unsigned)MISC[q];
                        if (pass == 0) MISC[q] = fb; else MISC[48 + q] = (int)((old << 11) | (unsigned)fb);
                        MISC[16 + q] = R - ab; }
                } else if (lane == 0) { MISC[48 + q] = 0; MISC[16 + q] = 1 << 20; }
            }
            __syncthreads();
            if (pass == 0) { for (int i = tid; i < 4100; i += NTHR) ((LAS u32x4*)HIST)[i] = (u32x4){0u, 0u, 0u, 0u}; }
            __syncthreads();
            TSEC_END(22)
        }
    }
    TSEC_END(2) TSEC_BEGIN(3)
#pragma unroll 1
    for (int qq = 0; qq < 2; ++qq) { const int q = wave * 2 + qq; const int R = MISC[16 + q];
        const unsigned g0 = GTM[q * 129 + 2 * lane], g1 = GTM[q * 129 + 2 * lane + 1], e0 = EQM[q * 129 + 2 * lane], e1 = EQM[q * 129 + 2 * lane + 1];
        const int tc = (int)__popc(e0) + (int)__popc(e1); const int tpre = scan_add_i(tc, lane) - tc;
        const unsigned s0 = g0 | keep_lowest(e0, R - tpre), s1 = g1 | keep_lowest(e1, R - tpre - (int)__popc(e0));
        const int c = (int)__popc(s0) + (int)__popc(s1); const int incl = scan_add_i(c, lane); int pos = incl - c;
        unsigned m = s0; while (m) { const int bit = __ffs((int)m) - 1; m &= m - 1u; const int ki = lane * 64 + bit; if (pos < 256) { SEL[q * 256 + pos] = (unsigned short)ki; SELB[q * 256 + pos] = BKT8[t0 + q - ki]; } ++pos; }
        m = s1; while (m) { const int bit = __ffs((int)m) - 1; m &= m - 1u; const int ki = lane * 64 + 32 + bit; if (pos < 256) { SEL[q * 256 + pos] = (unsigned short)ki; SELB[q * 256 + pos] = BKT8[t0 + q - ki]; } ++pos; }
        const int total = __shfl(incl, 63);
        if (lane == 0) MISC[32 + q] = total < 256 ? total : 256;
    }
    __syncthreads();
    TSEC_END(3) TSEC_BEGIN(4)
    LAS unsigned char* gb = GBUF + wave * 8704;
    const unsigned gba = (unsigned)(unsigned long long)gb;
#pragma unroll 1
    for (int qq = 0; qq < 2; ++qq) { const int q = wave * 2 + qq; const int count = MISC[32 + q]; const int tpos = t0 + q; const int nch = (count + 31) >> 5;
        bf16x8 qh[4];
#pragma unroll
        for (int kk = 0; kk < 4; ++kk) { const bf16x8 v = *(const LAS bf16x8*)(QAB + ((q * 8 + (fr & 7)) * 128 + kk * 32 + g * 8) * 2); qh[kk] = (fr < 8) ? v : (bf16x8){0, 0, 0, 0, 0, 0, 0, 0}; }
        float m_run = -1e30f, l_part = 0.f; f32x4 ao[8];
#pragma unroll
        for (int rt = 0; rt < 8; ++rt) ao[rt] = (f32x4){0.f, 0.f, 0.f, 0.f};
        u32x4 gv[8];
#pragma unroll
        for (int it = 0; it < 8; ++it) { const int slot = g + 4 * it; const int idx = SEL[q * 256 + (slot < count ? slot : 0)];
            gload16(gv[it], CKC + (rowb + idx) * 128 + fr * 8); }
        const unsigned alo = gba + (unsigned)((4 * g + (fr >> 2)) * 272 + (4 * (fr & 3)) * 2), ahi = alo + 16u * 272u;
#pragma unroll 1
        for (int c = 0; c < nch; ++c) {
            TSEC_BEGIN(41)
            pf_wait8(gv);
            TSEC_END(41) TSEC_BEGIN(42)
#pragma unroll
            for (int it = 0; it < 8; ++it) *(LAS u32x4*)(gb + (g + 4 * it) * 272 + fr * 16) = gv[it];
            asm volatile("s_waitcnt lgkmcnt(0)" ::: "memory");
            {
                const int cn = (c + 1 < nch) ? c + 1 : 0;
#pragma unroll
                for (int it = 0; it < 8; ++it) { const int slot = cn * 32 + g + 4 * it; const int idx = SEL[q * 256 + (slot < count ? slot : 0)];
                    gload16(gv[it], CKC + (rowb + idx) * 128 + fr * 8); } }
            float lg[2][4];
#pragma unroll
            for (int k2 = 0; k2 < 2; ++k2) { f32x4 a = (f32x4){0.f, 0.f, 0.f, 0.f};
#pragma unroll
                for (int kk = 0; kk < 4; ++kk) a = mfma16(*(const LAS bf16x8*)(gb + (k2 * 16 + fr) * 272 + (kk * 32 + g * 8) * 2), qh[kk], a);
                const unsigned bk4 = *(const LAS unsigned*)(SELB + q * 256 + c * 32 + k2 * 16 + 4 * g);
#pragma unroll
                for (int r = 0; r < 4; ++r) { const int slot = c * 32 + k2 * 16 + 4 * g + r; const float bias = RELB[((bk4 >> (8 * r)) & 31u) * 8u + (unsigned)(fr & 7)];
                    lg[k2][r] = (slot < count) ? (a[r] + bias) * 1.44269504f : -1e30f; } }
            float ml = fmaxf(fmaxf(fmaxf(lg[0][0], lg[0][1]), fmaxf(lg[0][2], lg[0][3])), fmaxf(fmaxf(lg[1][0], lg[1][1]), fmaxf(lg[1][2], lg[1][3])));
            ml = fmaxf(ml, __shfl_xor(ml, 16)); ml = fmaxf(ml, __shfl_xor(ml, 32));
            const float m_new = fmaxf(m_run, ml); const float alpha = __builtin_amdgcn_exp2f(m_run - m_new);
            float pr[2][4]; float ps = 0.f;
#pragma unroll
            for (int k2 = 0; k2 < 2; ++k2)
#pragma unroll
                for (int r = 0; r < 4; ++r) { pr[k2][r] = __builtin_amdgcn_exp2f(lg[k2][r] - m_new); ps += pr[k2][r]; }
            l_part = l_part * alpha + ps; m_run = m_new;
            u32x4 pfu; pfu.x = pk2(pr[0][0], pr[0][1]); pfu.y = pk2(pr[0][2], pr[0][3]); pfu.z = pk2(pr[1][0], pr[1][1]); pfu.w = pk2(pr[1][2], pr[1][3]);
            const bf16x8 pf = __builtin_bit_cast(bf16x8, pfu);
            TSEC_END(42) TSEC_BEGIN(43)
            bf16x4 tl[8], th[8];
            asm volatile(
                "ds_read_b64_tr_b16 %0, %16\n\tds_read_b64_tr_b16 %8, %17\n\t"
                "ds_read_b64_tr_b16 %1, %16 offset:32\n\tds_read_b64_tr_b16 %9, %17 offset:32\n\t"
                "ds_read_b64_tr_b16 %2, %16 offset:64\n\tds_read_b64_tr_b16 %10, %17 offset:64\n\t"
                "ds_read_b64_tr_b16 %3, %16 offset:96\n\tds_read_b64_tr_b16 %11, %17 offset:96\n\t"
                "ds_read_b64_tr_b16 %4, %16 offset:128\n\tds_read_b64_tr_b16 %12, %17 offset:128\n\t"
                "ds_read_b64_tr_b16 %5, %16 offset:160\n\tds_read_b64_tr_b16 %13, %17 offset:160\n\t"
                "ds_read_b64_tr_b16 %6, %16 offset:192\n\tds_read_b64_tr_b16 %14, %17 offset:192\n\t"
                "ds_read_b64_tr_b16 %7, %16 offset:224\n\tds_read_b64_tr_b16 %15, %17 offset:224\n\t"
                "s_waitcnt lgkmcnt(0)"
                : "=&v"(tl[0]), "=&v"(tl[1]), "=&v"(tl[2]), "=&v"(tl[3]), "=&v"(tl[4]), "=&v"(tl[5]), "=&v"(tl[6]), "=&v"(tl[7]),
                  "=&v"(th[0]), "=&v"(th[1]), "=&v"(th[2]), "=&v"(th[3]), "=&v"(th[4]), "=&v"(th[5]), "=&v"(th[6]), "=&v"(th[7])
                : "v"(alo), "v"(ahi) : "memory");
#pragma unroll
            for (int rt = 0; rt < 8; ++rt) { ao[rt] = ao[rt] * alpha;
                bf16x8 af; af[0] = tl[rt][0]; af[1] = tl[rt][1]; af[2] = tl[rt][2]; af[3] = tl[rt][3]; af[4] = th[rt][0]; af[5] = th[rt][1]; af[6] = th[rt][2]; af[7] = th[rt][3];
                ao[rt] = mfma16(af, pf, ao[rt]); }
            TSEC_END(43)
        }
        pf_wait8(gv);
        float l = l_part; l += __shfl_xor(l, 16); l += __shfl_xor(l, 32);
        const float inv = 1.0f / l;
        if (fr < 8) {
#pragma unroll
            for (int rt = 0; rt < 8; ++rt) { u32x2 w; w.x = pk2(ao[rt][0] * inv, ao[rt][1] * inv); w.y = pk2(ao[rt][2] * inv, ao[rt][3] * inv);
                *(LAS u32x2*)(QAB + ((q * 8 + fr) * 128 + rt * 16 + 4 * g) * 2) = w; } }
    }
    __syncthreads();
    TSEC_END(4) TSEC_BEGIN(5)
    { const int h = wave; f32x4 acc[4];
#pragma unroll
      for (int nt = 0; nt < 4; ++nt) acc[nt] = (f32x4){0.f, 0.f, 0.f, 0.f};
#pragma unroll
      for (int kk = 0; kk < 4; ++kk) { const bf16x8 a = *(const LAS bf16x8*)(QAB + ((fr * 8 + h) * 128 + kk * 32 + g * 8) * 2);
#pragma unroll
        for (int nt = 0; nt < 4; ++nt) { const bf16x8 bw = *(const bf16x8*)(WUV + ((size_t)(h * 64 + nt * 16 + fr)) * 128 + kk * 32 + g * 8); acc[nt] = mfma16(a, bw, acc[nt]); } }
#pragma unroll
      for (int nt = 0; nt < 4; ++nt)
#pragma unroll
        for (int r = 0; r < 4; ++r) YMIX[(rowb + t0 + 4 * g + r) * D + 512 + h * 64 + nt * 16 + fr] = f2bf(acc[nt][r]); }
    __syncthreads();
    TSEC_END(5) TSEC_END(6)
}

struct DilRegs { u32x4 kv[4], vv[4]; bf16x8 qf[2]; };
__device__ __forceinline__ void dil_issue(const Params& p, int b, int h, int pat, int res, int n, DilRegs& r) {
    const int tid = ltid(), lane = tid & 63, wave = __builtin_amdgcn_readfirstlane(tid >> 6), fr = lane & 15, g = lane >> 4;
    const bf16_t* P = (const bf16_t*)(p.ws + WS_P);
    const int d = (pat == 0) ? 1 : (pat == 1 ? 4 : 16);
    const size_t rowb = (size_t)b * SEQ;
    const int row = tid >> 1, half = tid & 1; const int jsub = 128 * (n - 1) + row; const bool ok = jsub >= 0;
    const size_t tok = rowb + (size_t)(ok ? jsub : 0) * d + res;
#pragma unroll
    for (int q = 0; q < 4; ++q) { r.kv[q] = *(const u32x4*)(P + tok * NP_CD + CD_KD + h * 64 + half * 32 + q * 8); r.vv[q] = *(const u32x4*)(P + tok * NP_CD + CD_VD + h * 64 + half * 32 + q * 8); }
    const int qi = 128 * n + 16 * wave + fr; const size_t qtok = rowb + (size_t)qi * d + res;
#pragma unroll
    for (int kk = 0; kk < 2; ++kk) r.qf[kk] = *(const bf16x8*)(P + qtok * NP_CD + CD_QD + h * 64 + kk * 32 + g * 8);
}
__device__ __forceinline__ void dil_compute(const Params& p, LAS unsigned char* lds, int b, int h, int pat, int res, int n, const DilRegs& rg) {
    const int tid = ltid(), lane = tid & 63, wave = __builtin_amdgcn_readfirstlane(tid >> 6), fr = lane & 15, g = lane >> 4;
    LAS unsigned char* KS2 = lds; LAS unsigned char* VT2 = lds + 36864;
    const LAS unsigned char* BKT8 = lds + L_BKT8; const LAS float* RELB = (const LAS float*)(lds + L_RELB);
    const int d = (pat == 0) ? 1 : (pat == 1 ? 4 : 16);
    const size_t rowb = (size_t)b * SEQ;
    bf16_t* OP = (bf16_t*)(p.ws + (pat == 0 ? WS_HBF : (pat == 1 ? WS_HBF + 32 * MiB : WS_H1)));
    float* LSE = (float*)(p.ws + WS_H1 + 32 * MiB) + (size_t)pat * NTOK * 8;
    { const int row = tid >> 1, half = tid & 1; const bool ok = (128 * (n - 1) + row) >= 0;
#pragma unroll
      for (int q = 0; q < 4; ++q) { const u32x4 kq = ok ? rg.kv[q] : (u32x4){0u, 0u, 0u, 0u}, vq = ok ? rg.vv[q] : (u32x4){0u, 0u, 0u, 0u};
          *(LAS u32x4*)(KS2 + row * 144 + (half * 32 + q * 8) * 2) = kq;
#pragma unroll
          for (int e = 0; e < 4; ++e) { const unsigned w = vq[e]; const int dv = half * 32 + q * 8 + 2 * e;
              ((LAS bf16_t*)VT2)[dv * 264 + row] = (bf16_t)(w & 0xffffu); ((LAS bf16_t*)VT2)[(dv + 1) * 264 + row] = (bf16_t)(w >> 16); } } }
    LAS float* TAPB = (LAS float*)(lds + 70656);
    if (tid < 400) { const int tap = tid - 144; TAPB[tid] = (tap >= 0 && tap <= 128) ? RELB[(int)BKT8[tap * d] * 8 + h] * 1.44269504f : -1e30f; }
    __syncthreads();
    const int qi = 128 * n + 16 * wave + fr; const size_t qtok = rowb + (size_t)qi * d + res;
    const bf16x8 qf[2] = {rg.qf[0], rg.qf[1]};
    const int ql = 128 + 16 * wave + fr;
    float m_run = -1e30f, l_part = 0.f; f32x4 ao[4];
#pragma unroll
    for (int vt = 0; vt < 4; ++vt) ao[vt] = (f32x4){0.f, 0.f, 0.f, 0.f};
#pragma unroll 1
    for (int c = 0; c < 5; ++c) { const int kl0 = 16 * wave + 32 * c;
        float lg[2][4];
#pragma unroll
        for (int k2 = 0; k2 < 2; ++k2) {
            if (c == 4 && k2 == 1) {
#pragma unroll
                for (int r = 0; r < 4; ++r) lg[k2][r] = -1e30f;
            } else { f32x4 a = (f32x4){0.f, 0.f, 0.f, 0.f};
#pragma unroll
                for (int kk = 0; kk < 2; ++kk) a = mfma16(ldfrag(KS2, kl0 + k2 * 16 + fr, 144, kk, g), qf[kk], a);
#pragma unroll
                for (int r = 0; r < 4; ++r) { const int kl = kl0 + k2 * 16 + 4 * g + r; const int tap = ql - kl;
                    float v = fmaf(a[r], 0.125f * 1.44269504f, TAPB[tap + 144]);
                    if (n == 0) v = (kl >= 128) ? v : -1e30f;
                    lg[k2][r] = v; } } }
        float ml = fmaxf(fmaxf(fmaxf(lg[0][0], lg[0][1]), fmaxf(lg[0][2], lg[0][3])), fmaxf(fmaxf(lg[1][0], lg[1][1]), fmaxf(lg[1][2], lg[1][3])));
        ml = fmaxf(ml, __shfl_xor(ml, 16)); ml = fmaxf(ml, __shfl_xor(ml, 32));
        const float m_new = fmaxf(m_run, ml); const float alpha = __builtin_amdgcn_exp2f(m_run - m_new);
        float pr[2][4]; float ps = 0.f;
#pragma unroll
        for (int k2 = 0; k2 < 2; ++k2)
#pragma unroll
            for (int r = 0; r < 4; ++r) { pr[k2][r] = (lg[k2][r] > -1e29f) ? __builtin_amdgcn_exp2f(lg[k2][r] - m_new) : 0.f; ps += pr[k2][r]; }
        l_part = l_part * alpha + ps; m_run = m_new;
        u32x4 pfu; pfu.x = pk2(pr[0][0], pr[0][1]); pfu.y = pk2(pr[0][2], pr[0][3]); pfu.z = pk2(pr[1][0], pr[1][1]); pfu.w = pk2(pr[1][2], pr[1][3]);
        const bf16x8 pf = __builtin_bit_cast(bf16x8, pfu);
#pragma unroll
        for (int vt = 0; vt < 4; ++vt) { ao[vt] = ao[vt] * alpha;
            const bf16x4 lo = *(const LAS bf16x4*)(VT2 + (vt * 16 + fr) * 528 + (kl0 + 4 * g) * 2);
            bf16x4 hi = (bf16x4){0, 0, 0, 0};
            if (c < 4) hi = *(const LAS bf16x4*)(VT2 + (vt * 16 + fr) * 528 + (kl0 + 16 + 4 * g) * 2);
            bf16x8 af; af[0] = lo[0]; af[1] = lo[1]; af[2] = lo[2]; af[3] = lo[3]; af[4] = hi[0]; af[5] = hi[1]; af[6] = hi[2]; af[7] = hi[3];
            ao[vt] = mfma16(af, pf, ao[vt]); }
    }
    float l = l_part; l += __shfl_xor(l, 16); l += __shfl_xor(l, 32);
    const float inv = 1.0f / l;
#pragma unroll
    for (int vt = 0; vt < 4; ++vt) { u32x2 w; w.x = pk2(ao[vt][0] * inv, ao[vt][1] * inv); w.y = pk2(ao[vt][2] * inv, ao[vt][3] * inv);
        *(u32x2*)(OP + qtok * 512 + h * 64 + vt * 16 + 4 * g) = w; }
    if (g == 0) LSE[qtok * 8 + h] = (m_run + __log2f(l)) * 0.69314718f;
    __syncthreads();
}

__device__ __forceinline__ void phase_dil_combine(const Params& p) {
    const bf16_t* O0 = (const bf16_t*)(p.ws + WS_HBF); const bf16_t* O1 = (const bf16_t*)(p.ws + WS_HBF + 32 * MiB); const bf16_t* O2 = (const bf16_t*)(p.ws + WS_H1);
    const float* LSE = (const float*)(p.ws + WS_H1 + 32 * MiB); bf16_t* YMIX = (bf16_t*)(p.ws + WS_YMIX);
    for (int idx = BID * NTHR + TID; idx < NTOK * 64; idx += GDIM * NTHR) {
        const int tok = idx >> 6, h = (idx >> 3) & 7, dg = idx & 7;
        const float l0 = LSE[(size_t)tok * 8 + h], l1 = LSE[(size_t)NTOK * 8 + (size_t)tok * 8 + h], l2 = LSE[(size_t)2 * NTOK * 8 + (size_t)tok * 8 + h];
        const float mx = fmaxf(l0, fmaxf(l1, l2)); const float w0 = __expf(l0 - mx), w1 = __expf(l1 - mx), w2 = __expf(l2 - mx); const float inv = 1.0f / (w0 + w1 + w2);
        const size_t off = (size_t)tok * 512 + h * 64 + dg * 8;
        const u32x4 a = *(const u32x4*)(O0 + off), bq = *(const u32x4*)(O1 + off), c = *(const u32x4*)(O2 + off);
        u32x4 o;
#pragma unroll
        for (int e = 0; e < 4; ++e) {
            const float v0 = (__uint_as_float(a[e] << 16) * w0 + __uint_as_float(bq[e] << 16) * w1 + __uint_as_float(c[e] << 16) * w2) * inv;
            const float v1 = (__uint_as_float(a[e] & 0xffff0000u) * w0 + __uint_as_float(bq[e] & 0xffff0000u) * w1 + __uint_as_float(c[e] & 0xffff0000u) * w2) * inv;
            o[e] = pk2(v0, v1); }
        *(u32x4*)(YMIX + (size_t)tok * D + 512 + h * 64 + dg * 8) = o;
    }
}

__device__ __forceinline__ unsigned grab_issue(unsigned* ctr) { unsigned v = 0u; if (TID == 0) v = __hip_atomic_fetch_add(ctr, 1u, __ATOMIC_RELAXED, __HIP_MEMORY_SCOPE_AGENT); return v; }
__device__ __forceinline__ int grab_finish(unsigned v, LAS int* slot) { __syncthreads(); if (TID == 0) *slot = (int)v; __syncthreads(); return *slot; }
__device__ __forceinline__ int grab_unit(unsigned* ctr, LAS int* slot) {
    __syncthreads();
    if (TID == 0) *slot = (int)__hip_atomic_fetch_add(ctr, 1u, __ATOMIC_RELAXED, __HIP_MEMORY_SCOPE_AGENT);
    __syncthreads();
    return *slot;
}
__device__ __forceinline__ void phase_rec_L(const Params& p, LAS unsigned char* lds, int j, bool is_ab) {
    for (int u = BID; u < 2048; u += GDIM) { const int bh = u >> 6, ck = u & 63;
        if (is_ab) unit_mlstm_L(p, lds, j, bh >> 2, bh & 3, ck); else unit_gla_L(p, lds, j, bh >> 2, bh & 3, ck); }
}
__device__ __forceinline__ void phase_mixer_ab(const Params& p, LAS unsigned char* lds, int j, unsigned* ctr, int nrec = 2048) {
    LAS int* slot = (LAS int*)(lds + LDS_PERS + LP_SLOT);
    load_attn_tables(p, lds);
    int u = grab_unit(ctr, slot);
    while (u < 2048) { const unsigned pend = grab_issue(ctr); unit_dsa(p, lds, u >> 8, 255 - (u & 255)); u = grab_finish(pend, slot); }
    const int total = 2048 + nrec;
    MlstmOIn cur, nxt;
    if (u < total) { const int k = u - 2048, bh = k >> 6; mlstm_O_issue(p, bh >> 2, bh & 3, k & 63, cur); }
    int un = (u < total) ? grab_unit(ctr, slot) : total;
    while (u < total) {
        const unsigned pend = grab_issue(ctr);
        if (un < total) { const int k2 = un - 2048, bh2 = k2 >> 6; mlstm_O_issue(p, bh2 >> 2, bh2 & 3, k2 & 63, nxt); }
        { const int k = u - 2048, bh = k >> 6; TSEC_BEGIN(7) mlstm_O_compute(p, lds, j, bh >> 2, bh & 3, k & 63, cur); TSEC_END(7) }
        cur = nxt; u = un; un = grab_finish(pend, slot);
    }
}
__device__ __forceinline__ void dil_decode(int k, int& b, int& h, int& pat, int& res, int& n) {
    const int n32 = k & 31, bh = k / 96; pat = (k >> 5) % 3; b = bh >> 3; h = bh & 7;
    if (pat == 0) { res = 0; n = n32; } else if (pat == 1) { res = n32 >> 3; n = n32 & 7; } else { res = n32 >> 1; n = n32 & 1; }
}
__device__ __forceinline__ void phase_mixer_cd(const Params& p, LAS unsigned char* lds, int j, unsigned* ctr, int nrec = 2048) {
    LAS int* slot = (LAS int*)(lds + LDS_PERS + LP_SLOT);
    load_attn_tables(p, lds);
    const int total = 6144 + nrec;
    int u = grab_unit(ctr, slot);
    DilRegs cur, nxt;
    if (u < 6144) { int b, h, pat, res, n; dil_decode(u, b, h, pat, res, n); dil_issue(p, b, h, pat, res, n, cur); }
    int un = (u < total) ? grab_unit(ctr, slot) : total;
    while (u < total) {
        const unsigned pend = grab_issue(ctr);
        if (u < 6144) { int b, h, pat, res, n; dil_decode(u, b, h, pat, res, n);
            if (un < 6144) { int b2, h2, pat2, res2, n2; dil_decode(un, b2, h2, pat2, res2, n2); dil_issue(p, b2, h2, pat2, res2, n2, nxt); }
            TSEC_BEGIN(8) dil_compute(p, lds, b, h, pat, res, n, cur); TSEC_END(8)
            cur = nxt; }
        else { const int k = u - 6144; const int bh = k >> 6; TSEC_BEGIN(9) unit_gla_O(p, lds, j, bh >> 2, bh & 3, k & 63); TSEC_END(9) }
        u = un; un = grab_finish(pend, slot);
    }
}
typedef const __attribute__((address_space(4))) Params* KernargP;
__device__ __forceinline__ const Params& lparams() { KernargP k = (KernargP)__builtin_amdgcn_kernarg_segment_ptr(); asm volatile("" : "+s"(k)); return *(const Params*)k; }
#define PP (lparams())
__device__ __forceinline__ LAS unsigned char* llds(LAS unsigned char* q) { asm volatile("" : "+s"(q)); return q; }
#define LL (llds(lds))
__global__ void __launch_bounds__(NTHR, 2) hybrid_fwd(Params p) {
    extern __shared__ __attribute__((aligned(16))) unsigned char lds_raw[];
    LAS unsigned char* lds = (LAS unsigned char*)lds_raw;
    const int tid = TID, G = GDIM;
    for (int i = tid; i < (LDS_TOTAL - LDS_PERS) / 4; i += NTHR) ((LAS unsigned*)(lds + LDS_PERS))[i] = 0u;
    __syncthreads();
    unsigned* ctl = (unsigned*)(PP.ws + WS_CTL);
    XcdBarrier bar = xcd_barrier_post(ctl + CW_BAR, (volatile LAS unsigned*)(lds + LDS_PERS));
    LAS int* tbase = (LAS int*)(lds + LDS_PERS + LP_TBASE);

    p0_prologue(PP, LL);
    __syncthreads();
#pragma unroll 1
    for (int l = 0; l < DEPTH; ++l) {
        const bool is_ab = (l & 1) == 0; const int j = l >> 1;
        prep_layer(PP, LL, l);
#if DBL == 1
        __syncthreads(); prep_layer(PP, LL, l);
#endif
        if (l == 0) xcd_barrier(bar);
        __syncthreads();
        phase_norm1(PP, LL, l);
        xcd_barrier(bar);
        {
            const int N = is_ab ? NP_AB : NP_CD;
            pg8::Gemm gm{(const bf16_t*)(PP.ws + WS_HBF), (const bf16_t*)(PP.ws + WS_WIN), NTOK, N, D};
            pg8::StaticOrder S; S.init(NTOK, N, G, BID);
            pg8::EpiBf16<false> E{(bf16_t*)(PP.ws + WS_P), N, is_ab ? (bf16_t*)(PP.ws + WS_KIC) : nullptr, is_ab ? (bf16_t*)(PP.ws + WS_CKC) : nullptr};
            pg8::gemm_phase(LL, gm, S, E);
#if DBL == 3
            pg8::gemm_phase(LL, gm, S, E);
#endif
        }
        xcd_barrier(bar);
        phase_rec_L(PP, LL, j, is_ab);
#if DBL == 11
        __syncthreads(); phase_rec_L(PP, LL, j, is_ab);
#endif
        xcd_barrier(bar);
        if (is_ab) phase_scan_mlstm(PP); else phase_scan_gla(PP);
#if DBL == 12
        xcd_barrier(bar); if (is_ab) phase_scan_mlstm(PP); else phase_scan_gla(PP);
#endif
        xcd_barrier(bar);
        if (is_ab) { phase_mixer_ab(PP, LL, j, ctl + CW_WQ + 64 * l);
#if DBL == 4
            xcd_barrier(bar); phase_mixer_ab(PP, LL, j, ctl + CW_WQ + 64 * (l + 4));
#endif
#if DBL == 9
            xcd_barrier(bar); phase_mixer_ab(PP, LL, j, ctl + CW_WQ + 64 * (l + 4), 0);
#endif
        } else { phase_mixer_cd(PP, LL, j, ctl + CW_WQ + 64 * l); xcd_barrier(bar); phase_dil_combine(PP);
#if DBL == 5
            xcd_barrier(bar); phase_mixer_cd(PP, LL, j, ctl + CW_WQ + 64 * (l + 4)); xcd_barrier(bar); phase_dil_combine(PP);
#endif
#if DBL == 10
            xcd_barrier(bar); phase_mixer_cd(PP, LL, j, ctl + CW_WQ + 64 * (l + 4), 0); xcd_barrier(bar); phase_dil_combine(PP);
#endif
        }
        xcd_barrier(bar);
        {
            pg8::Gemm gm{(const bf16_t*)(PP.ws + WS_YMIX), (const bf16_t*)(PP.ws + WS_WOUT), NTOK, D, D};
            pg8::StaticOrder S; S.init(NTOK, D, G, BID);
            pg8::EpiOutRes E{(float*)(PP.ws + WS_X), (const float*)(PP.ws + WS_MOD) + (size_t)l * 8 * 6 * D + 2 * D};
            pg8::gemm_phase(LL, gm, S, E);
        }
        xcd_barrier(bar);
        phase_norm2(PP, LL, l);
#if DBL == 2
        xcd_barrier(bar); phase_norm2(PP, LL, l);
#endif
        xcd_barrier(bar);
        phase_dispatch(PP, LL, tbase);
#if DBL == 6
        xcd_barrier(bar); phase_dispatch(PP, LL, tbase);
#endif
        xcd_barrier(bar);
        {
            pg8::Gemm gm{(const bf16_t*)(PP.ws + WS_HBF), (const bf16_t*)(PP.ws + WS_WGU), MOE_ROWS, 16 * 1024, D, (const int*)(PP.ws + WS_ROWTOK)};
            pg8::MoeOrder S{tbase, G, BID};
            pg8::EpiMoe1 E{(bf16_t*)(PP.ws + WS_H1)};
            pg8::gemm_phase<pg8::EpiMoe1, pg8::MoeOrder, true>(LL, gm, S, E);
#if DBL == 7
            pg8::gemm_phase<pg8::EpiMoe1, pg8::MoeOrder, true>(LL, gm, S, E);
#endif
        }
        xcd_barrier(bar);
        {
            pg8::Gemm gm{(const bf16_t*)(PP.ws + WS_H1), (const bf16_t*)(PP.ws + WS_WDN), MOE_ROWS, 16 * 1024, 512};
            pg8::MoeOrder S{tbase, G, BID};
            pg8::EpiBf16<true> E{(bf16_t*)(PP.ws + WS_P), D, nullptr, nullptr};
            pg8::gemm_phase(LL, gm, S, E);
#if DBL == 8
            pg8::gemm_phase(LL, gm, S, E);
#endif
        }
        xcd_barrier(bar);
    }
    phase_final(PP, LL);
#if PROF
    if (BID == 0) { __syncthreads(); const unsigned long long acc = *(LAS unsigned long long*)(lds + LDS_PERS + LP_TACC); const unsigned long long t0 = wall_clock64(); while (wall_clock64() - t0 < acc * 10ull) __builtin_amdgcn_s_sleep(8); }
#endif
}

extern "C" void kernel_launch(void* const* d_in, const int* in_sizes, int n_in, void* d_out, int out_size, void* d_ws, size_t ws_size, hipStream_t stream) {
    static int grid = 0;
    if (grid == 0) {
        if (n_in != 28 || ws_size < WS_END2) { fprintf(stderr, "kernel_launch: unexpected n_in %d / ws_size %zu (need %zu)\n", n_in, ws_size, (size_t)WS_END2); grid = -1; return; }
        int dev = 0, cus = 0, per_cu = 0;
        if (hipGetDevice(&dev) != hipSuccess || hipDeviceGetAttribute(&cus, hipDeviceAttributeMultiprocessorCount, dev) != hipSuccess) { grid = -1; return; }
        if (hipFuncSetAttribute((const void*)hybrid_fwd, hipFuncAttributeMaxDynamicSharedMemorySize, LDS_TOTAL) != hipSuccess) { fprintf(stderr, "kernel_launch: hipFuncSetAttribute failed\n"); grid = -1; return; }
        if (hipOccupancyMaxActiveBlocksPerMultiprocessor(&per_cu, (const void*)hybrid_fwd, NTHR, LDS_TOTAL) != hipSuccess || per_cu < 1) { fprintf(stderr, "kernel_launch: occupancy query says %d\n", per_cu); }
        (void)hipGetLastError();
        grid = cus;
    }
    if (grid < 0) return;
    if (hipMemsetAsync((char*)d_ws + WS_CTL, 0, CTL_BYTES, stream) != hipSuccess) return;
    Params p{};
    for (int i = 0; i < 28; ++i) p.in[i] = (const float*)d_in[i];
    p.out = (float*)d_out; p.ws = (unsigned char*)d_ws;
    hipLaunchKernelGGL(hybrid_fwd, dim3(grid), dim3(NTHR), LDS_TOTAL, stream, p);
}
```

```cpp
#define DBL 0
#define PROF 0
#define PERTURB 0
#include <hip/hip_runtime.h>
#include <cstdio>
#include <cstdint>

#define LAS __attribute__((address_space(3)))
typedef unsigned short bf16_t;
typedef short bf16x8 __attribute__((ext_vector_type(8)));
typedef short bf16x4 __attribute__((ext_vector_type(4)));
typedef float f32x4 __attribute__((ext_vector_type(4)));
typedef float f32x2 __attribute__((ext_vector_type(2)));
typedef unsigned u32x4 __attribute__((ext_vector_type(4)));
typedef unsigned u32x2 __attribute__((ext_vector_type(2)));

constexpr int D = 1024, NB = 8, SEQ = 4096, NTOK = NB * SEQ, DEPTH = 4;
constexpr int W_AB = 2508, W_CD = 3088;
constexpr int NP_AB = 2560, NP_CD = 3072;
constexpr int AB_QA = 0, AB_KA = 256, AB_VA = 512, AB_OA = 1024, AB_QB = 1536, AB_CKV = 2048, AB_QI = 2176, AB_KI = 2432;
constexpr int CD_QC = 0, CD_KC = 256, CD_VC = 512, CD_RC = 1024, CD_QD = 1536, CD_KD = 2048, CD_VD = 2560;
constexpr int MOE_ROWS = 2 * NTOK + 16 * 256;

__device__ __forceinline__ int lbid() { int t = (int)blockIdx.x; asm volatile("" : "+s"(t)); return t; }
__device__ __forceinline__ int lgdim() { int t = (int)gridDim.x; asm volatile("" : "+s"(t)); return t; }
#define BID (lbid())
#define GDIM (lgdim())
__device__ __forceinline__ int ltid() { int t = (int)threadIdx.x; asm volatile("" : "+v"(t)); return t; }
__device__ __forceinline__ void gload16(u32x4& dst, const void* ptr) { asm volatile("global_load_dwordx4 %0, %1, off" : "=&v"(dst) : "v"(ptr) : "memory"); }
__device__ __forceinline__ float bf2f(bf16_t b) { return __uint_as_float(((unsigned)b) << 16); }
__device__ __forceinline__ unsigned pk2(float lo, float hi) { unsigned r; asm("v_cvt_pk_bf16_f32 %0, %1, %2" : "=v"(r) : "v"(lo), "v"(hi)); return r; }
__device__ __forceinline__ bf16_t f2bf(float f) { return (bf16_t)(pk2(f, 0.f) & 0xffffu); }
__device__ __forceinline__ float wave_sum(float v) {
#pragma unroll
    for (int o = 32; o > 0; o >>= 1) v += __shfl_xor(v, o);
    return v;
}
__device__ __forceinline__ float sigmoidf_(float x) { return 1.0f / (1.0f + __expf(-x)); }
__device__ __forceinline__ float siluf_(float x) { return x / (1.0f + __expf(-x)); }
__device__ __forceinline__ float logsigmoidf_(float x) { return fminf(x, 0.0f) - log1pf(__expf(-fabsf(x))); }

#define XB_TMO      128
#define XB_XCNT(j)  (256  + 64 * (j))
#define XB_XSUB(j)  (1280 + 64 * (j))
#define XB_XGEN(j)  (2304 + 64 * (j))
#define XB_TOP      3328
#define XB_TOPGEN   3392
#define XCD_BAR_WORDS 3456
#define XB_SPIN_CAP (1u << 18)

__device__ __forceinline__ unsigned xb_ld(unsigned* p)              { return __hip_atomic_load(p, __ATOMIC_RELAXED, __HIP_MEMORY_SCOPE_AGENT); }
__device__ __forceinline__ unsigned xb_add(unsigned* p, unsigned v) { return __hip_atomic_fetch_add(p, v, __ATOMIC_RELAXED, __HIP_MEMORY_SCOPE_AGENT); }
__device__ __forceinline__ unsigned xb_xcc_id() { return (unsigned)__builtin_amdgcn_s_getreg((3 << 11) | 20) & 0xFu; }
#define XB_SPIN(cond, bar) do { unsigned _sp = 0; while (cond) { __builtin_amdgcn_s_sleep(1); \
    if ((++_sp & 255u) == 0u) { if (xb_ld(&(bar)[XB_TMO])) break; if (_sp > XB_SPIN_CAP) { atomicAdd(&(bar)[XB_TMO], 1u); break; } } } } while (0)

struct XcdBarrier { unsigned* bar; unsigned x; volatile LAS unsigned* st; };

__device__ __forceinline__ XcdBarrier xcd_barrier_post(unsigned* bar, volatile LAS unsigned* st) {
    XcdBarrier b; b.bar = bar; b.x = xb_xcc_id(); b.st = st;
    if (ltid() == 0) (void)xb_add(&bar[XB_XCNT(b.x)], 1u);
    return b;
}
__device__ __forceinline__ void xcd_barrier_complete(unsigned* bar, unsigned x, unsigned& nloc, unsigned& nx) {
    const unsigned G = (unsigned)GDIM;
    unsigned sum, cnt, mine, sp = 0u;
    for (;;) {
        sum = 0u; cnt = 0u; mine = 0u;
#pragma unroll
        for (unsigned j = 0; j < 16; ++j) { const unsigned c = xb_ld(&bar[XB_XCNT(j)]); sum += c; cnt += (c > 0u) ? 1u : 0u; mine = (j == x) ? c : mine; }
        if (sum == G) break;
        __builtin_amdgcn_s_sleep(1);
        if ((++sp & 255u) == 0u) { if (xb_ld(&bar[XB_TMO])) break; if (sp > XB_SPIN_CAP) { atomicAdd(&bar[XB_TMO], 1u); break; } }
    }
    nloc = mine > 0u ? mine : 1u; nx = cnt > 0u ? cnt : 1u;
}
__device__ __forceinline__ void xcd_barrier1(const XcdBarrier& b) {
    asm volatile("s_waitcnt vmcnt(0)" ::: "memory");
    __syncthreads();
    if (ltid() == 0) {
        unsigned* bar = b.bar;
        __builtin_amdgcn_s_waitcnt(0);
        unsigned nloc = b.st[0], nx = b.st[1];
        if (nloc == 0u) { xcd_barrier_complete(bar, b.x, nloc, nx); b.st[0] = nloc; b.st[1] = nx; }
        const unsigned old = xb_add(&bar[XB_XSUB(b.x)], 1u);
        const unsigned gen = old / nloc;
        if (old + 1u == (gen + 1u) * nloc) {
            __builtin_amdgcn_fence(__ATOMIC_RELEASE, "agent");
            asm volatile("s_waitcnt vmcnt(0)" ::: "memory");
            const unsigned og = xb_add(&bar[XB_TOP], 1u);
            const unsigned tg = og / nx;
            if (og + 1u == (tg + 1u) * nx) xb_add(&bar[XB_TOPGEN], 1u);
            else XB_SPIN(xb_ld(&bar[XB_TOPGEN]) == tg, bar);
            __builtin_amdgcn_fence(__ATOMIC_ACQUIRE, "agent");
            xb_add(&bar[XB_XGEN(b.x)], 1u);
            asm volatile("s_waitcnt vmcnt(0)" ::: "memory");
        } else {
            XB_SPIN(xb_ld(&bar[XB_XGEN(b.x)]) == gen, bar);
            __builtin_amdgcn_fence(__ATOMIC_ACQUIRE, "agent");
            asm volatile("s_waitcnt vmcnt(0)" ::: "memory");
        }
    }
    __syncthreads();
}

#ifndef DBL
#define DBL 0
#endif
__device__ __forceinline__ void xcd_barrier(const XcdBarrier& b) { xcd_barrier1(b);
#if DBL == 20
    xcd_barrier1(b);
#endif
}

namespace pg8 {
constexpr int BM = 256, BK = 64, HALF = 128, HTB = HALF * BK * 2, STAGE_BYTES = 8 * HTB, NXCD = 8, WGM = 8;
__host__ __device__ __forceinline__ int lds_byte(int r, int c) { const int st = (r >> 4) * 2 + (c >> 5), rr = r & 15, cc = c & 31, ob = rr * 64 + cc * 2; return st * 1024 + (ob ^ (((ob >> 9) & 1) << 5)); }
__host__ __device__ __forceinline__ void stage_rc(int b, int& R, int& C) { const int st = b / 1024, sb = b % 1024, swz = sb ^ (((sb >> 9) & 1) << 5); R = (st >> 1) * 16 + swz / 64; C = (st & 1) * 32 + (swz % 64) / 2; }
__host__ __device__ __forceinline__ int perm32(int rho) { const int n = rho >> 4, i = rho & 15; return 8 * (i >> 2) + 4 * n + (i & 3); }

struct Unit { int pm, pn; };
struct Gemm { const bf16_t* A; const bf16_t* Bt; int M, N, K; const int* rowtok; };

struct StaticOrder {
    int nM, nN, nwg, G, c;
    __host__ __device__ void init(int M, int N, int G_, int c_) { nM = M / BM; nN = N / BM; nwg = nM * nN; G = G_; c = c_; }
    __host__ __device__ bool next(int i, Unit& u) const {
        const long L = (long)i * G + c; if (L >= nwg) return false;
        int wgid = (int)L; { const int q = nwg / NXCD, r = nwg % NXCD, xcd = wgid % NXCD, off = wgid / NXCD; wgid = (xcd < r ? xcd * (q + 1) : r * (q + 1) + (xcd - r) * q) + off; }
        const int nig = WGM * nN, gid = wgid / nig, fm = gid * WGM, gsz = (nM - fm) < WGM ? (nM - fm) : WGM;
        u.pm = fm + ((wgid % nig) % gsz); u.pn = (wgid % nig) / gsz; return true;
    }
    __device__ __forceinline__ void a_ready(const Unit&) const {}
    __device__ __forceinline__ void done(const Unit&) const {}
};
struct MoeOrder {
    const LAS int* tbase;
    int G, c;
    __device__ bool next(int i, Unit& u) const {
        const int L = i * G + c; const int total = tbase[16] * 4; if (L >= total) return false;
        const int pm = L >> 2; int e = 0;
#pragma unroll
        for (int k = 1; k < 16; ++k) e += (pm >= tbase[k]) ? 1 : 0;
        u.pm = pm; u.pn = e * 4 + (L & 3); return true;
    }
    __device__ __forceinline__ void a_ready(const Unit&) const {}
    __device__ __forceinline__ void done(const Unit&) const {}
};

__device__ __forceinline__ unsigned cvt_pk_bf16(float lo, float hi) { unsigned r; asm volatile("v_cvt_pk_bf16_f32 %0, %1, %2" : "=v"(r) : "v"(lo), "v"(hi)); return r; }

template <bool MOE> struct EpiBf16 {
    static constexpr bool PERM = true, AFTER_DRAIN = false;
    bf16_t* O; int ldc;
    bf16_t* kic; bf16_t* ckc;
    __device__ __forceinline__ void operator()(const f32x4 (&acc)[2][2][4][2], const Unit& u, int wr, int wc, int fr, int fq) const {
        const int row0 = u.pm * BM + wr * 64 + fr; const int colt = (MOE ? (u.pn & 3) : u.pn) * BM; const int col0 = colt + wc * 32 + 8 * fq;
#pragma unroll
        for (int ai = 0; ai < 2; ++ai)
#pragma unroll
            for (int m = 0; m < 4; ++m) { bf16_t* rowp = O + (size_t)(row0 + ai * HALF + m * 16) * ldc + col0;
#pragma unroll
                for (int bj = 0; bj < 2; ++bj) { const f32x4 v0 = acc[ai][bj][m][0], v1 = acc[ai][bj][m][1];
                    u32x4 w; w.x = cvt_pk_bf16(v0[0], v0[1]); w.y = cvt_pk_bf16(v0[2], v0[3]); w.z = cvt_pk_bf16(v1[0], v1[1]); w.w = cvt_pk_bf16(v1[2], v1[3]);
                    *(u32x4*)(rowp + bj * HALF) = w;
                    if (!MOE) { const size_t row = (size_t)(row0 + ai * HALF + m * 16);
                        if (kic && u.pn == 9 && bj == 1 && wc < 2) *(u32x4*)(kic + row * 64 + wc * 32 + 8 * fq) = w;
                        if (ckc && u.pn == 8 && bj == 0) *(u32x4*)(ckc + row * 128 + wc * 32 + 8 * fq) = w; } } }
    }
};
struct EpiOutRes {
    static constexpr bool PERM = false, AFTER_DRAIN = false;
    float* X; const float* gate;
    __device__ __forceinline__ void operator()(const f32x4 (&acc)[2][2][4][2], const Unit& u, int wr, int wc, int fr, int fq) const {
        const int row0 = u.pm * BM + wr * 64 + fr, col0 = u.pn * BM + wc * 32 + 4 * fq;
        const float* gp = gate + (size_t)((u.pm * BM) >> 12) * (6 * D) + col0;
        f32x4 gv[2][2];
#pragma unroll
        for (int bj = 0; bj < 2; ++bj)
#pragma unroll
            for (int n = 0; n < 2; ++n) gv[bj][n] = *(const f32x4*)(gp + bj * HALF + n * 16);
        f32x4 xa[2][2], xb[2][2];
        { const float* rowp = X + (size_t)row0 * D + col0;
#pragma unroll
          for (int bj = 0; bj < 2; ++bj)
#pragma unroll
            for (int n = 0; n < 2; ++n) xa[bj][n] = *(const f32x4*)(rowp + bj * HALF + n * 16); }
#pragma unroll
        for (int gi = 0; gi < 8; ++gi) { const int ai = gi >> 2, m = gi & 3;
            float* rowp = X + (size_t)(row0 + ai * HALF + m * 16) * D + col0;
            if (gi + 1 < 8) { const int ai2 = (gi + 1) >> 2, m2 = (gi + 1) & 3; const float* rown = X + (size_t)(row0 + ai2 * HALF + m2 * 16) * D + col0;
#pragma unroll
                for (int bj = 0; bj < 2; ++bj)
#pragma unroll
                    for (int n = 0; n < 2; ++n) { if (gi & 1) xa[bj][n] = *(const f32x4*)(rown + bj * HALF + n * 16); else xb[bj][n] = *(const f32x4*)(rown + bj * HALF + n * 16); } }
#pragma unroll
            for (int bj = 0; bj < 2; ++bj)
#pragma unroll
                for (int n = 0; n < 2; ++n) { const f32x4 xv = (gi & 1) ? xb[bj][n] : xa[bj][n]; *(f32x4*)(rowp + bj * HALF + n * 16) = xv + gv[bj][n] * acc[ai][bj][m][n]; } }
    }
};
struct EpiMoe1 {
    static constexpr bool PERM = false, AFTER_DRAIN = false;
    bf16_t* H1;
    __device__ __forceinline__ void operator()(const f32x4 (&acc)[2][2][4][2], const Unit& u, int wr, int wc, int fr, int fq) const {
        const int row0 = u.pm * BM + wr * 64 + fr, col0 = (u.pn & 3) * 128 + wc * 16 + 4 * fq;
#pragma unroll
        for (int ai = 0; ai < 2; ++ai)
#pragma unroll
            for (int m = 0; m < 4; ++m) { bf16_t* rowp = H1 + (size_t)(row0 + ai * HALF + m * 16) * 512 + col0;
#pragma unroll
                for (int bj = 0; bj < 2; ++bj) { const f32x4 g = acc[ai][bj][m][0], up = acc[ai][bj][m][1]; float h[4];
#pragma unroll
                    for (int j = 0; j < 4; ++j) h[j] = g[j] / (1.0f + __expf(-g[j])) * up[j];
                    u32x2 w; w.x = cvt_pk_bf16(h[0], h[1]); w.y = cvt_pk_bf16(h[2], h[3]);
                    *(u32x2*)(rowp + bj * 64) = w; } }
    }
};

template <class Epi, class Sched, bool GATHER = false>
__device__ __forceinline__ void gemm_phase(LAS unsigned char* lds, const Gemm g, const Sched& S, const Epi& E) {
    const int tid = ltid(), wid = __builtin_amdgcn_readfirstlane(tid >> 6), lane = tid & 63, wr = wid >> 2, wc = wid & 3, fr = lane & 15, fq = lane >> 4;
    const int K = g.K, nt = K / BK;
    unsigned voffA[2], voffB[2];
#pragma unroll
    for (int i = 0; i < 2; ++i) { int R, C; stage_rc(tid * 16 + i * 8192, R, C); const int Rb = Epi::PERM ? ((R & ~31) + perm32(R & 31)) : R;
        voffA[i] = (unsigned)(R * K + C) * 2u; voffB[i] = (unsigned)(Rb * K + C) * 2u; }
    unsigned vc0[2] = {0u, 0u}, vc1[2] = {0u, 0u}, vn0[2] = {0u, 0u}, vn1[2] = {0u, 0u};
#define PG8_GOFF(pm_, v0_, v1_) do { const int _tz = ltid(); _Pragma("unroll") for (int _i = 0; _i < 2; ++_i) { int _R, _C; stage_rc(_tz * 16 + _i * 8192, _R, _C); \
        v0_[_i] = (unsigned)g.rowtok[(pm_) * BM + _R] * (unsigned)(K * 2) + (unsigned)_C * 2u; v1_[_i] = (unsigned)g.rowtok[(pm_) * BM + HALF + _R] * (unsigned)(K * 2) + (unsigned)_C * 2u; } } while (0)
    const size_t kstep = (size_t)(BK * 2);
    const size_t hstep = (size_t)HALF * K * 2;
    const size_t tstep = 2 * hstep;
    const unsigned ldsw = (unsigned)wid * 1024u;
    const int aoff = lds_byte(wr * 64 + fr, fq * 8), boff = lds_byte(wc * 32 + fr, fq * 8);
#define PG8_SA(b, h) (((b) * 2 + (h)) * HTB)
#define PG8_SB(b, h) ((4 + (b) * 2 + (h)) * HTB)
#define PG8_STAGE(bufoff, gbase, voff) do { _Pragma("unroll") for (int _i = 0; _i < 2; ++_i) \
        __builtin_amdgcn_global_load_lds((const unsigned*)((const char*)(gbase) + (voff)[_i]), (LAS unsigned*)(lds + (bufoff) + ldsw + _i * 8192), 16, 0, 0); } while (0)
#define PG8_LDA(dst, b, h) do { _Pragma("unroll") for (int m = 0; m < 4; ++m) _Pragma("unroll") for (int k = 0; k < 2; ++k) dst[m][k] = *(const LAS bf16x8*)(lds + PG8_SA(b, h) + aoff + m * 2048 + k * 1024); } while (0)
#define PG8_LDB(dst, b, h) do { _Pragma("unroll") for (int n = 0; n < 2; ++n) _Pragma("unroll") for (int k = 0; k < 2; ++k) dst[n][k] = *(const LAS bf16x8*)(lds + PG8_SB(b, h) + boff + n * 2048 + k * 1024); } while (0)
#define PG8_MMA(ai, bj, At, Bt) do { __builtin_amdgcn_s_setprio(1); _Pragma("unroll") for (int m = 0; m < 4; ++m) _Pragma("unroll") for (int n = 0; n < 2; ++n) _Pragma("unroll") for (int k = 0; k < 2; ++k) \
        acc[ai][bj][m][n] = __builtin_amdgcn_mfma_f32_16x16x32_bf16(Bt[n][k], At[m][k], acc[ai][bj][m][n], 0, 0, 0); __builtin_amdgcn_s_setprio(0); } while (0)
#define PG8_WAIT_V(n) asm volatile("s_waitcnt vmcnt(" #n ")" ::: "memory")
#define PG8_WAIT_L(n) asm volatile("s_waitcnt lgkmcnt(" #n ")" ::: "memory")
#define PG8_BAR __builtin_amdgcn_s_barrier()
#define PG8_SCHED __builtin_amdgcn_sched_barrier(0)
    Unit cur, nxt; int ui = 0;
    if (!S.next(0, cur)) return;
    f32x4 acc[2][2][4][2];
#pragma unroll
    for (int a = 0; a < 2; ++a)
#pragma unroll
        for (int b = 0; b < 2; ++b)
#pragma unroll
            for (int m = 0; m < 4; ++m)
#pragma unroll
                for (int n = 0; n < 2; ++n) acc[a][b][m][n] = (f32x4){0.f, 0.f, 0.f, 0.f};
    bf16x8 At[4][2], B0[2][2], B1[2][2];
    const char* cA = GATHER ? (const char*)g.A : (const char*)g.A + (size_t)cur.pm * tstep; const char* cB = (const char*)g.Bt + (size_t)cur.pn * tstep;
    S.a_ready(cur);
    if constexpr (GATHER) { PG8_GOFF(cur.pm, vc0, vc1); vn0[0] = vc0[0]; vn0[1] = vc0[1]; vn1[0] = vc1[0]; vn1[1] = vc1[1]; }
    if constexpr (GATHER) { PG8_STAGE(PG8_SB(0, 0), cB, voffB); PG8_STAGE(PG8_SA(0, 0), cA, vc0); PG8_STAGE(PG8_SB(0, 1), cB + hstep, voffB); PG8_STAGE(PG8_SA(0, 1), cA, vc1); }
    else { PG8_STAGE(PG8_SB(0, 0), cB, voffB); PG8_STAGE(PG8_SA(0, 0), cA, voffA); PG8_STAGE(PG8_SB(0, 1), cB + hstep, voffB); PG8_STAGE(PG8_SA(0, 1), cA + hstep, voffA); }
    if (wr == 1) PG8_BAR;
    PG8_WAIT_V(4); PG8_BAR;
    if constexpr (GATHER) { PG8_STAGE(PG8_SB(1, 0), cB + kstep, voffB); PG8_STAGE(PG8_SA(1, 0), cA + kstep, vc0); PG8_STAGE(PG8_SB(1, 1), cB + hstep + kstep, voffB); }
    else { PG8_STAGE(PG8_SB(1, 0), cB + kstep, voffB); PG8_STAGE(PG8_SA(1, 0), cA + kstep, voffA); PG8_STAGE(PG8_SB(1, 1), cB + hstep + kstep, voffB); }
    PG8_WAIT_V(6); PG8_BAR;
    for (;;) {
        const bool has_next = S.next(ui + 1, nxt);
        const char* nA = GATHER ? cA : (has_next ? (const char*)g.A + (size_t)nxt.pm * tstep : cA); const char* nB = has_next ? (const char*)g.Bt + (size_t)nxt.pn * tstep : cB;
        if constexpr (GATHER) { if (has_next) PG8_GOFF(nxt.pm, vn0, vn1); }
        for (int t = 0; t < nt; t += 2) {
            const bool last = (t == nt - 2);
            unsigned s0[2] = {vc0[0], vc0[1]}, s1[2] = {vc1[0], vc1[1]};
            if constexpr (GATHER) { if (last) { asm volatile("" : "+v"(vn0[0]), "+v"(vn0[1]), "+v"(vn1[0]), "+v"(vn1[1])); s0[0] = vn0[0]; s0[1] = vn0[1]; s1[0] = vn1[0]; s1[1] = vn1[1]; } }
            const char* a1 = cA + (size_t)(t + 1) * kstep;
            const char* a2 = last ? nA : cA + (size_t)(t + 2) * kstep; const char* b2 = last ? nB : cB + (size_t)(t + 2) * kstep;
            const char* a3 = a2 + kstep; const char* b3 = b2 + kstep;
            if (last && has_next) S.a_ready(nxt);
            PG8_LDB(B0, 0, 0); PG8_SCHED; PG8_LDA(At, 0, 0); if constexpr (GATHER) PG8_STAGE(PG8_SA(1, 1), a1, vc1); else PG8_STAGE(PG8_SA(1, 1), a1 + hstep, voffA);
            PG8_WAIT_L(8); PG8_BAR; PG8_WAIT_L(0); PG8_MMA(0, 0, At, B0); PG8_BAR; PG8_SCHED;
            PG8_LDB(B1, 0, 1); PG8_STAGE(PG8_SB(0, 0), b2, voffB);
            PG8_BAR; PG8_WAIT_L(0); PG8_MMA(0, 1, At, B1); PG8_BAR;
            PG8_LDA(At, 0, 1); if constexpr (GATHER) PG8_STAGE(PG8_SA(0, 0), a2, s0); else PG8_STAGE(PG8_SA(0, 0), a2, voffA);
            PG8_BAR; PG8_WAIT_L(0); PG8_MMA(1, 0, At, B0); PG8_BAR; PG8_SCHED;
            PG8_STAGE(PG8_SB(0, 1), b2 + hstep, voffB);
            PG8_WAIT_V(6); PG8_BAR; PG8_MMA(1, 1, At, B1); PG8_BAR;
            PG8_LDB(B0, 1, 0); PG8_SCHED; PG8_LDA(At, 1, 0); if constexpr (GATHER) PG8_STAGE(PG8_SA(0, 1), a2, s1); else PG8_STAGE(PG8_SA(0, 1), a2 + hstep, voffA);
            PG8_WAIT_L(8); PG8_BAR; PG8_WAIT_L(0); PG8_MMA(0, 0, At, B0); PG8_BAR; PG8_SCHED;
            PG8_LDB(B1, 1, 1); PG8_STAGE(PG8_SB(1, 0), b3, voffB);
            PG8_BAR; PG8_WAIT_L(0); PG8_MMA(0, 1, At, B1); PG8_BAR;
            PG8_LDA(At, 1, 1); if constexpr (GATHER) PG8_STAGE(PG8_SA(1, 0), a3, s0); else PG8_STAGE(PG8_SA(1, 0), a3, voffA);
            PG8_BAR; PG8_WAIT_L(0); PG8_MMA(1, 0, At, B0); PG8_BAR; PG8_SCHED;
            PG8_STAGE(PG8_SB(1, 1), b3 + hstep, voffB);
            PG8_WAIT_V(6); PG8_BAR; PG8_MMA(1, 1, At, B1); PG8_BAR;
        }
        E(acc, cur, wr, wc, fr, fq); S.done(cur);
        if (!has_next) break;
#pragma unroll
        for (int a = 0; a < 2; ++a)
#pragma unroll
            for (int b = 0; b < 2; ++b)
#pragma unroll
                for (int m = 0; m < 4; ++m)
#pragma unroll
                    for (int n = 0; n < 2; ++n) acc[a][b][m][n] = (f32x4){0.f, 0.f, 0.f, 0.f};
        cur = nxt; cA = nA; cB = nB; ++ui;
        if constexpr (GATHER) { vc0[0] = vn0[0]; vc0[1] = vn0[1]; vc1[0] = vn1[0]; vc1[1] = vn1[1]; }
    }
    PG8_WAIT_V(0);
    if (wr == 0) PG8_BAR;
    PG8_BAR;
#undef PG8_GOFF
#undef PG8_SA
#undef PG8_SB
#undef PG8_STAGE
#undef PG8_LDA
#undef PG8_LDB
#undef PG8_MMA
#undef PG8_WAIT_V
#undef PG8_WAIT_L
#undef PG8_BAR
#undef PG8_SCHED
}
}
constexpr size_t MiB = 1024 * 1024;
constexpr size_t WS_CTL  = 0;
constexpr size_t CTL_BYTES = 65536;
constexpr size_t WS_MOD  = WS_CTL + CTL_BYTES;
constexpr size_t WS_BKT  = WS_MOD + 4 * 8 * 6144 * 4;
constexpr size_t WS_SP   = WS_BKT + 4096 * 4;
constexpr size_t WS_RTE  = WS_SP + (size_t)NTOK * 16 * 4;
constexpr size_t WS_RTW  = WS_RTE + (size_t)NTOK * 4;
constexpr size_t WS_POS  = WS_RTW + (size_t)NTOK * 8;
constexpr size_t WS_TC   = WS_POS + (size_t)NTOK * 8;
constexpr size_t WS_WUK  = WS_TC + 256 * 16 * 4;
constexpr size_t WS_WUV  = WS_WUK + 65536 * 2;
constexpr size_t WS_X    = 4 * MiB;
constexpr size_t WS_HBF  = WS_X + 128 * MiB;
constexpr size_t WS_P    = WS_HBF + 64 * MiB;
constexpr size_t WS_YMIX = WS_P + 192 * MiB;
constexpr size_t WS_H1   = WS_YMIX + 64 * MiB;
constexpr size_t WS_WIN  = WS_H1 + 68 * MiB;
constexpr size_t WS_WOUT = WS_WIN + 6 * MiB;
constexpr size_t WS_WGU  = WS_WOUT + 2 * MiB;
constexpr size_t WS_WDN  = WS_WGU + 32 * MiB;
constexpr size_t WS_END  = WS_WDN + 16 * MiB;
constexpr size_t WS_CL   = WS_END;
constexpr size_t WS_SCAL = WS_CL + 72 * MiB;
constexpr size_t WS_MC   = WS_SCAL + 512 * 1024;
constexpr size_t WS_KIC  = WS_MC + 1024 * 1024;
constexpr size_t WS_CKC  = WS_KIC + 4 * MiB;
constexpr size_t WS_ROWTOK = WS_MC + 512 * 1024;
constexpr size_t WS_END2 = WS_CKC + 8 * MiB;
constexpr size_t WS_CTG  = WS_HBF;
constexpr size_t WS_STG  = WS_H1 + 36 * MiB;
static_assert(WS_WUV + 65536 * 2 <= WS_X, "small region overflow");
static_assert((size_t)MOE_ROWS * 512 * 2 <= 68 * MiB, "H1");
static_assert((size_t)MOE_ROWS * 1024 * 2 <= 192 * MiB, "AS");

constexpr int CW_BAR = 0;
constexpr int CW_WQ  = 4096;

constexpr int LDS_TOTAL = 147456;
constexpr int LDS_PERS  = 143360;
constexpr int LP_SLOT = 16, LP_TBASE = 64;

struct Params { const float* in[28]; float* out; unsigned char* ws; };
enum { I_X = 0, I_C, I_WADA, I_BADA, I_GMIX, I_GFFN, I_GFINAL, I_RELB, I_ABWIN, I_ABCONVW, I_ABCONVB, I_ABGATEB, I_ABHNORM, I_ABWUK, I_ABWUV, I_ABWOUT,
       I_CDWIN, I_CDWALPHA, I_CDBALPHA, I_CDHNORM, I_CDWOUT, I_MWC, I_MBC, I_MWF, I_MBF, I_MWG, I_MWU, I_MWD };

#define TID (ltid())
#define NTHR 512

__device__ __forceinline__ void p0_prologue(const Params& p, LAS unsigned char* lds) {
    const int tid = ltid(), G = GDIM;
    LAS float* sc = (LAS float*)lds;
    LAS float* red = (LAS float*)(lds + 32768);
    const float* c = p.in[I_C];
    for (int i = tid; i < 8 * 1024; i += NTHR) { const float v = c[i]; sc[i] = v / (1.0f + __expf(-v)); }
    __syncthreads();
    float* mod = (float*)(p.ws + WS_MOD);
    for (int u = BID; u < 4 * 48; u += G) {
        const int l = u / 48, e0 = (u % 48) * 128, col = tid & 127, ds = tid >> 7;
        const float* w = p.in[I_WADA] + (size_t)l * D * 6 * D + e0 + col;
        float a[8];
#pragma unroll
        for (int b = 0; b < 8; ++b) a[b] = 0.f;
#pragma unroll 16
        for (int d = ds * 256; d < ds * 256 + 256; ++d) { const float wv = w[(size_t)d * 6 * D];
#pragma unroll
            for (int b = 0; b < 8; ++b) a[b] += sc[b * 1024 + d] * wv; }
#pragma unroll
        for (int b = 0; b < 8; ++b) red[(ds * 8 + b) * 128 + col] = a[b];
        __syncthreads();
        for (int i = tid; i < 8 * 128; i += NTHR) { const int b = i >> 7, cc = i & 127;
            const float s = ((red[(0 * 8 + b) * 128 + cc] + red[(1 * 8 + b) * 128 + cc]) + red[(2 * 8 + b) * 128 + cc]) + red[(3 * 8 + b) * 128 + cc];
            mod[((size_t)l * 8 + b) * 6 * D + e0 + cc] = s + p.in[I_BADA][(size_t)l * 6 * D + e0 + cc]; }
        __syncthreads();
    }
    int* bkt = (int*)(p.ws + WS_BKT);
    for (int n = BID * NTHR + tid; n < 4096; n += G * NTHR) {
        int v;
        if (n < 16) v = n; else { v = 16 + (int)(log((double)n / 16.0) / log(128.0) * 16.0); if (v > 31) v = 31; }
        bkt[n] = v;
    }
}

template <class SrcF>
__device__ __forceinline__ void prep_tr(LAS unsigned char* lds, const SrcF& src, int K, int Nd, bf16_t* Bt) {
    LAS float* tile = (LAS float*)lds;
    const int tid = TID, G = GDIM, tnN = Nd / 64, ntile = tnN * (K / 64);
    float cur[8], nxt[8];
    int u = BID;
    if (u < ntile) { const int tn = u % tnN, tk = u / tnN;
#pragma unroll
        for (int i = 0; i < 8; ++i) cur[i] = src(tn * 64 + (tid & 63), tk * 64 + (tid >> 6) + 8 * i); }
    for (; u < ntile; u += G) {
        const int tn = u % tnN, tk = u / tnN; const int un = u + G;
        if (un < ntile) { const int tn2 = un % tnN, tk2 = un / tnN;
#pragma unroll
            for (int i = 0; i < 8; ++i) nxt[i] = src(tn2 * 64 + (tid & 63), tk2 * 64 + (tid >> 6) + 8 * i); }
#pragma unroll
        for (int i = 0; i < 8; ++i) tile[((tid >> 6) + 8 * i) * 65 + (tid & 63)] = cur[i];
        __syncthreads();
#pragma unroll
        for (int i = 0; i < 4; ++i) { const int nn = (tid >> 5) + 16 * i, kk = (tid & 31) * 2;
            *(unsigned*)(Bt + (size_t)(tn * 64 + nn) * K + tk * 64 + kk) = pk2(tile[kk * 65 + nn], tile[(kk + 1) * 65 + nn]); }
        __syncthreads();
#pragma unroll
        for (int i = 0; i < 8; ++i) cur[i] = nxt[i];
    }
}
struct SrcShift { const float* W; int ldw, n0, shift, nvalid;
    __device__ __forceinline__ float operator()(int n, int k) const { if (n >= nvalid) return 0.f; return W[(size_t)k * ldw + (n >= n0 ? n + shift : n)]; } };
struct SrcGU { const float* Wg; const float* Wu;
    __device__ __forceinline__ float operator()(int n, int k) const { const int e = n >> 10, r = n & 1023, j = (r >> 5) * 16 + (r & 15); const unsigned long long dlt = (unsigned long long)Wu - (unsigned long long)Wg; const float* W = (const float*)((unsigned long long)Wg + (unsigned long long)((r >> 4) & 1) * dlt); return W[((size_t)e * 1024 + k) * 512 + j]; } };
struct SrcDN { const float* Wd;
    __device__ __forceinline__ float operator()(int n, int k) const { return Wd[((size_t)(n >> 10) * 512 + k) * 1024 + (n & 1023)]; } };

constexpr size_t WS_TAB = WS_WUV + 65536 * 2;
static_assert(WS_TAB + 13 * 16384 <= WS_X, "small region overflow");
struct WfAB { const float* W; __device__ __forceinline__ float operator()(int k, int c) const {
        if (c >= 12) return 0.f; const int col = c < 8 ? 1536 + c : 2504 + (c - 8); return W[(size_t)k * W_AB + col]; } };
struct WfCD { const float* W; __device__ __forceinline__ float operator()(int k, int c) const { return W[(size_t)k * W_CD + 1024 + c]; } };
struct WfRT { const float* Wc; const float* Wf; __device__ __forceinline__ float operator()(int k, int c) const {
        if (c < 4) return Wc[(size_t)k * 4 + c]; const int g = (c - 4) >> 2, e = (c - 4) & 3; return Wf[((size_t)g * D + k) * 4 + e]; } };
template <class WF>
__device__ __forceinline__ void build_small_tab(f32x4* tab, int nc4, const WF& wf) {
    for (int idx = BID * NTHR + TID; idx < nc4 * 1024; idx += GDIM * NTHR) {
        const int c4 = idx >> 10, r = idx & 1023, ij = r >> 6, lane = r & 63, k = 512 * (ij >> 3) + 8 * lane + (ij & 7);
        f32x4 v; v[0] = wf(k, 4 * c4); v[1] = wf(k, 4 * c4 + 1); v[2] = wf(k, 4 * c4 + 2); v[3] = wf(k, 4 * c4 + 3);
        tab[idx] = v; }
}
__device__ __forceinline__ void prep_layer(const Params& p, LAS unsigned char* lds, int l) {
    const int j = l >> 1;
    if ((l & 1) == 0) {
        SrcShift s{p.in[I_ABWIN] + (size_t)j * D * W_AB, W_AB, 1536, 8, 2496};
        prep_tr(lds, s, D, NP_AB, (bf16_t*)(p.ws + WS_WIN));
        SrcShift so{p.in[I_ABWOUT] + (size_t)j * D * D, D, 1 << 30, 0, D};
        prep_tr(lds, so, D, D, (bf16_t*)(p.ws + WS_WOUT));
        const float* wuk = p.in[I_ABWUK] + (size_t)j * 65536; const float* wuv = p.in[I_ABWUV] + (size_t)j * 65536;
        bf16_t* ouk = (bf16_t*)(p.ws + WS_WUK); bf16_t* ouv = (bf16_t*)(p.ws + WS_WUV);
        for (int i = BID * NTHR + TID; i < 65536; i += GDIM * NTHR) {
            ouk[i] = f2bf(wuk[i]);
            const int h = i >> 13, d = (i >> 7) & 63, r = i & 127;
            ouv[i] = f2bf(wuv[((size_t)r * 8 + h) * 64 + d]);
        }
    } else {
        SrcShift s{p.in[I_CDWIN] + (size_t)j * D * W_CD, W_CD, 1024, 16, 3072};
        prep_tr(lds, s, D, NP_CD, (bf16_t*)(p.ws + WS_WIN));
        SrcShift so{p.in[I_CDWOUT] + (size_t)j * D * D, D, 1 << 30, 0, D};
        prep_tr(lds, so, D, D, (bf16_t*)(p.ws + WS_WOUT));
    }
    { f32x4* tabg = (f32x4*)(p.ws + WS_TAB);
      if (l == 0) { WfAB wf{p.in[I_ABWIN]}; build_small_tab(tabg, 4, wf); }
      if (l + 1 < DEPTH) { const int ln = l + 1, jn = ln >> 1;
          if ((ln & 1) == 0) { WfAB wf{p.in[I_ABWIN] + (size_t)jn * D * W_AB}; build_small_tab(tabg + (ln & 1) * 4096, 4, wf); } else { WfCD wf{p.in[I_CDWIN] + (size_t)jn * D * W_CD}; build_small_tab(tabg + (ln & 1) * 4096, 4, wf); } }
      WfRT wr{p.in[I_MWC] + (size_t)l * D * 4, p.in[I_MWF] + (size_t)l * 4 * D * 4}; build_small_tab(tabg + 8 * 1024, 5, wr); }
    SrcGU sg{p.in[I_MWG] + (size_t)l * 16 * 1024 * 512, p.in[I_MWU] + (size_t)l * 16 * 1024 * 512};
    prep_tr(lds, sg, 1024, 16 * 1024, (bf16_t*)(p.ws + WS_WGU));
    SrcDN sd{p.in[I_MWD] + (size_t)l * 16 * 512 * 1024};
    prep_tr(lds, sd, 512, 16 * 1024, (bf16_t*)(p.ws + WS_WDN));
}

__device__ __forceinline__ void copy_tab_to_lds(LAS f32x4* dst, const f32x4* src, int n) { for (int i = TID; i < n; i += NTHR) dst[i] = src[i]; }
template <int NC4>
__device__ __forceinline__ void small_proj(const LAS f32x4* tab, const float (&h)[2][8], int lane, f32x4 (&out)[NC4]) {
#pragma unroll
    for (int c4 = 0; c4 < NC4; ++c4) { f32x4 a = (f32x4){0.f, 0.f, 0.f, 0.f};
#pragma unroll
        for (int i = 0; i < 2; ++i) { f32x4 t[8];
#pragma unroll
            for (int j = 0; j < 8; ++j) t[j] = tab[(c4 * 16 + i * 8 + j) * 64 + lane];
            asm volatile("" ::: "memory");
#pragma unroll
            for (int j = 0; j < 8; ++j) a += t[j] * h[i][j]; }
        out[c4] = a; asm volatile("" ::: "memory"); }
}
__device__ __forceinline__ float reduce16(const f32x4 (&a)[4], int lane) {
    const bool b5 = (lane & 32) != 0, b4 = (lane & 16) != 0, b3 = (lane & 8) != 0, b2 = (lane & 4) != 0;
    float w8[8], w4[4], w2[2];
#pragma unroll
    for (int c = 0; c < 8; ++c) { const float lo = a[c >> 2][c & 3], hi = a[(c + 8) >> 2][c & 3]; w8[c] = (b5 ? hi : lo) + __shfl_xor(b5 ? lo : hi, 32); }
#pragma unroll
    for (int c = 0; c < 4; ++c) w4[c] = (b4 ? w8[c + 4] : w8[c]) + __shfl_xor(b4 ? w8[c] : w8[c + 4], 16);
#pragma unroll
    for (int c = 0; c < 2; ++c) w2[c] = (b3 ? w4[c + 2] : w4[c]) + __shfl_xor(b3 ? w4[c] : w4[c + 2], 8);
    float w1 = (b2 ? w2[1] : w2[0]) + __shfl_xor(b2 ? w2[0] : w2[1], 4);
    w1 += __shfl_xor(w1, 2); w1 += __shfl_xor(w1, 1);
    return w1;
}
__device__ __forceinline__ float reduce4(const f32x4& a, int lane) {
    const bool b5 = (lane & 32) != 0, b4 = (lane & 16) != 0;
    const float u0 = (b5 ? a[2] : a[0]) + __shfl_xor(b5 ? a[0] : a[2], 32), u1 = (b5 ? a[3] : a[1]) + __shfl_xor(b5 ? a[1] : a[3], 32);
    float w = (b4 ? u1 : u0) + __shfl_xor(b4 ? u0 : u1, 16);
    w += __shfl_xor(w, 8); w += __shfl_xor(w, 4); w += __shfl_xor(w, 2); w += __shfl_xor(w, 1);
    return w;
}
__device__ __forceinline__ float rdl(float v, int l) { return __int_as_float(__builtin_amdgcn_readlane(__float_as_int(v), l)); }
__device__ __forceinline__ void unpack8(const u32x4& v, float (&o)[8]) {
#pragma unroll
    for (int e = 0; e < 4; ++e) { o[2 * e] = __uint_as_float(v[e] << 16); o[2 * e + 1] = __uint_as_float(v[e] & 0xffff0000u); } }

template <int MODE>
__device__ __forceinline__ void phase_tokens(const Params& p, LAS unsigned char* lds, int l) {
    const int tid = ltid(), lane = tid & 63, wave = tid >> 6, G = GDIM;
    LAS f32x4* tab = (LAS f32x4*)lds;
    LAS int* cnts = (LAS int*)(lds + 5 * 16384);
    if (MODE == 1) copy_tab_to_lds(tab, (const f32x4*)(p.ws + WS_TAB) + (l & 1) * 4096, 4 * 1024);
    if (MODE == 2) copy_tab_to_lds(tab, (const f32x4*)(p.ws + WS_TAB) + 8 * 1024, 5 * 1024);
    __syncthreads();
    const float* mod = (const float*)(p.ws + WS_MOD);
    float* X = (float*)(p.ws + WS_X); bf16_t* HBF = (bf16_t*)(p.ws + WS_HBF); float* SP = (float*)(p.ws + WS_SP);
    const bf16_t* YS = (const bf16_t*)(p.ws + WS_P);
    const int* POS = (const int*)(p.ws + WS_POS); float* RTW = (float*)(p.ws + WS_RTW); int* RTE = (int*)(p.ws + WS_RTE); int* TC = (int*)(p.ws + WS_TC);
    const bool comb = (MODE == 3) || (MODE == 1 && l > 0);
    const int lprev = (MODE == 3) ? 3 : l - 1;
    const float* biasc = p.in[I_MBC] + l * 4; const float* biasf = p.in[I_MBF] + l * 16;
    for (int grp = BID; grp < NTOK / 128; grp += G) {
        const int b = (grp * 128) >> 12;
        float ca[2][8], cb[2][8], gf[2][8];
#pragma unroll
        for (int i = 0; i < 2; ++i)
#pragma unroll
            for (int j = 0; j < 8; ++j) { const int col = 512 * i + 8 * lane + j;
                if (MODE == 1) { const float* mrow = mod + ((size_t)l * 8 + b) * 6 * D; ca[i][j] = p.in[I_GMIX][(size_t)l * D + col] * (mrow[D + col] + 1.0f); cb[i][j] = mrow[col]; }
                if (MODE == 2) { const float* mrow = mod + ((size_t)l * 8 + b) * 6 * D; ca[i][j] = p.in[I_GFFN][(size_t)l * D + col] * (mrow[4 * D + col] + 1.0f); cb[i][j] = mrow[3 * D + col]; }
                if (MODE == 3) { ca[i][j] = p.in[I_GFINAL][col]; cb[i][j] = 0.f; }
                gf[i][j] = comb ? mod[((size_t)lprev * 8 + b) * 6 * D + 5 * D + col] : 0.f; }
        int pos1v = 0, pos2v = 0; float w1v = 0.f, w2v = 0.f;
        if (comb && lane < 16) { const int tk = grp * 128 + wave * 16 + lane; pos1v = POS[2 * tk]; pos2v = POS[2 * tk + 1]; w1v = RTW[2 * tk]; w2v = RTW[2 * tk + 1]; }
        const float* xsrc = (MODE == 1 && l == 0) ? p.in[I_X] : X;
        LAS unsigned char* mb = lds + ((MODE == 2) ? (5 * 16384 + 1024) : (4 * 16384 + 1024)) + __builtin_amdgcn_readfirstlane(wave) * ((MODE == 2) ? 4096 : 8192);
#define TOK_ISSUE(tt_) do { const int tok_ = grp * 128 + wave * 16 + (tt_); \
            __builtin_amdgcn_global_load_lds((const unsigned*)(xsrc + (size_t)tok_ * D + 8 * lane), (LAS unsigned*)(mb), 16, 0, 0); \
            __builtin_amdgcn_global_load_lds((const unsigned*)(xsrc + (size_t)tok_ * D + 8 * lane + 4), (LAS unsigned*)(mb + 1024), 16, 0, 0); \
            __builtin_amdgcn_global_load_lds((const unsigned*)(xsrc + (size_t)tok_ * D + 512 + 8 * lane), (LAS unsigned*)(mb + 2048), 16, 0, 0); \
            __builtin_amdgcn_global_load_lds((const unsigned*)(xsrc + (size_t)tok_ * D + 512 + 8 * lane + 4), (LAS unsigned*)(mb + 3072), 16, 0, 0); \
            if (comb) { const int q1_ = __builtin_amdgcn_readlane(pos1v, (tt_)), q2_ = __builtin_amdgcn_readlane(pos2v, (tt_)); \
                __builtin_amdgcn_global_load_lds((const unsigned*)(YS + (size_t)q1_ * D + 8 * lane), (LAS unsigned*)(mb + 4096), 16, 0, 0); \
                __builtin_amdgcn_global_load_lds((const unsigned*)(YS + (size_t)q1_ * D + 512 + 8 * lane), (LAS unsigned*)(mb + 5120), 16, 0, 0); \
                __builtin_amdgcn_global_load_lds((const unsigned*)(YS + (size_t)q2_ * D + 8 * lane), (LAS unsigned*)(mb + 6144), 16, 0, 0); \
                __builtin_amdgcn_global_load_lds((const unsigned*)(YS + (size_t)q2_ * D + 512 + 8 * lane), (LAS unsigned*)(mb + 7168), 16, 0, 0); } } while (0)
        TOK_ISSUE(0);
        int cnt = 0;
#pragma unroll 1
        for (int tt = 0; tt < 16; ++tt) {
            const int tok = grp * 128 + wave * 16 + tt;
            asm volatile("s_waitcnt vmcnt(0)" ::: "memory");
            u32x4 xb[4], yb[4];
#pragma unroll
            for (int k4 = 0; k4 < 4; ++k4) xb[k4] = *(const LAS u32x4*)(mb + k4 * 1024 + lane * 16);
            if (comb) {
#pragma unroll
                for (int k4 = 0; k4 < 4; ++k4) yb[k4] = *(const LAS u32x4*)(mb + 4096 + k4 * 1024 + lane * 16);
            }
            asm volatile("s_waitcnt lgkmcnt(0)" ::: "memory");
            float x[2][8];
#pragma unroll
            for (int i = 0; i < 2; ++i)
#pragma unroll
                for (int j = 0; j < 8; ++j) x[i][j] = __uint_as_float(xb[2 * i + (j >> 2)][j & 3]);
            if (comb) { const float w1 = rdl(w1v, tt), w2 = rdl(w2v, tt);
#pragma unroll
                for (int i = 0; i < 2; ++i) { float y1[8], y2[8]; unpack8(yb[i], y1); unpack8(yb[2 + i], y2);
#pragma unroll
                    for (int j = 0; j < 8; ++j) x[i][j] += gf[i][j] * (y1[j] * w1 + y2[j] * w2); } }
            if (tt + 1 < 16) TOK_ISSUE(tt + 1);
            asm volatile("" ::: "memory");
            float ss = 0.f;
#pragma unroll
            for (int i = 0; i < 2; ++i)
#pragma unroll
                for (int j = 0; j < 8; ++j) ss += x[i][j] * x[i][j];
            ss = wave_sum(ss);
            const float rstd = 1.0f / sqrtf(ss * (1.0f / 1024.0f) + 1e-6f);
            float h[2][8];
#pragma unroll
            for (int i = 0; i < 2; ++i)
#pragma unroll
                for (int j = 0; j < 8; ++j) h[i][j] = x[i][j] * rstd * ca[i][j] + cb[i][j];
            if (MODE == 1) {
#pragma unroll
                for (int i = 0; i < 2; ++i) { *(f32x4*)(X + (size_t)tok * D + 512 * i + 8 * lane) = (f32x4){x[i][0], x[i][1], x[i][2], x[i][3]}; *(f32x4*)(X + (size_t)tok * D + 512 * i + 8 * lane + 4) = (f32x4){x[i][4], x[i][5], x[i][6], x[i][7]}; }
            }
            if (MODE == 3) {
#pragma unroll
                for (int i = 0; i < 2; ++i) { *(f32x4*)(p.out + (size_t)tok * D + 512 * i + 8 * lane) = (f32x4){h[i][0], h[i][1], h[i][2], h[i][3]}; *(f32x4*)(p.out + (size_t)tok * D + 512 * i + 8 * lane + 4) = (f32x4){h[i][4], h[i][5], h[i][6], h[i][7]}; }
            } else {
#pragma unroll
                for (int i = 0; i < 2; ++i) { u32x4 w; w.x = pk2(h[i][0], h[i][1]); w.y = pk2(h[i][2], h[i][3]); w.z = pk2(h[i][4], h[i][5]); w.w = pk2(h[i][6], h[i][7]); *(u32x4*)(HBF + (size_t)tok * D + 512 * i + 8 * lane) = w; }
            }
            if (MODE == 1) {
                f32x4 o[4]; o[3] = (f32x4){0.f, 0.f, 0.f, 0.f};
                if ((l & 1) == 0) { f32x4 o3[3]; small_proj<3>(tab, h, lane, o3); o[0] = o3[0]; o[1] = o3[1]; o[2] = o3[2]; }
                else small_proj<4>(tab, h, lane, o);
                const float v = reduce16(o, lane);
                if ((lane & 3) == 0) SP[(size_t)tok * 16 + (lane >> 2)] = v;
            }
            if (MODE == 2) {
                f32x4 oc = (f32x4){0.f, 0.f, 0.f, 0.f};
#pragma unroll
                for (int i = 0; i < 2; ++i) { f32x4 t[8];
#pragma unroll
                  for (int jj = 0; jj < 8; ++jj) t[jj] = tab[(i * 8 + jj) * 64 + lane];
                  asm volatile("" ::: "memory");
#pragma unroll
                  for (int jj = 0; jj < 8; ++jj) oc += t[jj] * h[i][jj]; }
                const float vc = reduce4(oc, lane);
                float lc[4];
#pragma unroll
                for (int c = 0; c < 4; ++c) lc[c] = rdl(vc, 16 * c) + biasc[c];
                int g = 0; float mx = lc[0];
#pragma unroll
                for (int c = 1; c < 4; ++c) if (lc[c] > mx) { mx = lc[c]; g = c; }
                g = __builtin_amdgcn_readfirstlane(g);
                float se = 0.f;
#pragma unroll
                for (int c = 0; c < 4; ++c) se += expf(lc[c] - mx);
                const float pg = 1.0f / se;
                f32x4 of = (f32x4){0.f, 0.f, 0.f, 0.f};
                const LAS f32x4* tabf = tab + (1 + g) * 1024;
#pragma unroll
                for (int i = 0; i < 2; ++i) { f32x4 t[8];
#pragma unroll
                  for (int jj = 0; jj < 8; ++jj) t[jj] = tabf[(i * 8 + jj) * 64 + lane];
                  asm volatile("" ::: "memory");
#pragma unroll
                  for (int jj = 0; jj < 8; ++jj) of += t[jj] * h[i][jj]; }
                const float vf = reduce4(of, lane);
                float lf[4];
#pragma unroll
                for (int e = 0; e < 4; ++e) lf[e] = rdl(vf, 16 * e) + biasf[g * 4 + e];
                int i1 = 0; float v1 = lf[0];
#pragma unroll
                for (int e = 1; e < 4; ++e) if (lf[e] > v1) { v1 = lf[e]; i1 = e; }
                int i2 = -1; float v2 = -3.0e38f;
#pragma unroll
                for (int e = 0; e < 4; ++e) if (e != i1 && lf[e] > v2) { v2 = lf[e]; i2 = e; }
                const float ex = expf(v2 - v1); const float p1 = 1.0f / (1.0f + ex), p2 = ex / (1.0f + ex);
                const int e1 = g * 4 + i1, e2 = g * 4 + i2;
                if (lane == 0) { RTE[tok] = e1 | (e2 << 8); RTW[2 * tok] = pg * p1; RTW[2 * tok + 1] = pg * p2; }
                cnt += (lane == e1 ? 1 : 0) + (lane == e2 ? 1 : 0);
            }
        }
#undef TOK_ISSUE
        if (MODE == 2) {
            __syncthreads();
            if (lane < 16) cnts[wave * 16 + lane] = cnt;
            __syncthreads();
            if (tid < 16) { int s = 0;
#pragma unroll
                for (int w = 0; w < 8; ++w) s += cnts[w * 16 + tid];
                TC[grp * 16 + tid] = s; }
        }
    }
}
__device__ __forceinline__ void phase_norm1(const Params& p, LAS unsigned char* lds, int l) { phase_tokens<1>(p, lds, l); }
__device__ __forceinline__ void phase_norm2(const Params& p, LAS unsigned char* lds, int l) { phase_tokens<2>(p, lds, l); }

__device__ __forceinline__ void phase_dispatch(const Params& p, LAS unsigned char* lds, LAS int* tbase) {
    const int tid = ltid(), lane = tid & 63, wave = tid >> 6, G = GDIM;
    LAS int* tc = (LAS int*)lds;
    LAS int* part = (LAS int*)(lds + 16384);
    LAS int* tot = (LAS int*)(lds + 16384 + 4096);
    LAS int* toff = (LAS int*)(lds + 16384 + 4096 + 128);
    LAS int* wcnt = (LAS int*)(lds + 16384 + 4096 + 256);
    const int* TC = (const int*)(p.ws + WS_TC); const int* RTE = (const int*)(p.ws + WS_RTE);
    int* POS = (int*)(p.ws + WS_POS);
    int* ROWTOK = (int*)(p.ws + WS_ROWTOK);
    for (int i = tid; i < 256 * 16; i += NTHR) tc[i] = TC[i];
    __syncthreads();
    { const int e = tid & 15, c8 = tid >> 4; int sa = 0;
#pragma unroll
      for (int q = 0; q < 8; ++q) sa += tc[(c8 * 8 + q) * 16 + e];
      part[c8 * 16 + e] = sa; }
    __syncthreads();
    if (tid < 16) { int sa = 0;
#pragma unroll
        for (int c8 = 0; c8 < 32; ++c8) sa += part[c8 * 16 + tid];
        tot[tid] = sa; }
    __syncthreads();
    if (tid == 0) { int rb = 0; for (int e = 0; e < 16; ++e) { tot[16 + e] = rb; tbase[e] = rb >> 8; rb += (tot[e] + 255) & ~255; } tbase[16] = rb >> 8; }
    __syncthreads();
    for (int grp = BID; grp < NTOK / 128; grp += G) {
        { const int e = tid & 15, c8 = tid >> 4; int sb = 0;
#pragma unroll
          for (int q = 0; q < 8; ++q) { const int gq = c8 * 8 + q; sb += (gq < grp) ? tc[gq * 16 + e] : 0; }
          part[512 + c8 * 16 + e] = sb; }
        int e_me = 0, rank_l = 0;
        if (tid < 256) { const int ee = RTE[grp * 128 + (tid >> 1)]; e_me = (tid & 1) ? ((ee >> 8) & 255) : (ee & 255); }
        if (wave < 4) {
            const unsigned long long lt = (lane == 0) ? 0ull : (~0ull >> (64 - lane));
#pragma unroll
            for (int e = 0; e < 16; ++e) { const unsigned long long m = __ballot(e_me == e); if (e_me == e) rank_l = __popcll(m & lt); if (lane == 0) wcnt[wave * 16 + e] = __popcll(m); }
        }
        __syncthreads();
        if (tid < 16) { int sb = 0;
#pragma unroll
            for (int c8 = 0; c8 < 32; ++c8) sb += part[512 + c8 * 16 + tid];
            toff[tid] = sb; }
        __syncthreads();
        if (tid < 256) { int rank = rank_l;
#pragma unroll
            for (int w = 0; w < 3; ++w) rank += (w < wave) ? wcnt[w * 16 + e_me] : 0;
            const int pos = tot[16 + e_me] + toff[e_me] + rank; POS[(size_t)(grp * 128) * 2 + tid] = pos; ROWTOK[pos] = grp * 128 + (tid >> 1); }
        __syncthreads();
    }
    for (int e = 0; e < 16; ++e) { const int lo_ = tot[16 + e] + tot[e], hi_ = tot[16 + e] + ((tot[e] + 255) & ~255); for (int r = lo_ + tid; r < hi_; r += NTHR) ROWTOK[r] = 0; }
}

__device__ __forceinline__ void phase_final(const Params& p, LAS unsigned char* lds) { phase_tokens<3>(p, lds, 3); }
#ifndef PROF
#define PROF 0
#endif
constexpr int LP_TACC = 32;
#define TSEC_BEGIN(k) unsigned long long _ts##k = 0; if (PROF == (k) && ltid() == 0) _ts##k = wall_clock64();
#define TSEC_END(k) if (PROF == (k) && ltid() == 0) { *(LAS unsigned long long*)(lds + LDS_PERS + LP_TACC) += wall_clock64() - _ts##k; }
__device__ __forceinline__ f32x4 mfma16(bf16x8 a, bf16x8 b, f32x4 c) { return __builtin_amdgcn_mfma_f32_16x16x32_bf16(a, b, c, 0, 0, 0); }
__device__ __forceinline__ bf16x8 ldfrag(const LAS unsigned char* base, int row, int stride_bytes, int kk, int g) { return *(const LAS bf16x8*)(base + row * stride_bytes + (kk * 32 + g * 8) * 2); }
__device__ __forceinline__ float scan_add(float v, int lane) {
#pragma unroll
    for (int o = 1; o < 64; o <<= 1) { const float t = __shfl_up(v, o); if (lane >= o) v += t; }
    return v;
}
__device__ __forceinline__ float scan_max(float v, int lane) {
#pragma unroll
    for (int o = 1; o < 64; o <<= 1) { const float t = __shfl_up(v, o); if (lane >= o) v = fmaxf(v, t); }
    return v;
}
__device__ __forceinline__ float bfe(const u32x4& v, int e) { const unsigned w = v[e >> 1]; return __uint_as_float((e & 1) ? (w & 0xffff0000u) : (w << 16)); }
__device__ __forceinline__ bf16_t bfr(const u32x4& v, int e) { const unsigned w = v[e >> 1]; return (bf16_t)((e & 1) ? (w >> 16) : (w & 0xffffu)); }

constexpr int RS = 144;

__device__ __forceinline__ void unit_mlstm_L(const Params& p, LAS unsigned char* lds, int j, int b, int h, int ck) {
    const int tid = ltid(), lane = tid & 63, wave = __builtin_amdgcn_readfirstlane(tid >> 6), fr = lane & 15, g = lane >> 4;
    LAS unsigned char* KWT = lds; LAS unsigned char* VT = lds + 9216; LAS float* GA = (LAS float*)(lds + 29952);
    const bf16_t* P = (const bf16_t*)(p.ws + WS_P); const float* SP = (const float*)(p.ws + WS_SP);
    float* CL = (float*)(p.ws + WS_CL); float* SCAL = (float*)(p.ws + WS_SCAL);
    const int unit = (b * 4 + h) * 64 + ck; const int tok0 = b * SEQ + ck * 64;
    const int t = tid >> 3, seg = tid & 7, kc0 = 256 + h * 64 + seg * 8, pos = ck * 64 + t;
    TSEC_BEGIN(31) TSEC_BEGIN(32)
    u32x4 kin[4], vin[2];
#pragma unroll
    for (int q = 0; q < 4; ++q) { const int pp = pos - 3 + q; kin[q] = (pp >= 0) ? *(const u32x4*)(P + (size_t)(b * SEQ + pp) * NP_AB + kc0) : (u32x4){0u, 0u, 0u, 0u}; }
#pragma unroll
    for (int i = 0; i < 2; ++i) { const int idx = tid + 512 * i; vin[i] = *(const u32x4*)(P + (size_t)(tok0 + (idx >> 4)) * NP_AB + AB_VA + h * 128 + (idx & 15) * 8); }
    float we;
    {
        const int tok = tok0 + lane;
        const float li = SP[(size_t)tok * 16 + h] + p.in[I_ABGATEB][j * 8 + h]; const float lf = logsigmoidf_(SP[(size_t)tok * 16 + 4 + h] + p.in[I_ABGATEB][j * 8 + 4 + h]);
        const float bc = scan_add(lf, lane); const float a = li - bc; const float amax = __shfl(scan_max(a, lane), 63);
        we = __shfl(__expf(a - amax), t & 63);
        if (wave == 0 && lane == 63) { SCAL[unit * 2] = bc; SCAL[unit * 2 + 1] = amax; }
    }
    for (int i = tid; i < 16 * 72; i += NTHR) { const int r = i / 72; ((LAS bf16_t*)VT)[(128 + r) * 72 + (i % 72)] = (r == 0) ? (bf16_t)0x3F80 : (bf16_t)0; }
    { const float* convw = p.in[I_ABCONVW] + (size_t)j * 4 * 512 + kc0; const float* convb = p.in[I_ABCONVB] + j * 512 + kc0;
#pragma unroll
      for (int e = 0; e < 8; ++e) { float acc = convb[e];
#pragma unroll
        for (int q = 0; q < 4; ++q) acc += convw[q * 512 + e] * bfe(kin[q], e);
        const float v = acc / (1.0f + __expf(-acc)); ((LAS bf16_t*)KWT)[(seg * 8 + e) * 72 + t] = f2bf(v * we); } }
#pragma unroll
    for (int i = 0; i < 2; ++i) { const int idx = tid + 512 * i; const int s = idx >> 4, sg = idx & 15;
#pragma unroll
        for (int e = 0; e < 8; ++e) ((LAS bf16_t*)VT)[(sg * 8 + e) * 72 + s] = bfr(vin[i], e); }
    __syncthreads();
    TSEC_END(32) TSEC_BEGIN(33)
#pragma unroll
    for (int i = 0; i < 5; ++i) { const int id = wave + 8 * i;
        if (id < 36) { const int tk = id / 9, tv = id % 9; f32x4 acc = (f32x4){0.f, 0.f, 0.f, 0.f};
#pragma unroll
            for (int kk = 0; kk < 2; ++kk) acc = mfma16(ldfrag(KWT, tk * 16 + fr, RS, kk, g), ldfrag(VT, tv * 16 + fr, RS, kk, g), acc);
#pragma unroll
            for (int r = 0; r < 4; ++r) CL[(size_t)unit * 9216 + (tk * 16 + 4 * g + r) * 144 + tv * 16 + fr] = acc[r]; } }
    __syncthreads();
    TSEC_END(33) TSEC_END(31)
}

__device__ __forceinline__ void phase_scan_mlstm(const Params& p) {
    const float* CL = (const float*)(p.ws + WS_CL); const float* SCAL = (const float*)(p.ws + WS_SCAL); float* MC = (float*)(p.ws + WS_MC); bf16_t* CTG = (bf16_t*)(p.ws + WS_CTG);
    for (int e = BID * NTHR + TID; e < 32 * 9216; e += GDIM * NTHR) {
        const int bh = e / 9216, r = e % 9216;
        float C = 0.f, m = -1e30f;
#pragma unroll 1
        for (int c0 = 0; c0 < 64; c0 += 8) { float v[8], sb[8], sa[8];
#pragma unroll
            for (int i = 0; i < 8; ++i) { v[i] = CL[(size_t)(bh * 64 + c0 + i) * 9216 + r]; sb[i] = SCAL[(bh * 64 + c0 + i) * 2]; sa[i] = SCAL[(bh * 64 + c0 + i) * 2 + 1]; }
#pragma unroll
            for (int i = 0; i < 8; ++i) { const int unit = bh * 64 + c0 + i; const float bL = sb[i], amax = sa[i];
                CTG[(size_t)unit * 9216 + r] = f2bf(C); if (r == 0) MC[unit] = m;
                const float M = fmaxf(m, amax); C = __expf(m - M) * C + __expf(amax - M) * v[i]; m = bL + M; } }
    }
}

struct MlstmOIn { u32x4 qkin[2][4], vin[2], cin[3], oin[2]; float sp_i, sp_f, mc; };
__device__ __forceinline__ void mlstm_O_issue(const Params& p, int b, int h, int ck, MlstmOIn& r) {
    const int tid = ltid(), lane = tid & 63;
    const bf16_t* P = (const bf16_t*)(p.ws + WS_P); const float* SP = (const float*)(p.ws + WS_SP);
    const bf16_t* CTG = (const bf16_t*)(p.ws + WS_CTG); const float* MC = (const float*)(p.ws + WS_MC);
    const int unit = (b * 4 + h) * 64 + ck; const int tok0 = b * SEQ + ck * 64;
    const int sg = tid & 15; const int ch0 = (sg < 8) ? h * 64 + sg * 8 : 256 + h * 64 + (sg - 8) * 8;
#pragma unroll
    for (int i = 0; i < 2; ++i) { const int tt = (tid + 512 * i) >> 4; const int pos = ck * 64 + tt;
#pragma unroll
        for (int q = 0; q < 4; ++q) { const int pp = pos - 3 + q; r.qkin[i][q] = (pp >= 0) ? *(const u32x4*)(P + (size_t)(b * SEQ + pp) * NP_AB + ch0) : (u32x4){0u, 0u, 0u, 0u}; }
        r.vin[i] = *(const u32x4*)(P + (size_t)(tok0 + tt) * NP_AB + AB_VA + h * 128 + sg * 8);
        r.oin[i] = *(const u32x4*)(P + (size_t)(tok0 + tt) * NP_AB + AB_OA + h * 128 + sg * 8); }
#pragma unroll
    for (int i = 0; i < 3; ++i) { const int idx = tid + 512 * i; r.cin[i] = (idx < 1152) ? *(const u32x4*)(CTG + (size_t)unit * 9216 + idx * 8) : (u32x4){0u, 0u, 0u, 0u}; }
    r.sp_i = SP[(size_t)(tok0 + lane) * 16 + h]; r.sp_f = SP[(size_t)(tok0 + lane) * 16 + 4 + h]; r.mc = MC[unit];
}
__device__ __forceinline__ void mlstm_O_compute(const Params& p, LAS unsigned char* lds, int j, int b, int h, int ck, const MlstmOIn& rg) {
    const int tid = ltid(), lane = tid & 63, wave = __builtin_amdgcn_readfirstlane(tid >> 6), fr = lane & 15, g = lane >> 4;
    LAS unsigned char* QS = lds; LAS unsigned char* KS = lds + 9216; LAS unsigned char* VT = lds + 18432; LAS unsigned char* CT = lds + 39168; LAS unsigned char* PS = lds + 59904;
    LAS float* OS = (LAS float*)(lds + 69120); LAS float* GA = (LAS float*)(lds + 107008);
    constexpr int OSS = 148;
    bf16_t* YMIX = (bf16_t*)(p.ws + WS_YMIX);
    const int tok0 = b * SEQ + ck * 64;
    const int sg = tid & 15;
    const int ch0 = (sg < 8) ? h * 64 + sg * 8 : 256 + h * 64 + (sg - 8) * 8;
    const u32x4 (&qkin)[2][4] = rg.qkin; const u32x4 (&vin)[2] = rg.vin; const u32x4 (&cin)[3] = rg.cin; const u32x4 (&oin)[2] = rg.oin;
    {
        const float mc = rg.mc;
        const float li = rg.sp_i + p.in[I_ABGATEB][j * 8 + h]; const float lf = logsigmoidf_(rg.sp_f + p.in[I_ABGATEB][j * 8 + 4 + h]);
        const float bc = scan_add(lf, lane); const float a = li - bc; const float M = fmaxf(mc, scan_max(a, lane));
        GA[lane] = a; GA[64 + lane] = M; GA[128 + lane] = __expf(mc - M); GA[192 + lane] = __expf(-(bc + M));
    }
    for (int i = tid; i < 16 * 72; i += NTHR) { const int r = i / 72; ((LAS bf16_t*)VT)[(128 + r) * 72 + (i % 72)] = (r == 0) ? (bf16_t)0x3F80 : (bf16_t)0; }
    { const float* convw = p.in[I_ABCONVW] + (size_t)j * 4 * 512 + ch0; const float* convb = p.in[I_ABCONVB] + j * 512 + ch0;
      float cw[4][8], cb[8];
#pragma unroll
      for (int e = 0; e < 8; ++e) { cb[e] = convb[e];
#pragma unroll
        for (int q = 0; q < 4; ++q) cw[q][e] = convw[q * 512 + e]; }
      const float qs = (sg < 8) ? 0.125f : 1.0f;
#pragma unroll
      for (int i = 0; i < 2; ++i) { const int tt = (tid + 512 * i) >> 4; float o[8];
#pragma unroll
        for (int e = 0; e < 8; ++e) { float acc = cb[e];
#pragma unroll
            for (int q = 0; q < 4; ++q) acc += cw[q][e] * bfe(qkin[i][q], e);
            o[e] = acc / (1.0f + __expf(-acc)) * qs; }
        u32x4 w; w.x = pk2(o[0], o[1]); w.y = pk2(o[2], o[3]); w.z = pk2(o[4], o[5]); w.w = pk2(o[6], o[7]);
        *(LAS u32x4*)(((sg < 8) ? QS : KS) + tt * RS + (sg & 7) * 16) = w;
#pragma unroll
        for (int e = 0; e < 8; ++e) ((LAS bf16_t*)VT)[(sg * 8 + e) * 72 + tt] = bfr(vin[i], e); } }
#pragma unroll
    for (int i = 0; i < 3; ++i) { const int idx = tid + 512 * i;
        if (idx < 1152) { const int dk = idx / 18, sv = idx % 18;
#pragma unroll
            for (int e = 0; e < 8; ++e) ((LAS bf16_t*)CT)[(sv * 8 + e) * 72 + dk] = bfr(cin[i], e); } }
    __syncthreads();
    { const int tq = wave >> 1;
#pragma unroll
      for (int u = 0; u < 2; ++u) { const int ts = (wave & 1) * 2 + u; f32x4 acc = (f32x4){0.f, 0.f, 0.f, 0.f};
        if (ts <= tq) {
#pragma unroll
            for (int kk = 0; kk < 2; ++kk) acc = mfma16(ldfrag(QS, tq * 16 + fr, RS, kk, g), ldfrag(KS, ts * 16 + fr, RS, kk, g), acc);
        }
        const int s = ts * 16 + fr; const float as = GA[s];
#pragma unroll
        for (int r = 0; r < 4; ++r) { const int t = tq * 16 + 4 * g + r; const float pv = (ts <= tq && s <= t) ? acc[r] * __expf(as - GA[64 + t]) : 0.f; ((LAS bf16_t*)PS)[t * 72 + s] = f2bf(pv); } } }
    __syncthreads();
#pragma unroll
    for (int i = 0; i < 5; ++i) { const int id = wave + 8 * i;
        if (id < 36) { const int tq = id / 9, tv = id % 9; f32x4 acc = (f32x4){0.f, 0.f, 0.f, 0.f};
#pragma unroll
            for (int kk = 0; kk < 2; ++kk) acc = mfma16(ldfrag(QS, tq * 16 + fr, RS, kk, g), ldfrag(CT, tv * 16 + fr, RS, kk, g), acc);
#pragma unroll
            for (int r = 0; r < 4; ++r) acc[r] *= GA[128 + tq * 16 + 4 * g + r];
#pragma unroll
            for (int kk = 0; kk < 2; ++kk) acc = mfma16(ldfrag(PS, tq * 16 + fr, RS, kk, g), ldfrag(VT, tv * 16 + fr, RS, kk, g), acc);
#pragma unroll
            for (int r = 0; r < 4; ++r) OS[(tq * 16 + 4 * g + r) * OSS + tv * 16 + fr] = acc[r]; } }
    __syncthreads();
    { const float* hgp = p.in[I_ABHNORM] + j * 512 + h * 128 + sg * 8;
#pragma unroll
      for (int i = 0; i < 2; ++i) { const int tt = (tid + 512 * i) >> 4;
        const float den = OS[tt * OSS + 128]; const float dn = fmaxf(fabsf(den), GA[192 + tt]); const float idn = 1.0f / dn;
        const f32x4 a0 = *(const LAS f32x4*)(OS + tt * OSS + sg * 8), a1 = *(const LAS f32x4*)(OS + tt * OSS + sg * 8 + 4);
        float hv[8] = {a0[0] * idn, a0[1] * idn, a0[2] * idn, a0[3] * idn, a1[0] * idn, a1[1] * idn, a1[2] * idn, a1[3] * idn};
        float ss = 0.f;
#pragma unroll
        for (int e = 0; e < 8; ++e) ss += hv[e] * hv[e];
        ss += __shfl_xor(ss, 1); ss += __shfl_xor(ss, 2); ss += __shfl_xor(ss, 4); ss += __shfl_xor(ss, 8);
        const float rn = 1.0f / sqrtf(ss * (1.0f / 128.0f) + 1e-6f);
        float y[8];
#pragma unroll
        for (int e = 0; e < 8; ++e) y[e] = hv[e] * rn * hgp[e] * sigmoidf_(bfe(oin[i], e));
        u32x4 w; w.x = pk2(y[0], y[1]); w.y = pk2(y[2], y[3]); w.z = pk2(y[4], y[5]); w.w = pk2(y[6], y[7]);
        *(u32x4*)(YMIX + (size_t)(tok0 + tt) * D + h * 128 + sg * 8) = w; } }
    __syncthreads();
}

__device__ __forceinline__ void unit_mlstm_O(const Params& p, LAS unsigned char* lds, int j, int b, int h, int ck) { MlstmOIn r; mlstm_O_issue(p, b, h, ck, r); mlstm_O_compute(p, lds, j, b, h, ck, r); }

__device__ __forceinline__ float rdlf(float v, int l) { return __int_as_float(__builtin_amdgcn_readlane(__float_as_int(v), l)); }
__device__ __forceinline__ void gla_cumsum(const Params& p, int j, int h, int tok0, int lane, int wave, LAS float* BS, LAS float* BL, float* scal_unit) {
    const float* SP = (const float*)(p.ws + WS_SP);
    f32x4 gq[4];
#pragma unroll
    for (int r = 0; r < 4; ++r) gq[r] = *(const f32x4*)(SP + (size_t)(tok0 + lane) * 16 + 4 * r);
    const float* wa = p.in[I_CDWALPHA] + (size_t)j * 16 * 256 + h * 64 + wave * 8; const float* ba = p.in[I_CDBALPHA] + j * 256 + h * 64 + wave * 8;
    const float wv0 = wa[(lane >> 3) * 256 + (lane & 7)], wv1 = wa[(8 + (lane >> 3)) * 256 + (lane & 7)], bv = ba[lane & 7];
#pragma unroll
    for (int i = 0; i < 8; ++i) { float z = rdlf(bv, i);
#pragma unroll
        for (int r = 0; r < 16; ++r) z += gq[r >> 2][r & 3] * rdlf(r < 8 ? wv0 : wv1, (r & 7) * 8 + i);
        const float la = logsigmoidf_(z) * (1.0f / 16.0f); const float bc = scan_add(la, lane);
        BS[lane * 65 + wave * 8 + i] = bc;
        if (lane == 63) { BL[wave * 8 + i] = bc; if (scal_unit) scal_unit[wave * 8 + i] = __expf(bc); } }
}
__device__ __forceinline__ void unit_gla_L(const Params& p, LAS unsigned char* lds, int j, int b, int h, int ck) {
    const int tid = ltid(), lane = tid & 63, wave = __builtin_amdgcn_readfirstlane(tid >> 6), fr = lane & 15, g = lane >> 4;
    LAS unsigned char* KWT = lds; LAS unsigned char* VT = lds + 9216; LAS float* BS = (LAS float*)(lds + 27648); LAS float* BL = (LAS float*)(lds + 44288);
    const bf16_t* P = (const bf16_t*)(p.ws + WS_P); float* CL = (float*)(p.ws + WS_CL); float* SCAL = (float*)(p.ws + WS_SCAL);
    const int unit = (b * 4 + h) * 64 + ck; const int tok0 = b * SEQ + ck * 64;
    const int t = tid >> 3, seg = tid & 7;
    const u32x4 kin = *(const u32x4*)(P + (size_t)(tok0 + t) * NP_CD + CD_KC + h * 64 + seg * 8);
    u32x4 vin[2];
#pragma unroll
    for (int i = 0; i < 2; ++i) { const int idx = tid + 512 * i; vin[i] = *(const u32x4*)(P + (size_t)(tok0 + (idx >> 4)) * NP_CD + CD_VC + h * 128 + (idx & 15) * 8); }
    gla_cumsum(p, j, h, tok0, lane, wave, BS, BL, SCAL + (size_t)unit * 64);
    __syncthreads();
#pragma unroll
    for (int e = 0; e < 8; ++e) { const int kk = seg * 8 + e; ((LAS bf16_t*)KWT)[kk * 72 + t] = f2bf(bfe(kin, e) * __expf(BL[kk] - BS[t * 65 + kk])); }
#pragma unroll
    for (int i = 0; i < 2; ++i) { const int idx = tid + 512 * i; const int s = idx >> 4, sg = idx & 15;
#pragma unroll
        for (int e = 0; e < 8; ++e) ((LAS bf16_t*)VT)[(sg * 8 + e) * 72 + s] = bfr(vin[i], e); }
    __syncthreads();
#pragma unroll
    for (int i = 0; i < 4; ++i) { const int id = wave + 8 * i; const int tk = id >> 3, tv = id & 7; f32x4 acc = (f32x4){0.f, 0.f, 0.f, 0.f};
#pragma unroll
        for (int kk = 0; kk < 2; ++kk) acc = mfma16(ldfrag(KWT, tk * 16 + fr, RS, kk, g), ldfrag(VT, tv * 16 + fr, RS, kk, g), acc);
#pragma unroll
        for (int r = 0; r < 4; ++r) CL[(size_t)unit * 8192 + (tk * 16 + 4 * g + r) * 128 + tv * 16 + fr] = acc[r]; }
    __syncthreads();
}
__device__ __forceinline__ void phase_scan_gla(const Params& p) {
    const float* CL = (const float*)(p.ws + WS_CL); const float* SCAL = (const float*)(p.ws + WS_SCAL); bf16_t* STG = (bf16_t*)(p.ws + WS_STG);
    for (int e = BID * NTHR + TID; e < 32 * 8192; e += GDIM * NTHR) {
        const int bh = e >> 13, r = e & 8191, dk = r >> 7;
        float S = 0.f;
#pragma unroll 1
        for (int c0 = 0; c0 < 64; c0 += 8) { float v[8], dc[8];
#pragma unroll
            for (int i = 0; i < 8; ++i) { v[i] = CL[(size_t)(bh * 64 + c0 + i) * 8192 + r]; dc[i] = SCAL[(size_t)(bh * 64 + c0 + i) * 64 + dk]; }
#pragma unroll
            for (int i = 0; i < 8; ++i) { STG[(size_t)(bh * 64 + c0 + i) * 8192 + r] = f2bf(S); S = dc[i] * S + v[i]; } }
    }
}
__device__ __forceinline__ void unit_gla_O(const Params& p, LAS unsigned char* lds, int j, int b, int h, int ck) {
    const int tid = ltid(), lane = tid & 63, wave = __builtin_amdgcn_readfirstlane(tid >> 6), fr = lane & 15, g = lane >> 4;
    LAS unsigned char* QS = lds; LAS unsigned char* KS = lds + 9216; LAS unsigned char* VT = lds + 18432; LAS unsigned char* ST = lds + 36864; LAS unsigned char* PS = lds + 55296;
    LAS float* OS = (LAS float*)(lds + 64512); LAS float* BS = (LAS float*)(lds + 98304); LAS float* BL = (LAS float*)(lds + 114944);
    constexpr int OSS = 132;
    const bf16_t* P = (const bf16_t*)(p.ws + WS_P); bf16_t* YMIX = (bf16_t*)(p.ws + WS_YMIX); const bf16_t* STG = (const bf16_t*)(p.ws + WS_STG);
    const int unit = (b * 4 + h) * 64 + ck; const int tok0 = b * SEQ + ck * 64;
    const int sg = tid & 15; const int ch0 = (sg < 8) ? CD_QC + h * 64 + sg * 8 : CD_KC + h * 64 + (sg - 8) * 8;
    u32x4 qkin[2], vin[2], sin_[2], rin[2];
#pragma unroll
    for (int i = 0; i < 2; ++i) { const int idx = tid + 512 * i; const int tt = idx >> 4;
        qkin[i] = *(const u32x4*)(P + (size_t)(tok0 + tt) * NP_CD + ch0);
        vin[i] = *(const u32x4*)(P + (size_t)(tok0 + tt) * NP_CD + CD_VC + h * 128 + sg * 8);
        rin[i] = *(const u32x4*)(P + (size_t)(tok0 + tt) * NP_CD + CD_RC + h * 128 + sg * 8);
        sin_[i] = *(const u32x4*)(STG + (size_t)unit * 8192 + idx * 8); }
    gla_cumsum(p, j, h, tok0, lane, wave, BS, BL, nullptr);
    __syncthreads();
#pragma unroll
    for (int i = 0; i < 2; ++i) { const int idx = tid + 512 * i; const int tt = idx >> 4; float o[8];
#pragma unroll
        for (int e = 0; e < 8; ++e) { const float bb = BS[tt * 65 + (sg & 7) * 8 + e]; o[e] = (sg < 8) ? bfe(qkin[i], e) * 0.125f * __expf(bb) : bfe(qkin[i], e) * __expf(-bb); }
        u32x4 w; w.x = pk2(o[0], o[1]); w.y = pk2(o[2], o[3]); w.z = pk2(o[4], o[5]); w.w = pk2(o[6], o[7]);
        *(LAS u32x4*)(((sg < 8) ? QS : KS) + tt * RS + (sg & 7) * 16) = w;
#pragma unroll
        for (int e = 0; e < 8; ++e) { ((LAS bf16_t*)VT)[(sg * 8 + e) * 72 + tt] = bfr(vin[i], e); ((LAS bf16_t*)ST)[(sg * 8 + e) * 72 + tt] = bfr(sin_[i], e); } }
    __syncthreads();
    { const int tq = wave >> 1;
#pragma unroll
      for (int u = 0; u < 2; ++u) { const int ts = (wave & 1) * 2 + u; f32x4 acc = (f32x4){0.f, 0.f, 0.f, 0.f};
        if (ts <= tq) {
#pragma unroll
            for (int kk = 0; kk < 2; ++kk) acc = mfma16(ldfrag(QS, tq * 16 + fr, RS, kk, g), ldfrag(KS, ts * 16 + fr, RS, kk, g), acc);
        }
        const int s = ts * 16 + fr;
#pragma unroll
        for (int r = 0; r < 4; ++r) { const int t = tq * 16 + 4 * g + r; const float pv = (ts <= tq && s <= t) ? acc[r] : 0.f; ((LAS bf16_t*)PS)[t * 72 + s] = f2bf(pv); } } }
    __syncthreads();
#pragma unroll
    for (int i = 0; i < 4; ++i) { const int id = wave + 8 * i; const int tq = id >> 3, tv = id & 7; f32x4 acc = (f32x4){0.f, 0.f, 0.f, 0.f};
#pragma unroll
        for (int kk = 0; kk < 2; ++kk) acc = mfma16(ldfrag(QS, tq * 16 + fr, RS, kk, g), ldfrag(ST, tv * 16 + fr, RS, kk, g), acc);
#pragma unroll
        for (int kk = 0; kk < 2; ++kk) acc = mfma16(ldfrag(PS, tq * 16 + fr, RS, kk, g), ldfrag(VT, tv * 16 + fr, RS, kk, g), acc);
#pragma unroll
        for (int r = 0; r < 4; ++r) OS[(tq * 16 + 4 * g + r) * OSS + tv * 16 + fr] = acc[r]; }
    __syncthreads();
    { const float* hgp = p.in[I_CDHNORM] + j * 512 + h * 128 + sg * 8;
#pragma unroll
      for (int i = 0; i < 2; ++i) { const int tt = (tid + 512 * i) >> 4;
        const f32x4 a0 = *(const LAS f32x4*)(OS + tt * OSS + sg * 8), a1 = *(const LAS f32x4*)(OS + tt * OSS + sg * 8 + 4);
        float hv[8] = {a0[0], a0[1], a0[2], a0[3], a1[0], a1[1], a1[2], a1[3]};
        float ss = 0.f;
#pragma unroll
        for (int e = 0; e < 8; ++e) ss += hv[e] * hv[e];
        ss += __shfl_xor(ss, 1); ss += __shfl_xor(ss, 2); ss += __shfl_xor(ss, 4); ss += __shfl_xor(ss, 8);
        const float rn = 1.0f / sqrtf(ss * (1.0f / 128.0f) + 1e-6f);
        float y[8];
#pragma unroll
        for (int e = 0; e < 8; ++e) y[e] = hv[e] * rn * hgp[e] * siluf_(bfe(rin[i], e));
        u32x4 w; w.x = pk2(y[0], y[1]); w.y = pk2(y[2], y[3]); w.z = pk2(y[4], y[5]); w.w = pk2(y[6], y[7]);
        *(u32x4*)(YMIX + (size_t)(tok0 + tt) * D + h * 128 + sg * 8) = w; } }
    __syncthreads();
}
constexpr int L_BKT8 = 134144, L_RELB = 138240;
__device__ __forceinline__ void load_attn_tables(const Params& p, LAS unsigned char* lds) {
    const int* bkt = (const int*)(p.ws + WS_BKT);
    for (int i = TID; i < 4096; i += NTHR) lds[L_BKT8 + i] = (unsigned char)bkt[i];
    if (TID < 256) ((LAS float*)(lds + L_RELB))[TID] = p.in[I_RELB][TID];
}
__device__ __forceinline__ int scan_add_i(int v, int lane) {
#pragma unroll
    for (int o = 1; o < 64; o <<= 1) { const int t = __shfl_up(v, o); if (lane >= o) v += t; }
    return v;
}
__device__ __forceinline__ unsigned keep_lowest(unsigned m, int n) {
    if (n <= 0) return 0u;
    while ((int)__popc(m) > n) m &= ~(1u << (31 - __clz((int)m)));
    return m;
}
__device__ __forceinline__ bf16x4 tr_read(unsigned lds_addr) { bf16x4 r; asm volatile("ds_read_b64_tr_b16 %0, %1\n\ts_waitcnt lgkmcnt(0)" : "=&v"(r) : "v"(lds_addr) : "memory"); return r; }
__device__ __forceinline__ u32x4 ldg16(const void* ptr) { return *(const u32x4*)ptr; }
__device__ __forceinline__ void pf_wait4_unused(u32x4& a, u32x4& b, u32x4& c, u32x4& d) { asm volatile("s_waitcnt vmcnt(0)" : "+v"(a), "+v"(b), "+v"(c), "+v"(d) :: "memory"); }
__device__ __forceinline__ void pf_wait8_unused(u32x4 (&v)[8]) { asm volatile("s_waitcnt vmcnt(0)" : "+v"(v[0]), "+v"(v[1]), "+v"(v[2]), "+v"(v[3]), "+v"(v[4]), "+v"(v[5]), "+v"(v[6]), "+v"(v[7]) :: "memory"); }
__device__ __forceinline__ bf16x8 as_bf16x8(const u32x4& v) { return __builtin_bit_cast(bf16x8, v); }
template <int N> __device__ __forceinline__ void pin_batch(bf16x8 (&f)[N]) {
    if constexpr (N == 16) asm volatile("" : "+v"(f[0]), "+v"(f[1]), "+v"(f[2]), "+v"(f[3]), "+v"(f[4]), "+v"(f[5]), "+v"(f[6]), "+v"(f[7]), "+v"(f[8]), "+v"(f[9]), "+v"(f[10]), "+v"(f[11]), "+v"(f[12]), "+v"(f[13]), "+v"(f[14]), "+v"(f[15]));
    else { _Pragma("unroll") for (int i = 0; i < N; ++i) asm volatile("" : "+v"(f[i])); }
}
__device__ __forceinline__ void lds_add_u32(unsigned byte_addr, unsigned v) { asm volatile("ds_add_u32 %0, %1" :: "v"(byte_addr), "v"(v) : "memory"); }
__device__ __forceinline__ void lds_or_b32(unsigned byte_addr, unsigned v) { asm volatile("ds_or_b32 %0, %1" :: "v"(byte_addr), "v"(v) : "memory"); }
__device__ __forceinline__ unsigned sortable(float f) { const int u = __float_as_int(f); return (unsigned)u ^ ((unsigned)(u >> 31) | 0x80000000u); }

template <int PASS>
__device__ __forceinline__ void dsa_score_pass(const bf16_t* KIC, size_t rowb, int nkt, int wave, int fr, int g, int tq, const bf16x8 (&qf)[4][2], const float (&wq)[4],
                                               unsigned pfx, unsigned tau, unsigned hist_a, unsigned gtm_a, unsigned eqm_a) {
        const bf16_t* kbase = KIC + (rowb + fr) * 64 + g * 8;
        u32x4 c0, c1, c2, c3, n0, n1, n2, n3;
        { const int ka = wave < nkt ? wave : nkt - 1, kb = wave + 8 < nkt ? wave + 8 : nkt - 1;
          c0 = ldg16(kbase + (size_t)ka * 16 * 64); c1 = ldg16(kbase + (size_t)ka * 16 * 64 + 32); c2 = ldg16(kbase + (size_t)kb * 16 * 64); c3 = ldg16(kbase + (size_t)kb * 16 * 64 + 32); }
#pragma unroll 1
        for (int kt = wave; kt < nkt; kt += 16) {
            { const int ka = kt + 16 < nkt ? kt + 16 : nkt - 1, kb = kt + 24 < nkt ? kt + 24 : nkt - 1;
              n0 = ldg16(kbase + (size_t)ka * 16 * 64); n1 = ldg16(kbase + (size_t)ka * 16 * 64 + 32); n2 = ldg16(kbase + (size_t)kb * 16 * 64); n3 = ldg16(kbase + (size_t)kb * 16 * 64 + 32);
              asm volatile("" ::: "memory"); }
            f32x4 a[2][4];
#pragma unroll
            for (int half = 0; half < 2; ++half) { const bf16x8 k0 = as_bf16x8(half ? c2 : c0), k1 = as_bf16x8(half ? c3 : c1);
#pragma unroll
                for (int hh = 0; hh < 4; ++hh) { f32x4 z = (f32x4){0.f, 0.f, 0.f, 0.f}; z = mfma16(k0, qf[hh][0], z); a[half][hh] = mfma16(k1, qf[hh][1], z); } }
#pragma unroll
            for (int half = 0; half < 2; ++half) { const int kth = kt + 8 * half; const bool live = kth < nkt;
                f32x4 sc = (f32x4){0.f, 0.f, 0.f, 0.f};
#pragma unroll
                for (int hh = 0; hh < 4; ++hh)
#pragma unroll
                    for (int r = 0; r < 4; ++r) { const int ai = __float_as_int(a[half][hh][r]); sc[r] = fmaf(__int_as_float(ai > 0 ? ai : 0), wq[hh], sc[r]); }
                unsigned gtb = 0u, eqb = 0u;
#pragma unroll
                for (int r = 0; r < 4; ++r) { const int s = kth * 16 + 4 * g + r; const bool valid = live && s <= tq; const unsigned key = sortable(sc[r]);
                    if (PASS == 0) { const unsigned bin = key >> 21; lds_add_u32(hist_a + (bin >> 1) * 4u, valid ? (1u << ((bin & 1u) * 16u)) : 0u); }
                    else if (PASS == 1) { const unsigned bin = (key >> 10) & 2047u; lds_add_u32(hist_a + (bin >> 1) * 4u, (valid && (key >> 21) == pfx) ? (1u << ((bin & 1u) * 16u)) : 0u); }
                    else { gtb |= (valid && (key >> 10) > tau) ? (1u << r) : 0u; eqb |= (valid && (key >> 10) == tau) ? (1u << r) : 0u; } }
                if (PASS == 2) { const unsigned word = (unsigned)(kth >> 1), sh = (unsigned)((kth & 1) * 16 + 4 * g);
                    lds_or_b32(gtm_a + word * 4u, gtb << sh); lds_or_b32(eqm_a + word * 4u, eqb << sh); }
            }
            c0 = n0; c1 = n1; c2 = n2; c3 = n3;
        }
}

__device__ __forceinline__ void unit_dsa(const Params& p, LAS unsigned char* lds, int b, int ti) {
    const int tid = ltid(), lane = tid & 63, wave = __builtin_amdgcn_readfirstlane(tid >> 6), fr = lane & 15, g = lane >> 4;
    LAS unsigned* HIST = (LAS unsigned*)lds; LAS unsigned char* GBUF = lds;
    LAS unsigned* GTM = (LAS unsigned*)(lds + 69632); LAS unsigned* EQM = (LAS unsigned*)(lds + 69632 + 8256);
    LAS unsigned short* SEL = (LAS unsigned short*)(lds + 86272); LAS unsigned char* QAB = lds + 94464;
    LAS int* MISC = (LAS int*)(lds + 127232); LAS unsigned char* SELB = lds + 127488;
    const LAS unsigned char* BKT8 = lds + L_BKT8; const LAS float* RELB = (const LAS float*)(lds + L_RELB);
    const bf16_t* P = (const bf16_t*)(p.ws + WS_P); const float* SP = (const float*)(p.ws + WS_SP); bf16_t* YMIX = (bf16_t*)(p.ws + WS_YMIX);
    const bf16_t* WUK = (const bf16_t*)(p.ws + WS_WUK); const bf16_t* WUV = (const bf16_t*)(p.ws + WS_WUV);
    const bf16_t* KIC = (const bf16_t*)(p.ws + WS_KIC); const bf16_t* CKC = (const bf16_t*)(p.ws + WS_CKC);
    const int t0 = ti * 16; const size_t rowb = (size_t)b * SEQ;
    TSEC_BEGIN(6) TSEC_BEGIN(1)
    for (int i = tid; i < 4100; i += NTHR) ((LAS u32x4*)HIST)[i] = (u32x4){0u, 0u, 0u, 0u};
    { const int h = wave; f32x4 acc[8];
#pragma unroll
      for (int rt = 0; rt < 8; ++rt) acc[rt] = (f32x4){0.f, 0.f, 0.f, 0.f};
      bf16x8 bw[16], aq[2];
#pragma unroll
      for (int kk = 0; kk < 2; ++kk) { aq[kk] = *(const bf16x8*)(P + (rowb + t0 + fr) * NP_AB + AB_QB + h * 64 + kk * 32 + g * 8);
#pragma unroll
        for (int rt = 0; rt < 8; ++rt) bw[kk * 8 + rt] = *(const bf16x8*)(WUK + ((size_t)(rt * 16 + fr) * 8 + h) * 64 + kk * 32 + g * 8); }
      asm volatile("" ::: "memory");
#pragma unroll
      for (int kk = 0; kk < 2; ++kk)
#pragma unroll
        for (int rt = 0; rt < 8; ++rt) acc[rt] = mfma16(aq[kk], bw[kk * 8 + rt], acc[rt]);
#pragma unroll
      for (int rt = 0; rt < 8; ++rt)
#pragma unroll
        for (int r = 0; r < 4; ++r) ((LAS bf16_t*)QAB)[((4 * g + r) * 8 + h) * 128 + rt * 16 + fr] = f2bf(acc[rt][r] * 0.125f); }
    bf16x8 qf[4][2];
#pragma unroll
    for (int hh = 0; hh < 4; ++hh)
#pragma unroll
        for (int kk = 0; kk < 2; ++kk) qf[hh][kk] = *(const bf16x8*)(P + (rowb + t0 + fr) * NP_AB + AB_QI + hh * 64 + kk * 32 + g * 8);
    float wq[4];
#pragma unroll
    for (int hh = 0; hh < 4; ++hh) wq[hh] = SP[(rowb + t0 + fr) * 16 + 8 + hh] * 0.5f;
    const int tq = t0 + fr; const int nkt = ti + 1;
    if (tid < 16) { MISC[tid] = 0; MISC[16 + tid] = (t0 + 16 > 256) ? 256 : (1 << 20); MISC[48 + tid] = 0; }
    for (int i = tid; i < 2 * 16 * 129; i += NTHR) GTM[i] = 0u;
    __syncthreads();
    TSEC_END(1) TSEC_BEGIN(2)
    const unsigned hist_a = (unsigned)(unsigned long long)(HIST + fr * 1025), gtm_a = (unsigned)(unsigned long long)(GTM + fr * 129), eqm_a = (unsigned)(unsigned long long)(EQM + fr * 129);
    const bool need_sel = (t0 + 16) > 256;
#pragma unroll 1
    for (int pass = need_sel ? 0 : 2; pass < 3; ++pass) {
        const unsigned pfx = (unsigned)MISC[fr], tau = (unsigned)MISC[48 + fr];
        TSEC_BEGIN(21)
#if defined(PERTURB) && PERTURB == 7
        if (pass == 0) dsa_score_pass<0>(KIC, rowb, nkt < 8 ? nkt : 8, wave, fr, g, -1, qf, wq, pfx, tau, hist_a, gtm_a, eqm_a);
#endif
#if defined(PERTURB) && PERTURB == 8
        __syncthreads(); __syncthreads();
#endif
#if defined(PERTURB) && PERTURB == 6
        if (pass == 0) dsa_score_pass<0>(KIC, rowb, (nkt + 1) >> 1, wave, fr, g, -1, qf, wq, pfx, tau, hist_a, gtm_a, eqm_a);
#endif
#if defined(PERTURB) && PERTURB == 4
        if (pass == 0) dsa_score_pass<0>(KIC, rowb, nkt, wave, fr, g, -1, qf, wq, pfx, tau, hist_a, gtm_a, eqm_a);
#endif
        if (pass == 0) dsa_score_pass<0>(KIC, rowb, nkt, wave, fr, g, tq, qf, wq, pfx, tau, hist_a, gtm_a, eqm_a);
        else if (pass == 1) dsa_score_pass<1>(KIC, rowb, nkt, wave, fr, g, tq, qf, wq, pfx, tau, hist_a, gtm_a, eqm_a);
        else dsa_score_pass<2>(KIC, rowb, nkt, wave, fr, g, tq, qf, wq, pfx, tau, hist_a, gtm_a, eqm_a);
        asm volatile("s_waitcnt lgkmcnt(0)" ::: "memory");
        __syncthreads();
        TSEC_END(21)
        if (pass < 2) {
            TSEC_BEGIN(22)
#pragma unroll
            for (int qq = 0; qq < 2; ++qq) { const int q = wave * 2 + qq; const int nq = t0 + q + 1;
                if (nq > 256) {
                    const int R = MISC[16 + q]; const int lo = 2016 - 32 * lane;
                    unsigned w[16];
#pragma unroll
                    for (int i = 0; i < 16; ++i) w[i] = HIST[q * 1025 + (lo >> 1) + i];
                    int sl = 0;
#pragma unroll
                    for (int i = 0; i < 16; ++i) sl += (int)(w[i] & 0xffffu) + (int)(w[i] >> 16);
                    const int cum = scan_add_i(sl, lane);
                    const unsigned long long mk = __ballot(cum >= R);
                    const int Ls = mk ? (int)__ffsll((long long)mk) - 1 : 63;
                    const int c0 = cum - sl; int c = c0, nlt = 0, above = c0;
#pragma unroll
                    for (int i = 15; i >= 0; --i) {
                        c += (int)(w[i] >> 16); nlt += (c < R) ? 1 : 0; above = (c < R) ? c : above;
                        c += (int)(w[i] & 0xffffu); nlt += (c < R) ? 1 : 0; above = (c < R) ? c : above; }
                    const int fbin = lo + 31 - nlt;
                    const int fb = __shfl(fbin, Ls), ab = __shfl(above, Ls);
                    if (lane == 0) { const unsigned old = (unsigned)MISC[q];
                        if (pass == 0) MISC[q] = fb; else MISC[48 + q] = (int)((old << 11) | (unsigned)fb);
                        MISC[16 + q] = R - ab; }
                } else if (lane == 0) { MISC[48 + q] = 0; MISC[16 + q] = 1 << 20; }
            }
            __syncthreads();
            if (pass == 0) { for (int i = tid; i < 4100; i += NTHR) ((LAS u32x4*)HIST)[i] = (u32x4){0u, 0u, 0u, 0u}; }
            __syncthreads();
            TSEC_END(22)
        }
    }
    TSEC_END(2) TSEC_BEGIN(3)
#pragma unroll 1
    for (int qq = 0; qq < 2; ++qq) { const int q = wave * 2 + qq; const int R = MISC[16 + q];
        const unsigned g0 = GTM[q * 129 + 2 * lane], g1 = GTM[q * 129 + 2 * lane + 1], e0 = EQM[q * 129 + 2 * lane], e1 = EQM[q * 129 + 2 * lane + 1];
        const int tc = (int)__popc(e0) + (int)__popc(e1); const int tpre = scan_add_i(tc, lane) - tc;
        const unsigned s0 = g0 | keep_lowest(e0, R - tpre), s1 = g1 | keep_lowest(e1, R - tpre - (int)__popc(e0));
        const int c = (int)__popc(s0) + (int)__popc(s1); const int incl = scan_add_i(c, lane); int pos = incl - c;
        unsigned m = s0; while (m) { const int bit = __ffs((int)m) - 1; m &= m - 1u; const int ki = lane * 64 + bit; if (pos < 256) { SEL[q * 256 + pos] = (unsigned short)ki; SELB[q * 256 + pos] = BKT8[t0 + q - ki]; } ++pos; }
        m = s1; while (m) { const int bit = __ffs((int)m) - 1; m &= m - 1u; const int ki = lane * 64 + 32 + bit; if (pos < 256) { SEL[q * 256 + pos] = (unsigned short)ki; SELB[q * 256 + pos] = BKT8[t0 + q - ki]; } ++pos; }
        const int total = __shfl(incl, 63);
        if (lane == 0) MISC[32 + q] = total < 256 ? total : 256;
    }
    __syncthreads();
    TSEC_END(3) TSEC_BEGIN(4)
    LAS unsigned char* gb = GBUF + wave * 8704;
    const unsigned gba = (unsigned)(unsigned long long)gb;
#pragma unroll 1
    for (int qq = 0; qq < 2; ++qq) { const int q = wave * 2 + qq; const int count = MISC[32 + q]; const int tpos = t0 + q; const int nch = (count + 31) >> 5;
        bf16x8 qh[4];
#pragma unroll
        for (int kk = 0; kk < 4; ++kk) { const bf16x8 v = *(const LAS bf16x8*)(QAB + ((q * 8 + (fr & 7)) * 128 + kk * 32 + g * 8) * 2); qh[kk] = (fr < 8) ? v : (bf16x8){0, 0, 0, 0, 0, 0, 0, 0}; }
        float m_run = -1e30f, l_part = 0.f; f32x4 ao[8];
#pragma unroll
        for (int rt = 0; rt < 8; ++rt) ao[rt] = (f32x4){0.f, 0.f, 0.f, 0.f};
        u32x4 gv[8];
#pragma unroll
        for (int it = 0; it < 8; ++it) { const int slot = g + 4 * it; const int idx = SEL[q * 256 + (slot < count ? slot : 0)];
            gv[it] = ldg16(CKC + (rowb + idx) * 128 + fr * 8); }
        asm volatile("" ::: "memory");
        const unsigned alo = gba + (unsigned)((4 * g + (fr >> 2)) * 272 + (4 * (fr & 3)) * 2), ahi = alo + 16u * 272u;
#pragma unroll 1
        for (int c = 0; c < nch; ++c) {
            TSEC_BEGIN(41)
            TSEC_END(41) TSEC_BEGIN(42)
#pragma unroll
            for (int it = 0; it < 8; ++it) *(LAS u32x4*)(gb + (g + 4 * it) * 272 + fr * 16) = gv[it];
            asm volatile("s_waitcnt lgkmcnt(0)" ::: "memory");
            {
                const int cn = (c + 1 < nch) ? c + 1 : 0;
#pragma unroll
                for (int it = 0; it < 8; ++it) { const int slot = cn * 32 + g + 4 * it; const int idx = SEL[q * 256 + (slot < count ? slot : 0)];
                    gv[it] = ldg16(CKC + (rowb + idx) * 128 + fr * 8); }
                asm volatile("" ::: "memory"); }
            float lg[2][4];
#pragma unroll
            for (int k2 = 0; k2 < 2; ++k2) { f32x4 a = (f32x4){0.f, 0.f, 0.f, 0.f};
#pragma unroll
                for (int kk = 0; kk < 4; ++kk) a = mfma16(*(const LAS bf16x8*)(gb + (k2 * 16 + fr) * 272 + (kk * 32 + g * 8) * 2), qh[kk], a);
                const unsigned bk4 = *(const LAS unsigned*)(SELB + q * 256 + c * 32 + k2 * 16 + 4 * g);
#pragma unroll
                for (int r = 0; r < 4; ++r) { const int slot = c * 32 + k2 * 16 + 4 * g + r; const float bias = RELB[((bk4 >> (8 * r)) & 31u) * 8u + (unsigned)(fr & 7)];
                    lg[k2][r] = (slot < count) ? (a[r] + bias) * 1.44269504f : -1e30f; } }
            float ml = fmaxf(fmaxf(fmaxf(lg[0][0], lg[0][1]), fmaxf(lg[0][2], lg[0][3])), fmaxf(fmaxf(lg[1][0], lg[1][1]), fmaxf(lg[1][2], lg[1][3])));
            ml = fmaxf(ml, __shfl_xor(ml, 16)); ml = fmaxf(ml, __shfl_xor(ml, 32));
            const float m_new = fmaxf(m_run, ml); const float alpha = __builtin_amdgcn_exp2f(m_run - m_new);
            float pr[2][4]; float ps = 0.f;
#pragma unroll
            for (int k2 = 0; k2 < 2; ++k2)
#pragma unroll
                for (int r = 0; r < 4; ++r) { pr[k2][r] = __builtin_amdgcn_exp2f(lg[k2][r] - m_new); ps += pr[k2][r]; }
            l_part = l_part * alpha + ps; m_run = m_new;
            u32x4 pfu; pfu.x = pk2(pr[0][0], pr[0][1]); pfu.y = pk2(pr[0][2], pr[0][3]); pfu.z = pk2(pr[1][0], pr[1][1]); pfu.w = pk2(pr[1][2], pr[1][3]);
            const bf16x8 pf = __builtin_bit_cast(bf16x8, pfu);
            TSEC_END(42) TSEC_BEGIN(43)
            bf16x4 tl[8], th[8];
            asm volatile(
                "ds_read_b64_tr_b16 %0, %16\n\tds_read_b64_tr_b16 %8, %17\n\t"
                "ds_read_b64_tr_b16 %1, %16 offset:32\n\tds_read_b64_tr_b16 %9, %17 offset:32\n\t"
                "ds_read_b64_tr_b16 %2, %16 offset:64\n\tds_read_b64_tr_b16 %10, %17 offset:64\n\t"
                "ds_read_b64_tr_b16 %3, %16 offset:96\n\tds_read_b64_tr_b16 %11, %17 offset:96\n\t"
                "ds_read_b64_tr_b16 %4, %16 offset:128\n\tds_read_b64_tr_b16 %12, %17 offset:128\n\t"
                "ds_read_b64_tr_b16 %5, %16 offset:160\n\tds_read_b64_tr_b16 %13, %17 offset:160\n\t"
                "ds_read_b64_tr_b16 %6, %16 offset:192\n\tds_read_b64_tr_b16 %14, %17 offset:192\n\t"
                "ds_read_b64_tr_b16 %7, %16 offset:224\n\tds_read_b64_tr_b16 %15, %17 offset:224\n\t"
                "s_waitcnt lgkmcnt(0)"
                : "=&v"(tl[0]), "=&v"(tl[1]), "=&v"(tl[2]), "=&v"(tl[3]), "=&v"(tl[4]), "=&v"(tl[5]), "=&v"(tl[6]), "=&v"(tl[7]),
                  "=&v"(th[0]), "=&v"(th[1]), "=&v"(th[2]), "=&v"(th[3]), "=&v"(th[4]), "=&v"(th[5]), "=&v"(th[6]), "=&v"(th[7])
                : "v"(alo), "v"(ahi) : "memory");
#pragma unroll
            for (int rt = 0; rt < 8; ++rt) { ao[rt] = ao[rt] * alpha;
                bf16x8 af; af[0] = tl[rt][0]; af[1] = tl[rt][1]; af[2] = tl[rt][2]; af[3] = tl[rt][3]; af[4] = th[rt][0]; af[5] = th[rt][1]; af[6] = th[rt][2]; af[7] = th[rt][3];
                ao[rt] = mfma16(af, pf, ao[rt]); }
            TSEC_END(43)
        }
        float l = l_part; l += __shfl_xor(l, 16); l += __shfl_xor(l, 32);
        const float inv = 1.0f / l;
        if (fr < 8) {
#pragma unroll
            for (int rt = 0; rt < 8; ++rt) { u32x2 w; w.x = pk2(ao[rt][0] * inv, ao[rt][1] * inv); w.y = pk2(ao[rt][2] * inv, ao[rt][3] * inv);
                *(LAS u32x2*)(QAB + ((q * 8 + fr) * 128 + rt * 16 + 4 * g) * 2) = w; } }
    }
    __syncthreads();
    TSEC_END(4) TSEC_BEGIN(5)
    { const int h = wave; f32x4 acc[4];
#pragma unroll
      for (int nt = 0; nt < 4; ++nt) acc[nt] = (f32x4){0.f, 0.f, 0.f, 0.f};
      bf16x8 bw[16];
#pragma unroll
      for (int kk = 0; kk < 4; ++kk)
#pragma unroll
        for (int nt = 0; nt < 4; ++nt) bw[kk * 4 + nt] = *(const bf16x8*)(WUV + ((size_t)(h * 64 + nt * 16 + fr)) * 128 + kk * 32 + g * 8);
      asm volatile("" ::: "memory");
#pragma unroll
      for (int kk = 0; kk < 4; ++kk) { const bf16x8 a = *(const LAS bf16x8*)(QAB + ((fr * 8 + h) * 128 + kk * 32 + g * 8) * 2);
#pragma unroll
        for (int nt = 0; nt < 4; ++nt) acc[nt] = mfma16(a, bw[kk * 4 + nt], acc[nt]); }
#pragma unroll
      for (int nt = 0; nt < 4; ++nt)
#pragma unroll
        for (int r = 0; r < 4; ++r) YMIX[(rowb + t0 + 4 * g + r) * D + 512 + h * 64 + nt * 16 + fr] = f2bf(acc[nt][r]); }
    __syncthreads();
    TSEC_END(5) TSEC_END(6)
}

struct DilRegs { u32x4 kv[4], vv[4]; bf16x8 qf[2]; };
__device__ __forceinline__ void dil_issue(const Params& p, int b, int h, int pat, int res, int n, DilRegs& r) {
    const int tid = ltid(), lane = tid & 63, wave = __builtin_amdgcn_readfirstlane(tid >> 6), fr = lane & 15, g = lane >> 4;
    const bf16_t* P = (const bf16_t*)(p.ws + WS_P);
    const int d = (pat == 0) ? 1 : (pat == 1 ? 4 : 16);
    const size_t rowb = (size_t)b * SEQ;
    const int row = tid >> 1, half = tid & 1; const int jsub = 128 * (n - 1) + row; const bool ok = jsub >= 0;
    const size_t tok = rowb + (size_t)(ok ? jsub : 0) * d + res;
#pragma unroll
    for (int q = 0; q < 4; ++q) { r.kv[q] = *(const u32x4*)(P + tok * NP_CD + CD_KD + h * 64 + half * 32 + q * 8); r.vv[q] = *(const u32x4*)(P + tok * NP_CD + CD_VD + h * 64 + half * 32 + q * 8); }
    const int qi = 128 * n + 16 * wave + fr; const size_t qtok = rowb + (size_t)qi * d + res;
#pragma unroll
    for (int kk = 0; kk < 2; ++kk) r.qf[kk] = *(const bf16x8*)(P + qtok * NP_CD + CD_QD + h * 64 + kk * 32 + g * 8);
}
__device__ __forceinline__ void dil_compute(const Params& p, LAS unsigned char* lds, int b, int h, int pat, int res, int n, const DilRegs& rg) {
    const int tid = ltid(), lane = tid & 63, wave = __builtin_amdgcn_readfirstlane(tid >> 6), fr = lane & 15, g = lane >> 4;
    LAS unsigned char* KS2 = lds; LAS unsigned char* VT2 = lds + 36864;
    const LAS unsigned char* BKT8 = lds + L_BKT8; const LAS float* RELB = (const LAS float*)(lds + L_RELB);
    const int d = (pat == 0) ? 1 : (pat == 1 ? 4 : 16);
    const size_t rowb = (size_t)b * SEQ;
    bf16_t* OP = (bf16_t*)(p.ws + (pat == 0 ? WS_HBF : (pat == 1 ? WS_HBF + 32 * MiB : WS_H1)));
    float* LSE = (float*)(p.ws + WS_H1 + 32 * MiB) + (size_t)pat * NTOK * 8;
    { const int row = tid >> 1, half = tid & 1; const bool ok = (128 * (n - 1) + row) >= 0;
#pragma unroll
      for (int q = 0; q < 4; ++q) { const u32x4 kq = ok ? rg.kv[q] : (u32x4){0u, 0u, 0u, 0u}, vq = ok ? rg.vv[q] : (u32x4){0u, 0u, 0u, 0u};
          *(LAS u32x4*)(KS2 + row * 144 + (half * 32 + q * 8) * 2) = kq;
#pragma unroll
          for (int e = 0; e < 4; ++e) { const unsigned w = vq[e]; const int dv = half * 32 + q * 8 + 2 * e;
              ((LAS bf16_t*)VT2)[dv * 264 + row] = (bf16_t)(w & 0xffffu); ((LAS bf16_t*)VT2)[(dv + 1) * 264 + row] = (bf16_t)(w >> 16); } } }
    LAS float* TAPB = (LAS float*)(lds + 70656);
    if (tid < 400) { const int tap = tid - 144; TAPB[tid] = (tap >= 0 && tap <= 128) ? RELB[(int)BKT8[tap * d] * 8 + h] * 1.44269504f : -1e30f; }
    __syncthreads();
    const int qi = 128 * n + 16 * wave + fr; const size_t qtok = rowb + (size_t)qi * d + res;
    const bf16x8 qf[2] = {rg.qf[0], rg.qf[1]};
    const int ql = 128 + 16 * wave + fr;
    float m_run = -1e30f, l_part = 0.f; f32x4 ao[4];
#pragma unroll
    for (int vt = 0; vt < 4; ++vt) ao[vt] = (f32x4){0.f, 0.f, 0.f, 0.f};
#pragma unroll 1
    for (int c = 0; c < 5; ++c) { const int kl0 = 16 * wave + 32 * c;
        float lg[2][4];
#pragma unroll
        for (int k2 = 0; k2 < 2; ++k2) {
            if (c == 4 && k2 == 1) {
#pragma unroll
                for (int r = 0; r < 4; ++r) lg[k2][r] = -1e30f;
            } else { f32x4 a = (f32x4){0.f, 0.f, 0.f, 0.f};
#pragma unroll
                for (int kk = 0; kk < 2; ++kk) a = mfma16(ldfrag(KS2, kl0 + k2 * 16 + fr, 144, kk, g), qf[kk], a);
#pragma unroll
                for (int r = 0; r < 4; ++r) { const int kl = kl0 + k2 * 16 + 4 * g + r; const int tap = ql - kl;
                    float v = fmaf(a[r], 0.125f * 1.44269504f, TAPB[tap + 144]);
                    if (n == 0) v = (kl >= 128) ? v : -1e30f;
                    lg[k2][r] = v; } } }
        float ml = fmaxf(fmaxf(fmaxf(lg[0][0], lg[0][1]), fmaxf(lg[0][2], lg[0][3])), fmaxf(fmaxf(lg[1][0], lg[1][1]), fmaxf(lg[1][2], lg[1][3])));
        ml = fmaxf(ml, __shfl_xor(ml, 16)); ml = fmaxf(ml, __shfl_xor(ml, 32));
        const float m_new = fmaxf(m_run, ml); const float alpha = __builtin_amdgcn_exp2f(m_run - m_new);
        float pr[2][4]; float ps = 0.f;
#pragma unroll
        for (int k2 = 0; k2 < 2; ++k2)
#pragma unroll
            for (int r = 0; r < 4; ++r) { pr[k2][r] = (lg[k2][r] > -1e29f) ? __builtin_amdgcn_exp2f(lg[k2][r] - m_new) : 0.f; ps += pr[k2][r]; }
        l_part = l_part * alpha + ps; m_run = m_new;
        u32x4 pfu; pfu.x = pk2(pr[0][0], pr[0][1]); pfu.y = pk2(pr[0][2], pr[0][3]); pfu.z = pk2(pr[1][0], pr[1][1]); pfu.w = pk2(pr[1][2], pr[1][3]);
        const bf16x8 pf = __builtin_bit_cast(bf16x8, pfu);
#pragma unroll
        for (int vt = 0; vt < 4; ++vt) { ao[vt] = ao[vt] * alpha;
            const bf16x4 lo = *(const LAS bf16x4*)(VT2 + (vt * 16 + fr) * 528 + (kl0 + 4 * g) * 2);
            bf16x4 hi = (bf16x4){0, 0, 0, 0};
            if (c < 4) hi = *(const LAS bf16x4*)(VT2 + (vt * 16 + fr) * 528 + (kl0 + 16 + 4 * g) * 2);
            bf16x8 af; af[0] = lo[0]; af[1] = lo[1]; af[2] = lo[2]; af[3] = lo[3]; af[4] = hi[0]; af[5] = hi[1]; af[6] = hi[2]; af[7] = hi[3];
            ao[vt] = mfma16(af, pf, ao[vt]); }
    }
    float l = l_part; l += __shfl_xor(l, 16); l += __shfl_xor(l, 32);
    const float inv = 1.0f / l;
#pragma unroll
    for (int vt = 0; vt < 4; ++vt) { u32x2 w; w.x = pk2(ao[vt][0] * inv, ao[vt][1] * inv); w.y = pk2(ao[vt][2] * inv, ao[vt][3] * inv);
        *(u32x2*)(OP + qtok * 512 + h * 64 + vt * 16 + 4 * g) = w; }
    if (g == 0) LSE[qtok * 8 + h] = (m_run + __log2f(l)) * 0.69314718f;
    __syncthreads();
}

__device__ __forceinline__ void phase_dil_combine(const Params& p) {
    const bf16_t* __restrict__ O0 = (const bf16_t*)(p.ws + WS_HBF); const bf16_t* __restrict__ O1 = (const bf16_t*)(p.ws + WS_HBF + 32 * MiB); const bf16_t* __restrict__ O2 = (const bf16_t*)(p.ws + WS_H1);
    const float* __restrict__ LSE = (const float*)(p.ws + WS_H1 + 32 * MiB); bf16_t* __restrict__ YMIX = (bf16_t*)(p.ws + WS_YMIX);
#pragma unroll 2
    for (int idx = BID * NTHR + TID; idx < NTOK * 64; idx += GDIM * NTHR) {
        const int tok = idx >> 6, h = (idx >> 3) & 7, dg = idx & 7;
        const float l0 = LSE[(size_t)tok * 8 + h], l1 = LSE[(size_t)NTOK * 8 + (size_t)tok * 8 + h], l2 = LSE[(size_t)2 * NTOK * 8 + (size_t)tok * 8 + h];
        const float mx = fmaxf(l0, fmaxf(l1, l2)); const float w0 = __expf(l0 - mx), w1 = __expf(l1 - mx), w2 = __expf(l2 - mx); const float inv = 1.0f / (w0 + w1 + w2);
        const size_t off = (size_t)tok * 512 + h * 64 + dg * 8;
        const u32x4 a = *(const u32x4*)(O0 + off), bq = *(const u32x4*)(O1 + off), c = *(const u32x4*)(O2 + off);
        u32x4 o;
#pragma unroll
        for (int e = 0; e < 4; ++e) {
            const float v0 = (__uint_as_float(a[e] << 16) * w0 + __uint_as_float(bq[e] << 16) * w1 + __uint_as_float(c[e] << 16) * w2) * inv;
            const float v1 = (__uint_as_float(a[e] & 0xffff0000u) * w0 + __uint_as_float(bq[e] & 0xffff0000u) * w1 + __uint_as_float(c[e] & 0xffff0000u) * w2) * inv;
            o[e] = pk2(v0, v1); }
        *(u32x4*)(YMIX + (size_t)tok * D + 512 + h * 64 + dg * 8) = o;
    }
}

__device__ __forceinline__ unsigned grab_issue(unsigned* ctr) { unsigned v = 0u; if (TID == 0) v = __hip_atomic_fetch_add(ctr, 1u, __ATOMIC_RELAXED, __HIP_MEMORY_SCOPE_AGENT); return v; }
__device__ __forceinline__ int grab_finish(unsigned v, LAS int* slot) { __syncthreads(); if (TID == 0) *slot = (int)v; __syncthreads(); return *slot; }
__device__ __forceinline__ int grab_unit(unsigned* ctr, LAS int* slot) {
    __syncthreads();
    if (TID == 0) *slot = (int)__hip_atomic_fetch_add(ctr, 1u, __ATOMIC_RELAXED, __HIP_MEMORY_SCOPE_AGENT);
    __syncthreads();
    return *slot;
}
__device__ __forceinline__ void phase_rec_L(const Params& p, LAS unsigned char* lds, int j, bool is_ab) {
    for (int u = BID; u < 2048; u += GDIM) { const int bh = u >> 6, ck = u & 63;
        if (is_ab) unit_mlstm_L(p, lds, j, bh >> 2, bh & 3, ck); else unit_gla_L(p, lds, j, bh >> 2, bh & 3, ck); }
}
__device__ __forceinline__ void phase_mixer_ab(const Params& p, LAS unsigned char* lds, int j, unsigned* ctr, int nrec = 2048) {
    LAS int* slot = (LAS int*)(lds + LDS_PERS + LP_SLOT);
    load_attn_tables(p, lds);
    int u = grab_unit(ctr, slot);
    while (u < 2048) { const unsigned pend = grab_issue(ctr); unit_dsa(p, lds, u >> 8, 255 - (u & 255)); u = grab_finish(pend, slot); }
    const int total = 2048 + nrec;
    MlstmOIn cur, nxt;
    if (u < total) { const int k = u - 2048, bh = k >> 6; mlstm_O_issue(p, bh >> 2, bh & 3, k & 63, cur); }
    int un = (u < total) ? grab_unit(ctr, slot) : total;
    while (u < total) {
        const unsigned pend = grab_issue(ctr);
        if (un < total) { const int k2 = un - 2048, bh2 = k2 >> 6; mlstm_O_issue(p, bh2 >> 2, bh2 & 3, k2 & 63, nxt); }
        { const int k = u - 2048, bh = k >> 6; TSEC_BEGIN(7) mlstm_O_compute(p, lds, j, bh >> 2, bh & 3, k & 63, cur); TSEC_END(7) }
        cur = nxt; u = un; un = grab_finish(pend, slot);
    }
}
__device__ __forceinline__ void dil_decode(int k, int& b, int& h, int& pat, int& res, int& n) {
    const int n32 = k & 31, bh = k / 96; pat = (k >> 5) % 3; b = bh >> 3; h = bh & 7;
    if (pat == 0) { res = 0; n = n32; } else if (pat == 1) { res = n32 >> 3; n = n32 & 7; } else { res = n32 >> 1; n = n32 & 1; }
}
__device__ __forceinline__ void phase_mixer_cd(const Params& p, LAS unsigned char* lds, int j, unsigned* ctr, int nrec = 2048) {
    LAS int* slot = (LAS int*)(lds + LDS_PERS + LP_SLOT);
    load_attn_tables(p, lds);
    const int total = 6144 + nrec;
    int u = grab_unit(ctr, slot);
    DilRegs cur, nxt;
    if (u < 6144) { int b, h, pat, res, n; dil_decode(u, b, h, pat, res, n); dil_issue(p, b, h, pat, res, n, cur); }
    int un = (u < total) ? grab_unit(ctr, slot) : total;
    while (u < total) {
        const unsigned pend = grab_issue(ctr);
        if (u < 6144) { int b, h, pat, res, n; dil_decode(u, b, h, pat, res, n);
            if (un < 6144) { int b2, h2, pat2, res2, n2; dil_decode(un, b2, h2, pat2, res2, n2); dil_issue(p, b2, h2, pat2, res2, n2, nxt); }
            TSEC_BEGIN(8) dil_compute(p, lds, b, h, pat, res, n, cur); TSEC_END(8)
            cur = nxt; }
        else { const int k = u - 6144; const int bh = k >> 6; TSEC_BEGIN(9) unit_gla_O(p, lds, j, bh >> 2, bh & 3, k & 63); TSEC_END(9) }
        u = un; un = grab_finish(pend, slot);
    }
}
typedef const __attribute__((address_space(4))) Params* KernargP;
__device__ __forceinline__ const Params& lparams() { KernargP k = (KernargP)__builtin_amdgcn_kernarg_segment_ptr(); asm volatile("" : "+s"(k)); return *(const Params*)k; }
#define PP (lparams())
__device__ __forceinline__ LAS unsigned char* llds(LAS unsigned char* q) { asm volatile("" : "+s"(q)); return q; }
#define LL (llds(lds))
__global__ void __launch_bounds__(NTHR, 2) hybrid_fwd(Params p) {
    extern __shared__ __attribute__((aligned(16))) unsigned char lds_raw[];
    LAS unsigned char* lds = (LAS unsigned char*)lds_raw;
    const int tid = TID, G = GDIM;
    for (int i = tid; i < (LDS_TOTAL - LDS_PERS) / 4; i += NTHR) ((LAS unsigned*)(lds + LDS_PERS))[i] = 0u;
    __syncthreads();
    unsigned* ctl = (unsigned*)(PP.ws + WS_CTL);
    XcdBarrier bar = xcd_barrier_post(ctl + CW_BAR, (volatile LAS unsigned*)(lds + LDS_PERS));
    LAS int* tbase = (LAS int*)(lds + LDS_PERS + LP_TBASE);

    { TSEC_BEGIN(54) p0_prologue(PP, LL); TSEC_END(54) }
    __syncthreads();
#pragma unroll 1
    for (int l = 0; l < DEPTH; ++l) {
        const bool is_ab = (l & 1) == 0; const int j = l >> 1;
        prep_layer(PP, LL, l);
#if DBL == 1
        __syncthreads(); prep_layer(PP, LL, l);
#endif
        if (l == 0) xcd_barrier(bar);
        __syncthreads();
        { TSEC_BEGIN(51) phase_norm1(PP, LL, l); TSEC_END(51) }
        { TSEC_BEGIN(55) xcd_barrier(bar); TSEC_END(55) }
        {
            const int N = is_ab ? NP_AB : NP_CD;
            pg8::Gemm gm{(const bf16_t*)(PP.ws + WS_HBF), (const bf16_t*)(PP.ws + WS_WIN), NTOK, N, D};
            pg8::StaticOrder S; S.init(NTOK, N, G, BID);
            pg8::EpiBf16<false> E{(bf16_t*)(PP.ws + WS_P), N, is_ab ? (bf16_t*)(PP.ws + WS_KIC) : nullptr, is_ab ? (bf16_t*)(PP.ws + WS_CKC) : nullptr};
            pg8::gemm_phase(LL, gm, S, E);
#if DBL == 3
            pg8::gemm_phase(LL, gm, S, E);
#endif
        }
        xcd_barrier(bar);
        phase_rec_L(PP, LL, j, is_ab);
#if DBL == 11
        __syncthreads(); phase_rec_L(PP, LL, j, is_ab);
#endif
        xcd_barrier(bar);
        if (is_ab) phase_scan_mlstm(PP); else phase_scan_gla(PP);
#if DBL == 12
        xcd_barrier(bar); if (is_ab) phase_scan_mlstm(PP); else phase_scan_gla(PP);
#endif
        xcd_barrier(bar);
        if (is_ab) { phase_mixer_ab(PP, LL, j, ctl + CW_WQ + 64 * l);
#if DBL == 4
            xcd_barrier(bar); phase_mixer_ab(PP, LL, j, ctl + CW_WQ + 64 * (l + 4));
#endif
#if DBL == 9
            xcd_barrier(bar); phase_mixer_ab(PP, LL, j, ctl + CW_WQ + 64 * (l + 4), 0);
#endif
        } else { phase_mixer_cd(PP, LL, j, ctl + CW_WQ + 64 * l); xcd_barrier(bar); phase_dil_combine(PP);
#if DBL == 5
            xcd_barrier(bar); phase_mixer_cd(PP, LL, j, ctl + CW_WQ + 64 * (l + 4)); xcd_barrier(bar); phase_dil_combine(PP);
#endif
#if DBL == 10
            xcd_barrier(bar); phase_mixer_cd(PP, LL, j, ctl + CW_WQ + 64 * (l + 4), 0); xcd_barrier(bar); phase_dil_combine(PP);
#endif
        }
        xcd_barrier(bar);
        {
            pg8::Gemm gm{(const bf16_t*)(PP.ws + WS_YMIX), (const bf16_t*)(PP.ws + WS_WOUT), NTOK, D, D};
            pg8::StaticOrder S; S.init(NTOK, D, G, BID);
            pg8::EpiOutRes E{(float*)(PP.ws + WS_X), (const float*)(PP.ws + WS_MOD) + (size_t)l * 8 * 6 * D + 2 * D};
            { TSEC_BEGIN(52) pg8::gemm_phase(LL, gm, S, E); TSEC_END(52) }
        }
        xcd_barrier(bar);
        phase_norm2(PP, LL, l);
#if DBL == 2
        xcd_barrier(bar); phase_norm2(PP, LL, l);
#endif
        xcd_barrier(bar);
        phase_dispatch(PP, LL, tbase);
#if DBL == 6
        xcd_barrier(bar); phase_dispatch(PP, LL, tbase);
#endif
        xcd_barrier(bar);
        {
            pg8::Gemm gm{(const bf16_t*)(PP.ws + WS_HBF), (const bf16_t*)(PP.ws + WS_WGU), MOE_ROWS, 16 * 1024, D, (const int*)(PP.ws + WS_ROWTOK)};
            pg8::MoeOrder S{tbase, G, BID};
            pg8::EpiMoe1 E{(bf16_t*)(PP.ws + WS_H1)};
            pg8::gemm_phase<pg8::EpiMoe1, pg8::MoeOrder, true>(LL, gm, S, E);
#if DBL == 7
            pg8::gemm_phase<pg8::EpiMoe1, pg8::MoeOrder, true>(LL, gm, S, E);
#endif
        }
        xcd_barrier(bar);
        {
            pg8::Gemm gm{(const bf16_t*)(PP.ws + WS_H1), (const bf16_t*)(PP.ws + WS_WDN), MOE_ROWS, 16 * 1024, 512};
            pg8::MoeOrder S{tbase, G, BID};
            pg8::EpiBf16<true> E{(bf16_t*)(PP.ws + WS_P), D, nullptr, nullptr};
            pg8::gemm_phase(LL, gm, S, E);
#if DBL == 8
            pg8::gemm_phase(LL, gm, S, E);
#endif
        }
        xcd_barrier(bar);
    }
    { TSEC_BEGIN(53) phase_final(PP, LL); TSEC_END(53) }
#if PROF
    if (BID == 0) { __syncthreads(); const unsigned long long acc = *(LAS unsigned long long*)(lds + LDS_PERS + LP_TACC); const unsigned long long t0 = wall_clock64(); while (wall_clock64() - t0 < acc * 10ull) __builtin_amdgcn_s_sleep(8); }
#endif
}

extern "C" void kernel_launch(void* const* d_in, const int* in_sizes, int n_in, void* d_out, int out_size, void* d_ws, size_t ws_size, hipStream_t stream) {
    static int grid = 0;
    if (grid == 0) {
        if (n_in != 28 || ws_size < WS_END2) { fprintf(stderr, "kernel_launch: unexpected n_in %d / ws_size %zu (need %zu)\n", n_in, ws_size, (size_t)WS_END2); grid = -1; return; }
        int dev = 0, cus = 0, per_cu = 0;
        if (hipGetDevice(&dev) != hipSuccess || hipDeviceGetAttribute(&cus, hipDeviceAttributeMultiprocessorCount, dev) != hipSuccess) { grid = -1; return; }
        if (hipFuncSetAttribute((const void*)hybrid_fwd, hipFuncAttributeMaxDynamicSharedMemorySize, LDS_TOTAL) != hipSuccess) { fprintf(stderr, "kernel_launch: hipFuncSetAttribute failed\n"); grid = -1; return; }
        if (hipOccupancyMaxActiveBlocksPerMultiprocessor(&per_cu, (const void*)hybrid_fwd, NTHR, LDS_TOTAL) != hipSuccess || per_cu < 1) { fprintf(stderr, "kernel_launch: occupancy query says %d\n", per_cu); }
        (void)hipGetLastError();
        grid = cus;
    }
    if (grid < 0) return;
    if (hipMemsetAsync((char*)d_ws + WS_CTL, 0, CTL_BYTES, stream) != hipSuccess) return;
    Params p{};
    for (int i = 0; i < 28; ++i) p.in[i] = (const float*)d_in[i];
    p.out = (float*)d_out; p.ws = (unsigned char*)d_ws;
    hipLaunchKernelGGL(hybrid_fwd, dim3(grid), dim3(NTHR), LDS_TOTAL, stream, p);
}
```

```cpp
#include <hip/hip_runtime.h>
#include <cstdio>
#include <cstdint>

#define LAS __attribute__((address_space(3)))
typedef unsigned short bf16_t;
typedef short bf16x8 __attribute__((ext_vector_type(8)));
typedef short bf16x4 __attribute__((ext_vector_type(4)));
typedef float f32x4 __attribute__((ext_vector_type(4)));
typedef float f32x2 __attribute__((ext_vector_type(2)));
typedef unsigned u32x4 __attribute__((ext_vector_type(4)));
typedef unsigned u32x2 __attribute__((ext_vector_type(2)));

constexpr int D = 1024, NB = 8, SEQ = 4096, NTOK = NB * SEQ, DEPTH = 4;
constexpr int W_AB = 2508, W_CD = 3088;
constexpr int NP_AB = 2560, NP_CD = 3072;
constexpr int AB_QA = 0, AB_KA = 256, AB_VA = 512, AB_OA = 1024, AB_QB = 1536, AB_CKV = 2048, AB_QI = 2176, AB_KI = 2432;
constexpr int CD_QC = 0, CD_KC = 256, CD_VC = 512, CD_RC = 1024, CD_QD = 1536, CD_KD = 2048, CD_VD = 2560;
constexpr int MOE_ROWS = 2 * NTOK + 16 * 256;

__device__ __forceinline__ int lbid() { int t = (int)blockIdx.x; asm volatile("" : "+s"(t)); return t; }
__device__ __forceinline__ int lgdim() { int t = (int)gridDim.x; asm volatile("" : "+s"(t)); return t; }
#define BID (lbid())
#define GDIM (lgdim())
__device__ __forceinline__ int ltid() { int t = (int)threadIdx.x; asm volatile("" : "+v"(t)); return t; }
__device__ __forceinline__ void gload16(u32x4& dst, const void* ptr) { asm volatile("global_load_dwordx4 %0, %1, off" : "=&v"(dst) : "v"(ptr) : "memory"); }
__device__ __forceinline__ float bf2f(bf16_t b) { return __uint_as_float(((unsigned)b) << 16); }
__device__ __forceinline__ unsigned pk2(float lo, float hi) { unsigned r; asm("v_cvt_pk_bf16_f32 %0, %1, %2" : "=v"(r) : "v"(lo), "v"(hi)); return r; }
__device__ __forceinline__ bf16_t f2bf(float f) { return (bf16_t)(pk2(f, 0.f) & 0xffffu); }
__device__ __forceinline__ float wave_sum(float v) {
#pragma unroll
    for (int o = 32; o > 0; o >>= 1) v += __shfl_xor(v, o);
    return v;
}
__device__ __forceinline__ float sigmoidf_(float x) { return 1.0f / (1.0f + __expf(-x)); }
__device__ __forceinline__ float siluf_(float x) { return x / (1.0f + __expf(-x)); }
__device__ __forceinline__ float logsigmoidf_(float x) { return fminf(x, 0.0f) - log1pf(__expf(-fabsf(x))); }

#define XB_TMO      128
#define XB_XCNT(j)  (256  + 64 * (j))
#define XB_XSUB(j)  (1280 + 64 * (j))
#define XB_XGEN(j)  (2304 + 64 * (j))
#define XB_TOP      3328
#define XB_TOPGEN   3392
#define XCD_BAR_WORDS 3456
#define XB_SPIN_CAP (1u << 18)

__device__ __forceinline__ unsigned xb_ld(unsigned* p)              { return __hip_atomic_load(p, __ATOMIC_RELAXED, __HIP_MEMORY_SCOPE_AGENT); }
__device__ __forceinline__ unsigned xb_add(unsigned* p, unsigned v) { return __hip_atomic_fetch_add(p, v, __ATOMIC_RELAXED, __HIP_MEMORY_SCOPE_AGENT); }
__device__ __forceinline__ unsigned xb_xcc_id() { return (unsigned)__builtin_amdgcn_s_getreg((3 << 11) | 20) & 0xFu; }
#define XB_SPIN(cond, bar) do { unsigned _sp = 0; while (cond) { __builtin_amdgcn_s_sleep(1); \
    if ((++_sp & 255u) == 0u) { if (xb_ld(&(bar)[XB_TMO])) break; if (_sp > XB_SPIN_CAP) { atomicAdd(&(bar)[XB_TMO], 1u); break; } } } } while (0)

struct XcdBarrier { unsigned* bar; unsigned x; volatile LAS unsigned* st; };

__device__ __forceinline__ XcdBarrier xcd_barrier_post(unsigned* bar, volatile LAS unsigned* st) {
    XcdBarrier b; b.bar = bar; b.x = xb_xcc_id(); b.st = st;
    if (ltid() == 0) (void)xb_add(&bar[XB_XCNT(b.x)], 1u);
    return b;
}
__device__ __forceinline__ void xcd_barrier_complete(unsigned* bar, unsigned x, unsigned& nloc, unsigned& nx) {
    const unsigned G = (unsigned)GDIM;
    unsigned sum, cnt, mine, sp = 0u;
    for (;;) {
        sum = 0u; cnt = 0u; mine = 0u;
#pragma unroll
        for (unsigned j = 0; j < 16; ++j) { const unsigned c = xb_ld(&bar[XB_XCNT(j)]); sum += c; cnt += (c > 0u) ? 1u : 0u; mine = (j == x) ? c : mine; }
        if (sum == G) break;
        __builtin_amdgcn_s_sleep(1);
        if ((++sp & 255u) == 0u) { if (xb_ld(&bar[XB_TMO])) break; if (sp > XB_SPIN_CAP) { atomicAdd(&bar[XB_TMO], 1u); break; } }
    }
    nloc = mine > 0u ? mine : 1u; nx = cnt > 0u ? cnt : 1u;
}
__device__ __forceinline__ void xcd_barrier1(const XcdBarrier& b) {
    asm volatile("s_waitcnt vmcnt(0)" ::: "memory");
    __syncthreads();
    if (ltid() == 0) {
        unsigned* bar = b.bar;
        __builtin_amdgcn_s_waitcnt(0);
        unsigned nloc = b.st[0], nx = b.st[1];
        if (nloc == 0u) { xcd_barrier_complete(bar, b.x, nloc, nx); b.st[0] = nloc; b.st[1] = nx; }
        const unsigned old = xb_add(&bar[XB_XSUB(b.x)], 1u);
        const unsigned gen = old / nloc;
        if (old + 1u == (gen + 1u) * nloc) {
            __builtin_amdgcn_fence(__ATOMIC_RELEASE, "agent");
            asm volatile("s_waitcnt vmcnt(0)" ::: "memory");
            const unsigned og = xb_add(&bar[XB_TOP], 1u);
            const unsigned tg = og / nx;
            if (og + 1u == (tg + 1u) * nx) xb_add(&bar[XB_TOPGEN], 1u);
            else XB_SPIN(xb_ld(&bar[XB_TOPGEN]) == tg, bar);
            __builtin_amdgcn_fence(__ATOMIC_ACQUIRE, "agent");
            xb_add(&bar[XB_XGEN(b.x)], 1u);
            asm volatile("s_waitcnt vmcnt(0)" ::: "memory");
        } else {
            XB_SPIN(xb_ld(&bar[XB_XGEN(b.x)]) == gen, bar);
            __builtin_amdgcn_fence(__ATOMIC_ACQUIRE, "agent");
            asm volatile("s_waitcnt vmcnt(0)" ::: "memory");
        }
    }
    __syncthreads();
}

__device__ __forceinline__ void xcd_barrier(const XcdBarrier& b) { xcd_barrier1(b); }

namespace pg8 {
constexpr int BM = 256, BK = 64, HALF = 128, HTB = HALF * BK * 2, STAGE_BYTES = 8 * HTB, NXCD = 8, WGM = 8;
__host__ __device__ __forceinline__ int lds_byte(int r, int c) { const int st = (r >> 4) * 2 + (c >> 5), rr = r & 15, cc = c & 31, ob = rr * 64 + cc * 2; return st * 1024 + (ob ^ (((ob >> 9) & 1) << 5)); }
__host__ __device__ __forceinline__ void stage_rc(int b, int& R, int& C) { const int st = b / 1024, sb = b % 1024, swz = sb ^ (((sb >> 9) & 1) << 5); R = (st >> 1) * 16 + swz / 64; C = (st & 1) * 32 + (swz % 64) / 2; }
__host__ __device__ __forceinline__ int perm32(int rho) { const int n = rho >> 4, i = rho & 15; return 8 * (i >> 2) + 4 * n + (i & 3); }

struct Unit { int pm, pn; };
struct Gemm { const bf16_t* A; const bf16_t* Bt; int M, N, K; const int* rowtok; };

struct StaticOrder {
    int nM, nN, nwg, G, c;
    __host__ __device__ void init(int M, int N, int G_, int c_) { nM = M / BM; nN = N / BM; nwg = nM * nN; G = G_; c = c_; }
    __host__ __device__ bool next(int i, Unit& u) const {
        const long L = (long)i * G + c; if (L >= nwg) return false;
        int wgid = (int)L; { const int q = nwg / NXCD, r = nwg % NXCD, xcd = wgid % NXCD, off = wgid / NXCD; wgid = (xcd < r ? xcd * (q + 1) : r * (q + 1) + (xcd - r) * q) + off; }
        const int nig = WGM * nN, gid = wgid / nig, fm = gid * WGM, gsz = (nM - fm) < WGM ? (nM - fm) : WGM;
        u.pm = fm + ((wgid % nig) % gsz); u.pn = (wgid % nig) / gsz; return true;
    }
    __device__ __forceinline__ void a_ready(const Unit&) const {}
    __device__ __forceinline__ void done(const Unit&) const {}
};
struct MoeOrder {
    const LAS int* tbase;
    int G, c;
    __device__ bool next(int i, Unit& u) const {
        const int L = i * G + c; const int total = tbase[16] * 4; if (L >= total) return false;
        const int pm = L >> 2; int e = 0;
#pragma unroll
        for (int k = 1; k < 16; ++k) e += (pm >= tbase[k]) ? 1 : 0;
        u.pm = pm; u.pn = e * 4 + (L & 3); return true;
    }
    __device__ __forceinline__ void a_ready(const Unit&) const {}
    __device__ __forceinline__ void done(const Unit&) const {}
};

__device__ __forceinline__ unsigned cvt_pk_bf16(float lo, float hi) { unsigned r; asm volatile("v_cvt_pk_bf16_f32 %0, %1, %2" : "=v"(r) : "v"(lo), "v"(hi)); return r; }

template <bool MOE> struct EpiBf16 {
    static constexpr bool PERM = true, AFTER_DRAIN = false;
    bf16_t* O; int ldc;
    bf16_t* kic; bf16_t* ckc;
    __device__ __forceinline__ void operator()(const f32x4 (&acc)[2][2][4][2], const Unit& u, int wr, int wc, int fr, int fq) const {
        const int row0 = u.pm * BM + wr * 64 + fr; const int colt = (MOE ? (u.pn & 3) : u.pn) * BM; const int col0 = colt + wc * 32 + 8 * fq;
#pragma unroll
        for (int ai = 0; ai < 2; ++ai)
#pragma unroll
            for (int m = 0; m < 4; ++m) { bf16_t* rowp = O + (size_t)(row0 + ai * HALF + m * 16) * ldc + col0;
#pragma unroll
                for (int bj = 0; bj < 2; ++bj) { const f32x4 v0 = acc[ai][bj][m][0], v1 = acc[ai][bj][m][1];
                    u32x4 w; w.x = cvt_pk_bf16(v0[0], v0[1]); w.y = cvt_pk_bf16(v0[2], v0[3]); w.z = cvt_pk_bf16(v1[0], v1[1]); w.w = cvt_pk_bf16(v1[2], v1[3]);
                    *(u32x4*)(rowp + bj * HALF) = w;
                    if (!MOE) { const size_t row = (size_t)(row0 + ai * HALF + m * 16);
                        if (kic && u.pn == 9 && bj == 1 && wc < 2) *(u32x4*)(kic + row * 64 + wc * 32 + 8 * fq) = w;
                        if (ckc && u.pn == 8 && bj == 0) *(u32x4*)(ckc + row * 128 + wc * 32 + 8 * fq) = w; } } }
    }
};
struct EpiOutRes {
    static constexpr bool PERM = false, AFTER_DRAIN = false;
    float* X; const float* gate;
    __device__ __forceinline__ void operator()(const f32x4 (&acc)[2][2][4][2], const Unit& u, int wr, int wc, int fr, int fq) const {
        const int row0 = u.pm * BM + wr * 64 + fr, col0 = u.pn * BM + wc * 32 + 4 * fq;
        const float* gp = gate + (size_t)((u.pm * BM) >> 12) * (6 * D) + col0;
        f32x4 gv[2][2];
#pragma unroll
        for (int bj = 0; bj < 2; ++bj)
#pragma unroll
            for (int n = 0; n < 2; ++n) gv[bj][n] = *(const f32x4*)(gp + bj * HALF + n * 16);
        f32x4 xa[2][2], xb[2][2];
        { const float* rowp = X + (size_t)row0 * D + col0;
#pragma unroll
          for (int bj = 0; bj < 2; ++bj)
#pragma unroll
            for (int n = 0; n < 2; ++n) xa[bj][n] = *(const f32x4*)(rowp + bj * HALF + n * 16); }
#pragma unroll
        for (int gi = 0; gi < 8; ++gi) { const int ai = gi >> 2, m = gi & 3;
            float* rowp = X + (size_t)(row0 + ai * HALF + m * 16) * D + col0;
            if (gi + 1 < 8) { const int ai2 = (gi + 1) >> 2, m2 = (gi + 1) & 3; const float* rown = X + (size_t)(row0 + ai2 * HALF + m2 * 16) * D + col0;
#pragma unroll
                for (int bj = 0; bj < 2; ++bj)
#pragma unroll
                    for (int n = 0; n < 2; ++n) { if (gi & 1) xa[bj][n] = *(const f32x4*)(rown + bj * HALF + n * 16); else xb[bj][n] = *(const f32x4*)(rown + bj * HALF + n * 16); } }
#pragma unroll
            for (int bj = 0; bj < 2; ++bj)
#pragma unroll
                for (int n = 0; n < 2; ++n) { const f32x4 xv = (gi & 1) ? xb[bj][n] : xa[bj][n]; *(f32x4*)(rowp + bj * HALF + n * 16) = xv + gv[bj][n] * acc[ai][bj][m][n]; } }
    }
};
struct EpiMoe1 {
    static constexpr bool PERM = false, AFTER_DRAIN = false;
    bf16_t* H1;
    __device__ __forceinline__ void operator()(const f32x4 (&acc)[2][2][4][2], const Unit& u, int wr, int wc, int fr, int fq) const {
        const int row0 = u.pm * BM + wr * 64 + fr, col0 = (u.pn & 3) * 128 + wc * 16 + 4 * fq;
#pragma unroll
        for (int ai = 0; ai < 2; ++ai)
#pragma unroll
            for (int m = 0; m < 4; ++m) { bf16_t* rowp = H1 + (size_t)(row0 + ai * HALF + m * 16) * 512 + col0;
#pragma unroll
                for (int bj = 0; bj < 2; ++bj) { const f32x4 g = acc[ai][bj][m][0], up = acc[ai][bj][m][1]; float h[4];
#pragma unroll
                    for (int j = 0; j < 4; ++j) h[j] = g[j] / (1.0f + __expf(-g[j])) * up[j];
                    u32x2 w; w.x = cvt_pk_bf16(h[0], h[1]); w.y = cvt_pk_bf16(h[2], h[3]);
                    *(u32x2*)(rowp + bj * 64) = w; } }
    }
};

template <class Epi, class Sched, bool GATHER = false>
__device__ __forceinline__ void gemm_phase(LAS unsigned char* lds, const Gemm g, const Sched& S, const Epi& E) {
    const int tid = ltid(), wid = __builtin_amdgcn_readfirstlane(tid >> 6), lane = tid & 63, wr = wid >> 2, wc = wid & 3, fr = lane & 15, fq = lane >> 4;
    const int K = g.K, nt = K / BK;
    unsigned voffA[2], voffB[2];
#pragma unroll
    for (int i = 0; i < 2; ++i) { int R, C; stage_rc(tid * 16 + i * 8192, R, C); const int Rb = Epi::PERM ? ((R & ~31) + perm32(R & 31)) : R;
        voffA[i] = (unsigned)(R * K + C) * 2u; voffB[i] = (unsigned)(Rb * K + C) * 2u; }
    unsigned vc0[2] = {0u, 0u}, vc1[2] = {0u, 0u}, vn0[2] = {0u, 0u}, vn1[2] = {0u, 0u};
#define PG8_GOFF(pm_, v0_, v1_) do { const int _tz = ltid(); _Pragma("unroll") for (int _i = 0; _i < 2; ++_i) { int _R, _C; stage_rc(_tz * 16 + _i * 8192, _R, _C); \
        v0_[_i] = (unsigned)g.rowtok[(pm_) * BM + _R] * (unsigned)(K * 2) + (unsigned)_C * 2u; v1_[_i] = (unsigned)g.rowtok[(pm_) * BM + HALF + _R] * (unsigned)(K * 2) + (unsigned)_C * 2u; } } while (0)
    const size_t kstep = (size_t)(BK * 2);
    const size_t hstep = (size_t)HALF * K * 2;
    const size_t tstep = 2 * hstep;
    const unsigned ldsw = (unsigned)wid * 1024u;
    const int aoff = lds_byte(wr * 64 + fr, fq * 8), boff = lds_byte(wc * 32 + fr, fq * 8);
#define PG8_SA(b, h) (((b) * 2 + (h)) * HTB)
#define PG8_SB(b, h) ((4 + (b) * 2 + (h)) * HTB)
#define PG8_STAGE(bufoff, gbase, voff) do { _Pragma("unroll") for (int _i = 0; _i < 2; ++_i) \
        __builtin_amdgcn_global_load_lds((const unsigned*)((const char*)(gbase) + (voff)[_i]), (LAS unsigned*)(lds + (bufoff) + ldsw + _i * 8192), 16, 0, 0); } while (0)
#define PG8_LDA(dst, b, h) do { _Pragma("unroll") for (int m = 0; m < 4; ++m) _Pragma("unroll") for (int k = 0; k < 2; ++k) dst[m][k] = *(const LAS bf16x8*)(lds + PG8_SA(b, h) + aoff + m * 2048 + k * 1024); } while (0)
#define PG8_LDB(dst, b, h) do { _Pragma("unroll") for (int n = 0; n < 2; ++n) _Pragma("unroll") for (int k = 0; k < 2; ++k) dst[n][k] = *(const LAS bf16x8*)(lds + PG8_SB(b, h) + boff + n * 2048 + k * 1024); } while (0)
#define PG8_MMA(ai, bj, At, Bt) do { __builtin_amdgcn_s_setprio(1); _Pragma("unroll") for (int m = 0; m < 4; ++m) _Pragma("unroll") for (int n = 0; n < 2; ++n) _Pragma("unroll") for (int k = 0; k < 2; ++k) \
        acc[ai][bj][m][n] = __builtin_amdgcn_mfma_f32_16x16x32_bf16(Bt[n][k], At[m][k], acc[ai][bj][m][n], 0, 0, 0); __builtin_amdgcn_s_setprio(0); } while (0)
#define PG8_WAIT_V(n) asm volatile("s_waitcnt vmcnt(" #n ")" ::: "memory")
#define PG8_WAIT_L(n) asm volatile("s_waitcnt lgkmcnt(" #n ")" ::: "memory")
#define PG8_BAR __builtin_amdgcn_s_barrier()
#define PG8_SCHED __builtin_amdgcn_sched_barrier(0)
    Unit cur, nxt; int ui = 0;
    if (!S.next(0, cur)) return;
    f32x4 acc[2][2][4][2];
#pragma unroll
    for (int a = 0; a < 2; ++a)
#pragma unroll
        for (int b = 0; b < 2; ++b)
#pragma unroll
            for (int m = 0; m < 4; ++m)
#pragma unroll
                for (int n = 0; n < 2; ++n) acc[a][b][m][n] = (f32x4){0.f, 0.f, 0.f, 0.f};
    bf16x8 At[4][2], B0[2][2], B1[2][2];
    const char* cA = GATHER ? (const char*)g.A : (const char*)g.A + (size_t)cur.pm * tstep; const char* cB = (const char*)g.Bt + (size_t)cur.pn * tstep;
    S.a_ready(cur);
    if constexpr (GATHER) { PG8_GOFF(cur.pm, vc0, vc1); vn0[0] = vc0[0]; vn0[1] = vc0[1]; vn1[0] = vc1[0]; vn1[1] = vc1[1]; }
    if constexpr (GATHER) { PG8_STAGE(PG8_SB(0, 0), cB, voffB); PG8_STAGE(PG8_SA(0, 0), cA, vc0); PG8_STAGE(PG8_SB(0, 1), cB + hstep, voffB); PG8_STAGE(PG8_SA(0, 1), cA, vc1); }
    else { PG8_STAGE(PG8_SB(0, 0), cB, voffB); PG8_STAGE(PG8_SA(0, 0), cA, voffA); PG8_STAGE(PG8_SB(0, 1), cB + hstep, voffB); PG8_STAGE(PG8_SA(0, 1), cA + hstep, voffA); }
    if (wr == 1) PG8_BAR;
    PG8_WAIT_V(4); PG8_BAR;
    if constexpr (GATHER) { PG8_STAGE(PG8_SB(1, 0), cB + kstep, voffB); PG8_STAGE(PG8_SA(1, 0), cA + kstep, vc0); PG8_STAGE(PG8_SB(1, 1), cB + hstep + kstep, voffB); }
    else { PG8_STAGE(PG8_SB(1, 0), cB + kstep, voffB); PG8_STAGE(PG8_SA(1, 0), cA + kstep, voffA); PG8_STAGE(PG8_SB(1, 1), cB + hstep + kstep, voffB); }
    PG8_WAIT_V(6); PG8_BAR;
    for (;;) {
        const bool has_next = S.next(ui + 1, nxt);
        const char* nA = GATHER ? cA : (has_next ? (const char*)g.A + (size_t)nxt.pm * tstep : cA); const char* nB = has_next ? (const char*)g.Bt + (size_t)nxt.pn * tstep : cB;
        if constexpr (GATHER) { if (has_next) PG8_GOFF(nxt.pm, vn0, vn1); }
        for (int t = 0; t < nt; t += 2) {
            const bool last = (t == nt - 2);
            unsigned s0[2] = {vc0[0], vc0[1]}, s1[2] = {vc1[0], vc1[1]};
            if constexpr (GATHER) { if (last) { asm volatile("" : "+v"(vn0[0]), "+v"(vn0[1]), "+v"(vn1[0]), "+v"(vn1[1])); s0[0] = vn0[0]; s0[1] = vn0[1]; s1[0] = vn1[0]; s1[1] = vn1[1]; } }
            const char* a1 = cA + (size_t)(t + 1) * kstep;
            const char* a2 = last ? nA : cA + (size_t)(t + 2) * kstep; const char* b2 = last ? nB : cB + (size_t)(t + 2) * kstep;
            const char* a3 = a2 + kstep; const char* b3 = b2 + kstep;
            if (last && has_next) S.a_ready(nxt);
            PG8_LDB(B0, 0, 0); PG8_SCHED; PG8_LDA(At, 0, 0); if constexpr (GATHER) PG8_STAGE(PG8_SA(1, 1), a1, vc1); else PG8_STAGE(PG8_SA(1, 1), a1 + hstep, voffA);
            PG8_WAIT_L(8); PG8_BAR; PG8_WAIT_L(0); PG8_MMA(0, 0, At, B0); PG8_BAR; PG8_SCHED;
            PG8_LDB(B1, 0, 1); PG8_STAGE(PG8_SB(0, 0), b2, voffB);
            PG8_BAR; PG8_WAIT_L(0); PG8_MMA(0, 1, At, B1); PG8_BAR;
            PG8_LDA(At, 0, 1); if constexpr (GATHER) PG8_STAGE(PG8_SA(0, 0), a2, s0); else PG8_STAGE(PG8_SA(0, 0), a2, voffA);
            PG8_BAR; PG8_WAIT_L(0); PG8_MMA(1, 0, At, B0); PG8_BAR; PG8_SCHED;
            PG8_STAGE(PG8_SB(0, 1), b2 + hstep, voffB);
            PG8_WAIT_V(6); PG8_BAR; PG8_MMA(1, 1, At, B1); PG8_BAR;
            PG8_LDB(B0, 1, 0); PG8_SCHED; PG8_LDA(At, 1, 0); if constexpr (GATHER) PG8_STAGE(PG8_SA(0, 1), a2, s1); else PG8_STAGE(PG8_SA(0, 1), a2 + hstep, voffA);
            PG8_WAIT_L(8); PG8_BAR; PG8_WAIT_L(0); PG8_MMA(0, 0, At, B0); PG8_BAR; PG8_SCHED;
            PG8_LDB(B1, 1, 1); PG8_STAGE(PG8_SB(1, 0), b3, voffB);
            PG8_BAR; PG8_WAIT_L(0); PG8_MMA(0, 1, At, B1); PG8_BAR;
            PG8_LDA(At, 1, 1); if constexpr (GATHER) PG8_STAGE(PG8_SA(1, 0), a3, s0); else PG8_STAGE(PG8_SA(1, 0), a3, voffA);
            PG8_BAR; PG8_WAIT_L(0); PG8_MMA(1, 0, At, B0); PG8_BAR; PG8_SCHED;
            PG8_STAGE(PG8_SB(1, 1), b3 + hstep, voffB);
            PG8_WAIT_V(6); PG8_BAR; PG8_MMA(1, 1, At, B1); PG8_BAR;
        }
        E(acc, cur, wr, wc, fr, fq); S.done(cur);
        if (!has_next) break;
#pragma unroll
        for (int a = 0; a < 2; ++a)
#pragma unroll
            for (int b = 0; b < 2; ++b)
#pragma unroll
                for (int m = 0; m < 4; ++m)
#pragma unroll
                    for (int n = 0; n < 2; ++n) acc[a][b][m][n] = (f32x4){0.f, 0.f, 0.f, 0.f};
        cur = nxt; cA = nA; cB = nB; ++ui;
        if constexpr (GATHER) { vc0[0] = vn0[0]; vc0[1] = vn0[1]; vc1[0] = vn1[0]; vc1[1] = vn1[1]; }
    }
    PG8_WAIT_V(0);
    if (wr == 0) PG8_BAR;
    PG8_BAR;
#undef PG8_GOFF
#undef PG8_SA
#undef PG8_SB
#undef PG8_STAGE
#undef PG8_LDA
#undef PG8_LDB
#undef PG8_MMA
#undef PG8_WAIT_V
#undef PG8_WAIT_L
#undef PG8_BAR
#undef PG8_SCHED
}
}
constexpr size_t MiB = 1024 * 1024;
constexpr size_t WS_CTL  = 0;
constexpr size_t CTL_BYTES = 65536;
constexpr size_t WS_MOD  = WS_CTL + CTL_BYTES;
constexpr size_t WS_BKT  = WS_MOD + 4 * 8 * 6144 * 4;
constexpr size_t WS_SP   = WS_BKT + 4096 * 4;
constexpr size_t WS_RTE  = WS_SP + (size_t)NTOK * 16 * 4;
constexpr size_t WS_RTW  = WS_RTE + (size_t)NTOK * 4;
constexpr size_t WS_POS  = WS_RTW + (size_t)NTOK * 8;
constexpr size_t WS_TC   = WS_POS + (size_t)NTOK * 8;
constexpr size_t WS_WUK  = WS_TC + 256 * 16 * 4;
constexpr size_t WS_WUV  = WS_WUK + 65536 * 2;
constexpr size_t WS_X    = 4 * MiB;
constexpr size_t WS_HBF  = WS_X + 128 * MiB;
constexpr size_t WS_P    = WS_HBF + 64 * MiB;
constexpr size_t WS_YMIX = WS_P + 192 * MiB;
constexpr size_t WS_H1   = WS_YMIX + 64 * MiB;
constexpr size_t WS_WIN  = WS_H1 + 68 * MiB;
constexpr size_t WS_WOUT = WS_WIN + 6 * MiB;
constexpr size_t WS_WGU  = WS_WOUT + 2 * MiB;
constexpr size_t WS_WDN  = WS_WGU + 32 * MiB;
constexpr size_t WS_END  = WS_WDN + 16 * MiB;
constexpr size_t WS_CL   = WS_END;
constexpr size_t WS_SCAL = WS_CL + 72 * MiB;
constexpr size_t WS_MC   = WS_SCAL + 512 * 1024;
constexpr size_t WS_KIC  = WS_MC + 1024 * 1024;
constexpr size_t WS_CKC  = WS_KIC + 4 * MiB;
constexpr size_t WS_ROWTOK = WS_MC + 512 * 1024;
constexpr size_t WS_END2 = WS_CKC + 8 * MiB;
constexpr size_t WS_CTG  = WS_HBF;
constexpr size_t WS_STG  = WS_H1 + 36 * MiB;
static_assert(WS_WUV + 65536 * 2 <= WS_X, "small region overflow");
static_assert((size_t)MOE_ROWS * 512 * 2 <= 68 * MiB, "H1");
static_assert((size_t)MOE_ROWS * 1024 * 2 <= 192 * MiB, "AS");

constexpr int CW_BAR = 0;
constexpr int CW_WQ  = 4096;

constexpr int LDS_TOTAL = 147456;
constexpr int LDS_PERS  = 143360;
constexpr int LP_SLOT = 16, LP_TBASE = 64;

struct Params { const float* in[28]; float* out; unsigned char* ws; };
enum { I_X = 0, I_C, I_WADA, I_BADA, I_GMIX, I_GFFN, I_GFINAL, I_RELB, I_ABWIN, I_ABCONVW, I_ABCONVB, I_ABGATEB, I_ABHNORM, I_ABWUK, I_ABWUV, I_ABWOUT,
       I_CDWIN, I_CDWALPHA, I_CDBALPHA, I_CDHNORM, I_CDWOUT, I_MWC, I_MBC, I_MWF, I_MBF, I_MWG, I_MWU, I_MWD };

#define TID (ltid())
#define NTHR 512

__device__ __forceinline__ void p0_prologue(const Params& p, LAS unsigned char* lds) {
    const int tid = ltid(), G = GDIM;
    LAS float* sc = (LAS float*)lds;
    LAS float* red = (LAS float*)(lds + 32768);
    const float* c = p.in[I_C];
    for (int i = tid; i < 8 * 1024; i += NTHR) { const float v = c[i]; sc[i] = v / (1.0f + __expf(-v)); }
    __syncthreads();
    float* mod = (float*)(p.ws + WS_MOD);
    for (int u = BID; u < 4 * 48; u += G) {
        const int l = u / 48, e0 = (u % 48) * 128, col = tid & 127, ds = tid >> 7;
        const float* w = p.in[I_WADA] + (size_t)l * D * 6 * D + e0 + col;
        float a[8];
#pragma unroll
        for (int b = 0; b < 8; ++b) a[b] = 0.f;
#pragma unroll 16
        for (int d = ds * 256; d < ds * 256 + 256; ++d) { const float wv = w[(size_t)d * 6 * D];
#pragma unroll
            for (int b = 0; b < 8; ++b) a[b] += sc[b * 1024 + d] * wv; }
#pragma unroll
        for (int b = 0; b < 8; ++b) red[(ds * 8 + b) * 128 + col] = a[b];
        __syncthreads();
        for (int i = tid; i < 8 * 128; i += NTHR) { const int b = i >> 7, cc = i & 127;
            const float s = ((red[(0 * 8 + b) * 128 + cc] + red[(1 * 8 + b) * 128 + cc]) + red[(2 * 8 + b) * 128 + cc]) + red[(3 * 8 + b) * 128 + cc];
            mod[((size_t)l * 8 + b) * 6 * D + e0 + cc] = s + p.in[I_BADA][(size_t)l * 6 * D + e0 + cc]; }
        __syncthreads();
    }
    int* bkt = (int*)(p.ws + WS_BKT);
    for (int n = BID * NTHR + tid; n < 4096; n += G * NTHR) {
        int v;
        if (n < 16) v = n; else { v = 16 + (int)(log((double)n / 16.0) / log(128.0) * 16.0); if (v > 31) v = 31; }
        bkt[n] = v;
    }
}

template <class SrcF>
__device__ __forceinline__ void prep_tr(LAS unsigned char* lds, const SrcF& src, int K, int Nd, bf16_t* Bt) {
    LAS float* tile = (LAS float*)lds;
    const int tid = TID, G = GDIM, tnN = Nd / 64, ntile = tnN * (K / 64);
    float cur[8], nxt[8];
    int u = BID;
    if (u < ntile) { const int tn = u % tnN, tk = u / tnN;
#pragma unroll
        for (int i = 0; i < 8; ++i) cur[i] = src(tn * 64 + (tid & 63), tk * 64 + (tid >> 6) + 8 * i); }
    for (; u < ntile; u += G) {
        const int tn = u % tnN, tk = u / tnN; const int un = u + G;
        if (un < ntile) { const int tn2 = un % tnN, tk2 = un / tnN;
#pragma unroll
            for (int i = 0; i < 8; ++i) nxt[i] = src(tn2 * 64 + (tid & 63), tk2 * 64 + (tid >> 6) + 8 * i); }
#pragma unroll
        for (int i = 0; i < 8; ++i) tile[((tid >> 6) + 8 * i) * 65 + (tid & 63)] = cur[i];
        __syncthreads();
#pragma unroll
        for (int i = 0; i < 4; ++i) { const int nn = (tid >> 5) + 16 * i, kk = (tid & 31) * 2;
            *(unsigned*)(Bt + (size_t)(tn * 64 + nn) * K + tk * 64 + kk) = pk2(tile[kk * 65 + nn], tile[(kk + 1) * 65 + nn]); }
        __syncthreads();
#pragma unroll
        for (int i = 0; i < 8; ++i) cur[i] = nxt[i];
    }
}
struct SrcShift { const float* W; int ldw, n0, shift, nvalid;
    __device__ __forceinline__ float operator()(int n, int k) const { if (n >= nvalid) return 0.f; return W[(size_t)k * ldw + (n >= n0 ? n + shift : n)]; } };
struct SrcGU { const float* Wg; const float* Wu;
    __device__ __forceinline__ float operator()(int n, int k) const { const int e = n >> 10, r = n & 1023, j = (r >> 5) * 16 + (r & 15); const unsigned long long dlt = (unsigned long long)Wu - (unsigned long long)Wg; const float* W = (const float*)((unsigned long long)Wg + (unsigned long long)((r >> 4) & 1) * dlt); return W[((size_t)e * 1024 + k) * 512 + j]; } };
struct SrcDN { const float* Wd;
    __device__ __forceinline__ float operator()(int n, int k) const { return Wd[((size_t)(n >> 10) * 512 + k) * 1024 + (n & 1023)]; } };

constexpr size_t WS_TAB = WS_WUV + 65536 * 2;
static_assert(WS_TAB + 13 * 16384 <= WS_X, "small region overflow");
struct WfAB { const float* W; __device__ __forceinline__ float operator()(int k, int c) const {
        if (c >= 12) return 0.f; const int col = c < 8 ? 1536 + c : 2504 + (c - 8); return W[(size_t)k * W_AB + col]; } };
struct WfCD { const float* W; __device__ __forceinline__ float operator()(int k, int c) const { return W[(size_t)k * W_CD + 1024 + c]; } };
struct WfRT { const float* Wc; const float* Wf; __device__ __forceinline__ float operator()(int k, int c) const {
        if (c < 4) return Wc[(size_t)k * 4 + c]; const int g = (c - 4) >> 2, e = (c - 4) & 3; return Wf[((size_t)g * D + k) * 4 + e]; } };
template <class WF>
__device__ __forceinline__ void build_small_tab(f32x4* tab, int nc4, const WF& wf) {
    for (int idx = BID * NTHR + TID; idx < nc4 * 1024; idx += GDIM * NTHR) {
        const int c4 = idx >> 10, r = idx & 1023, ij = r >> 6, lane = r & 63, k = 512 * (ij >> 3) + 8 * lane + (ij & 7);
        f32x4 v; v[0] = wf(k, 4 * c4); v[1] = wf(k, 4 * c4 + 1); v[2] = wf(k, 4 * c4 + 2); v[3] = wf(k, 4 * c4 + 3);
        tab[idx] = v; }
}
__device__ __forceinline__ void prep_layer(const Params& p, LAS unsigned char* lds, int l) {
    const int j = l >> 1;
    if ((l & 1) == 0) {
        SrcShift s{p.in[I_ABWIN] + (size_t)j * D * W_AB, W_AB, 1536, 8, 2496};
        prep_tr(lds, s, D, NP_AB, (bf16_t*)(p.ws + WS_WIN));
        SrcShift so{p.in[I_ABWOUT] + (size_t)j * D * D, D, 1 << 30, 0, D};
        prep_tr(lds, so, D, D, (bf16_t*)(p.ws + WS_WOUT));
        const float* wuk = p.in[I_ABWUK] + (size_t)j * 65536; const float* wuv = p.in[I_ABWUV] + (size_t)j * 65536;
        bf16_t* ouk = (bf16_t*)(p.ws + WS_WUK); bf16_t* ouv = (bf16_t*)(p.ws + WS_WUV);
        for (int i = BID * NTHR + TID; i < 65536; i += GDIM * NTHR) {
            ouk[i] = f2bf(wuk[i]);
            const int h = i >> 13, d = (i >> 7) & 63, r = i & 127;
            ouv[i] = f2bf(wuv[((size_t)r * 8 + h) * 64 + d]);
        }
    } else {
        SrcShift s{p.in[I_CDWIN] + (size_t)j * D * W_CD, W_CD, 1024, 16, 3072};
        prep_tr(lds, s, D, NP_CD, (bf16_t*)(p.ws + WS_WIN));
        SrcShift so{p.in[I_CDWOUT] + (size_t)j * D * D, D, 1 << 30, 0, D};
        prep_tr(lds, so, D, D, (bf16_t*)(p.ws + WS_WOUT));
    }
    { f32x4* tabg = (f32x4*)(p.ws + WS_TAB);
      if (l == 0) { WfAB wf{p.in[I_ABWIN]}; build_small_tab(tabg, 4, wf); }
      if (l + 1 < DEPTH) { const int ln = l + 1, jn = ln >> 1;
          if ((ln & 1) == 0) { WfAB wf{p.in[I_ABWIN] + (size_t)jn * D * W_AB}; build_small_tab(tabg + (ln & 1) * 4096, 4, wf); } else { WfCD wf{p.in[I_CDWIN] + (size_t)jn * D * W_CD}; build_small_tab(tabg + (ln & 1) * 4096, 4, wf); } }
      WfRT wr{p.in[I_MWC] + (size_t)l * D * 4, p.in[I_MWF] + (size_t)l * 4 * D * 4}; build_small_tab(tabg + 8 * 1024, 5, wr); }
    SrcGU sg{p.in[I_MWG] + (size_t)l * 16 * 1024 * 512, p.in[I_MWU] + (size_t)l * 16 * 1024 * 512};
    prep_tr(lds, sg, 1024, 16 * 1024, (bf16_t*)(p.ws + WS_WGU));
    SrcDN sd{p.in[I_MWD] + (size_t)l * 16 * 512 * 1024};
    prep_tr(lds, sd, 512, 16 * 1024, (bf16_t*)(p.ws + WS_WDN));
}

__device__ __forceinline__ void copy_tab_to_lds(LAS f32x4* dst, const f32x4* src, int n) { for (int i = TID; i < n; i += NTHR) dst[i] = src[i]; }
template <int NC4>
__device__ __forceinline__ void small_proj(const LAS f32x4* tab, const float (&h)[2][8], int lane, f32x4 (&out)[NC4]) {
#pragma unroll
    for (int c4 = 0; c4 < NC4; ++c4) { f32x4 a = (f32x4){0.f, 0.f, 0.f, 0.f};
#pragma unroll
        for (int i = 0; i < 2; ++i) { f32x4 t[8];
#pragma unroll
            for (int j = 0; j < 8; ++j) t[j] = tab[(c4 * 16 + i * 8 + j) * 64 + lane];
            asm volatile("" ::: "memory");
#pragma unroll
            for (int j = 0; j < 8; ++j) a += t[j] * h[i][j]; }
        out[c4] = a; asm volatile("" ::: "memory"); }
}
__device__ __forceinline__ float reduce16(const f32x4 (&a)[4], int lane) {
    const bool b5 = (lane & 32) != 0, b4 = (lane & 16) != 0, b3 = (lane & 8) != 0, b2 = (lane & 4) != 0;
    float w8[8], w4[4], w2[2];
#pragma unroll
    for (int c = 0; c < 8; ++c) { const float lo = a[c >> 2][c & 3], hi = a[(c + 8) >> 2][c & 3]; w8[c] = (b5 ? hi : lo) + __shfl_xor(b5 ? lo : hi, 32); }
#pragma unroll
    for (int c = 0; c < 4; ++c) w4[c] = (b4 ? w8[c + 4] : w8[c]) + __shfl_xor(b4 ? w8[c] : w8[c + 4], 16);
#pragma unroll
    for (int c = 0; c < 2; ++c) w2[c] = (b3 ? w4[c + 2] : w4[c]) + __shfl_xor(b3 ? w4[c] : w4[c + 2], 8);
    float w1 = (b2 ? w2[1] : w2[0]) + __shfl_xor(b2 ? w2[0] : w2[1], 4);
    w1 += __shfl_xor(w1, 2); w1 += __shfl_xor(w1, 1);
    return w1;
}
__device__ __forceinline__ float reduce4(const f32x4& a, int lane) {
    const bool b5 = (lane & 32) != 0, b4 = (lane & 16) != 0;
    const float u0 = (b5 ? a[2] : a[0]) + __shfl_xor(b5 ? a[0] : a[2], 32), u1 = (b5 ? a[3] : a[1]) + __shfl_xor(b5 ? a[1] : a[3], 32);
    float w = (b4 ? u1 : u0) + __shfl_xor(b4 ? u0 : u1, 16);
    w += __shfl_xor(w, 8); w += __shfl_xor(w, 4); w += __shfl_xor(w, 2); w += __shfl_xor(w, 1);
    return w;
}
__device__ __forceinline__ float rdl(float v, int l) { return __int_as_float(__builtin_amdgcn_readlane(__float_as_int(v), l)); }
__device__ __forceinline__ void unpack8(const u32x4& v, float (&o)[8]) {
#pragma unroll
    for (int e = 0; e < 4; ++e) { o[2 * e] = __uint_as_float(v[e] << 16); o[2 * e + 1] = __uint_as_float(v[e] & 0xffff0000u); } }

template <int MODE>
__device__ __forceinline__ void phase_tokens(const Params& p, LAS unsigned char* lds, int l) {
    const int tid = ltid(), lane = tid & 63, wave = tid >> 6, G = GDIM;
    LAS f32x4* tab = (LAS f32x4*)lds;
    LAS int* cnts = (LAS int*)(lds + 5 * 16384);
    if (MODE == 1) copy_tab_to_lds(tab, (const f32x4*)(p.ws + WS_TAB) + (l & 1) * 4096, 4 * 1024);
    if (MODE == 2) copy_tab_to_lds(tab, (const f32x4*)(p.ws + WS_TAB) + 8 * 1024, 5 * 1024);
    __syncthreads();
    const float* mod = (const float*)(p.ws + WS_MOD);
    float* X = (float*)(p.ws + WS_X); bf16_t* HBF = (bf16_t*)(p.ws + WS_HBF); float* SP = (float*)(p.ws + WS_SP);
    const bf16_t* YS = (const bf16_t*)(p.ws + WS_P);
    const int* POS = (const int*)(p.ws + WS_POS); float* RTW = (float*)(p.ws + WS_RTW); int* RTE = (int*)(p.ws + WS_RTE); int* TC = (int*)(p.ws + WS_TC);
    const bool comb = (MODE == 3) || (MODE == 1 && l > 0);
    const int lprev = (MODE == 3) ? 3 : l - 1;
    const float* biasc = p.in[I_MBC] + l * 4; const float* biasf = p.in[I_MBF] + l * 16;
    for (int grp = BID; grp < NTOK / 128; grp += G) {
        const int b = (grp * 128) >> 12;
        float ca[2][8], cb[2][8], gf[2][8];
#pragma unroll
        for (int i = 0; i < 2; ++i)
#pragma unroll
            for (int j = 0; j < 8; ++j) { const int col = 512 * i + 8 * lane + j;
                if (MODE == 1) { const float* mrow = mod + ((size_t)l * 8 + b) * 6 * D; ca[i][j] = p.in[I_GMIX][(size_t)l * D + col] * (mrow[D + col] + 1.0f); cb[i][j] = mrow[col]; }
                if (MODE == 2) { const float* mrow = mod + ((size_t)l * 8 + b) * 6 * D; ca[i][j] = p.in[I_GFFN][(size_t)l * D + col] * (mrow[4 * D + col] + 1.0f); cb[i][j] = mrow[3 * D + col]; }
                if (MODE == 3) { ca[i][j] = p.in[I_GFINAL][col]; cb[i][j] = 0.f; }
                gf[i][j] = comb ? mod[((size_t)lprev * 8 + b) * 6 * D + 5 * D + col] : 0.f; }
        int pos1v = 0, pos2v = 0; float w1v = 0.f, w2v = 0.f;
        if (comb && lane < 16) { const int tk = grp * 128 + wave * 16 + lane; pos1v = POS[2 * tk]; pos2v = POS[2 * tk + 1]; w1v = RTW[2 * tk]; w2v = RTW[2 * tk + 1]; }
        const float* xsrc = (MODE == 1 && l == 0) ? p.in[I_X] : X;
        LAS unsigned char* mb = lds + ((MODE == 2) ? (5 * 16384 + 1024) : (4 * 16384 + 1024)) + __builtin_amdgcn_readfirstlane(wave) * ((MODE == 2) ? 4096 : 8192);
#define TOK_ISSUE(tt_) do { const int tok_ = grp * 128 + wave * 16 + (tt_); \
            __builtin_amdgcn_global_load_lds((const unsigned*)(xsrc + (size_t)tok_ * D + 8 * lane), (LAS unsigned*)(mb), 16, 0, 0); \
            __builtin_amdgcn_global_load_lds((const unsigned*)(xsrc + (size_t)tok_ * D + 8 * lane + 4), (LAS unsigned*)(mb + 1024), 16, 0, 0); \
            __builtin_amdgcn_global_load_lds((const unsigned*)(xsrc + (size_t)tok_ * D + 512 + 8 * lane), (LAS unsigned*)(mb + 2048), 16, 0, 0); \
            __builtin_amdgcn_global_load_lds((const unsigned*)(xsrc + (size_t)tok_ * D + 512 + 8 * lane + 4), (LAS unsigned*)(mb + 3072), 16, 0, 0); \
            if (comb) { const int q1_ = __builtin_amdgcn_readlane(pos1v, (tt_)), q2_ = __builtin_amdgcn_readlane(pos2v, (tt_)); \
                __builtin_amdgcn_global_load_lds((const unsigned*)(YS + (size_t)q1_ * D + 8 * lane), (LAS unsigned*)(mb + 4096), 16, 0, 0); \
                __builtin_amdgcn_global_load_lds((const unsigned*)(YS + (size_t)q1_ * D + 512 + 8 * lane), (LAS unsigned*)(mb + 5120), 16, 0, 0); \
                __builtin_amdgcn_global_load_lds((const unsigned*)(YS + (size_t)q2_ * D + 8 * lane), (LAS unsigned*)(mb + 6144), 16, 0, 0); \
                __builtin_amdgcn_global_load_lds((const unsigned*)(YS + (size_t)q2_ * D + 512 + 8 * lane), (LAS unsigned*)(mb + 7168), 16, 0, 0); } } while (0)
        TOK_ISSUE(0);
        int cnt = 0;
#pragma unroll 1
        for (int tt = 0; tt < 16; ++tt) {
            const int tok = grp * 128 + wave * 16 + tt;
            asm volatile("s_waitcnt vmcnt(0)" ::: "memory");
            u32x4 xb[4], yb[4];
#pragma unroll
            for (int k4 = 0; k4 < 4; ++k4) xb[k4] = *(const LAS u32x4*)(mb + k4 * 1024 + lane * 16);
            if (comb) {
#pragma unroll
                for (int k4 = 0; k4 < 4; ++k4) yb[k4] = *(const LAS u32x4*)(mb + 4096 + k4 * 1024 + lane * 16);
            }
            asm volatile("s_waitcnt lgkmcnt(0)" ::: "memory");
            float x[2][8];
#pragma unroll
            for (int i = 0; i < 2; ++i)
#pragma unroll
                for (int j = 0; j < 8; ++j) x[i][j] = __uint_as_float(xb[2 * i + (j >> 2)][j & 3]);
            if (comb) { const float w1 = rdl(w1v, tt), w2 = rdl(w2v, tt);
#pragma unroll
                for (int i = 0; i < 2; ++i) { float y1[8], y2[8]; unpack8(yb[i], y1); unpack8(yb[2 + i], y2);
#pragma unroll
                    for (int j = 0; j < 8; ++j) x[i][j] += gf[i][j] * (y1[j] * w1 + y2[j] * w2); } }
            if (tt + 1 < 16) TOK_ISSUE(tt + 1);
            asm volatile("" ::: "memory");
            float ss = 0.f;
#pragma unroll
            for (int i = 0; i < 2; ++i)
#pragma unroll
                for (int j = 0; j < 8; ++j) ss += x[i][j] * x[i][j];
            ss = wave_sum(ss);
            const float rstd = 1.0f / sqrtf(ss * (1.0f / 1024.0f) + 1e-6f);
            float h[2][8];
#pragma unroll
            for (int i = 0; i < 2; ++i)
#pragma unroll
                for (int j = 0; j < 8; ++j) h[i][j] = x[i][j] * rstd * ca[i][j] + cb[i][j];
            if (MODE == 1) {
#pragma unroll
                for (int i = 0; i < 2; ++i) { *(f32x4*)(X + (size_t)tok * D + 512 * i + 8 * lane) = (f32x4){x[i][0], x[i][1], x[i][2], x[i][3]}; *(f32x4*)(X + (size_t)tok * D + 512 * i + 8 * lane + 4) = (f32x4){x[i][4], x[i][5], x[i][6], x[i][7]}; }
            }
            if (MODE == 3) {
#pragma unroll
                for (int i = 0; i < 2; ++i) { *(f32x4*)(p.out + (size_t)tok * D + 512 * i + 8 * lane) = (f32x4){h[i][0], h[i][1], h[i][2], h[i][3]}; *(f32x4*)(p.out + (size_t)tok * D + 512 * i + 8 * lane + 4) = (f32x4){h[i][4], h[i][5], h[i][6], h[i][7]}; }
            } else {
#pragma unroll
                for (int i = 0; i < 2; ++i) { u32x4 w; w.x = pk2(h[i][0], h[i][1]); w.y = pk2(h[i][2], h[i][3]); w.z = pk2(h[i][4], h[i][5]); w.w = pk2(h[i][6], h[i][7]); *(u32x4*)(HBF + (size_t)tok * D + 512 * i + 8 * lane) = w; }
            }
            if (MODE == 1) {
                f32x4 o[4]; o[3] = (f32x4){0.f, 0.f, 0.f, 0.f};
                if ((l & 1) == 0) { f32x4 o3[3]; small_proj<3>(tab, h, lane, o3); o[0] = o3[0]; o[1] = o3[1]; o[2] = o3[2]; }
                else small_proj<4>(tab, h, lane, o);
                const float v = reduce16(o, lane);
                if ((lane & 3) == 0) SP[(size_t)tok * 16 + (lane >> 2)] = v;
            }
            if (MODE == 2) {
                f32x4 oc = (f32x4){0.f, 0.f, 0.f, 0.f};
#pragma unroll
                for (int i = 0; i < 2; ++i) { f32x4 t[8];
#pragma unroll
                  for (int jj = 0; jj < 8; ++jj) t[jj] = tab[(i * 8 + jj) * 64 + lane];
                  asm volatile("" ::: "memory");
#pragma unroll
                  for (int jj = 0; jj < 8; ++jj) oc += t[jj] * h[i][jj]; }
                const float vc = reduce4(oc, lane);
                float lc[4];
#pragma unroll
                for (int c = 0; c < 4; ++c) lc[c] = rdl(vc, 16 * c) + biasc[c];
                int g = 0; float mx = lc[0];
#pragma unroll
                for (int c = 1; c < 4; ++c) if (lc[c] > mx) { mx = lc[c]; g = c; }
                g = __builtin_amdgcn_readfirstlane(g);
                float se = 0.f;
#pragma unroll
                for (int c = 0; c < 4; ++c) se += expf(lc[c] - mx);
                const float pg = 1.0f / se;
                f32x4 of = (f32x4){0.f, 0.f, 0.f, 0.f};
                const LAS f32x4* tabf = tab + (1 + g) * 1024;
#pragma unroll
                for (int i = 0; i < 2; ++i) { f32x4 t[8];
#pragma unroll
                  for (int jj = 0; jj < 8; ++jj) t[jj] = tabf[(i * 8 + jj) * 64 + lane];
                  asm volatile("" ::: "memory");
#pragma unroll
                  for (int jj = 0; jj < 8; ++jj) of += t[jj] * h[i][jj]; }
                const float vf = reduce4(of, lane);
                float lf[4];
#pragma unroll
                for (int e = 0; e < 4; ++e) lf[e] = rdl(vf, 16 * e) + biasf[g * 4 + e];
                int i1 = 0; float v1 = lf[0];
#pragma unroll
                for (int e = 1; e < 4; ++e) if (lf[e] > v1) { v1 = lf[e]; i1 = e; }
                int i2 = -1; float v2 = -3.0e38f;
#pragma unroll
                for (int e = 0; e < 4; ++e) if (e != i1 && lf[e] > v2) { v2 = lf[e]; i2 = e; }
                const float ex = expf(v2 - v1); const float p1 = 1.0f / (1.0f + ex), p2 = ex / (1.0f + ex);
                const int e1 = g * 4 + i1, e2 = g * 4 + i2;
                if (lane == 0) { RTE[tok] = e1 | (e2 << 8); RTW[2 * tok] = pg * p1; RTW[2 * tok + 1] = pg * p2; }
                cnt += (lane == e1 ? 1 : 0) + (lane == e2 ? 1 : 0);
            }
        }
#undef TOK_ISSUE
        if (MODE == 2) {
            __syncthreads();
            if (lane < 16) cnts[wave * 16 + lane] = cnt;
            __syncthreads();
            if (tid < 16) { int s = 0;
#pragma unroll
                for (int w = 0; w < 8; ++w) s += cnts[w * 16 + tid];
                TC[grp * 16 + tid] = s; }
        }
    }
}
__device__ __forceinline__ void phase_norm1(const Params& p, LAS unsigned char* lds, int l) { phase_tokens<1>(p, lds, l); }
__device__ __forceinline__ void phase_norm2(const Params& p, LAS unsigned char* lds, int l) { phase_tokens<2>(p, lds, l); }

__device__ __forceinline__ void phase_dispatch(const Params& p, LAS unsigned char* lds, LAS int* tbase) {
    const int tid = ltid(), lane = tid & 63, wave = tid >> 6, G = GDIM;
    LAS int* tc = (LAS int*)lds;
    LAS int* part = (LAS int*)(lds + 16384);
    LAS int* tot = (LAS int*)(lds + 16384 + 4096);
    LAS int* toff = (LAS int*)(lds + 16384 + 4096 + 128);
    LAS int* wcnt = (LAS int*)(lds + 16384 + 4096 + 256);
    const int* TC = (const int*)(p.ws + WS_TC); const int* RTE = (const int*)(p.ws + WS_RTE);
    int* POS = (int*)(p.ws + WS_POS);
    int* ROWTOK = (int*)(p.ws + WS_ROWTOK);
    for (int i = tid; i < 256 * 16; i += NTHR) tc[i] = TC[i];
    __syncthreads();
    { const int e = tid & 15, c8 = tid >> 4; int sa = 0;
#pragma unroll
      for (int q = 0; q < 8; ++q) sa += tc[(c8 * 8 + q) * 16 + e];
      part[c8 * 16 + e] = sa; }
    __syncthreads();
    if (tid < 16) { int sa = 0;
#pragma unroll
        for (int c8 = 0; c8 < 32; ++c8) sa += part[c8 * 16 + tid];
        tot[tid] = sa; }
    __syncthreads();
    if (tid == 0) { int rb = 0; for (int e = 0; e < 16; ++e) { tot[16 + e] = rb; tbase[e] = rb >> 8; rb += (tot[e] + 255) & ~255; } tbase[16] = rb >> 8; }
    __syncthreads();
    for (int grp = BID; grp < NTOK / 128; grp += G) {
        { const int e = tid & 15, c8 = tid >> 4; int sb = 0;
#pragma unroll
          for (int q = 0; q < 8; ++q) { const int gq = c8 * 8 + q; sb += (gq < grp) ? tc[gq * 16 + e] : 0; }
          part[512 + c8 * 16 + e] = sb; }
        int e_me = 0, rank_l = 0;
        if (tid < 256) { const int ee = RTE[grp * 128 + (tid >> 1)]; e_me = (tid & 1) ? ((ee >> 8) & 255) : (ee & 255); }
        if (wave < 4) {
            const unsigned long long lt = (lane == 0) ? 0ull : (~0ull >> (64 - lane));
#pragma unroll
            for (int e = 0; e < 16; ++e) { const unsigned long long m = __ballot(e_me == e); if (e_me == e) rank_l = __popcll(m & lt); if (lane == 0) wcnt[wave * 16 + e] = __popcll(m); }
        }
        __syncthreads();
        if (tid < 16) { int sb = 0;
#pragma unroll
            for (int c8 = 0; c8 < 32; ++c8) sb += part[512 + c8 * 16 + tid];
            toff[tid] = sb; }
        __syncthreads();
        if (tid < 256) { int rank = rank_l;
#pragma unroll
            for (int w = 0; w < 3; ++w) rank += (w < wave) ? wcnt[w * 16 + e_me] : 0;
            const int pos = tot[16 + e_me] + toff[e_me] + rank; POS[(size_t)(grp * 128) * 2 + tid] = pos; ROWTOK[pos] = grp * 128 + (tid >> 1); }
        __syncthreads();
    }
    for (int e = 0; e < 16; ++e) { const int lo_ = tot[16 + e] + tot[e], hi_ = tot[16 + e] + ((tot[e] + 255) & ~255); for (int r = lo_ + tid; r < hi_; r += NTHR) ROWTOK[r] = 0; }
}

__device__ __forceinline__ void phase_final(const Params& p, LAS unsigned char* lds) { phase_tokens<3>(p, lds, 3); }
__device__ __forceinline__ f32x4 mfma16(bf16x8 a, bf16x8 b, f32x4 c) { return __builtin_amdgcn_mfma_f32_16x16x32_bf16(a, b, c, 0, 0, 0); }
__device__ __forceinline__ bf16x8 ldfrag(const LAS unsigned char* base, int row, int stride_bytes, int kk, int g) { return *(const LAS bf16x8*)(base + row * stride_bytes + (kk * 32 + g * 8) * 2); }
__device__ __forceinline__ float scan_add(float v, int lane) {
#pragma unroll
    for (int o = 1; o < 64; o <<= 1) { const float t = __shfl_up(v, o); if (lane >= o) v += t; }
    return v;
}
__device__ __forceinline__ float scan_max(float v, int lane) {
#pragma unroll
    for (int o = 1; o < 64; o <<= 1) { const float t = __shfl_up(v, o); if (lane >= o) v = fmaxf(v, t); }
    return v;
}
__device__ __forceinline__ float bfe(const u32x4& v, int e) { const unsigned w = v[e >> 1]; return __uint_as_float((e & 1) ? (w & 0xffff0000u) : (w << 16)); }
__device__ __forceinline__ bf16_t bfr(const u32x4& v, int e) { const unsigned w = v[e >> 1]; return (bf16_t)((e & 1) ? (w >> 16) : (w & 0xffffu)); }

constexpr int RS = 144;

__device__ __forceinline__ void unit_mlstm_L(const Params& p, LAS unsigned char* lds, int j, int b, int h, int ck) {
    const int tid = ltid(), lane = tid & 63, wave = __builtin_amdgcn_readfirstlane(tid >> 6), fr = lane & 15, g = lane >> 4;
    LAS unsigned char* KWT = lds; LAS unsigned char* VT = lds + 9216; LAS float* GA = (LAS float*)(lds + 29952);
    const bf16_t* P = (const bf16_t*)(p.ws + WS_P); const float* SP = (const float*)(p.ws + WS_SP);
    float* CL = (float*)(p.ws + WS_CL); float* SCAL = (float*)(p.ws + WS_SCAL);
    const int unit = (b * 4 + h) * 64 + ck; const int tok0 = b * SEQ + ck * 64;
    const int t = tid >> 3, seg = tid & 7, kc0 = 256 + h * 64 + seg * 8, pos = ck * 64 + t;

    u32x4 kin[4], vin[2];
#pragma unroll
    for (int q = 0; q < 4; ++q) { const int pp = pos - 3 + q; kin[q] = (pp >= 0) ? *(const u32x4*)(P + (size_t)(b * SEQ + pp) * NP_AB + kc0) : (u32x4){0u, 0u, 0u, 0u}; }
#pragma unroll
    for (int i = 0; i < 2; ++i) { const int idx = tid + 512 * i; vin[i] = *(const u32x4*)(P + (size_t)(tok0 + (idx >> 4)) * NP_AB + AB_VA + h * 128 + (idx & 15) * 8); }
    float we;
    {
        const int tok = tok0 + lane;
        const float li = SP[(size_t)tok * 16 + h] + p.in[I_ABGATEB][j * 8 + h]; const float lf = logsigmoidf_(SP[(size_t)tok * 16 + 4 + h] + p.in[I_ABGATEB][j * 8 + 4 + h]);
        const float bc = scan_add(lf, lane); const float a = li - bc; const float amax = __shfl(scan_max(a, lane), 63);
        we = __shfl(__expf(a - amax), t & 63);
        if (wave == 0 && lane == 63) { SCAL[unit * 2] = bc; SCAL[unit * 2 + 1] = amax; }
    }
    for (int i = tid; i < 16 * 72; i += NTHR) { const int r = i / 72; ((LAS bf16_t*)VT)[(128 + r) * 72 + (i % 72)] = (r == 0) ? (bf16_t)0x3F80 : (bf16_t)0; }
    { const float* convw = p.in[I_ABCONVW] + (size_t)j * 4 * 512 + kc0; const float* convb = p.in[I_ABCONVB] + j * 512 + kc0;
#pragma unroll
      for (int e = 0; e < 8; ++e) { float acc = convb[e];
#pragma unroll
        for (int q = 0; q < 4; ++q) acc += convw[q * 512 + e] * bfe(kin[q], e);
        const float v = acc / (1.0f + __expf(-acc)); ((LAS bf16_t*)KWT)[(seg * 8 + e) * 72 + t] = f2bf(v * we); } }
#pragma unroll
    for (int i = 0; i < 2; ++i) { const int idx = tid + 512 * i; const int s = idx >> 4, sg = idx & 15;
#pragma unroll
        for (int e = 0; e < 8; ++e) ((LAS bf16_t*)VT)[(sg * 8 + e) * 72 + s] = bfr(vin[i], e); }
    __syncthreads();

#pragma unroll
    for (int i = 0; i < 5; ++i) { const int id = wave + 8 * i;
        if (id < 36) { const int tk = id / 9, tv = id % 9; f32x4 acc = (f32x4){0.f, 0.f, 0.f, 0.f};
#pragma unroll
            for (int kk = 0; kk < 2; ++kk) acc = mfma16(ldfrag(KWT, tk * 16 + fr, RS, kk, g), ldfrag(VT, tv * 16 + fr, RS, kk, g), acc);
#pragma unroll
            for (int r = 0; r < 4; ++r) CL[(size_t)unit * 9216 + (tk * 16 + 4 * g + r) * 144 + tv * 16 + fr] = acc[r]; } }
    __syncthreads();

}

__device__ __forceinline__ void phase_scan_mlstm(const Params& p) {
    const float* CL = (const float*)(p.ws + WS_CL); const float* SCAL = (const float*)(p.ws + WS_SCAL); float* MC = (float*)(p.ws + WS_MC); bf16_t* CTG = (bf16_t*)(p.ws + WS_CTG);
    for (int e = BID * NTHR + TID; e < 32 * 9216; e += GDIM * NTHR) {
        const int bh = e / 9216, r = e % 9216;
        float C = 0.f, m = -1e30f;
#pragma unroll 1
        for (int c0 = 0; c0 < 64; c0 += 8) { float v[8], sb[8], sa[8];
#pragma unroll
            for (int i = 0; i < 8; ++i) { v[i] = CL[(size_t)(bh * 64 + c0 + i) * 9216 + r]; sb[i] = SCAL[(bh * 64 + c0 + i) * 2]; sa[i] = SCAL[(bh * 64 + c0 + i) * 2 + 1]; }
#pragma unroll
            for (int i = 0; i < 8; ++i) { const int unit = bh * 64 + c0 + i; const float bL = sb[i], amax = sa[i];
                CTG[(size_t)unit * 9216 + r] = f2bf(C); if (r == 0) MC[unit] = m;
                const float M = fmaxf(m, amax); C = __expf(m - M) * C + __expf(amax - M) * v[i]; m = bL + M; } }
    }
}

struct MlstmOIn { u32x4 qkin[2][4], vin[2], cin[3], oin[2]; float sp_i, sp_f, mc; };
__device__ __forceinline__ void mlstm_O_issue(const Params& p, int b, int h, int ck, MlstmOIn& r) {
    const int tid = ltid(), lane = tid & 63;
    const bf16_t* P = (const bf16_t*)(p.ws + WS_P); const float* SP = (const float*)(p.ws + WS_SP);
    const bf16_t* CTG = (const bf16_t*)(p.ws + WS_CTG); const float* MC = (const float*)(p.ws + WS_MC);
    const int unit = (b * 4 + h) * 64 + ck; const int tok0 = b * SEQ + ck * 64;
    const int sg = tid & 15; const int ch0 = (sg < 8) ? h * 64 + sg * 8 : 256 + h * 64 + (sg - 8) * 8;
#pragma unroll
    for (int i = 0; i < 2; ++i) { const int tt = (tid + 512 * i) >> 4; const int pos = ck * 64 + tt;
#pragma unroll
        for (int q = 0; q < 4; ++q) { const int pp = pos - 3 + q; r.qkin[i][q] = (pp >= 0) ? *(const u32x4*)(P + (size_t)(b * SEQ + pp) * NP_AB + ch0) : (u32x4){0u, 0u, 0u, 0u}; }
        r.vin[i] = *(const u32x4*)(P + (size_t)(tok0 + tt) * NP_AB + AB_VA + h * 128 + sg * 8);
        r.oin[i] = *(const u32x4*)(P + (size_t)(tok0 + tt) * NP_AB + AB_OA + h * 128 + sg * 8); }
#pragma unroll
    for (int i = 0; i < 3; ++i) { const int idx = tid + 512 * i; r.cin[i] = (idx < 1152) ? *(const u32x4*)(CTG + (size_t)unit * 9216 + idx * 8) : (u32x4){0u, 0u, 0u, 0u}; }
    r.sp_i = SP[(size_t)(tok0 + lane) * 16 + h]; r.sp_f = SP[(size_t)(tok0 + lane) * 16 + 4 + h]; r.mc = MC[unit];
}
__device__ __forceinline__ void mlstm_O_compute(const Params& p, LAS unsigned char* lds, int j, int b, int h, int ck, const MlstmOIn& rg) {
    const int tid = ltid(), lane = tid & 63, wave = __builtin_amdgcn_readfirstlane(tid >> 6), fr = lane & 15, g = lane >> 4;
    LAS unsigned char* QS = lds; LAS unsigned char* KS = lds + 9216; LAS unsigned char* VT = lds + 18432; LAS unsigned char* CT = lds + 39168; LAS unsigned char* PS = lds + 59904;
    LAS float* OS = (LAS float*)(lds + 69120); LAS float* GA = (LAS float*)(lds + 107008);
    constexpr int OSS = 148;
    bf16_t* YMIX = (bf16_t*)(p.ws + WS_YMIX);
    const int tok0 = b * SEQ + ck * 64;
    const int sg = tid & 15;
    const int ch0 = (sg < 8) ? h * 64 + sg * 8 : 256 + h * 64 + (sg - 8) * 8;
    const u32x4 (&qkin)[2][4] = rg.qkin; const u32x4 (&vin)[2] = rg.vin; const u32x4 (&cin)[3] = rg.cin; const u32x4 (&oin)[2] = rg.oin;
    {
        const float mc = rg.mc;
        const float li = rg.sp_i + p.in[I_ABGATEB][j * 8 + h]; const float lf = logsigmoidf_(rg.sp_f + p.in[I_ABGATEB][j * 8 + 4 + h]);
        const float bc = scan_add(lf, lane); const float a = li - bc; const float M = fmaxf(mc, scan_max(a, lane));
        GA[lane] = a; GA[64 + lane] = M; GA[128 + lane] = __expf(mc - M); GA[192 + lane] = __expf(-(bc + M));
    }
    for (int i = tid; i < 16 * 72; i += NTHR) { const int r = i / 72; ((LAS bf16_t*)VT)[(128 + r) * 72 + (i % 72)] = (r == 0) ? (bf16_t)0x3F80 : (bf16_t)0; }
    { const float* convw = p.in[I_ABCONVW] + (size_t)j * 4 * 512 + ch0; const float* convb = p.in[I_ABCONVB] + j * 512 + ch0;
      float cw[4][8], cb[8];
#pragma unroll
      for (int e = 0; e < 8; ++e) { cb[e] = convb[e];
#pragma unroll
        for (int q = 0; q < 4; ++q) cw[q][e] = convw[q * 512 + e]; }
      const float qs = (sg < 8) ? 0.125f : 1.0f;
#pragma unroll
      for (int i = 0; i < 2; ++i) { const int tt = (tid + 512 * i) >> 4; float o[8];
#pragma unroll
        for (int e = 0; e < 8; ++e) { float acc = cb[e];
#pragma unroll
            for (int q = 0; q < 4; ++q) acc += cw[q][e] * bfe(qkin[i][q], e);
            o[e] = acc / (1.0f + __expf(-acc)) * qs; }
        u32x4 w; w.x = pk2(o[0], o[1]); w.y = pk2(o[2], o[3]); w.z = pk2(o[4], o[5]); w.w = pk2(o[6], o[7]);
        *(LAS u32x4*)(((sg < 8) ? QS : KS) + tt * RS + (sg & 7) * 16) = w;
#pragma unroll
        for (int e = 0; e < 8; ++e) ((LAS bf16_t*)VT)[(sg * 8 + e) * 72 + tt] = bfr(vin[i], e); } }
#pragma unroll
    for (int i = 0; i < 3; ++i) { const int idx = tid + 512 * i;
        if (idx < 1152) { const int dk = idx / 18, sv = idx % 18;
#pragma unroll
            for (int e = 0; e < 8; ++e) ((LAS bf16_t*)CT)[(sv * 8 + e) * 72 + dk] = bfr(cin[i], e); } }
    __syncthreads();
    { const int tq = wave >> 1;
#pragma unroll
      for (int u = 0; u < 2; ++u) { const int ts = (wave & 1) * 2 + u; f32x4 acc = (f32x4){0.f, 0.f, 0.f, 0.f};
        if (ts <= tq) {
#pragma unroll
            for (int kk = 0; kk < 2; ++kk) acc = mfma16(ldfrag(QS, tq * 16 + fr, RS, kk, g), ldfrag(KS, ts * 16 + fr, RS, kk, g), acc);
        }
        const int s = ts * 16 + fr; const float as = GA[s];
#pragma unroll
        for (int r = 0; r < 4; ++r) { const int t = tq * 16 + 4 * g + r; const float pv = (ts <= tq && s <= t) ? acc[r] * __expf(as - GA[64 + t]) : 0.f; ((LAS bf16_t*)PS)[t * 72 + s] = f2bf(pv); } } }
    __syncthreads();
#pragma unroll
    for (int i = 0; i < 5; ++i) { const int id = wave + 8 * i;
        if (id < 36) { const int tq = id / 9, tv = id % 9; f32x4 acc = (f32x4){0.f, 0.f, 0.f, 0.f};
#pragma unroll
            for (int kk = 0; kk < 2; ++kk) acc = mfma16(ldfrag(QS, tq * 16 + fr, RS, kk, g), ldfrag(CT, tv * 16 + fr, RS, kk, g), acc);
#pragma unroll
            for (int r = 0; r < 4; ++r) acc[r] *= GA[128 + tq * 16 + 4 * g + r];
#pragma unroll
            for (int kk = 0; kk < 2; ++kk) acc = mfma16(ldfrag(PS, tq * 16 + fr, RS, kk, g), ldfrag(VT, tv * 16 + fr, RS, kk, g), acc);
#pragma unroll
            for (int r = 0; r < 4; ++r) OS[(tq * 16 + 4 * g + r) * OSS + tv * 16 + fr] = acc[r]; } }
    __syncthreads();
    { const float* hgp = p.in[I_ABHNORM] + j * 512 + h * 128 + sg * 8;
#pragma unroll
      for (int i = 0; i < 2; ++i) { const int tt = (tid + 512 * i) >> 4;
        const float den = OS[tt * OSS + 128]; const float dn = fmaxf(fabsf(den), GA[192 + tt]); const float idn = 1.0f / dn;
        const f32x4 a0 = *(const LAS f32x4*)(OS + tt * OSS + sg * 8), a1 = *(const LAS f32x4*)(OS + tt * OSS + sg * 8 + 4);
        float hv[8] = {a0[0] * idn, a0[1] * idn, a0[2] * idn, a0[3] * idn, a1[0] * idn, a1[1] * idn, a1[2] * idn, a1[3] * idn};
        float ss = 0.f;
#pragma unroll
        for (int e = 0; e < 8; ++e) ss += hv[e] * hv[e];
        ss += __shfl_xor(ss, 1); ss += __shfl_xor(ss, 2); ss += __shfl_xor(ss, 4); ss += __shfl_xor(ss, 8);
        const float rn = 1.0f / sqrtf(ss * (1.0f / 128.0f) + 1e-6f);
        float y[8];
#pragma unroll
        for (int e = 0; e < 8; ++e) y[e] = hv[e] * rn * hgp[e] * sigmoidf_(bfe(oin[i], e));
        u32x4 w; w.x = pk2(y[0], y[1]); w.y = pk2(y[2], y[3]); w.z = pk2(y[4], y[5]); w.w = pk2(y[6], y[7]);
        *(u32x4*)(YMIX + (size_t)(tok0 + tt) * D + h * 128 + sg * 8) = w; } }
    __syncthreads();
}

__device__ __forceinline__ void unit_mlstm_O(const Params& p, LAS unsigned char* lds, int j, int b, int h, int ck) { MlstmOIn r; mlstm_O_issue(p, b, h, ck, r); mlstm_O_compute(p, lds, j, b, h, ck, r); }

__device__ __forceinline__ float rdlf(float v, int l) { return __int_as_float(__builtin_amdgcn_readlane(__float_as_int(v), l)); }
__device__ __forceinline__ void gla_cumsum(const Params& p, int j, int h, int tok0, int lane, int wave, LAS float* BS, LAS float* BL, float* scal_unit) {
    const float* SP = (const float*)(p.ws + WS_SP);
    f32x4 gq[4];
#pragma unroll
    for (int r = 0; r < 4; ++r) gq[r] = *(const f32x4*)(SP + (size_t)(tok0 + lane) * 16 + 4 * r);
    const float* wa = p.in[I_CDWALPHA] + (size_t)j * 16 * 256 + h * 64 + wave * 8; const float* ba = p.in[I_CDBALPHA] + j * 256 + h * 64 + wave * 8;
    const float wv0 = wa[(lane >> 3) * 256 + (lane & 7)], wv1 = wa[(8 + (lane >> 3)) * 256 + (lane & 7)], bv = ba[lane & 7];
#pragma unroll
    for (int i = 0; i < 8; ++i) { float z = rdlf(bv, i);
#pragma unroll
        for (int r = 0; r < 16; ++r) z += gq[r >> 2][r & 3] * rdlf(r < 8 ? wv0 : wv1, (r & 7) * 8 + i);
        const float la = logsigmoidf_(z) * (1.0f / 16.0f); const float bc = scan_add(la, lane);
        BS[lane * 65 + wave * 8 + i] = bc;
        if (lane == 63) { BL[wave * 8 + i] = bc; if (scal_unit) scal_unit[wave * 8 + i] = __expf(bc); } }
}
__device__ __forceinline__ void unit_gla_L(const Params& p, LAS unsigned char* lds, int j, int b, int h, int ck) {
    const int tid = ltid(), lane = tid & 63, wave = __builtin_amdgcn_readfirstlane(tid >> 6), fr = lane & 15, g = lane >> 4;
    LAS unsigned char* KWT = lds; LAS unsigned char* VT = lds + 9216; LAS float* BS = (LAS float*)(lds + 27648); LAS float* BL = (LAS float*)(lds + 44288);
    const bf16_t* P = (const bf16_t*)(p.ws + WS_P); float* CL = (float*)(p.ws + WS_CL); float* SCAL = (float*)(p.ws + WS_SCAL);
    const int unit = (b * 4 + h) * 64 + ck; const int tok0 = b * SEQ + ck * 64;
    const int t = tid >> 3, seg = tid & 7;
    const u32x4 kin = *(const u32x4*)(P + (size_t)(tok0 + t) * NP_CD + CD_KC + h * 64 + seg * 8);
    u32x4 vin[2];
#pragma unroll
    for (int i = 0; i < 2; ++i) { const int idx = tid + 512 * i; vin[i] = *(const u32x4*)(P + (size_t)(tok0 + (idx >> 4)) * NP_CD + CD_VC + h * 128 + (idx & 15) * 8); }
    gla_cumsum(p, j, h, tok0, lane, wave, BS, BL, SCAL + (size_t)unit * 64);
    __syncthreads();
#pragma unroll
    for (int e = 0; e < 8; ++e) { const int kk = seg * 8 + e; ((LAS bf16_t*)KWT)[kk * 72 + t] = f2bf(bfe(kin, e) * __expf(BL[kk] - BS[t * 65 + kk])); }
#pragma unroll
    for (int i = 0; i < 2; ++i) { const int idx = tid + 512 * i; const int s = idx >> 4, sg = idx & 15;
#pragma unroll
        for (int e = 0; e < 8; ++e) ((LAS bf16_t*)VT)[(sg * 8 + e) * 72 + s] = bfr(vin[i], e); }
    __syncthreads();
#pragma unroll
    for (int i = 0; i < 4; ++i) { const int id = wave + 8 * i; const int tk = id >> 3, tv = id & 7; f32x4 acc = (f32x4){0.f, 0.f, 0.f, 0.f};
#pragma unroll
        for (int kk = 0; kk < 2; ++kk) acc = mfma16(ldfrag(KWT, tk * 16 + fr, RS, kk, g), ldfrag(VT, tv * 16 + fr, RS, kk, g), acc);
#pragma unroll
        for (int r = 0; r < 4; ++r) CL[(size_t)unit * 8192 + (tk * 16 + 4 * g + r) * 128 + tv * 16 + fr] = acc[r]; }
    __syncthreads();
}
__device__ __forceinline__ void phase_scan_gla(const Params& p) {
    const float* CL = (const float*)(p.ws + WS_CL); const float* SCAL = (const float*)(p.ws + WS_SCAL); bf16_t* STG = (bf16_t*)(p.ws + WS_STG);
    for (int e = BID * NTHR + TID; e < 32 * 8192; e += GDIM * NTHR) {
        const int bh = e >> 13, r = e & 8191, dk = r >> 7;
        float S = 0.f;
#pragma unroll 1
        for (int c0 = 0; c0 < 64; c0 += 8) { float v[8], dc[8];
#pragma unroll
            for (int i = 0; i < 8; ++i) { v[i] = CL[(size_t)(bh * 64 + c0 + i) * 8192 + r]; dc[i] = SCAL[(size_t)(bh * 64 + c0 + i) * 64 + dk]; }
#pragma unroll
            for (int i = 0; i < 8; ++i) { STG[(size_t)(bh * 64 + c0 + i) * 8192 + r] = f2bf(S); S = dc[i] * S + v[i]; } }
    }
}
__device__ __forceinline__ void unit_gla_O(const Params& p, LAS unsigned char* lds, int j, int b, int h, int ck) {
    const int tid = ltid(), lane = tid & 63, wave = __builtin_amdgcn_readfirstlane(tid >> 6), fr = lane & 15, g = lane >> 4;
    LAS unsigned char* QS = lds; LAS unsigned char* KS = lds + 9216; LAS unsigned char* VT = lds + 18432; LAS unsigned char* ST = lds + 36864; LAS unsigned char* PS = lds + 55296;
    LAS float* OS = (LAS float*)(lds + 64512); LAS float* BS = (LAS float*)(lds + 98304); LAS float* BL = (LAS float*)(lds + 114944);
    constexpr int OSS = 132;
    const bf16_t* P = (const bf16_t*)(p.ws + WS_P); bf16_t* YMIX = (bf16_t*)(p.ws + WS_YMIX); const bf16_t* STG = (const bf16_t*)(p.ws + WS_STG);
    const int unit = (b * 4 + h) * 64 + ck; const int tok0 = b * SEQ + ck * 64;
    const int sg = tid & 15; const int ch0 = (sg < 8) ? CD_QC + h * 64 + sg * 8 : CD_KC + h * 64 + (sg - 8) * 8;
    u32x4 qkin[2], vin[2], sin_[2], rin[2];
#pragma unroll
    for (int i = 0; i < 2; ++i) { const int idx = tid + 512 * i; const int tt = idx >> 4;
        qkin[i] = *(const u32x4*)(P + (size_t)(tok0 + tt) * NP_CD + ch0);
        vin[i] = *(const u32x4*)(P + (size_t)(tok0 + tt) * NP_CD + CD_VC + h * 128 + sg * 8);
        rin[i] = *(const u32x4*)(P + (size_t)(tok0 + tt) * NP_CD + CD_RC + h * 128 + sg * 8);
        sin_[i] = *(const u32x4*)(STG + (size_t)unit * 8192 + idx * 8); }
    gla_cumsum(p, j, h, tok0, lane, wave, BS, BL, nullptr);
    __syncthreads();
#pragma unroll
    for (int i = 0; i < 2; ++i) { const int idx = tid + 512 * i; const int tt = idx >> 4; float o[8];
#pragma unroll
        for (int e = 0; e < 8; ++e) { const float bb = BS[tt * 65 + (sg & 7) * 8 + e]; o[e] = (sg < 8) ? bfe(qkin[i], e) * 0.125f * __expf(bb) : bfe(qkin[i], e) * __expf(-bb); }
        u32x4 w; w.x = pk2(o[0], o[1]); w.y = pk2(o[2], o[3]); w.z = pk2(o[4], o[5]); w.w = pk2(o[6], o[7]);
        *(LAS u32x4*)(((sg < 8) ? QS : KS) + tt * RS + (sg & 7) * 16) = w;
#pragma unroll
        for (int e = 0; e < 8; ++e) { ((LAS bf16_t*)VT)[(sg * 8 + e) * 72 + tt] = bfr(vin[i], e); ((LAS bf16_t*)ST)[(sg * 8 + e) * 72 + tt] = bfr(sin_[i], e); } }
    __syncthreads();
    { const int tq = wave >> 1;
#pragma unroll
      for (int u = 0; u < 2; ++u) { const int ts = (wave & 1) * 2 + u; f32x4 acc = (f32x4){0.f, 0.f, 0.f, 0.f};
        if (ts <= tq) {
#pragma unroll
            for (int kk = 0; kk < 2; ++kk) acc = mfma16(ldfrag(QS, tq * 16 + fr, RS, kk, g), ldfrag(KS, ts * 16 + fr, RS, kk, g), acc);
        }
        const int s = ts * 16 + fr;
#pragma unroll
        for (int r = 0; r < 4; ++r) { const int t = tq * 16 + 4 * g + r; const float pv = (ts <= tq && s <= t) ? acc[r] : 0.f; ((LAS bf16_t*)PS)[t * 72 + s] = f2bf(pv); } } }
    __syncthreads();
#pragma unroll
    for (int i = 0; i < 4; ++i) { const int id = wave + 8 * i; const int tq = id >> 3, tv = id & 7; f32x4 acc = (f32x4){0.f, 0.f, 0.f, 0.f};
#pragma unroll
        for (int kk = 0; kk < 2; ++kk) acc = mfma16(ldfrag(QS, tq * 16 + fr, RS, kk, g), ldfrag(ST, tv * 16 + fr, RS, kk, g), acc);
#pragma unroll
        for (int kk = 0; kk < 2; ++kk) acc = mfma16(ldfrag(PS, tq * 16 + fr, RS, kk, g), ldfrag(VT, tv * 16 + fr, RS, kk, g), acc);
#pragma unroll
        for (int r = 0; r < 4; ++r) OS[(tq * 16 + 4 * g + r) * OSS + tv * 16 + fr] = acc[r]; }
    __syncthreads();
    { const float* hgp = p.in[I_CDHNORM] + j * 512 + h * 128 + sg * 8;
#pragma unroll
      for (int i = 0; i < 2; ++i) { const int tt = (tid + 512 * i) >> 4;
        const f32x4 a0 = *(const LAS f32x4*)(OS + tt * OSS + sg * 8), a1 = *(const LAS f32x4*)(OS + tt * OSS + sg * 8 + 4);
        float hv[8] = {a0[0], a0[1], a0[2], a0[3], a1[0], a1[1], a1[2], a1[3]};
        float ss = 0.f;
#pragma unroll
        for (int e = 0; e < 8; ++e) ss += hv[e] * hv[e];
        ss += __shfl_xor(ss, 1); ss += __shfl_xor(ss, 2); ss += __shfl_xor(ss, 4); ss += __shfl_xor(ss, 8);
        const float rn = 1.0f / sqrtf(ss * (1.0f / 128.0f) + 1e-6f);
        float y[8];
#pragma unroll
        for (int e = 0; e < 8; ++e) y[e] = hv[e] * rn * hgp[e] * siluf_(bfe(rin[i], e));
        u32x4 w; w.x = pk2(y[0], y[1]); w.y = pk2(y[2], y[3]); w.z = pk2(y[4], y[5]); w.w = pk2(y[6], y[7]);
        *(u32x4*)(YMIX + (size_t)(tok0 + tt) * D + h * 128 + sg * 8) = w; } }
    __syncthreads();
}
constexpr int L_BKT8 = 134144, L_RELB = 138240;
__device__ __forceinline__ void load_attn_tables(const Params& p, LAS unsigned char* lds) {
    const int* bkt = (const int*)(p.ws + WS_BKT);
    for (int i = TID; i < 4096; i += NTHR) lds[L_BKT8 + i] = (unsigned char)bkt[i];
    if (TID < 256) ((LAS float*)(lds + L_RELB))[TID] = p.in[I_RELB][TID];
}
__device__ __forceinline__ int scan_add_i(int v, int lane) {
#pragma unroll
    for (int o = 1; o < 64; o <<= 1) { const int t = __shfl_up(v, o); if (lane >= o) v += t; }
    return v;
}
__device__ __forceinline__ unsigned keep_lowest(unsigned m, int n) {
    if (n <= 0) return 0u;
    while ((int)__popc(m) > n) m &= ~(1u << (31 - __clz((int)m)));
    return m;
}
__device__ __forceinline__ bf16x4 tr_read(unsigned lds_addr) { bf16x4 r; asm volatile("ds_read_b64_tr_b16 %0, %1\n\ts_waitcnt lgkmcnt(0)" : "=&v"(r) : "v"(lds_addr) : "memory"); return r; }
__device__ __forceinline__ u32x4 ldg16(const void* ptr) { return *(const u32x4*)ptr; }
__device__ __forceinline__ void pf_wait4_unused(u32x4& a, u32x4& b, u32x4& c, u32x4& d) { asm volatile("s_waitcnt vmcnt(0)" : "+v"(a), "+v"(b), "+v"(c), "+v"(d) :: "memory"); }
__device__ __forceinline__ void pf_wait8_unused(u32x4 (&v)[8]) { asm volatile("s_waitcnt vmcnt(0)" : "+v"(v[0]), "+v"(v[1]), "+v"(v[2]), "+v"(v[3]), "+v"(v[4]), "+v"(v[5]), "+v"(v[6]), "+v"(v[7]) :: "memory"); }
__device__ __forceinline__ bf16x8 as_bf16x8(const u32x4& v) { return __builtin_bit_cast(bf16x8, v); }
template <int N> __device__ __forceinline__ void pin_batch(bf16x8 (&f)[N]) {
    if constexpr (N == 16) asm volatile("" : "+v"(f[0]), "+v"(f[1]), "+v"(f[2]), "+v"(f[3]), "+v"(f[4]), "+v"(f[5]), "+v"(f[6]), "+v"(f[7]), "+v"(f[8]), "+v"(f[9]), "+v"(f[10]), "+v"(f[11]), "+v"(f[12]), "+v"(f[13]), "+v"(f[14]), "+v"(f[15]));
    else { _Pragma("unroll") for (int i = 0; i < N; ++i) asm volatile("" : "+v"(f[i])); }
}
__device__ __forceinline__ void lds_add_u32(unsigned byte_addr, unsigned v) { asm volatile("ds_add_u32 %0, %1" :: "v"(byte_addr), "v"(v) : "memory"); }
__device__ __forceinline__ void lds_or_b32(unsigned byte_addr, unsigned v) { asm volatile("ds_or_b32 %0, %1" :: "v"(byte_addr), "v"(v) : "memory"); }
__device__ __forceinline__ unsigned sortable(float f) { const int u = __float_as_int(f); return (unsigned)u ^ ((unsigned)(u >> 31) | 0x80000000u); }

template <int PASS>
__device__ __forceinline__ void dsa_score_pass(const bf16_t* KIC, size_t rowb, int nkt, int wave, int fr, int g, int tq, const bf16x8 (&qf)[4][2], const float (&wq)[4],
                                               unsigned pfx, unsigned tau, unsigned hist_a, unsigned gtm_a, unsigned eqm_a, const u32x4 (&first)[8]) {
        const bf16_t* kbase = KIC + (rowb + fr) * 64 + g * 8;
        u32x4 c0 = first[0], c1 = first[1], c2 = first[2], c3 = first[3], n0 = first[4], n1 = first[5], n2 = first[6], n3 = first[7], m0, m1, m2, m3;
#pragma unroll 1
        for (int kt = wave; kt < nkt; kt += 16) {
            { const int ka = kt + 32 < nkt ? kt + 32 : nkt - 1, kb = kt + 40 < nkt ? kt + 40 : nkt - 1;
              m0 = ldg16(kbase + (size_t)ka * 16 * 64); m1 = ldg16(kbase + (size_t)ka * 16 * 64 + 32); m2 = ldg16(kbase + (size_t)kb * 16 * 64); m3 = ldg16(kbase + (size_t)kb * 16 * 64 + 32);
              asm volatile("" ::: "memory"); }
            f32x4 a[2][4];
#pragma unroll
            for (int half = 0; half < 2; ++half) { const bf16x8 k0 = as_bf16x8(half ? c2 : c0), k1 = as_bf16x8(half ? c3 : c1);
#pragma unroll
                for (int hh = 0; hh < 4; ++hh) { f32x4 z = (f32x4){0.f, 0.f, 0.f, 0.f}; z = mfma16(k0, qf[hh][0], z); a[half][hh] = mfma16(k1, qf[hh][1], z); } }
#pragma unroll
            for (int half = 0; half < 2; ++half) { const int kth = kt + 8 * half; const bool live = kth < nkt;
                f32x4 sc = (f32x4){0.f, 0.f, 0.f, 0.f};
#pragma unroll
                for (int hh = 0; hh < 4; ++hh)
#pragma unroll
                    for (int r = 0; r < 4; ++r) { const int ai = __float_as_int(a[half][hh][r]); sc[r] = fmaf(__int_as_float(ai > 0 ? ai : 0), wq[hh], sc[r]); }
                unsigned gtb = 0u, eqb = 0u;
#pragma unroll
                for (int r = 0; r < 4; ++r) { const int s = kth * 16 + 4 * g + r; const bool valid = live && s <= tq; const unsigned key = sortable(sc[r]);
                    if (PASS == 0) { const unsigned bin = key >> 21; lds_add_u32(hist_a + (bin >> 1) * 4u, valid ? (1u << ((bin & 1u) * 16u)) : 0u); }
                    else if (PASS == 1) { const unsigned bin = (key >> 10) & 2047u; lds_add_u32(hist_a + (bin >> 1) * 4u, (valid && (key >> 21) == pfx) ? (1u << ((bin & 1u) * 16u)) : 0u); }
                    else { gtb |= (valid && (key >> 10) > tau) ? (1u << r) : 0u; eqb |= (valid && (key >> 10) == tau) ? (1u << r) : 0u; } }
                if (PASS == 2) { const unsigned word = (unsigned)(kth >> 1), sh = (unsigned)((kth & 1) * 16 + 4 * g);
                    lds_or_b32(gtm_a + word * 4u, gtb << sh); lds_or_b32(eqm_a + word * 4u, eqb << sh); }
            }
            c0 = n0; c1 = n1; c2 = n2; c3 = n3; n0 = m0; n1 = m1; n2 = m2; n3 = m3;
        }
}

__device__ __forceinline__ void unit_dsa(const Params& p, LAS unsigned char* lds, int b, int ti) {
    const int tid = ltid(), lane = tid & 63, wave = __builtin_amdgcn_readfirstlane(tid >> 6), fr = lane & 15, g = lane >> 4;
    LAS unsigned* HIST = (LAS unsigned*)lds; LAS unsigned char* GBUF = lds;
    LAS unsigned* GTM = (LAS unsigned*)(lds + 69632); LAS unsigned* EQM = (LAS unsigned*)(lds + 69632 + 8256);
    LAS unsigned short* SEL = (LAS unsigned short*)(lds + 86272); LAS unsigned char* QAB = lds + 94464;
    LAS int* MISC = (LAS int*)(lds + 127232); LAS unsigned char* SELB = lds + 127488;
    const LAS unsigned char* BKT8 = lds + L_BKT8; const LAS float* RELB = (const LAS float*)(lds + L_RELB);
    const bf16_t* P = (const bf16_t*)(p.ws + WS_P); const float* SP = (const float*)(p.ws + WS_SP); bf16_t* YMIX = (bf16_t*)(p.ws + WS_YMIX);
    const bf16_t* WUK = (const bf16_t*)(p.ws + WS_WUK); const bf16_t* WUV = (const bf16_t*)(p.ws + WS_WUV);
    const bf16_t* KIC = (const bf16_t*)(p.ws + WS_KIC); const bf16_t* CKC = (const bf16_t*)(p.ws + WS_CKC);
    const int t0 = ti * 16; const size_t rowb = (size_t)b * SEQ;

    for (int i = tid; i < 4100; i += NTHR) ((LAS u32x4*)HIST)[i] = (u32x4){0u, 0u, 0u, 0u};
    { const int h = wave; f32x4 acc[8];
#pragma unroll
      for (int rt = 0; rt < 8; ++rt) acc[rt] = (f32x4){0.f, 0.f, 0.f, 0.f};
      bf16x8 bw[16], aq[2];
#pragma unroll
      for (int kk = 0; kk < 2; ++kk) { aq[kk] = *(const bf16x8*)(P + (rowb + t0 + fr) * NP_AB + AB_QB + h * 64 + kk * 32 + g * 8);
#pragma unroll
        for (int rt = 0; rt < 8; ++rt) bw[kk * 8 + rt] = *(const bf16x8*)(WUK + ((size_t)(rt * 16 + fr) * 8 + h) * 64 + kk * 32 + g * 8); }
      asm volatile("" ::: "memory");
#pragma unroll
      for (int kk = 0; kk < 2; ++kk)
#pragma unroll
        for (int rt = 0; rt < 8; ++rt) acc[rt] = mfma16(aq[kk], bw[kk * 8 + rt], acc[rt]);
#pragma unroll
      for (int rt = 0; rt < 8; ++rt)
#pragma unroll
        for (int r = 0; r < 4; ++r) ((LAS bf16_t*)QAB)[((4 * g + r) * 8 + h) * 128 + rt * 16 + fr] = f2bf(acc[rt][r] * 0.125f); }
    bf16x8 qf[4][2];
#pragma unroll
    for (int hh = 0; hh < 4; ++hh)
#pragma unroll
        for (int kk = 0; kk < 2; ++kk) qf[hh][kk] = *(const bf16x8*)(P + (rowb + t0 + fr) * NP_AB + AB_QI + hh * 64 + kk * 32 + g * 8);
    float wq[4];
#pragma unroll
    for (int hh = 0; hh < 4; ++hh) wq[hh] = SP[(rowb + t0 + fr) * 16 + 8 + hh] * 0.5f;
    const int tq = t0 + fr; const int nkt = ti + 1;
    u32x4 kfirst[8];
    { const bf16_t* kbase = KIC + (rowb + fr) * 64 + g * 8;
#pragma unroll
      for (int q4 = 0; q4 < 4; ++q4) { const int kq = wave + 8 * q4; const int kc = kq < nkt ? kq : nkt - 1; kfirst[2 * q4] = ldg16(kbase + (size_t)kc * 16 * 64); kfirst[2 * q4 + 1] = ldg16(kbase + (size_t)kc * 16 * 64 + 32); } }
    if (tid < 16) { MISC[tid] = 0; MISC[16 + tid] = (t0 + 16 > 256) ? 256 : (1 << 20); MISC[48 + tid] = 0; }
    for (int i = tid; i < 2 * 16 * 129; i += NTHR) GTM[i] = 0u;
    __syncthreads();

    const unsigned hist_a = (unsigned)(unsigned long long)(HIST + fr * 1025), gtm_a = (unsigned)(unsigned long long)(GTM + fr * 129), eqm_a = (unsigned)(unsigned long long)(EQM + fr * 129);
    const bool need_sel = (t0 + 16) > 256;
#pragma unroll 1
    for (int pass = need_sel ? 0 : 2; pass < 3; ++pass) {
        const unsigned pfx = (unsigned)MISC[fr], tau = (unsigned)MISC[48 + fr];

        if (pass == 0) dsa_score_pass<0>(KIC, rowb, nkt, wave, fr, g, tq, qf, wq, pfx, tau, hist_a, gtm_a, eqm_a, kfirst);
        else if (pass == 1) dsa_score_pass<1>(KIC, rowb, nkt, wave, fr, g, tq, qf, wq, pfx, tau, hist_a, gtm_a, eqm_a, kfirst);
        else dsa_score_pass<2>(KIC, rowb, nkt, wave, fr, g, tq, qf, wq, pfx, tau, hist_a, gtm_a, eqm_a, kfirst);
        asm volatile("s_waitcnt lgkmcnt(0)" ::: "memory");
        __syncthreads();

        if (pass < 2) {

#pragma unroll
            for (int qq = 0; qq < 2; ++qq) { const int q = wave * 2 + qq; const int nq = t0 + q + 1;
                if (nq > 256) {
                    const int R = MISC[16 + q]; const int lo = 2016 - 32 * lane;
                    unsigned w[16];
#pragma unroll
                    for (int i = 0; i < 16; ++i) w[i] = HIST[q * 1025 + (lo >> 1) + i];
                    int sl = 0;
#pragma unroll
                    for (int i = 0; i < 16; ++i) sl += (int)(w[i] & 0xffffu) + (int)(w[i] >> 16);
                    const int cum = scan_add_i(sl, lane);
                    const unsigned long long mk = __ballot(cum >= R);
                    const int Ls = mk ? (int)__ffsll((long long)mk) - 1 : 63;
                    const int c0 = cum - sl; int c = c0, nlt = 0, above = c0;
#pragma unroll
                    for (int i = 15; i >= 0; --i) {
                        c += (int)(w[i] >> 16); nlt += (c < R) ? 1 : 0; above = (c < R) ? c : above;
                        c += (int)(w[i] & 0xffffu); nlt += (c < R) ? 1 : 0; above = (c < R) ? c : above; }
                    const int fbin = lo + 31 - nlt;
                    const int fb = __shfl(fbin, Ls), ab = __shfl(above, Ls);
                    if (lane == 0) { const unsigned old = (unsigned)MISC[q];
                        if (pass == 0) MISC[q] = fb; else MISC[48 + q] = (int)((old << 11) | (unsigned)fb);
                        MISC[16 + q] = R - ab; }
                } else if (lane == 0) { MISC[48 + q] = 0; MISC[16 + q] = 1 << 20; }
            }
            __syncthreads();
            if (pass == 0) { for (int i = tid; i < 4100; i += NTHR) ((LAS u32x4*)HIST)[i] = (u32x4){0u, 0u, 0u, 0u}; }
            __syncthreads();

        }
    }

#pragma unroll 1
    for (int qq = 0; qq < 2; ++qq) { const int q = wave * 2 + qq; const int R = MISC[16 + q];
        const unsigned g0 = GTM[q * 129 + 2 * lane], g1 = GTM[q * 129 + 2 * lane + 1], e0 = EQM[q * 129 + 2 * lane], e1 = EQM[q * 129 + 2 * lane + 1];
        const int tc = (int)__popc(e0) + (int)__popc(e1); const int tpre = scan_add_i(tc, lane) - tc;
        const unsigned s0 = g0 | keep_lowest(e0, R - tpre), s1 = g1 | keep_lowest(e1, R - tpre - (int)__popc(e0));
        const int c = (int)__popc(s0) + (int)__popc(s1); const int incl = scan_add_i(c, lane); int pos = incl - c;
        unsigned m = s0; while (m) { const int bit = __ffs((int)m) - 1; m &= m - 1u; const int ki = lane * 64 + bit; if (pos < 256) { SEL[q * 256 + pos] = (unsigned short)ki; SELB[q * 256 + pos] = BKT8[t0 + q - ki]; } ++pos; }
        m = s1; while (m) { const int bit = __ffs((int)m) - 1; m &= m - 1u; const int ki = lane * 64 + 32 + bit; if (pos < 256) { SEL[q * 256 + pos] = (unsigned short)ki; SELB[q * 256 + pos] = BKT8[t0 + q - ki]; } ++pos; }
        const int total = __shfl(incl, 63);
        if (lane == 0) MISC[32 + q] = total < 256 ? total : 256;
    }
    __syncthreads();

    LAS unsigned char* gb = GBUF + wave * 8704;
    const unsigned gba = (unsigned)(unsigned long long)gb;
    u32x4 gv[8];
#pragma unroll 1
    for (int qq = 0; qq < 2; ++qq) { const int q = wave * 2 + qq; const int count = MISC[32 + q]; const int count_next = MISC[32 + (wave * 2 + 1)]; const int tpos = t0 + q; const int nch = (count + 31) >> 5;
        bf16x8 qh[4];
#pragma unroll
        for (int kk = 0; kk < 4; ++kk) { const bf16x8 v = *(const LAS bf16x8*)(QAB + ((q * 8 + (fr & 7)) * 128 + kk * 32 + g * 8) * 2); qh[kk] = (fr < 8) ? v : (bf16x8){0, 0, 0, 0, 0, 0, 0, 0}; }
        float m_run = -1e30f, l_part = 0.f; f32x4 ao[8];
#pragma unroll
        for (int rt = 0; rt < 8; ++rt) ao[rt] = (f32x4){0.f, 0.f, 0.f, 0.f};
        if (qq == 0) {
#pragma unroll
            for (int k2 = 0; k2 < 2; ++k2) { const int slot = k2 * 16 + fr; const int idx = SEL[q * 256 + (slot < count ? slot : 0)];
#pragma unroll
                for (int kk = 0; kk < 4; ++kk) gv[k2 * 4 + kk] = ldg16(CKC + (rowb + idx) * 128 + kk * 32 + g * 8); }
            asm volatile("" ::: "memory"); }
        const unsigned alo = gba + (unsigned)((4 * g + (fr >> 2)) * 272 + (4 * (fr & 3)) * 2), ahi = alo + 16u * 272u;
#pragma unroll 1
        for (int c = 0; c < nch; ++c) {


            bf16x8 af[8];
#pragma unroll
            for (int it = 0; it < 8; ++it) { af[it] = as_bf16x8(gv[it]); *(LAS u32x4*)(gb + ((it >> 2) * 16 + fr) * 272 + ((it & 3) * 32 + g * 8) * 2) = gv[it]; }
            {
                const bool lastc = !(c + 1 < nch);
                const int cn = lastc ? 0 : c + 1; const int qn = (lastc && qq == 0) ? q + 1 : q; const int countn = (lastc && qq == 0) ? count_next : count;
#pragma unroll
                for (int k2 = 0; k2 < 2; ++k2) { const int slot = cn * 32 + k2 * 16 + fr; const int idx = SEL[qn * 256 + (slot < countn ? slot : 0)];
#pragma unroll
                    for (int kk = 0; kk < 4; ++kk) gv[k2 * 4 + kk] = ldg16(CKC + (rowb + idx) * 128 + kk * 32 + g * 8); }
                asm volatile("" ::: "memory"); }
            float lg[2][4];
#pragma unroll
            for (int k2 = 0; k2 < 2; ++k2) { f32x4 a = (f32x4){0.f, 0.f, 0.f, 0.f};
#pragma unroll
                for (int kk = 0; kk < 4; ++kk) a = mfma16(af[k2 * 4 + kk], qh[kk], a);
                const unsigned bk4 = *(const LAS unsigned*)(SELB + q * 256 + c * 32 + k2 * 16 + 4 * g);
#pragma unroll
                for (int r = 0; r < 4; ++r) { const int slot = c * 32 + k2 * 16 + 4 * g + r; const float bias = RELB[((bk4 >> (8 * r)) & 31u) * 8u + (unsigned)(fr & 7)];
                    lg[k2][r] = (slot < count) ? (a[r] + bias) * 1.44269504f : -1e30f; } }
            float ml = fmaxf(fmaxf(fmaxf(lg[0][0], lg[0][1]), fmaxf(lg[0][2], lg[0][3])), fmaxf(fmaxf(lg[1][0], lg[1][1]), fmaxf(lg[1][2], lg[1][3])));
            ml = fmaxf(ml, __shfl_xor(ml, 16)); ml = fmaxf(ml, __shfl_xor(ml, 32));
            const float m_new = fmaxf(m_run, ml); const float alpha = __builtin_amdgcn_exp2f(m_run - m_new);
            float pr[2][4]; float ps = 0.f;
#pragma unroll
            for (int k2 = 0; k2 < 2; ++k2)
#pragma unroll
                for (int r = 0; r < 4; ++r) { pr[k2][r] = __builtin_amdgcn_exp2f(lg[k2][r] - m_new); ps += pr[k2][r]; }
            l_part = l_part * alpha + ps; m_run = m_new;
            u32x4 pfu; pfu.x = pk2(pr[0][0], pr[0][1]); pfu.y = pk2(pr[0][2], pr[0][3]); pfu.z = pk2(pr[1][0], pr[1][1]); pfu.w = pk2(pr[1][2], pr[1][3]);
            const bf16x8 pf = __builtin_bit_cast(bf16x8, pfu);

            asm volatile("s_waitcnt lgkmcnt(0)" ::: "memory");
            bf16x4 tl[8], th[8];
            asm volatile(
                "ds_read_b64_tr_b16 %0, %16\n\tds_read_b64_tr_b16 %8, %17\n\t"
                "ds_read_b64_tr_b16 %1, %16 offset:32\n\tds_read_b64_tr_b16 %9, %17 offset:32\n\t"
                "ds_read_b64_tr_b16 %2, %16 offset:64\n\tds_read_b64_tr_b16 %10, %17 offset:64\n\t"
                "ds_read_b64_tr_b16 %3, %16 offset:96\n\tds_read_b64_tr_b16 %11, %17 offset:96\n\t"
                "ds_read_b64_tr_b16 %4, %16 offset:128\n\tds_read_b64_tr_b16 %12, %17 offset:128\n\t"
                "ds_read_b64_tr_b16 %5, %16 offset:160\n\tds_read_b64_tr_b16 %13, %17 offset:160\n\t"
                "ds_read_b64_tr_b16 %6, %16 offset:192\n\tds_read_b64_tr_b16 %14, %17 offset:192\n\t"
                "ds_read_b64_tr_b16 %7, %16 offset:224\n\tds_read_b64_tr_b16 %15, %17 offset:224\n\t"
                "s_waitcnt lgkmcnt(0)"
                : "=&v"(tl[0]), "=&v"(tl[1]), "=&v"(tl[2]), "=&v"(tl[3]), "=&v"(tl[4]), "=&v"(tl[5]), "=&v"(tl[6]), "=&v"(tl[7]),
                  "=&v"(th[0]), "=&v"(th[1]), "=&v"(th[2]), "=&v"(th[3]), "=&v"(th[4]), "=&v"(th[5]), "=&v"(th[6]), "=&v"(th[7])
                : "v"(alo), "v"(ahi) : "memory");
#pragma unroll
            for (int rt = 0; rt < 8; ++rt) { ao[rt] = ao[rt] * alpha;
                bf16x8 af; af[0] = tl[rt][0]; af[1] = tl[rt][1]; af[2] = tl[rt][2]; af[3] = tl[rt][3]; af[4] = th[rt][0]; af[5] = th[rt][1]; af[6] = th[rt][2]; af[7] = th[rt][3];
                ao[rt] = mfma16(af, pf, ao[rt]); }

        }
        float l = l_part; l += __shfl_xor(l, 16); l += __shfl_xor(l, 32);
        const float inv = 1.0f / l;
        if (fr < 8) {
#pragma unroll
            for (int rt = 0; rt < 8; ++rt) { u32x2 w; w.x = pk2(ao[rt][0] * inv, ao[rt][1] * inv); w.y = pk2(ao[rt][2] * inv, ao[rt][3] * inv);
                *(LAS u32x2*)(QAB + ((q * 8 + fr) * 128 + rt * 16 + 4 * g) * 2) = w; } }
    }
    __syncthreads();

    { const int h = wave; f32x4 acc[4];
#pragma unroll
      for (int nt = 0; nt < 4; ++nt) acc[nt] = (f32x4){0.f, 0.f, 0.f, 0.f};
      bf16x8 bw[16];
#pragma unroll
      for (int kk = 0; kk < 4; ++kk)
#pragma unroll
        for (int nt = 0; nt < 4; ++nt) bw[kk * 4 + nt] = *(const bf16x8*)(WUV + ((size_t)(h * 64 + nt * 16 + fr)) * 128 + kk * 32 + g * 8);
      asm volatile("" ::: "memory");
#pragma unroll
      for (int kk = 0; kk < 4; ++kk) { const bf16x8 a = *(const LAS bf16x8*)(QAB + ((fr * 8 + h) * 128 + kk * 32 + g * 8) * 2);
#pragma unroll
        for (int nt = 0; nt < 4; ++nt) acc[nt] = mfma16(a, bw[kk * 4 + nt], acc[nt]); }
#pragma unroll
      for (int nt = 0; nt < 4; ++nt)
#pragma unroll
        for (int r = 0; r < 4; ++r) YMIX[(rowb + t0 + 4 * g + r) * D + 512 + h * 64 + nt * 16 + fr] = f2bf(acc[nt][r]); }
    __syncthreads();

}

struct DilRegs { u32x4 kv[4], vv[4]; bf16x8 qf[2]; };
__device__ __forceinline__ void dil_issue(const Params& p, int b, int h, int pat, int res, int n, DilRegs& r) {
    const int tid = ltid(), lane = tid & 63, wave = __builtin_amdgcn_readfirstlane(tid >> 6), fr = lane & 15, g = lane >> 4;
    const bf16_t* P = (const bf16_t*)(p.ws + WS_P);
    const int d = (pat == 0) ? 1 : (pat == 1 ? 4 : 16);
    const size_t rowb = (size_t)b * SEQ;
    const int row = tid >> 1, half = tid & 1; const int jsub = 128 * (n - 1) + row; const bool ok = jsub >= 0;
    const size_t tok = rowb + (size_t)(ok ? jsub : 0) * d + res;
#pragma unroll
    for (int q = 0; q < 4; ++q) { r.kv[q] = *(const u32x4*)(P + tok * NP_CD + CD_KD + h * 64 + half * 32 + q * 8); r.vv[q] = *(const u32x4*)(P + tok * NP_CD + CD_VD + h * 64 + half * 32 + q * 8); }
    const int qi = 128 * n + 16 * wave + fr; const size_t qtok = rowb + (size_t)qi * d + res;
#pragma unroll
    for (int kk = 0; kk < 2; ++kk) r.qf[kk] = *(const bf16x8*)(P + qtok * NP_CD + CD_QD + h * 64 + kk * 32 + g * 8);
}
__device__ __forceinline__ void dil_compute(const Params& p, LAS unsigned char* lds, int b, int h, int pat, int res, int n, const DilRegs& rg) {
    const int tid = ltid(), lane = tid & 63, wave = __builtin_amdgcn_readfirstlane(tid >> 6), fr = lane & 15, g = lane >> 4;
    LAS unsigned char* KS2 = lds; LAS unsigned char* VT2 = lds + 36864;
    const LAS unsigned char* BKT8 = lds + L_BKT8; const LAS float* RELB = (const LAS float*)(lds + L_RELB);
    const int d = (pat == 0) ? 1 : (pat == 1 ? 4 : 16);
    const size_t rowb = (size_t)b * SEQ;
    bf16_t* OP = (bf16_t*)(p.ws + (pat == 0 ? WS_HBF : (pat == 1 ? WS_HBF + 32 * MiB : WS_H1)));
    float* LSE = (float*)(p.ws + WS_H1 + 32 * MiB) + (size_t)pat * NTOK * 8;
    { const int row = tid >> 1, half = tid & 1; const bool ok = (128 * (n - 1) + row) >= 0;
#pragma unroll
      for (int q = 0; q < 4; ++q) { const u32x4 kq = ok ? rg.kv[q] : (u32x4){0u, 0u, 0u, 0u}, vq = ok ? rg.vv[q] : (u32x4){0u, 0u, 0u, 0u};
          *(LAS u32x4*)(KS2 + row * 144 + (half * 32 + q * 8) * 2) = kq;
#pragma unroll
          for (int e = 0; e < 4; ++e) { const unsigned w = vq[e]; const int dv = half * 32 + q * 8 + 2 * e;
              ((LAS bf16_t*)VT2)[dv * 264 + row] = (bf16_t)(w & 0xffffu); ((LAS bf16_t*)VT2)[(dv + 1) * 264 + row] = (bf16_t)(w >> 16); } } }
    LAS float* TAPB = (LAS float*)(lds + 70656);
    if (tid < 400) { const int tap = tid - 144; TAPB[tid] = (tap >= 0 && tap <= 128) ? RELB[(int)BKT8[tap * d] * 8 + h] * 1.44269504f : -1e30f; }
    __syncthreads();
    const int qi = 128 * n + 16 * wave + fr; const size_t qtok = rowb + (size_t)qi * d + res;
    const bf16x8 qf[2] = {rg.qf[0], rg.qf[1]};
    const int ql = 128 + 16 * wave + fr;
    float m_run = -1e30f, l_part = 0.f; f32x4 ao[4];
#pragma unroll
    for (int vt = 0; vt < 4; ++vt) ao[vt] = (f32x4){0.f, 0.f, 0.f, 0.f};
#pragma unroll 1
    for (int c = 0; c < 5; ++c) { const int kl0 = 16 * wave + 32 * c;
        float lg[2][4];
#pragma unroll
        for (int k2 = 0; k2 < 2; ++k2) {
            if (c == 4 && k2 == 1) {
#pragma unroll
                for (int r = 0; r < 4; ++r) lg[k2][r] = -1e30f;
            } else { f32x4 a = (f32x4){0.f, 0.f, 0.f, 0.f};
#pragma unroll
                for (int kk = 0; kk < 2; ++kk) a = mfma16(ldfrag(KS2, kl0 + k2 * 16 + fr, 144, kk, g), qf[kk], a);
#pragma unroll
                for (int r = 0; r < 4; ++r) { const int kl = kl0 + k2 * 16 + 4 * g + r; const int tap = ql - kl;
                    float v = fmaf(a[r], 0.125f * 1.44269504f, TAPB[tap + 144]);
                    if (n == 0) v = (kl >= 128) ? v : -1e30f;
                    lg[k2][r] = v; } } }
        float ml = fmaxf(fmaxf(fmaxf(lg[0][0], lg[0][1]), fmaxf(lg[0][2], lg[0][3])), fmaxf(fmaxf(lg[1][0], lg[1][1]), fmaxf(lg[1][2], lg[1][3])));
        ml = fmaxf(ml, __shfl_xor(ml, 16)); ml = fmaxf(ml, __shfl_xor(ml, 32));
        const float m_new = fmaxf(m_run, ml); const float alpha = __builtin_amdgcn_exp2f(m_run - m_new);
        float pr[2][4]; float ps = 0.f;
#pragma unroll
        for (int k2 = 0; k2 < 2; ++k2)
#pragma unroll
            for (int r = 0; r < 4; ++r) { pr[k2][r] = (lg[k2][r] > -1e29f) ? __builtin_amdgcn_exp2f(lg[k2][r] - m_new) : 0.f; ps += pr[k2][r]; }
        l_part = l_part * alpha + ps; m_run = m_new;
        u32x4 pfu; pfu.x = pk2(pr[0][0], pr[0][1]); pfu.y = pk2(pr[0][2], pr[0][3]); pfu.z = pk2(pr[1][0], pr[1][1]); pfu.w = pk2(pr[1][2], pr[1][3]);
        const bf16x8 pf = __builtin_bit_cast(bf16x8, pfu);
#pragma unroll
        for (int vt = 0; vt < 4; ++vt) { ao[vt] = ao[vt] * alpha;
            const bf16x4 lo = *(const LAS bf16x4*)(VT2 + (vt * 16 + fr) * 528 + (kl0 + 4 * g) * 2);
            bf16x4 hi = (bf16x4){0, 0, 0, 0};
            if (c < 4) hi = *(const LAS bf16x4*)(VT2 + (vt * 16 + fr) * 528 + (kl0 + 16 + 4 * g) * 2);
            bf16x8 af; af[0] = lo[0]; af[1] = lo[1]; af[2] = lo[2]; af[3] = lo[3]; af[4] = hi[0]; af[5] = hi[1]; af[6] = hi[2]; af[7] = hi[3];
            ao[vt] = mfma16(af, pf, ao[vt]); }
    }
    float l = l_part; l += __shfl_xor(l, 16); l += __shfl_xor(l, 32);
    const float inv = 1.0f / l;
#pragma unroll
    for (int vt = 0; vt < 4; ++vt) { u32x2 w; w.x = pk2(ao[vt][0] * inv, ao[vt][1] * inv); w.y = pk2(ao[vt][2] * inv, ao[vt][3] * inv);
        *(u32x2*)(OP + qtok * 512 + h * 64 + vt * 16 + 4 * g) = w; }
    if (g == 0) LSE[qtok * 8 + h] = (m_run + __log2f(l)) * 0.69314718f;
    __syncthreads();
}

__device__ __forceinline__ void phase_dil_combine(const Params& p) {
    const bf16_t* __restrict__ O0 = (const bf16_t*)(p.ws + WS_HBF); const bf16_t* __restrict__ O1 = (const bf16_t*)(p.ws + WS_HBF + 32 * MiB); const bf16_t* __restrict__ O2 = (const bf16_t*)(p.ws + WS_H1);
    const float* __restrict__ LSE = (const float*)(p.ws + WS_H1 + 32 * MiB); bf16_t* __restrict__ YMIX = (bf16_t*)(p.ws + WS_YMIX);
#pragma unroll 2
    for (int idx = BID * NTHR + TID; idx < NTOK * 64; idx += GDIM * NTHR) {
        const int tok = idx >> 6, h = (idx >> 3) & 7, dg = idx & 7;
        const float l0 = LSE[(size_t)tok * 8 + h], l1 = LSE[(size_t)NTOK * 8 + (size_t)tok * 8 + h], l2 = LSE[(size_t)2 * NTOK * 8 + (size_t)tok * 8 + h];
        const float mx = fmaxf(l0, fmaxf(l1, l2)); const float w0 = __expf(l0 - mx), w1 = __expf(l1 - mx), w2 = __expf(l2 - mx); const float inv = 1.0f / (w0 + w1 + w2);
        const size_t off = (size_t)tok * 512 + h * 64 + dg * 8;
        const u32x4 a = *(const u32x4*)(O0 + off), bq = *(const u32x4*)(O1 + off), c = *(const u32x4*)(O2 + off);
        u32x4 o;
#pragma unroll
        for (int e = 0; e < 4; ++e) {
            const float v0 = (__uint_as_float(a[e] << 16) * w0 + __uint_as_float(bq[e] << 16) * w1 + __uint_as_float(c[e] << 16) * w2) * inv;
            const float v1 = (__uint_as_float(a[e] & 0xffff0000u) * w0 + __uint_as_float(bq[e] & 0xffff0000u) * w1 + __uint_as_float(c[e] & 0xffff0000u) * w2) * inv;
            o[e] = pk2(v0, v1); }
        *(u32x4*)(YMIX + (size_t)tok * D + 512 + h * 64 + dg * 8) = o;
    }
}

__device__ __forceinline__ unsigned grab_issue(unsigned* ctr) { unsigned v = 0u; if (TID == 0) v = __hip_atomic_fetch_add(ctr, 1u, __ATOMIC_RELAXED, __HIP_MEMORY_SCOPE_AGENT); return v; }
__device__ __forceinline__ int grab_finish(unsigned v, LAS int* slot) { __syncthreads(); if (TID == 0) *slot = (int)v; __syncthreads(); return *slot; }
__device__ __forceinline__ int grab_unit(unsigned* ctr, LAS int* slot) {
    __syncthreads();
    if (TID == 0) *slot = (int)__hip_atomic_fetch_add(ctr, 1u, __ATOMIC_RELAXED, __HIP_MEMORY_SCOPE_AGENT);
    __syncthreads();
    return *slot;
}
__device__ __forceinline__ void phase_rec_L(const Params& p, LAS unsigned char* lds, int j, bool is_ab) {
    for (int u = BID; u < 2048; u += GDIM) { const int bh = u >> 6, ck = u & 63;
        if (is_ab) unit_mlstm_L(p, lds, j, bh >> 2, bh & 3, ck); else unit_gla_L(p, lds, j, bh >> 2, bh & 3, ck); }
}
__device__ __forceinline__ void phase_mixer_ab(const Params& p, LAS unsigned char* lds, int j, unsigned* ctr, int nrec = 2048) {
    LAS int* slot = (LAS int*)(lds + LDS_PERS + LP_SLOT);
    load_attn_tables(p, lds);
    int u = grab_unit(ctr, slot);
    while (u < 2048) { const unsigned pend = grab_issue(ctr); unit_dsa(p, lds, u >> 8, 255 - (u & 255)); u = grab_finish(pend, slot); }
    const int total = 2048 + nrec;
    MlstmOIn cur, nxt;
    if (u < total) { const int k = u - 2048, bh = k >> 6; mlstm_O_issue(p, bh >> 2, bh & 3, k & 63, cur); }
    int un = (u < total) ? grab_unit(ctr, slot) : total;
    while (u < total) {
        const unsigned pend = grab_issue(ctr);
        if (un < total) { const int k2 = un - 2048, bh2 = k2 >> 6; mlstm_O_issue(p, bh2 >> 2, bh2 & 3, k2 & 63, nxt); }
        { const int k = u - 2048, bh = k >> 6; mlstm_O_compute(p, lds, j, bh >> 2, bh & 3, k & 63, cur); }
        cur = nxt; u = un; un = grab_finish(pend, slot);
    }
}
__device__ __forceinline__ void dil_decode(int k, int& b, int& h, int& pat, int& res, int& n) {
    const int n32 = k & 31, bh = k / 96; pat = (k >> 5) % 3; b = bh >> 3; h = bh & 7;
    if (pat == 0) { res = 0; n = n32; } else if (pat == 1) { res = n32 >> 3; n = n32 & 7; } else { res = n32 >> 1; n = n32 & 1; }
}
__device__ __forceinline__ void phase_mixer_cd(const Params& p, LAS unsigned char* lds, int j, unsigned* ctr, int nrec = 2048) {
    LAS int* slot = (LAS int*)(lds + LDS_PERS + LP_SLOT);
    load_attn_tables(p, lds);
    const int total = 6144 + nrec;
    int u = grab_unit(ctr, slot);
    DilRegs cur, nxt;
    if (u < 6144) { int b, h, pat, res, n; dil_decode(u, b, h, pat, res, n); dil_issue(p, b, h, pat, res, n, cur); }
    int un = (u < total) ? grab_unit(ctr, slot) : total;
    while (u < total) {
        const unsigned pend = grab_issue(ctr);
        if (u < 6144) { int b, h, pat, res, n; dil_decode(u, b, h, pat, res, n);
            if (un < 6144) { int b2, h2, pat2, res2, n2; dil_decode(un, b2, h2, pat2, res2, n2); dil_issue(p, b2, h2, pat2, res2, n2, nxt); }
            dil_compute(p, lds, b, h, pat, res, n, cur);
            cur = nxt; }
        else { const int k = u - 6144; const int bh = k >> 6; unit_gla_O(p, lds, j, bh >> 2, bh & 3, k & 63); }
        u = un; un = grab_finish(pend, slot);
    }
}
typedef const __attribute__((address_space(4))) Params* KernargP;
__device__ __forceinline__ const Params& lparams() { KernargP k = (KernargP)__builtin_amdgcn_kernarg_segment_ptr(); asm volatile("" : "+s"(k)); return *(const Params*)k; }
#define PP (lparams())
__device__ __forceinline__ LAS unsigned char* llds(LAS unsigned char* q) { asm volatile("" : "+s"(q)); return q; }
#define LL (llds(lds))
__global__ void __launch_bounds__(NTHR, 2) hybrid_fwd(Params p) {
    extern __shared__ __attribute__((aligned(16))) unsigned char lds_raw[];
    LAS unsigned char* lds = (LAS unsigned char*)lds_raw;
    const int tid = TID, G = GDIM;
    for (int i = tid; i < (LDS_TOTAL - LDS_PERS) / 4; i += NTHR) ((LAS unsigned*)(lds + LDS_PERS))[i] = 0u;
    __syncthreads();
    unsigned* ctl = (unsigned*)(PP.ws + WS_CTL);
    XcdBarrier bar = xcd_barrier_post(ctl + CW_BAR, (volatile LAS unsigned*)(lds + LDS_PERS));
    LAS int* tbase = (LAS int*)(lds + LDS_PERS + LP_TBASE);

    { p0_prologue(PP, LL); }
    __syncthreads();
#pragma unroll 1
    for (int l = 0; l < DEPTH; ++l) {
        const bool is_ab = (l & 1) == 0; const int j = l >> 1;
        prep_layer(PP, LL, l);
        if (l == 0) xcd_barrier(bar);
        __syncthreads();
        { phase_norm1(PP, LL, l); }
        { xcd_barrier(bar); }
        {
            const int N = is_ab ? NP_AB : NP_CD;
            pg8::Gemm gm{(const bf16_t*)(PP.ws + WS_HBF), (const bf16_t*)(PP.ws + WS_WIN), NTOK, N, D};
            pg8::StaticOrder S; S.init(NTOK, N, G, BID);
            pg8::EpiBf16<false> E{(bf16_t*)(PP.ws + WS_P), N, is_ab ? (bf16_t*)(PP.ws + WS_KIC) : nullptr, is_ab ? (bf16_t*)(PP.ws + WS_CKC) : nullptr};
            pg8::gemm_phase(LL, gm, S, E);
        }
        xcd_barrier(bar);
        phase_rec_L(PP, LL, j, is_ab);
        xcd_barrier(bar);
        if (is_ab) phase_scan_mlstm(PP); else phase_scan_gla(PP);
        xcd_barrier(bar);
        if (is_ab) { phase_mixer_ab(PP, LL, j, ctl + CW_WQ + 64 * l);
        } else { phase_mixer_cd(PP, LL, j, ctl + CW_WQ + 64 * l); xcd_barrier(bar); phase_dil_combine(PP);
        }
        xcd_barrier(bar);
        {
            pg8::Gemm gm{(const bf16_t*)(PP.ws + WS_YMIX), (const bf16_t*)(PP.ws + WS_WOUT), NTOK, D, D};
            pg8::StaticOrder S; S.init(NTOK, D, G, BID);
            pg8::EpiOutRes E{(float*)(PP.ws + WS_X), (const float*)(PP.ws + WS_MOD) + (size_t)l * 8 * 6 * D + 2 * D};
            { pg8::gemm_phase(LL, gm, S, E); }
        }
        xcd_barrier(bar);
        phase_norm2(PP, LL, l);
        xcd_barrier(bar);
        phase_dispatch(PP, LL, tbase);
        xcd_barrier(bar);
        {
            pg8::Gemm gm{(const bf16_t*)(PP.ws + WS_HBF), (const bf16_t*)(PP.ws + WS_WGU), MOE_ROWS, 16 * 1024, D, (const int*)(PP.ws + WS_ROWTOK)};
            pg8::MoeOrder S{tbase, G, BID};
            pg8::EpiMoe1 E{(bf16_t*)(PP.ws + WS_H1)};
            pg8::gemm_phase<pg8::EpiMoe1, pg8::MoeOrder, true>(LL, gm, S, E);
        }
        xcd_barrier(bar);
        {
            pg8::Gemm gm{(const bf16_t*)(PP.ws + WS_H1), (const bf16_t*)(PP.ws + WS_WDN), MOE_ROWS, 16 * 1024, 512};
            pg8::MoeOrder S{tbase, G, BID};
            pg8::EpiBf16<true> E{(bf16_t*)(PP.ws + WS_P), D, nullptr, nullptr};
            pg8::gemm_phase(LL, gm, S, E);
        }
        xcd_barrier(bar);
    }
    { phase_final(PP, LL); }
}

extern "C" void kernel_launch(void* const* d_in, const int* in_sizes, int n_in, void* d_out, int out_size, void* d_ws, size_t ws_size, hipStream_t stream) {
    static int grid = 0;
    if (grid == 0) {
        if (n_in != 28 || ws_size < WS_END2) { fprintf(stderr, "kernel_launch: unexpected n_in %d / ws_size %zu (need %zu)\n", n_in, ws_size, (size_t)WS_END2); grid = -1; return; }
        int dev = 0, cus = 0, per_cu = 0;
        if (hipGetDevice(&dev) != hipSuccess || hipDeviceGetAttribute(&cus, hipDeviceAttributeMultiprocessorCount, dev) != hipSuccess) { grid = -1; return; }
        if (hipFuncSetAttribute((const void*)hybrid_fwd, hipFuncAttributeMaxDynamicSharedMemorySize, LDS_TOTAL) != hipSuccess) { fprintf(stderr, "kernel_launch: hipFuncSetAttribute failed\n"); grid = -1; return; }
        if (hipOccupancyMaxActiveBlocksPerMultiprocessor(&per_cu, (const void*)hybrid_fwd, NTHR, LDS_TOTAL) != hipSuccess || per_cu < 1) { fprintf(stderr, "kernel_launch: occupancy query says %d\n", per_cu); }
        (void)hipGetLastError();
        grid = cus;
    }
    if (grid < 0) return;
    if (hipMemsetAsync((char*)d_ws + WS_CTL, 0, CTL_BYTES, stream) != hipSuccess) return;
    Params p{};
    for (int i = 0; i < 28; ++i) p.in[i] = (const float*)d_in[i];
    p.out = (float*)d_out; p.ws = (unsigned char*)d_ws;
    hipLaunchKernelGGL(hybrid_fwd, dim3(grid), dim3(NTHR), LDS_TOTAL, stream, p);
}
```

```cpp
#include <hip/hip_runtime.h>
#include <cstdio>
#include <cstdint>

#define LAS __attribute__((address_space(3)))
typedef unsigned short bf16_t;
typedef short bf16x8 __attribute__((ext_vector_type(8)));
typedef short bf16x4 __attribute__((ext_vector_type(4)));
typedef float f32x4 __attribute__((ext_vector_type(4)));
typedef float f32x2 __attribute__((ext_vector_type(2)));
typedef unsigned u32x4 __attribute__((ext_vector_type(4)));
typedef unsigned u32x2 __attribute__((ext_vector_type(2)));

constexpr int D = 1024, NB = 8, SEQ = 4096, NTOK = NB * SEQ, DEPTH = 4;
constexpr int W_AB = 2508, W_CD = 3088;
constexpr int NP_AB = 2560, NP_CD = 3072;
constexpr int AB_QA = 0, AB_KA = 256, AB_VA = 512, AB_OA = 1024, AB_QB = 1536, AB_CKV = 2048, AB_QI = 2176, AB_KI = 2432;
constexpr int CD_QC = 0, CD_KC = 256, CD_VC = 512, CD_RC = 1024, CD_QD = 1536, CD_KD = 2048, CD_VD = 2560;
constexpr int MOE_ROWS = 2 * NTOK + 16 * 256;

__device__ __forceinline__ int lbid() { int t = (int)blockIdx.x; asm volatile("" : "+s"(t)); return t; }
__device__ __forceinline__ int lgdim() { int t = (int)gridDim.x; asm volatile("" : "+s"(t)); return t; }
#define BID (lbid())
#define GDIM (lgdim())
__device__ __forceinline__ int ltid() { int t = (int)threadIdx.x; asm volatile("" : "+v"(t)); return t; }
__device__ __forceinline__ float bf2f(bf16_t b) { return __uint_as_float(((unsigned)b) << 16); }
typedef __bf16 bf16x2n __attribute__((ext_vector_type(2)));
__device__ __forceinline__ unsigned pk2(float lo, float hi) { const f32x2 v = {lo, hi}; return __builtin_bit_cast(unsigned, __builtin_convertvector(v, bf16x2n)); }
__device__ __forceinline__ bf16_t f2bf(float f) { return (bf16_t)(pk2(f, 0.f) & 0xffffu); }
__device__ __forceinline__ float wave_sum(float v) {
    v += __int_as_float(__builtin_amdgcn_update_dpp(0, __float_as_int(v), 0x128, 0xf, 0xf, false)); v += __int_as_float(__builtin_amdgcn_update_dpp(0, __float_as_int(v), 0x124, 0xf, 0xf, false));
    v += __int_as_float(__builtin_amdgcn_update_dpp(0, __float_as_int(v), 0x122, 0xf, 0xf, false)); v += __int_as_float(__builtin_amdgcn_update_dpp(0, __float_as_int(v), 0x121, 0xf, 0xf, false));
    auto a = __builtin_amdgcn_permlane16_swap(__float_as_uint(v), __float_as_uint(v), false, false); v = __uint_as_float(a[0]) + __uint_as_float(a[1]);
    auto b = __builtin_amdgcn_permlane32_swap(__float_as_uint(v), __float_as_uint(v), false, false); return __uint_as_float(b[0]) + __uint_as_float(b[1]);
}
__device__ __forceinline__ float sigmoidf_(float x) { return 1.0f / (1.0f + __expf(-x)); }
__device__ __forceinline__ float siluf_(float x) { return x / (1.0f + __expf(-x)); }
__device__ __forceinline__ float logsigmoidf_(float x) { return fminf(x, 0.0f) - __logf(1.0f + __expf(-fabsf(x))); }

#define XB_TMO      128
#define XB_XCNT(j)  (256  + 64 * (j))
#define XB_XSUB(j)  (1280 + 64 * (j))
#define XB_XGEN(j)  (2304 + 64 * (j))
#define XB_TOP      3328
#define XB_TOPGEN   3392
#define XCD_BAR_WORDS 3456
#define XB_SPIN_CAP (1u << 18)

__device__ __forceinline__ unsigned xb_ld(unsigned* p)              { return __hip_atomic_load(p, __ATOMIC_RELAXED, __HIP_MEMORY_SCOPE_AGENT); }
__device__ __forceinline__ unsigned xb_add(unsigned* p, unsigned v) { return __hip_atomic_fetch_add(p, v, __ATOMIC_RELAXED, __HIP_MEMORY_SCOPE_AGENT); }
__device__ __forceinline__ unsigned xb_xcc_id() { return (unsigned)__builtin_amdgcn_s_getreg((3 << 11) | 20) & 0xFu; }
#define XB_SPIN(cond, bar) do { unsigned _sp = 0; while (cond) { __builtin_amdgcn_s_sleep(1); \
    if ((++_sp & 255u) == 0u) { if (xb_ld(&(bar)[XB_TMO])) break; if (_sp > XB_SPIN_CAP) { atomicAdd(&(bar)[XB_TMO], 1u); break; } } } } while (0)

struct XcdBarrier { unsigned* bar; unsigned x; volatile LAS unsigned* st; };

__device__ __forceinline__ XcdBarrier xcd_barrier_post(unsigned* bar, volatile LAS unsigned* st) {
    XcdBarrier b; b.bar = bar; b.x = xb_xcc_id(); b.st = st;
    if (ltid() == 0) (void)xb_add(&bar[XB_XCNT(b.x)], 1u);
    return b;
}
__device__ __forceinline__ void xcd_barrier_complete(unsigned* bar, unsigned x, unsigned& nloc, unsigned& nx) {
    const unsigned G = (unsigned)GDIM;
    unsigned sum, cnt, mine, sp = 0u;
    for (;;) {
        sum = 0u; cnt = 0u; mine = 0u;
#pragma unroll
        for (unsigned j = 0; j < 16; ++j) { const unsigned c = xb_ld(&bar[XB_XCNT(j)]); sum += c; cnt += (c > 0u) ? 1u : 0u; mine = (j == x) ? c : mine; }
        if (sum == G) break;
        __builtin_amdgcn_s_sleep(1);
        if ((++sp & 255u) == 0u) { if (xb_ld(&bar[XB_TMO])) break; if (sp > XB_SPIN_CAP) { atomicAdd(&bar[XB_TMO], 1u); break; } }
    }
    nloc = mine > 0u ? mine : 1u; nx = cnt > 0u ? cnt : 1u;
}
__device__ __forceinline__ void xcd_barrier1(const XcdBarrier& b) {
    asm volatile("s_waitcnt vmcnt(0)" ::: "memory");
    __syncthreads();
    if (ltid() == 0) {
        unsigned* bar = b.bar;
        __builtin_amdgcn_s_waitcnt(0);
        unsigned nloc = b.st[0], nx = b.st[1];
        if (nloc == 0u) { xcd_barrier_complete(bar, b.x, nloc, nx); b.st[0] = nloc; b.st[1] = nx; }
        const unsigned old = xb_add(&bar[XB_XSUB(b.x)], 1u);
        const unsigned gen = old / nloc;
        if (old + 1u == (gen + 1u) * nloc) {
            __builtin_amdgcn_fence(__ATOMIC_RELEASE, "agent");
            asm volatile("s_waitcnt vmcnt(0)" ::: "memory");
            const unsigned og = xb_add(&bar[XB_TOP], 1u);
            const unsigned tg = og / nx;
            if (og + 1u == (tg + 1u) * nx) xb_add(&bar[XB_TOPGEN], 1u);
            else XB_SPIN(xb_ld(&bar[XB_TOPGEN]) == tg, bar);
            __builtin_amdgcn_fence(__ATOMIC_ACQUIRE, "agent");
            xb_add(&bar[XB_XGEN(b.x)], 1u);
            asm volatile("s_waitcnt vmcnt(0)" ::: "memory");
        } else {
            XB_SPIN(xb_ld(&bar[XB_XGEN(b.x)]) == gen, bar);
            __builtin_amdgcn_fence(__ATOMIC_ACQUIRE, "agent");
            asm volatile("s_waitcnt vmcnt(0)" ::: "memory");
        }
    }
    __syncthreads();
}

__device__ __forceinline__ void xcd_barrier(const XcdBarrier& b) {
#if defined(PROF) && PROF == 60
    unsigned long long _t0 = 0; if (ltid() == 0) _t0 = wall_clock64();
#endif
    xcd_barrier1(b);
#if defined(PROF) && PROF == 60
    if (ltid() == 0) *(LAS unsigned long long*)((LAS unsigned char*)b.st - 0 + 32) += wall_clock64() - _t0;
#endif
}

namespace pg8 {
constexpr int BM = 256, BK = 64, HALF = 128, HTB = HALF * BK * 2, STAGE_BYTES = 8 * HTB, NXCD = 8, WGM = 8;
__host__ __device__ __forceinline__ int lds_byte(int r, int c) { const int st = (r >> 4) * 2 + (c >> 5), rr = r & 15, cc = c & 31, ob = rr * 64 + cc * 2; return st * 1024 + (ob ^ (((ob >> 9) & 1) << 5)); }
__host__ __device__ __forceinline__ void stage_rc(int b, int& R, int& C) { const int st = b / 1024, sb = b % 1024, swz = sb ^ (((sb >> 9) & 1) << 5); R = (st >> 1) * 16 + swz / 64; C = (st & 1) * 32 + (swz % 64) / 2; }
__host__ __device__ __forceinline__ int perm32(int rho) { const int n = rho >> 4, i = rho & 15; return 8 * (i >> 2) + 4 * n + (i & 3); }

struct Unit { int pm, pn; };
struct Gemm { const bf16_t* A; const bf16_t* Bt; int M, N, K; const int* rowtok; };

struct StaticOrder {
    int nM, nN, nwg, G, c;
    __host__ __device__ void init(int M, int N, int G_, int c_) { nM = M / BM; nN = N / BM; nwg = nM * nN; G = G_; c = c_; }
    __host__ __device__ bool next(int i, Unit& u) const {
        const long L = (long)i * G + c; if (L >= nwg) return false;
        int wgid = (int)L; { const int q = nwg / NXCD, r = nwg % NXCD, xcd = wgid % NXCD, off = wgid / NXCD; wgid = (xcd < r ? xcd * (q + 1) : r * (q + 1) + (xcd - r) * q) + off; }
        const int nig = WGM * nN, gid = wgid / nig, fm = gid * WGM, gsz = (nM - fm) < WGM ? (nM - fm) : WGM;
        u.pm = fm + ((wgid % nig) % gsz); u.pn = (wgid % nig) / gsz; return true;
    }
    __device__ __forceinline__ void a_ready(const Unit&) const {}
    __device__ __forceinline__ void done(const Unit&) const {}
};
struct MoeOrder {
    const LAS int* tbase;
    int G, c;
    __device__ bool next(int i, Unit& u) const {
        const int L = i * G + c; const int total = tbase[16] * 4; if (L >= total) return false;
        const int pm = L >> 2; int e = 0;
#pragma unroll
        for (int k = 1; k < 16; ++k) e += (pm >= tbase[k]) ? 1 : 0;
        u.pm = pm; u.pn = e * 4 + (L & 3); return true;
    }
    __device__ __forceinline__ void a_ready(const Unit&) const {}
    __device__ __forceinline__ void done(const Unit&) const {}
};

__device__ __forceinline__ unsigned cvt_pk_bf16(float lo, float hi) { return pk2(lo, hi); }

template <bool MOE> struct EpiBf16 {
    static constexpr bool PERM = true, AFTER_DRAIN = false;
    bf16_t* O; int ldc;
    bf16_t* kic; bf16_t* ckc;
    LAS unsigned char* scr;
    __device__ __forceinline__ void operator()(const f32x4 (&acc)[2][2][4][2], const Unit& u, int wr, int wc, int fr, int fq) const {
        const int lane = fq * 16 + fr, rr = lane >> 2, pc = lane & 3;
        LAS unsigned char* sw = scr + (wr * 4 + wc) * 1536;
        LAS u32x4* wp = (LAS u32x4*)(sw + fr * 80 + fq * 16); const LAS u32x4* rp = (const LAS u32x4*)(sw + rr * 80 + pc * 16);
        const int row0 = u.pm * BM + wr * 64 + fr, rowT = u.pm * BM + wr * 64 + rr; const int colt = (MOE ? (u.pn & 3) : u.pn) * BM; const int colT = colt + wc * 32 + 8 * pc;
#pragma unroll
        for (int ai = 0; ai < 2; ++ai)
#pragma unroll
            for (int m = 0; m < 4; ++m) { bf16_t* rowp = O + (size_t)(rowT + ai * HALF + m * 16) * ldc + colT;
#pragma unroll
                for (int bj = 0; bj < 2; ++bj) { const f32x4 v0 = acc[ai][bj][m][0], v1 = acc[ai][bj][m][1];
                    u32x4 w; w.x = cvt_pk_bf16(v0[0], v0[1]); w.y = cvt_pk_bf16(v0[2], v0[3]); w.z = cvt_pk_bf16(v1[0], v1[1]); w.w = cvt_pk_bf16(v1[2], v1[3]);
                    *wp = w; const u32x4 wt = *rp;
                    *(u32x4*)(rowp + bj * HALF) = wt;
                    if (!MOE) {
                        if (kic && u.pn == 9 && bj == 1 && wc < 2) { const size_t row = (size_t)(row0 + ai * HALF + m * 16); *(u32x4*)(kic + ((row >> 4) * 2 + wc) * 512 + (fq * 16 + (row & 15)) * 8) = w; }
                        if (ckc && u.pn == 8 && bj == 0) { const size_t row = (size_t)(rowT + ai * HALF + m * 16); *(u32x4*)(ckc + row * 128 + wc * 32 + 8 * pc) = wt; } } } }
    }
};
struct EpiOutRes {
    static constexpr bool PERM = false, AFTER_DRAIN = false;
    float* X; const float* gate;
    LAS unsigned char* scr;
    __device__ __forceinline__ void operator()(const f32x4 (&acc)[2][2][4][2], const Unit& u, int wr, int wc, int fr, int fq) const {
        const int lane = fq * 16 + fr, rr = lane >> 2, pc = lane & 3;
        LAS unsigned char* sw = scr + (wr * 4 + wc) * 1536;
        LAS f32x4* wp = (LAS f32x4*)(sw + fr * 80 + fq * 16); const LAS f32x4* rp = (const LAS f32x4*)(sw + rr * 80 + pc * 16);
        const int rowT = u.pm * BM + wr * 64 + rr, colT = u.pn * BM + wc * 32 + 4 * pc;
        const float* gp = gate + (size_t)((u.pm * BM) >> 12) * (6 * D) + colT;
        f32x4 gv[2][2];
#pragma unroll
        for (int bj = 0; bj < 2; ++bj)
#pragma unroll
            for (int n = 0; n < 2; ++n) gv[bj][n] = *(const f32x4*)(gp + bj * HALF + n * 16);
        f32x4 xr[4][2][2];
#pragma unroll
        for (int g0 = 0; g0 < 3; ++g0) { const float* rowp = X + (size_t)(rowT + (g0 >> 2) * HALF + (g0 & 3) * 16) * D + colT;
#pragma unroll
          for (int bj = 0; bj < 2; ++bj)
#pragma unroll
            for (int n = 0; n < 2; ++n) xr[g0][bj][n] = *(const f32x4*)(rowp + bj * HALF + n * 16); }
#pragma unroll
        for (int gi = 0; gi < 8; ++gi) { const int ai = gi >> 2, m = gi & 3;
            float* rowp = X + (size_t)(rowT + ai * HALF + m * 16) * D + colT;
            if (gi + 3 < 8) { const int ai2 = (gi + 3) >> 2, m2 = (gi + 3) & 3; const float* rown = X + (size_t)(rowT + ai2 * HALF + m2 * 16) * D + colT;
#pragma unroll
                for (int bj = 0; bj < 2; ++bj)
#pragma unroll
                    for (int n = 0; n < 2; ++n) xr[(gi + 3) % 4][bj][n] = *(const f32x4*)(rown + bj * HALF + n * 16); }
#pragma unroll
            for (int bj = 0; bj < 2; ++bj)
#pragma unroll
                for (int n = 0; n < 2; ++n) { *wp = acc[ai][bj][m][n]; const f32x4 at = *rp;
                    *(f32x4*)(rowp + bj * HALF + n * 16) = xr[gi % 4][bj][n] + gv[bj][n] * at; } }
    }
};
struct EpiMoe1 {
    static constexpr bool PERM = false, AFTER_DRAIN = false;
    bf16_t* H1; LAS unsigned char* scr;
    __device__ __forceinline__ void operator()(const f32x4 (&acc)[2][2][4][2], const Unit& u, int wr, int wc, int fr, int fq) const {
        const int row0 = u.pm * BM + wr * 64 + fr, col0 = (u.pn & 3) * 128 + wc * 16 + 4 * fq;
#pragma unroll
        for (int ai = 0; ai < 2; ++ai)
#pragma unroll
            for (int m = 0; m < 4; ++m) { bf16_t* rowp = H1 + (size_t)(row0 + ai * HALF + m * 16) * 512 + col0;
#pragma unroll
                for (int bj = 0; bj < 2; ++bj) { const f32x4 g = acc[ai][bj][m][0], up = acc[ai][bj][m][1]; float h[4];
#pragma unroll
                    for (int j = 0; j < 4; ++j) h[j] = g[j] / (1.0f + __expf(-g[j])) * up[j];
                    u32x2 w; w.x = cvt_pk_bf16(h[0], h[1]); w.y = cvt_pk_bf16(h[2], h[3]);
                    *(u32x2*)(rowp + bj * 64) = w; } }
    }
};

template <class Epi, class Sched, bool GATHER = false>
__device__ __forceinline__ void gemm_phase(LAS unsigned char* lds, const Gemm g, const Sched& S, const Epi& E) {
    const int tid = ltid(), wid = __builtin_amdgcn_readfirstlane(tid >> 6), lane = tid & 63, wr = wid >> 2, wc = wid & 3, fr = lane & 15, fq = lane >> 4;
    const int K = g.K, nt = K / BK;
    unsigned voffA[2], voffB[2];
#pragma unroll
    for (int i = 0; i < 2; ++i) { int R, C; stage_rc(tid * 16 + i * 8192, R, C); const int Rb = Epi::PERM ? ((R & ~31) + perm32(R & 31)) : R;
        voffA[i] = (unsigned)(R * K + C) * 2u; voffB[i] = (unsigned)(Rb * K + C) * 2u; }
    unsigned vc0[2] = {0u, 0u}, vc1[2] = {0u, 0u}, vn0[2] = {0u, 0u}, vn1[2] = {0u, 0u};
#define PG8_GOFF(pm_, v0_, v1_) do { const int _tz = ltid(); _Pragma("unroll") for (int _i = 0; _i < 2; ++_i) { int _R, _C; stage_rc(_tz * 16 + _i * 8192, _R, _C); \
        v0_[_i] = (unsigned)g.rowtok[(pm_) * BM + _R] * (unsigned)(K * 2) + (unsigned)_C * 2u; v1_[_i] = (unsigned)g.rowtok[(pm_) * BM + HALF + _R] * (unsigned)(K * 2) + (unsigned)_C * 2u; } } while (0)
    const size_t kstep = (size_t)(BK * 2);
    const size_t hstep = (size_t)HALF * K * 2;
    const size_t tstep = 2 * hstep;
    const unsigned ldsw = (unsigned)wid * 1024u;
    const int aoff = lds_byte(wr * 64 + fr, fq * 8), boff = lds_byte(wc * 32 + fr, fq * 8);
#define PG8_SA(b, h) (((b) * 2 + (h)) * HTB)
#define PG8_SB(b, h) ((4 + (b) * 2 + (h)) * HTB)
#define PG8_STAGE(bufoff, gbase, voff) do { _Pragma("unroll") for (int _i = 0; _i < 2; ++_i) \
        __builtin_amdgcn_global_load_lds((const unsigned*)((const char*)(gbase) + (voff)[_i]), (LAS unsigned*)(lds + (bufoff) + ldsw + _i * 8192), 16, 0, 0); } while (0)
#define PG8_LDA(dst, b, h) do { _Pragma("unroll") for (int m = 0; m < 4; ++m) _Pragma("unroll") for (int k = 0; k < 2; ++k) dst[m][k] = *(const LAS bf16x8*)(lds + PG8_SA(b, h) + aoff + m * 2048 + k * 1024); } while (0)
#define PG8_LDB(dst, b, h) do { _Pragma("unroll") for (int n = 0; n < 2; ++n) _Pragma("unroll") for (int k = 0; k < 2; ++k) dst[n][k] = *(const LAS bf16x8*)(lds + PG8_SB(b, h) + boff + n * 2048 + k * 1024); } while (0)
#define PG8_MMA(ai, bj, At, Bt) do { __builtin_amdgcn_s_setprio(1); _Pragma("unroll") for (int m = 0; m < 4; ++m) _Pragma("unroll") for (int n = 0; n < 2; ++n) _Pragma("unroll") for (int k = 0; k < 2; ++k) \
        acc[ai][bj][m][n] = __builtin_amdgcn_mfma_f32_16x16x32_bf16(Bt[n][k], At[m][k], acc[ai][bj][m][n], 0, 0, 0); __builtin_amdgcn_s_setprio(0); } while (0)
#define PG8_WAIT_V(n) asm volatile("s_waitcnt vmcnt(" #n ")" ::: "memory")
#define PG8_WAIT_L(n) asm volatile("s_waitcnt lgkmcnt(" #n ")" ::: "memory")
#define PG8_BAR __builtin_amdgcn_s_barrier()
#define PG8_SCHED __builtin_amdgcn_sched_barrier(0)
    Unit cur, nxt; int ui = 0;
    if (!S.next(0, cur)) return;
    f32x4 acc[2][2][4][2];
#pragma unroll
    for (int a = 0; a < 2; ++a)
#pragma unroll
        for (int b = 0; b < 2; ++b)
#pragma unroll
            for (int m = 0; m < 4; ++m)
#pragma unroll
                for (int n = 0; n < 2; ++n) acc[a][b][m][n] = (f32x4){0.f, 0.f, 0.f, 0.f};
    bf16x8 At[4][2], B0[2][2], B1[2][2];
    const char* cA = GATHER ? (const char*)g.A : (const char*)g.A + (size_t)cur.pm * tstep; const char* cB = (const char*)g.Bt + (size_t)cur.pn * tstep;
    S.a_ready(cur);
    if constexpr (GATHER) { PG8_GOFF(cur.pm, vc0, vc1); vn0[0] = vc0[0]; vn0[1] = vc0[1]; vn1[0] = vc1[0]; vn1[1] = vc1[1]; }
    if constexpr (GATHER) { PG8_STAGE(PG8_SB(0, 0), cB, voffB); PG8_STAGE(PG8_SA(0, 0), cA, vc0); PG8_STAGE(PG8_SB(0, 1), cB + hstep, voffB); PG8_STAGE(PG8_SA(0, 1), cA, vc1); }
    else { PG8_STAGE(PG8_SB(0, 0), cB, voffB); PG8_STAGE(PG8_SA(0, 0), cA, voffA); PG8_STAGE(PG8_SB(0, 1), cB + hstep, voffB); PG8_STAGE(PG8_SA(0, 1), cA + hstep, voffA); }
    if (wr == 1) PG8_BAR;
    PG8_WAIT_V(4); PG8_BAR;
    if constexpr (GATHER) { PG8_STAGE(PG8_SB(1, 0), cB + kstep, voffB); PG8_STAGE(PG8_SA(1, 0), cA + kstep, vc0); PG8_STAGE(PG8_SB(1, 1), cB + hstep + kstep, voffB); }
    else { PG8_STAGE(PG8_SB(1, 0), cB + kstep, voffB); PG8_STAGE(PG8_SA(1, 0), cA + kstep, voffA); PG8_STAGE(PG8_SB(1, 1), cB + hstep + kstep, voffB); }
    PG8_WAIT_V(6); PG8_BAR;
    for (;;) {
        const bool has_next = S.next(ui + 1, nxt);
        const char* nA = GATHER ? cA : (has_next ? (const char*)g.A + (size_t)nxt.pm * tstep : cA); const char* nB = has_next ? (const char*)g.Bt + (size_t)nxt.pn * tstep : cB;
        if constexpr (GATHER) { if (has_next) PG8_GOFF(nxt.pm, vn0, vn1); }
        for (int t = 0; t < nt; t += 2) {
            const bool last = (t == nt - 2);
            unsigned s0[2] = {vc0[0], vc0[1]}, s1[2] = {vc1[0], vc1[1]};
            if constexpr (GATHER) { if (last) { asm volatile("" : "+v"(vn0[0]), "+v"(vn0[1]), "+v"(vn1[0]), "+v"(vn1[1])); s0[0] = vn0[0]; s0[1] = vn0[1]; s1[0] = vn1[0]; s1[1] = vn1[1]; } }
            const char* a1 = cA + (size_t)(t + 1) * kstep;
            const char* a2 = last ? nA : cA + (size_t)(t + 2) * kstep; const char* b2 = last ? nB : cB + (size_t)(t + 2) * kstep;
            const char* a3 = a2 + kstep; const char* b3 = b2 + kstep;
            if (last && has_next) S.a_ready(nxt);
            PG8_LDB(B0, 0, 0); PG8_SCHED; PG8_LDA(At, 0, 0); if constexpr (GATHER) PG8_STAGE(PG8_SA(1, 1), a1, vc1); else PG8_STAGE(PG8_SA(1, 1), a1 + hstep, voffA);
            PG8_WAIT_L(8); PG8_BAR; PG8_WAIT_L(0); PG8_MMA(0, 0, At, B0); PG8_BAR; PG8_SCHED;
            PG8_LDB(B1, 0, 1); PG8_STAGE(PG8_SB(0, 0), b2, voffB);
            PG8_BAR; PG8_WAIT_L(0); PG8_MMA(0, 1, At, B1); PG8_BAR;
            PG8_LDA(At, 0, 1); if constexpr (GATHER) PG8_STAGE(PG8_SA(0, 0), a2, s0); else PG8_STAGE(PG8_SA(0, 0), a2, voffA);
            PG8_BAR; PG8_WAIT_L(0); PG8_MMA(1, 0, At, B0); PG8_BAR; PG8_SCHED;
            PG8_STAGE(PG8_SB(0, 1), b2 + hstep, voffB);
            PG8_WAIT_V(6); PG8_BAR; PG8_MMA(1, 1, At, B1); PG8_BAR;
            PG8_LDB(B0, 1, 0); PG8_SCHED; PG8_LDA(At, 1, 0); if constexpr (GATHER) PG8_STAGE(PG8_SA(0, 1), a2, s1); else PG8_STAGE(PG8_SA(0, 1), a2 + hstep, voffA);
            PG8_WAIT_L(8); PG8_BAR; PG8_WAIT_L(0); PG8_MMA(0, 0, At, B0); PG8_BAR; PG8_SCHED;
            PG8_LDB(B1, 1, 1); PG8_STAGE(PG8_SB(1, 0), b3, voffB);
            PG8_BAR; PG8_WAIT_L(0); PG8_MMA(0, 1, At, B1); PG8_BAR;
            PG8_LDA(At, 1, 1); if constexpr (GATHER) PG8_STAGE(PG8_SA(1, 0), a3, s0); else PG8_STAGE(PG8_SA(1, 0), a3, voffA);
            PG8_BAR; PG8_WAIT_L(0); PG8_MMA(1, 0, At, B0); PG8_BAR; PG8_SCHED;
            PG8_STAGE(PG8_SB(1, 1), b3 + hstep, voffB);
            PG8_WAIT_V(6); PG8_BAR; PG8_MMA(1, 1, At, B1); PG8_BAR;
        }
        E(acc, cur, wr, wc, fr, fq); S.done(cur);
        if (!has_next) break;
#pragma unroll
        for (int a = 0; a < 2; ++a)
#pragma unroll
            for (int b = 0; b < 2; ++b)
#pragma unroll
                for (int m = 0; m < 4; ++m)
#pragma unroll
                    for (int n = 0; n < 2; ++n) acc[a][b][m][n] = (f32x4){0.f, 0.f, 0.f, 0.f};
        cur = nxt; cA = nA; cB = nB; ++ui;
        if constexpr (GATHER) { vc0[0] = vn0[0]; vc0[1] = vn0[1]; vc1[0] = vn1[0]; vc1[1] = vn1[1]; }
    }
    PG8_WAIT_V(0);
    if (wr == 0) PG8_BAR;
    PG8_BAR;
#undef PG8_GOFF
#undef PG8_SA
#undef PG8_SB
#undef PG8_STAGE
#undef PG8_LDA
#undef PG8_LDB
#undef PG8_MMA
#undef PG8_WAIT_V
#undef PG8_WAIT_L
#undef PG8_BAR
#undef PG8_SCHED
}
}
constexpr size_t MiB = 1024 * 1024;
constexpr size_t WS_CTL  = 0;
constexpr size_t CTL_BYTES = 65536;
constexpr size_t WS_MOD  = WS_CTL + CTL_BYTES;
constexpr size_t WS_BKT  = WS_MOD + 4 * 8 * 6144 * 4;
constexpr size_t WS_SP   = WS_BKT + 4096 * 4;
constexpr size_t WS_RTE  = WS_SP + (size_t)NTOK * 16 * 4;
constexpr size_t WS_RTW  = WS_RTE + (size_t)NTOK * 4;
constexpr size_t WS_POS  = WS_RTW + (size_t)NTOK * 8;
constexpr size_t WS_TC   = WS_POS + (size_t)NTOK * 8;
constexpr size_t WS_WUK  = WS_TC + 256 * 16 * 4;
constexpr size_t WS_WUV  = WS_WUK + 65536 * 2;
constexpr size_t WS_X    = 4 * MiB;
constexpr size_t WS_HBF  = WS_X + 128 * MiB;
constexpr size_t WS_P    = WS_HBF + 64 * MiB;
constexpr size_t WS_YMIX = WS_P + 192 * MiB;
constexpr size_t WS_H1   = WS_YMIX + 64 * MiB;
constexpr size_t WS_WIN  = WS_H1 + 68 * MiB;
constexpr size_t WS_WOUT = WS_WIN + 6 * MiB;
constexpr size_t WS_WGU  = WS_WOUT + 2 * MiB;
constexpr size_t WS_WDN  = WS_WGU + 32 * MiB;
constexpr size_t WS_END  = WS_WDN + 16 * MiB;
constexpr size_t WS_CL   = WS_END;
constexpr size_t WS_SCAL = WS_CL + 72 * MiB;
constexpr size_t WS_MC   = WS_SCAL + 512 * 1024;
constexpr size_t WS_KIC  = WS_MC + 1024 * 1024;
constexpr size_t WS_CKC  = WS_KIC + 4 * MiB;
constexpr size_t WS_ROWTOK = WS_MC + 512 * 1024;
constexpr size_t WS_END2 = WS_CKC + 8 * MiB;
constexpr size_t WS_CTG  = WS_HBF;
constexpr size_t WS_STG  = WS_H1 + 36 * MiB;
static_assert(WS_WUV + 65536 * 2 <= WS_X, "small region overflow");
static_assert((size_t)MOE_ROWS * 512 * 2 <= 68 * MiB, "H1");
static_assert((size_t)MOE_ROWS * 1024 * 2 <= 192 * MiB, "AS");

constexpr int CW_BAR = 0;
constexpr int CW_WQ  = 4096;

constexpr int LDS_TOTAL = 147456;
constexpr int LDS_PERS  = 143360;
constexpr int LP_SLOT = 16, LP_TBASE = 64;
constexpr int LDS_EPI = 131072;
static_assert(LDS_EPI + 8 * 1536 <= LDS_PERS, "epilogue slots overlap the persistent words");

struct Params { const float* in[28]; float* out; unsigned char* ws; };
enum { I_X = 0, I_C, I_WADA, I_BADA, I_GMIX, I_GFFN, I_GFINAL, I_RELB, I_ABWIN, I_ABCONVW, I_ABCONVB, I_ABGATEB, I_ABHNORM, I_ABWUK, I_ABWUV, I_ABWOUT,
       I_CDWIN, I_CDWALPHA, I_CDBALPHA, I_CDHNORM, I_CDWOUT, I_MWC, I_MBC, I_MWF, I_MBF, I_MWG, I_MWU, I_MWD };

#define TID (ltid())
#define NTHR 512

__device__ __forceinline__ void p0_prologue(const Params& p, LAS unsigned char* lds) {
    const int tid = ltid(), G = GDIM;
    LAS float* sc = (LAS float*)lds;
    LAS float* red = (LAS float*)(lds + 32768);
    const float* c = p.in[I_C];
    for (int i = tid; i < 8 * 1024; i += NTHR) { const float v = c[i]; sc[i] = v / (1.0f + __expf(-v)); }
    __syncthreads();
    float* mod = (float*)(p.ws + WS_MOD);
    for (int u = BID; u < 4 * 48; u += G) {
        const int l = u / 48, e0 = (u % 48) * 128, col = tid & 127, ds = tid >> 7;
        const float* w = p.in[I_WADA] + (size_t)l * D * 6 * D + e0 + col;
        float a[8];
#pragma unroll
        for (int b = 0; b < 8; ++b) a[b] = 0.f;
#pragma unroll 16
        for (int d = ds * 256; d < ds * 256 + 256; ++d) { const float wv = w[(size_t)d * 6 * D];
#pragma unroll
            for (int b = 0; b < 8; ++b) a[b] += sc[b * 1024 + d] * wv; }
#pragma unroll
        for (int b = 0; b < 8; ++b) red[(ds * 8 + b) * 128 + col] = a[b];
        __syncthreads();
        for (int i = tid; i < 8 * 128; i += NTHR) { const int b = i >> 7, cc = i & 127;
            const float s = ((red[(0 * 8 + b) * 128 + cc] + red[(1 * 8 + b) * 128 + cc]) + red[(2 * 8 + b) * 128 + cc]) + red[(3 * 8 + b) * 128 + cc];
            mod[((size_t)l * 8 + b) * 6 * D + e0 + cc] = s + p.in[I_BADA][(size_t)l * 6 * D + e0 + cc]; }
        __syncthreads();
    }
    int* bkt = (int*)(p.ws + WS_BKT);
    for (int n = BID * NTHR + tid; n < 4096; n += G * NTHR) {
        int v;
        if (n < 16) v = n; else { v = 16 + (int)(log((double)n / 16.0) / log(128.0) * 16.0); if (v > 31) v = 31; }
        bkt[n] = v;
    }
}

template <class SrcF>
__device__ __forceinline__ void prep_tr(LAS unsigned char* lds, const SrcF& src, int K, int Nd, bf16_t* Bt) {
    LAS float* tile = (LAS float*)lds;
    const int tid = TID, G = GDIM, tnN = Nd / 64, ntile = tnN * (K / 64);
    float cur[8], nxt[8];
    int u = BID;
    if (u < ntile) { const int tn = u % tnN, tk = u / tnN;
#pragma unroll
        for (int i = 0; i < 8; ++i) cur[i] = src(tn * 64 + (tid & 63), tk * 64 + (tid >> 6) + 8 * i); }
    for (; u < ntile; u += G) {
        const int tn = u % tnN, tk = u / tnN; const int un = u + G;
        if (un < ntile) { const int tn2 = un % tnN, tk2 = un / tnN;
#pragma unroll
            for (int i = 0; i < 8; ++i) nxt[i] = src(tn2 * 64 + (tid & 63), tk2 * 64 + (tid >> 6) + 8 * i); }
#pragma unroll
        for (int i = 0; i < 8; ++i) tile[((tid >> 6) + 8 * i) * 65 + (tid & 63)] = cur[i];
        __syncthreads();
#pragma unroll
        for (int i = 0; i < 4; ++i) { const int nn = (tid >> 5) + 16 * i, kk = (tid & 31) * 2;
            *(unsigned*)(Bt + (size_t)(tn * 64 + nn) * K + tk * 64 + kk) = pk2(tile[kk * 65 + nn], tile[(kk + 1) * 65 + nn]); }
        __syncthreads();
#pragma unroll
        for (int i = 0; i < 8; ++i) cur[i] = nxt[i];
    }
}
struct SrcShift { const float* W; int ldw, n0, shift, nvalid;
    __device__ __forceinline__ float operator()(int n, int k) const { if (n >= nvalid) return 0.f; return W[(size_t)k * ldw + (n >= n0 ? n + shift : n)]; } };
struct SrcGU { const float* Wg; const float* Wu;
    __device__ __forceinline__ float operator()(int n, int k) const { const int e = n >> 10, r = n & 1023, j = (r >> 5) * 16 + (r & 15); const unsigned long long dlt = (unsigned long long)Wu - (unsigned long long)Wg; const float* W = (const float*)((unsigned long long)Wg + (unsigned long long)((r >> 4) & 1) * dlt); return W[((size_t)e * 1024 + k) * 512 + j]; } };
struct SrcDN { const float* Wd;
    __device__ __forceinline__ float operator()(int n, int k) const { return Wd[((size_t)(n >> 10) * 512 + k) * 1024 + (n & 1023)]; } };

constexpr size_t WS_TAB = WS_WUV + 65536 * 2;
static_assert(WS_TAB + 13 * 16384 <= WS_X, "small region overflow");
struct WfAB { const float* W; __device__ __forceinline__ float operator()(int k, int c) const {
        if (c >= 12) return 0.f; const int col = c < 8 ? 1536 + c : 2504 + (c - 8); return W[(size_t)k * W_AB + col]; } };
struct WfCD { const float* W; __device__ __forceinline__ float operator()(int k, int c) const { return W[(size_t)k * W_CD + 1024 + c]; } };
struct WfRT { const float* Wc; const float* Wf; __device__ __forceinline__ float operator()(int k, int c) const {
        if (c < 4) return Wc[(size_t)k * 4 + c]; const int g = (c - 4) >> 2, e = (c - 4) & 3; return Wf[((size_t)g * D + k) * 4 + e]; } };
template <class WF>
__device__ __forceinline__ void build_small_tab(f32x4* tab, int nc4, const WF& wf) {
    for (int idx = BID * NTHR + TID; idx < nc4 * 1024; idx += GDIM * NTHR) {
        const int c4 = idx >> 10, r = idx & 1023, ij = r >> 6, lane = r & 63, k = 512 * (ij >> 3) + 8 * lane + (ij & 7);
        f32x4 v; v[0] = wf(k, 4 * c4); v[1] = wf(k, 4 * c4 + 1); v[2] = wf(k, 4 * c4 + 2); v[3] = wf(k, 4 * c4 + 3);
        tab[idx] = v; }
}
__device__ __forceinline__ void prep_layer(const Params& p, LAS unsigned char* lds, int l) {
    const int j = l >> 1;
    if ((l & 1) == 0) {
        SrcShift s{p.in[I_ABWIN] + (size_t)j * D * W_AB, W_AB, 1536, 8, 2496};
        prep_tr(lds, s, D, NP_AB, (bf16_t*)(p.ws + WS_WIN));
        SrcShift so{p.in[I_ABWOUT] + (size_t)j * D * D, D, 1 << 30, 0, D};
        prep_tr(lds, so, D, D, (bf16_t*)(p.ws + WS_WOUT));
        const float* wuk = p.in[I_ABWUK] + (size_t)j * 65536; const float* wuv = p.in[I_ABWUV] + (size_t)j * 65536;
        bf16_t* ouk = (bf16_t*)(p.ws + WS_WUK); bf16_t* ouv = (bf16_t*)(p.ws + WS_WUV);
        for (int i = BID * NTHR + TID; i < 65536; i += GDIM * NTHR) {
            const int e = i & 7, fr = (i >> 3) & 15, g = (i >> 7) & 3, h = i >> 13;
            { const int rt = (i >> 9) & 7, kk = (i >> 12) & 1; ouk[i] = f2bf(wuk[((size_t)(rt * 16 + fr) * 8 + h) * 64 + kk * 32 + g * 8 + e]); }
            { const int nt = (i >> 9) & 3, kk = (i >> 11) & 3; ouv[i] = f2bf(wuv[((size_t)(kk * 32 + g * 8 + e) * 8 + h) * 64 + nt * 16 + fr]); }
        }
    } else {
        SrcShift s{p.in[I_CDWIN] + (size_t)j * D * W_CD, W_CD, 1024, 16, 3072};
        prep_tr(lds, s, D, NP_CD, (bf16_t*)(p.ws + WS_WIN));
        SrcShift so{p.in[I_CDWOUT] + (size_t)j * D * D, D, 1 << 30, 0, D};
        prep_tr(lds, so, D, D, (bf16_t*)(p.ws + WS_WOUT));
    }
    { f32x4* tabg = (f32x4*)(p.ws + WS_TAB);
      if (l == 0) { WfAB wf{p.in[I_ABWIN]}; build_small_tab(tabg, 4, wf); }
      if (l + 1 < DEPTH) { const int ln = l + 1, jn = ln >> 1;
          if ((ln & 1) == 0) { WfAB wf{p.in[I_ABWIN] + (size_t)jn * D * W_AB}; build_small_tab(tabg + (ln & 1) * 4096, 4, wf); } else { WfCD wf{p.in[I_CDWIN] + (size_t)jn * D * W_CD}; build_small_tab(tabg + (ln & 1) * 4096, 4, wf); } }
      WfRT wr{p.in[I_MWC] + (size_t)l * D * 4, p.in[I_MWF] + (size_t)l * 4 * D * 4}; build_small_tab(tabg + 8 * 1024, 5, wr); }
    SrcGU sg{p.in[I_MWG] + (size_t)l * 16 * 1024 * 512, p.in[I_MWU] + (size_t)l * 16 * 1024 * 512};
    prep_tr(lds, sg, 1024, 16 * 1024, (bf16_t*)(p.ws + WS_WGU));
    SrcDN sd{p.in[I_MWD] + (size_t)l * 16 * 512 * 1024};
    prep_tr(lds, sd, 512, 16 * 1024, (bf16_t*)(p.ws + WS_WDN));
}

__device__ __forceinline__ void copy_tab_to_lds(LAS f32x4* dst, const f32x4* src, int n) { for (int i = TID; i < n; i += NTHR) dst[i] = src[i]; }
template <int NC4>
__device__ __forceinline__ void small_proj(const LAS f32x4* tab, const float (&h)[2][8], int lane, f32x4 (&out)[NC4]) {
#pragma unroll
    for (int c4 = 0; c4 < NC4; ++c4) { f32x4 a = (f32x4){0.f, 0.f, 0.f, 0.f};
#pragma unroll
        for (int i = 0; i < 2; ++i) { f32x4 t[8];
#pragma unroll
            for (int j = 0; j < 8; ++j) t[j] = tab[(c4 * 16 + i * 8 + j) * 64 + lane];
            asm volatile("" ::: "memory");
#pragma unroll
            for (int j = 0; j < 8; ++j) a += t[j] * h[i][j]; }
        out[c4] = a; asm volatile("" ::: "memory"); }
}
template <int CTRL, int ROWS, int BANKS> __device__ __forceinline__ float dppf(float ident, float v) { return __int_as_float(__builtin_amdgcn_update_dpp(__float_as_int(ident), __float_as_int(v), CTRL, ROWS, BANKS, false)); }
__device__ __forceinline__ float swap32_sum(float lo, float hi) { auto r = __builtin_amdgcn_permlane32_swap(__float_as_uint(lo), __float_as_uint(hi), false, false); return __uint_as_float(r[0]) + __uint_as_float(r[1]); }
__device__ __forceinline__ float swap16_sum(float a, float b) { auto r = __builtin_amdgcn_permlane16_swap(__float_as_uint(a), __float_as_uint(b), false, false); return __uint_as_float(r[0]) + __uint_as_float(r[1]); }
__device__ __forceinline__ float reduce16(const f32x4 (&a)[4], int lane) {
    const bool b3 = (lane & 8) != 0, b2 = (lane & 4) != 0;
    float w8[8], w4[4], w2[2];
#pragma unroll
    for (int c = 0; c < 8; ++c) w8[c] = swap32_sum(a[c >> 2][c & 3], a[(c + 8) >> 2][c & 3]);
#pragma unroll
    for (int c = 0; c < 4; ++c) w4[c] = swap16_sum(w8[c], w8[c + 4]);
#pragma unroll
    for (int c = 0; c < 2; ++c) { const float keep = b3 ? w4[c + 2] : w4[c], send = b3 ? w4[c] : w4[c + 2]; w2[c] = keep + dppf<0x128, 0xf, 0xf>(0.f, send); }
    { const float keep = b2 ? w2[1] : w2[0], send = b2 ? w2[0] : w2[1];
      const float up = dppf<0x104, 0xf, 0x5>(0.f, send);
      const float pr = dppf<0x114, 0xf, 0xa>(up, send);
      float w1 = keep + pr;
      w1 += dppf<0x4e, 0xf, 0xf>(0.f, w1); w1 += dppf<0xb1, 0xf, 0xf>(0.f, w1);
      return w1; }
}
__device__ __forceinline__ float reduce4(const f32x4& a, int lane) {
    const float u0 = swap32_sum(a[0], a[2]), u1 = swap32_sum(a[1], a[3]);
    float w = swap16_sum(u0, u1);
    w += dppf<0x128, 0xf, 0xf>(0.f, w); w += dppf<0x124, 0xf, 0xf>(0.f, w); w += dppf<0x122, 0xf, 0xf>(0.f, w); w += dppf<0x121, 0xf, 0xf>(0.f, w);
    return w;
}
__device__ __forceinline__ float rdl(float v, int l) { return __int_as_float(__builtin_amdgcn_readlane(__float_as_int(v), l)); }
__device__ __forceinline__ void unpack8(const u32x4& v, float (&o)[8]) {
#pragma unroll
    for (int e = 0; e < 4; ++e) { o[2 * e] = __uint_as_float(v[e] << 16); o[2 * e + 1] = __uint_as_float(v[e] & 0xffff0000u); } }

template <int MODE>
__device__ __forceinline__ void phase_tokens(const Params& p, LAS unsigned char* lds, int l) {
    const int tid = ltid(), lane = tid & 63, wave = tid >> 6, G = GDIM;
    LAS f32x4* tab = (LAS f32x4*)lds;
    LAS int* cnts = (LAS int*)(lds + 5 * 16384);
    if (MODE == 1) copy_tab_to_lds(tab, (const f32x4*)(p.ws + WS_TAB) + (l & 1) * 4096, 4 * 1024);
    if (MODE == 2) copy_tab_to_lds(tab, (const f32x4*)(p.ws + WS_TAB) + 8 * 1024, 5 * 1024);
    __syncthreads();
    const float* mod = (const float*)(p.ws + WS_MOD);
    float* X = (float*)(p.ws + WS_X); bf16_t* HBF = (bf16_t*)(p.ws + WS_HBF); float* SP = (float*)(p.ws + WS_SP);
    const bf16_t* YS = (const bf16_t*)(p.ws + WS_P);
    const int* POS = (const int*)(p.ws + WS_POS); float* RTW = (float*)(p.ws + WS_RTW); int* RTE = (int*)(p.ws + WS_RTE); int* TC = (int*)(p.ws + WS_TC);
    const bool comb = (MODE == 3) || (MODE == 1 && l > 0);
    const int lprev = (MODE == 3) ? 3 : l - 1;
    const float* biasc = p.in[I_MBC] + l * 4; const float* biasf = p.in[I_MBF] + l * 16;
    for (int grp = BID; grp < NTOK / 128; grp += G) {
        const int b = (grp * 128) >> 12;
        float ca[2][8], cb[2][8], gf[2][8];
#pragma unroll
        for (int i = 0; i < 2; ++i)
#pragma unroll
            for (int j = 0; j < 8; ++j) { const int col = 512 * i + 8 * lane + j;
                if (MODE == 1) { const float* mrow = mod + ((size_t)l * 8 + b) * 6 * D; ca[i][j] = p.in[I_GMIX][(size_t)l * D + col] * (mrow[D + col] + 1.0f); cb[i][j] = mrow[col]; }
                if (MODE == 2) { const float* mrow = mod + ((size_t)l * 8 + b) * 6 * D; ca[i][j] = p.in[I_GFFN][(size_t)l * D + col] * (mrow[4 * D + col] + 1.0f); cb[i][j] = mrow[3 * D + col]; }
                if (MODE == 3) { ca[i][j] = p.in[I_GFINAL][col]; cb[i][j] = 0.f; }
                gf[i][j] = comb ? mod[((size_t)lprev * 8 + b) * 6 * D + 5 * D + col] : 0.f; }
        int pos1v = 0, pos2v = 0; float w1v = 0.f, w2v = 0.f;
        if (comb && lane < 16) { const int tk = grp * 128 + wave * 16 + lane; pos1v = POS[2 * tk]; pos2v = POS[2 * tk + 1]; w1v = RTW[2 * tk]; w2v = RTW[2 * tk + 1]; }
        const float* xsrc = (MODE == 1 && l == 0) ? p.in[I_X] : X;
        LAS unsigned char* mb = lds + ((MODE == 2) ? (5 * 16384 + 1024) : (4 * 16384 + 1024)) + __builtin_amdgcn_readfirstlane(wave) * ((MODE == 2) ? 4096 : 8192);
#define TOK_ISSUE(tt_) do { const int tok_ = grp * 128 + wave * 16 + (tt_); \
            __builtin_amdgcn_global_load_lds((const unsigned*)(xsrc + (size_t)tok_ * D + 8 * lane), (LAS unsigned*)(mb), 16, 0, 0); \
            __builtin_amdgcn_global_load_lds((const unsigned*)(xsrc + (size_t)tok_ * D + 8 * lane + 4), (LAS unsigned*)(mb + 1024), 16, 0, 0); \
            __builtin_amdgcn_global_load_lds((const unsigned*)(xsrc + (size_t)tok_ * D + 512 + 8 * lane), (LAS unsigned*)(mb + 2048), 16, 0, 0); \
            __builtin_amdgcn_global_load_lds((const unsigned*)(xsrc + (size_t)tok_ * D + 512 + 8 * lane + 4), (LAS unsigned*)(mb + 3072), 16, 0, 0); \
            if (comb) { const int q1_ = __builtin_amdgcn_readlane(pos1v, (tt_)), q2_ = __builtin_amdgcn_readlane(pos2v, (tt_)); \
                __builtin_amdgcn_global_load_lds((const unsigned*)(YS + (size_t)q1_ * D + 8 * lane), (LAS unsigned*)(mb + 4096), 16, 0, 0); \
                __builtin_amdgcn_global_load_lds((const unsigned*)(YS + (size_t)q1_ * D + 512 + 8 * lane), (LAS unsigned*)(mb + 5120), 16, 0, 0); \
                __builtin_amdgcn_global_load_lds((const unsigned*)(YS + (size_t)q2_ * D + 8 * lane), (LAS unsigned*)(mb + 6144), 16, 0, 0); \
                __builtin_amdgcn_global_load_lds((const unsigned*)(YS + (size_t)q2_ * D + 512 + 8 * lane), (LAS unsigned*)(mb + 7168), 16, 0, 0); } } while (0)
        TOK_ISSUE(0);
        int cnt = 0;
        int rte_v = 0; float rw1_v = 0.f, rw2_v = 0.f, sp_prev = 0.f;
        u32x4 hb_prev[2] = {(u32x4){0u, 0u, 0u, 0u}, (u32x4){0u, 0u, 0u, 0u}}; f32x4 xo_prev[4] = {(f32x4){0.f, 0.f, 0.f, 0.f}, (f32x4){0.f, 0.f, 0.f, 0.f}, (f32x4){0.f, 0.f, 0.f, 0.f}, (f32x4){0.f, 0.f, 0.f, 0.f}};
#pragma unroll 1
        for (int tt = 0; tt < 16; ++tt) {
            const int tok = grp * 128 + wave * 16 + tt;
            asm volatile("s_waitcnt vmcnt(0)" ::: "memory");
            u32x4 xb[4], yb[4];
#pragma unroll
            for (int k4 = 0; k4 < 4; ++k4) xb[k4] = *(const LAS u32x4*)(mb + k4 * 1024 + lane * 16);
            if (comb) {
#pragma unroll
                for (int k4 = 0; k4 < 4; ++k4) yb[k4] = *(const LAS u32x4*)(mb + 4096 + k4 * 1024 + lane * 16);
            }
            asm volatile("s_waitcnt lgkmcnt(0)" ::: "memory");
            float x[2][8];
#pragma unroll
            for (int i = 0; i < 2; ++i)
#pragma unroll
                for (int j = 0; j < 8; ++j) x[i][j] = __uint_as_float(xb[2 * i + (j >> 2)][j & 3]);
            if (comb) { const float w1 = rdl(w1v, tt), w2 = rdl(w2v, tt);
#pragma unroll
                for (int i = 0; i < 2; ++i) { float y1[8], y2[8]; unpack8(yb[i], y1); unpack8(yb[2 + i], y2);
#pragma unroll
                    for (int j = 0; j < 8; ++j) x[i][j] += gf[i][j] * (y1[j] * w1 + y2[j] * w2); } }
            if (tt > 0) { const int tp = tok - 1;
                if (MODE == 1) { if ((lane & 3) == 0) SP[(size_t)tp * 16 + (lane >> 2)] = sp_prev;
#pragma unroll
                    for (int i = 0; i < 2; ++i) { *(f32x4*)(X + (size_t)tp * D + 512 * i + 8 * lane) = xo_prev[2 * i]; *(f32x4*)(X + (size_t)tp * D + 512 * i + 8 * lane + 4) = xo_prev[2 * i + 1]; } }
                if (MODE == 3) {
#pragma unroll
                    for (int i = 0; i < 2; ++i) { *(f32x4*)(p.out + (size_t)tp * D + 512 * i + 8 * lane) = xo_prev[2 * i]; *(f32x4*)(p.out + (size_t)tp * D + 512 * i + 8 * lane + 4) = xo_prev[2 * i + 1]; } }
                else {
#pragma unroll
                    for (int i = 0; i < 2; ++i) *(u32x4*)(HBF + (size_t)tp * D + 512 * i + 8 * lane) = hb_prev[i]; } }
            if (tt + 1 < 16) TOK_ISSUE(tt + 1);
            asm volatile("" ::: "memory");
            float ss = 0.f;
#pragma unroll
            for (int i = 0; i < 2; ++i)
#pragma unroll
                for (int j = 0; j < 8; ++j) ss += x[i][j] * x[i][j];
            ss = wave_sum(ss);
            const float rstd = 1.0f / sqrtf(ss * (1.0f / 1024.0f) + 1e-6f);
            float h[2][8];
#pragma unroll
            for (int i = 0; i < 2; ++i)
#pragma unroll
                for (int j = 0; j < 8; ++j) h[i][j] = x[i][j] * rstd * ca[i][j] + cb[i][j];
            if (MODE == 1) {
#pragma unroll
                for (int i = 0; i < 2; ++i) { xo_prev[2 * i] = (f32x4){x[i][0], x[i][1], x[i][2], x[i][3]}; xo_prev[2 * i + 1] = (f32x4){x[i][4], x[i][5], x[i][6], x[i][7]}; }
            }
            if (MODE == 3) {
#pragma unroll
                for (int i = 0; i < 2; ++i) { xo_prev[2 * i] = (f32x4){h[i][0], h[i][1], h[i][2], h[i][3]}; xo_prev[2 * i + 1] = (f32x4){h[i][4], h[i][5], h[i][6], h[i][7]}; }
            } else {
#pragma unroll
                for (int i = 0; i < 2; ++i) { u32x4 w; w.x = pk2(h[i][0], h[i][1]); w.y = pk2(h[i][2], h[i][3]); w.z = pk2(h[i][4], h[i][5]); w.w = pk2(h[i][6], h[i][7]); hb_prev[i] = w; }
            }
            if (MODE == 1) {
                f32x4 o[4]; o[3] = (f32x4){0.f, 0.f, 0.f, 0.f};
                if ((l & 1) == 0) { f32x4 o3[3]; small_proj<3>(tab, h, lane, o3); o[0] = o3[0]; o[1] = o3[1]; o[2] = o3[2]; }
                else small_proj<4>(tab, h, lane, o);
                sp_prev = reduce16(o, lane);
            }
            if (MODE == 2) {
                f32x4 oc = (f32x4){0.f, 0.f, 0.f, 0.f};
#pragma unroll
                for (int i = 0; i < 2; ++i) { f32x4 t[8];
#pragma unroll
                  for (int jj = 0; jj < 8; ++jj) t[jj] = tab[(i * 8 + jj) * 64 + lane];
                  asm volatile("" ::: "memory");
#pragma unroll
                  for (int jj = 0; jj < 8; ++jj) oc += t[jj] * h[i][jj]; }
                const float vc = reduce4(oc, lane);
                float lc[4];
#pragma unroll
                for (int c = 0; c < 4; ++c) lc[c] = rdl(vc, 16 * c) + biasc[c];
                int g = 0; float mx = lc[0];
#pragma unroll
                for (int c = 1; c < 4; ++c) if (lc[c] > mx) { mx = lc[c]; g = c; }
                g = __builtin_amdgcn_readfirstlane(g);
                float se = 0.f;
#pragma unroll
                for (int c = 0; c < 4; ++c) se += expf(lc[c] - mx);
                const float pg = 1.0f / se;
                f32x4 of = (f32x4){0.f, 0.f, 0.f, 0.f};
                const LAS f32x4* tabf = tab + (1 + g) * 1024;
#pragma unroll
                for (int i = 0; i < 2; ++i) { f32x4 t[8];
#pragma unroll
                  for (int jj = 0; jj < 8; ++jj) t[jj] = tabf[(i * 8 + jj) * 64 + lane];
                  asm volatile("" ::: "memory");
#pragma unroll
                  for (int jj = 0; jj < 8; ++jj) of += t[jj] * h[i][jj]; }
                const float vf = reduce4(of, lane);
                float lf[4];
#pragma unroll
                for (int e = 0; e < 4; ++e) lf[e] = rdl(vf, 16 * e) + biasf[g * 4 + e];
                int i1 = 0; float v1 = lf[0];
#pragma unroll
                for (int e = 1; e < 4; ++e) if (lf[e] > v1) { v1 = lf[e]; i1 = e; }
                int i2 = -1; float v2 = -3.0e38f;
#pragma unroll
                for (int e = 0; e < 4; ++e) if (e != i1 && lf[e] > v2) { v2 = lf[e]; i2 = e; }
                if (i2 < 0) i2 = (i1 == 0) ? 1 : 0;
                const float ex = expf(v2 - v1); const float p1 = 1.0f / (1.0f + ex), p2 = ex / (1.0f + ex);
                const int e1 = g * 4 + i1, e2 = g * 4 + i2;
                if (lane == tt) { rte_v = e1 | (e2 << 8); rw1_v = pg * p1; rw2_v = pg * p2; }
                cnt += (lane == e1 ? 1 : 0) + (lane == e2 ? 1 : 0);
            }
        }
#undef TOK_ISSUE
        { const int tp = grp * 128 + wave * 16 + 15;
          if (MODE == 1) { if ((lane & 3) == 0) SP[(size_t)tp * 16 + (lane >> 2)] = sp_prev;
#pragma unroll
              for (int i = 0; i < 2; ++i) { *(f32x4*)(X + (size_t)tp * D + 512 * i + 8 * lane) = xo_prev[2 * i]; *(f32x4*)(X + (size_t)tp * D + 512 * i + 8 * lane + 4) = xo_prev[2 * i + 1]; } }
          if (MODE == 3) {
#pragma unroll
              for (int i = 0; i < 2; ++i) { *(f32x4*)(p.out + (size_t)tp * D + 512 * i + 8 * lane) = xo_prev[2 * i]; *(f32x4*)(p.out + (size_t)tp * D + 512 * i + 8 * lane + 4) = xo_prev[2 * i + 1]; } }
          else {
#pragma unroll
              for (int i = 0; i < 2; ++i) *(u32x4*)(HBF + (size_t)tp * D + 512 * i + 8 * lane) = hb_prev[i]; } }
        if (MODE == 2) { if (lane < 16) { const int tk = grp * 128 + wave * 16 + lane; RTE[tk] = rte_v; RTW[2 * tk] = rw1_v; RTW[2 * tk + 1] = rw2_v; } }
        if (MODE == 2) {
            __syncthreads();
            if (lane < 16) cnts[wave * 16 + lane] = cnt;
            __syncthreads();
            if (tid < 16) { int s = 0;
#pragma unroll
                for (int w = 0; w < 8; ++w) s += cnts[w * 16 + tid];
                TC[grp * 16 + tid] = s; }
        }
    }
}
__device__ __forceinline__ void phase_norm1(const Params& p, LAS unsigned char* lds, int l) { phase_tokens<1>(p, lds, l); }
__device__ __forceinline__ void phase_norm2(const Params& p, LAS unsigned char* lds, int l) { phase_tokens<2>(p, lds, l); }

__device__ __forceinline__ void phase_dispatch(const Params& p, LAS unsigned char* lds, LAS int* tbase) {
    const int tid = ltid(), lane = tid & 63, wave = tid >> 6, G = GDIM;
    LAS int* tc = (LAS int*)lds;
    LAS int* part = (LAS int*)(lds + 16384);
    LAS int* tot = (LAS int*)(lds + 16384 + 4096);
    LAS int* toff = (LAS int*)(lds + 16384 + 4096 + 128);
    LAS int* wcnt = (LAS int*)(lds + 16384 + 4096 + 256);
    const int* TC = (const int*)(p.ws + WS_TC); const int* RTE = (const int*)(p.ws + WS_RTE);
    int* POS = (int*)(p.ws + WS_POS);
    int* ROWTOK = (int*)(p.ws + WS_ROWTOK);
    for (int i = tid; i < 256 * 16; i += NTHR) tc[i] = TC[i];
    __syncthreads();
    { const int e = tid & 15, c8 = tid >> 4; int sa = 0;
#pragma unroll
      for (int q = 0; q < 8; ++q) sa += tc[(c8 * 8 + q) * 16 + e];
      part[c8 * 16 + e] = sa; }
    __syncthreads();
    if (tid < 16) { int sa = 0;
#pragma unroll
        for (int c8 = 0; c8 < 32; ++c8) sa += part[c8 * 16 + tid];
        tot[tid] = sa; }
    __syncthreads();
    if (tid == 0) { int rb = 0; for (int e = 0; e < 16; ++e) { tot[16 + e] = rb; tbase[e] = rb >> 8; rb += (tot[e] + 255) & ~255; } tbase[16] = rb >> 8; }
    __syncthreads();
    for (int grp = BID; grp < NTOK / 128; grp += G) {
        { const int e = tid & 15, c8 = tid >> 4; int sb = 0;
#pragma unroll
          for (int q = 0; q < 8; ++q) { const int gq = c8 * 8 + q; sb += (gq < grp) ? tc[gq * 16 + e] : 0; }
          part[512 + c8 * 16 + e] = sb; }
        int e_me = 0, rank_l = 0;
        if (tid < 256) { const int ee = RTE[grp * 128 + (tid >> 1)]; e_me = (tid & 1) ? ((ee >> 8) & 255) : (ee & 255); }
        if (wave < 4) {
            const unsigned long long lt = (lane == 0) ? 0ull : (~0ull >> (64 - lane));
#pragma unroll
            for (int e = 0; e < 16; ++e) { const unsigned long long m = __ballot(e_me == e); if (e_me == e) rank_l = __popcll(m & lt); if (lane == 0) wcnt[wave * 16 + e] = __popcll(m); }
        }
        __syncthreads();
        if (tid < 16) { int sb = 0;
#pragma unroll
            for (int c8 = 0; c8 < 32; ++c8) sb += part[512 + c8 * 16 + tid];
            toff[tid] = sb; }
        __syncthreads();
        if (tid < 256) { int rank = rank_l;
#pragma unroll
            for (int w = 0; w < 3; ++w) rank += (w < wave) ? wcnt[w * 16 + e_me] : 0;
            const int pos = tot[16 + e_me] + toff[e_me] + rank; POS[(size_t)(grp * 128) * 2 + tid] = pos; ROWTOK[pos] = grp * 128 + (tid >> 1); }
        __syncthreads();
    }
    for (int e = 0; e < 16; ++e) { const int lo_ = tot[16 + e] + tot[e], hi_ = tot[16 + e] + ((tot[e] + 255) & ~255); for (int r = lo_ + tid; r < hi_; r += NTHR) ROWTOK[r] = 0; }
}

__device__ __forceinline__ void phase_final(const Params& p, LAS unsigned char* lds) { phase_tokens<3>(p, lds, 3); }
__device__ __forceinline__ f32x4 mfma16(bf16x8 a, bf16x8 b, f32x4 c) { return __builtin_amdgcn_mfma_f32_16x16x32_bf16(a, b, c, 0, 0, 0); }
__device__ __forceinline__ bf16x8 ldfrag(const LAS unsigned char* base, int row, int stride_bytes, int kk, int g) { return *(const LAS bf16x8*)(base + row * stride_bytes + (kk * 32 + g * 8) * 2); }
__device__ __forceinline__ int xcol(int row, int col) { return ((((col >> 3) ^ (row >> 3)) & 7) << 3) | (col & 7); }
__device__ __forceinline__ bf16x8 ldfrag_x(const LAS unsigned char* base, int row, int kk, int g) { return *(const LAS bf16x8*)(base + row * 144 + ((((kk * 4 + g) ^ (row >> 3)) & 7) << 4)); }
template <int CTRL, int ROWS> __device__ __forceinline__ int dpp_mv(int ident, int v) { return __builtin_amdgcn_update_dpp(ident, v, CTRL, ROWS, 0xf, false); }
__device__ __forceinline__ float row_sum16(float v) {
    v += __int_as_float(dpp_mv<0x128, 0xf>(0, __float_as_int(v))); v += __int_as_float(dpp_mv<0x124, 0xf>(0, __float_as_int(v)));
    v += __int_as_float(dpp_mv<0x122, 0xf>(0, __float_as_int(v))); v += __int_as_float(dpp_mv<0x121, 0xf>(0, __float_as_int(v)));
    return v;
}
__device__ __forceinline__ float scan_add(float v, int) {
    v += __int_as_float(dpp_mv<0x111, 0xf>(0, __float_as_int(v))); v += __int_as_float(dpp_mv<0x112, 0xf>(0, __float_as_int(v)));
    v += __int_as_float(dpp_mv<0x114, 0xf>(0, __float_as_int(v))); v += __int_as_float(dpp_mv<0x118, 0xf>(0, __float_as_int(v)));
    v += __int_as_float(dpp_mv<0x142, 0xa>(0, __float_as_int(v))); v += __int_as_float(dpp_mv<0x143, 0xc>(0, __float_as_int(v)));
    return v;
}
__device__ __forceinline__ int scan_add_i(int v, int) {
    v += dpp_mv<0x111, 0xf>(0, v); v += dpp_mv<0x112, 0xf>(0, v); v += dpp_mv<0x114, 0xf>(0, v); v += dpp_mv<0x118, 0xf>(0, v);
    v += dpp_mv<0x142, 0xa>(0, v); v += dpp_mv<0x143, 0xc>(0, v);
    return v;
}
__device__ __forceinline__ float scan_max(float v, int) {
    constexpr int NI = (int)0xff800000u;
    v = fmaxf(v, __int_as_float(dpp_mv<0x111, 0xf>(NI, __float_as_int(v)))); v = fmaxf(v, __int_as_float(dpp_mv<0x112, 0xf>(NI, __float_as_int(v))));
    v = fmaxf(v, __int_as_float(dpp_mv<0x114, 0xf>(NI, __float_as_int(v)))); v = fmaxf(v, __int_as_float(dpp_mv<0x118, 0xf>(NI, __float_as_int(v))));
    v = fmaxf(v, __int_as_float(dpp_mv<0x142, 0xa>(NI, __float_as_int(v)))); v = fmaxf(v, __int_as_float(dpp_mv<0x143, 0xc>(NI, __float_as_int(v))));
    return v;
}
__device__ __forceinline__ float bfe(const u32x4& v, int e) { const unsigned w = v[e >> 1]; return __uint_as_float((e & 1) ? (w & 0xffff0000u) : (w << 16)); }
__device__ __forceinline__ bf16_t bfr(const u32x4& v, int e) { const unsigned w = v[e >> 1]; return (bf16_t)((e & 1) ? (w >> 16) : (w & 0xffffu)); }

constexpr int RS = 144;

struct MlstmLIn { u32x4 kin[4], vin[2]; float sp_i, sp_f; };
__device__ __forceinline__ void mlstm_L_issue(const Params& p, int b, int h, int ck, MlstmLIn& r) {
    const int tid = ltid(), lane = tid & 63;
    const bf16_t* P = (const bf16_t*)(p.ws + WS_P); const float* SP = (const float*)(p.ws + WS_SP);
    const int tok0 = b * SEQ + ck * 64; const int t = tid >> 3, seg = tid & 7, kc0 = 256 + h * 64 + seg * 8, pos = ck * 64 + t;
#pragma unroll
    for (int q = 0; q < 4; ++q) { const int pp = pos - 3 + q; r.kin[q] = (pp >= 0) ? *(const u32x4*)(P + (size_t)(b * SEQ + pp) * NP_AB + kc0) : (u32x4){0u, 0u, 0u, 0u}; }
#pragma unroll
    for (int i = 0; i < 2; ++i) { const int idx = tid + 512 * i; r.vin[i] = *(const u32x4*)(P + (size_t)(tok0 + (idx >> 4)) * NP_AB + AB_VA + h * 128 + (idx & 15) * 8); }
    r.sp_i = SP[(size_t)(tok0 + lane) * 16 + h]; r.sp_f = SP[(size_t)(tok0 + lane) * 16 + 4 + h];
}
__device__ __forceinline__ void mlstm_L_compute(const Params& p, LAS unsigned char* lds, int j, int b, int h, int ck, const MlstmLIn& rg) {
    const int tid = ltid(), lane = tid & 63, wave = __builtin_amdgcn_readfirstlane(tid >> 6), fr = lane & 15, g = lane >> 4;
    LAS unsigned char* KWT = lds; LAS unsigned char* VT = lds + 9216;
    float* CL = (float*)(p.ws + WS_CL); float* SCAL = (float*)(p.ws + WS_SCAL);
    const int unit = (b * 4 + h) * 64 + ck;
    const int t = tid >> 3, seg = tid & 7, kc0 = 256 + h * 64 + seg * 8;

    const u32x4 (&kin)[4] = rg.kin; const u32x4 (&vin)[2] = rg.vin;
    float we;
    {
        const float li = rg.sp_i + p.in[I_ABGATEB][j * 8 + h]; const float lf = logsigmoidf_(rg.sp_f + p.in[I_ABGATEB][j * 8 + 4 + h]);
        const float bc = scan_add(lf, lane); const float a = li - bc; const float amax = __int_as_float(__builtin_amdgcn_readlane(__float_as_int(scan_max(a, lane)), 63));
        we = __int_as_float(__builtin_amdgcn_ds_bpermute((t & 63) << 2, __float_as_int(__expf(a - amax))));
        if (wave == 0 && lane == 63) { SCAL[unit * 2] = bc; SCAL[unit * 2 + 1] = amax; }
    }
    for (int i = tid; i < 16 * 72; i += NTHR) { const int r = i / 72; ((LAS bf16_t*)VT)[(128 + r) * 72 + (i % 72)] = (r == 0) ? (bf16_t)0x3F80 : (bf16_t)0; }
    { const float* convw = p.in[I_ABCONVW] + (size_t)j * 4 * 512 + kc0; const float* convb = p.in[I_ABCONVB] + j * 512 + kc0;
#pragma unroll
      for (int e = 0; e < 8; ++e) { float acc = convb[e];
#pragma unroll
        for (int q = 0; q < 4; ++q) acc += convw[q * 512 + e] * bfe(kin[q], e);
        const float v = acc / (1.0f + __expf(-acc)); ((LAS bf16_t*)KWT)[(seg * 8 + e) * 72 + xcol(seg * 8 + e, t)] = f2bf(v * we); } }
#pragma unroll
    for (int i = 0; i < 2; ++i) { const int idx = tid + 512 * i; const int s = idx >> 4, sg = idx & 15;
#pragma unroll
        for (int e = 0; e < 8; ++e) ((LAS bf16_t*)VT)[(sg * 8 + e) * 72 + xcol(sg * 8 + e, s)] = bfr(vin[i], e); }
    __syncthreads();

#pragma unroll
    for (int i = 0; i < 5; ++i) { const int id = wave + 8 * i;
        if (id < 36) { const int tk = id / 9, tv = id % 9; f32x4 acc = (f32x4){0.f, 0.f, 0.f, 0.f};
#pragma unroll
            for (int kk = 0; kk < 2; ++kk) acc = mfma16(ldfrag_x(KWT, tk * 16 + fr, kk, g), ldfrag_x(VT, tv * 16 + fr, kk, g), acc);
#pragma unroll
            for (int r = 0; r < 4; ++r) CL[(size_t)unit * 9216 + (tk * 16 + 4 * g + r) * 144 + tv * 16 + fr] = acc[r]; } }
    __syncthreads();

}

__device__ __forceinline__ void phase_scan_mlstm(const Params& p) {
    const float* CL = (const float*)(p.ws + WS_CL); const float* SCAL = (const float*)(p.ws + WS_SCAL); float* MC = (float*)(p.ws + WS_MC); bf16_t* CTG = (bf16_t*)(p.ws + WS_CTG);
    for (int e = BID * NTHR + TID; e < 32 * 9216; e += GDIM * NTHR) {
        const int bh = e / 9216, r = e % 9216;
        float C = 0.f, m = -1e30f;
#pragma unroll 1
        for (int c0 = 0; c0 < 64; c0 += 8) { float v[8], sb[8], sa[8];
#pragma unroll
            for (int i = 0; i < 8; ++i) { v[i] = CL[(size_t)(bh * 64 + c0 + i) * 9216 + r]; sb[i] = SCAL[(bh * 64 + c0 + i) * 2]; sa[i] = SCAL[(bh * 64 + c0 + i) * 2 + 1]; }
#pragma unroll
            for (int i = 0; i < 8; ++i) { const int unit = bh * 64 + c0 + i; const float bL = sb[i], amax = sa[i];
                CTG[(size_t)unit * 9216 + r] = f2bf(C); if (r == 0) MC[unit] = m;
                const float M = fmaxf(m, amax); C = __expf(m - M) * C + __expf(amax - M) * v[i]; m = bL + M; } }
    }
}

struct MlstmOIn { u32x4 qkin[2][4], vin[2], cin[3], oin[2]; float sp_i, sp_f, mc; };
__device__ __forceinline__ void mlstm_O_issue(const Params& p, int b, int h, int ck, MlstmOIn& r) {
    const int tid = ltid(), lane = tid & 63;
    const bf16_t* P = (const bf16_t*)(p.ws + WS_P); const float* SP = (const float*)(p.ws + WS_SP);
    const bf16_t* CTG = (const bf16_t*)(p.ws + WS_CTG); const float* MC = (const float*)(p.ws + WS_MC);
    const int unit = (b * 4 + h) * 64 + ck; const int tok0 = b * SEQ + ck * 64;
    const int sg = tid & 15; const int ch0 = (sg < 8) ? h * 64 + sg * 8 : 256 + h * 64 + (sg - 8) * 8;
#pragma unroll
    for (int i = 0; i < 2; ++i) { const int tt = (tid + 512 * i) >> 4; const int pos = ck * 64 + tt;
#pragma unroll
        for (int q = 0; q < 4; ++q) { const int pp = pos - 3 + q; r.qkin[i][q] = (pp >= 0) ? *(const u32x4*)(P + (size_t)(b * SEQ + pp) * NP_AB + ch0) : (u32x4){0u, 0u, 0u, 0u}; }
        r.vin[i] = *(const u32x4*)(P + (size_t)(tok0 + tt) * NP_AB + AB_VA + h * 128 + sg * 8);
        r.oin[i] = *(const u32x4*)(P + (size_t)(tok0 + tt) * NP_AB + AB_OA + h * 128 + sg * 8); }
#pragma unroll
    for (int i = 0; i < 3; ++i) { const int idx = tid + 512 * i; r.cin[i] = (idx < 1152) ? *(const u32x4*)(CTG + (size_t)unit * 9216 + idx * 8) : (u32x4){0u, 0u, 0u, 0u}; }
    r.sp_i = SP[(size_t)(tok0 + lane) * 16 + h]; r.sp_f = SP[(size_t)(tok0 + lane) * 16 + 4 + h]; r.mc = MC[unit];
}
__device__ __forceinline__ void mlstm_O_compute(const Params& p, LAS unsigned char* lds, int j, int b, int h, int ck, const MlstmOIn& rg) {
    const int tid = ltid(), lane = tid & 63, wave = __builtin_amdgcn_readfirstlane(tid >> 6), fr = lane & 15, g = lane >> 4;
    LAS unsigned char* QS = lds; LAS unsigned char* KS = lds + 9216; LAS unsigned char* VT = lds + 18432; LAS unsigned char* CT = lds + 39168; LAS unsigned char* PS = lds + 59904;
    LAS float* OS = (LAS float*)(lds + 69120); LAS float* GA = (LAS float*)(lds + 107008);
    constexpr int OSS = 148;
    bf16_t* YMIX = (bf16_t*)(p.ws + WS_YMIX);
    const int tok0 = b * SEQ + ck * 64;
    const int sg = tid & 15;
    const int ch0 = (sg < 8) ? h * 64 + sg * 8 : 256 + h * 64 + (sg - 8) * 8;
    const u32x4 (&qkin)[2][4] = rg.qkin; const u32x4 (&vin)[2] = rg.vin; const u32x4 (&cin)[3] = rg.cin; const u32x4 (&oin)[2] = rg.oin;
    {
        const float mc = rg.mc;
        const float li = rg.sp_i + p.in[I_ABGATEB][j * 8 + h]; const float lf = logsigmoidf_(rg.sp_f + p.in[I_ABGATEB][j * 8 + 4 + h]);
        const float bc = scan_add(lf, lane); const float a = li - bc; const float M = fmaxf(mc, scan_max(a, lane));
        GA[lane] = a; GA[64 + lane] = M; GA[128 + lane] = __expf(mc - M); GA[192 + lane] = __expf(-(bc + M));
    }
    for (int i = tid; i < 16 * 72; i += NTHR) { const int r = i / 72; ((LAS bf16_t*)VT)[(128 + r) * 72 + (i % 72)] = (r == 0) ? (bf16_t)0x3F80 : (bf16_t)0; }
    { const float* convw = p.in[I_ABCONVW] + (size_t)j * 4 * 512 + ch0; const float* convb = p.in[I_ABCONVB] + j * 512 + ch0;
      float cw[4][8], cb[8];
#pragma unroll
      for (int e = 0; e < 8; ++e) { cb[e] = convb[e];
#pragma unroll
        for (int q = 0; q < 4; ++q) cw[q][e] = convw[q * 512 + e]; }
      const float qs = (sg < 8) ? 0.125f : 1.0f;
#pragma unroll
      for (int i = 0; i < 2; ++i) { const int tt = (tid + 512 * i) >> 4; float o[8];
#pragma unroll
        for (int e = 0; e < 8; ++e) { float acc = cb[e];
#pragma unroll
            for (int q = 0; q < 4; ++q) acc += cw[q][e] * bfe(qkin[i][q], e);
            o[e] = acc / (1.0f + __expf(-acc)) * qs; }
        u32x4 w; w.x = pk2(o[0], o[1]); w.y = pk2(o[2], o[3]); w.z = pk2(o[4], o[5]); w.w = pk2(o[6], o[7]);
        *(LAS u32x4*)(((sg < 8) ? QS : KS) + tt * RS + (sg & 7) * 16) = w;
#pragma unroll
        for (int e = 0; e < 8; ++e) ((LAS bf16_t*)VT)[(sg * 8 + e) * 72 + xcol(sg * 8 + e, tt)] = bfr(vin[i], e); } }
#pragma unroll
    for (int i = 0; i < 3; ++i) { const int idx = tid + 512 * i;
        if (idx < 1152) { const int dk = idx / 18, sv = idx % 18;
#pragma unroll
            for (int e = 0; e < 8; ++e) ((LAS bf16_t*)CT)[(sv * 8 + e) * 72 + xcol(sv * 8 + e, dk)] = bfr(cin[i], e); } }
    __syncthreads();
    { const int tq = wave >> 1;
#pragma unroll
      for (int u = 0; u < 2; ++u) { const int ts = (wave & 1) * 2 + u; f32x4 acc = (f32x4){0.f, 0.f, 0.f, 0.f};
        if (ts <= tq) {
#pragma unroll
            for (int kk = 0; kk < 2; ++kk) acc = mfma16(ldfrag(QS, tq * 16 + fr, RS, kk, g), ldfrag(KS, ts * 16 + fr, RS, kk, g), acc);
        }
        const int s = ts * 16 + fr; const float as = GA[s];
#pragma unroll
        for (int r = 0; r < 4; ++r) { const int t = tq * 16 + 4 * g + r; const float pv = (ts <= tq && s <= t) ? acc[r] * __expf(as - GA[64 + t]) : 0.f; ((LAS bf16_t*)PS)[t * 72 + s] = f2bf(pv); } } }
    __syncthreads();
#pragma unroll
    for (int i = 0; i < 5; ++i) { const int id = wave + 8 * i;
        if (id < 36) { const int tq = id / 9, tv = id % 9; f32x4 acc = (f32x4){0.f, 0.f, 0.f, 0.f};
#pragma unroll
            for (int kk = 0; kk < 2; ++kk) acc = mfma16(ldfrag(QS, tq * 16 + fr, RS, kk, g), ldfrag_x(CT, tv * 16 + fr, kk, g), acc);
#pragma unroll
            for (int r = 0; r < 4; ++r) acc[r] *= GA[128 + tq * 16 + 4 * g + r];
#pragma unroll
            for (int kk = 0; kk < 2; ++kk) acc = mfma16(ldfrag(PS, tq * 16 + fr, RS, kk, g), ldfrag_x(VT, tv * 16 + fr, kk, g), acc);
#pragma unroll
            for (int r = 0; r < 4; ++r) OS[(tq * 16 + 4 * g + r) * OSS + tv * 16 + fr] = acc[r]; } }
    __syncthreads();
    { const float* hgp = p.in[I_ABHNORM] + j * 512 + h * 128 + sg * 8;
#pragma unroll
      for (int i = 0; i < 2; ++i) { const int tt = (tid + 512 * i) >> 4;
        const float den = OS[tt * OSS + 128]; const float dn = fmaxf(fabsf(den), GA[192 + tt]); const float idn = 1.0f / dn;
        const f32x4 a0 = *(const LAS f32x4*)(OS + tt * OSS + sg * 8), a1 = *(const LAS f32x4*)(OS + tt * OSS + sg * 8 + 4);
        float hv[8] = {a0[0] * idn, a0[1] * idn, a0[2] * idn, a0[3] * idn, a1[0] * idn, a1[1] * idn, a1[2] * idn, a1[3] * idn};
        float ss = 0.f;
#pragma unroll
        for (int e = 0; e < 8; ++e) ss += hv[e] * hv[e];
        ss = row_sum16(ss);
        const float rn = 1.0f / sqrtf(ss * (1.0f / 128.0f) + 1e-6f);
        float y[8];
#pragma unroll
        for (int e = 0; e < 8; ++e) y[e] = hv[e] * rn * hgp[e] * sigmoidf_(bfe(oin[i], e));
        u32x4 w; w.x = pk2(y[0], y[1]); w.y = pk2(y[2], y[3]); w.z = pk2(y[4], y[5]); w.w = pk2(y[6], y[7]);
        *(u32x4*)(YMIX + (size_t)(tok0 + tt) * D + h * 128 + sg * 8) = w; } }
    __syncthreads();
}

__device__ __forceinline__ void unit_mlstm_O(const Params& p, LAS unsigned char* lds, int j, int b, int h, int ck) { MlstmOIn r; mlstm_O_issue(p, b, h, ck, r); mlstm_O_compute(p, lds, j, b, h, ck, r); }

__device__ __forceinline__ float rdlf(float v, int l) { return __int_as_float(__builtin_amdgcn_readlane(__float_as_int(v), l)); }
struct GlaCsIn { f32x4 gq[4]; float wv0, wv1, bv; };
__device__ __forceinline__ void gla_cumsum_issue(const Params& p, int j, int h, int tok0, int lane, int wave, GlaCsIn& c) {
    const float* SP = (const float*)(p.ws + WS_SP);
#pragma unroll
    for (int r = 0; r < 4; ++r) c.gq[r] = *(const f32x4*)(SP + (size_t)(tok0 + lane) * 16 + 4 * r);
    const float* wa = p.in[I_CDWALPHA] + (size_t)j * 16 * 256 + h * 64 + wave * 8; const float* ba = p.in[I_CDBALPHA] + j * 256 + h * 64 + wave * 8;
    c.wv0 = wa[(lane >> 3) * 256 + (lane & 7)]; c.wv1 = wa[(8 + (lane >> 3)) * 256 + (lane & 7)]; c.bv = ba[lane & 7];
}
__device__ __forceinline__ void gla_cumsum(const GlaCsIn& c, int lane, int wave, LAS float* BS, LAS float* BL, float* scal_unit, LAS float* WLa) {
    const f32x4 (&gq)[4] = c.gq;
    LAS float* WL = WLa + wave * 136;
    WL[lane] = c.wv0; WL[64 + lane] = c.wv1; if (lane < 8) WL[128 + lane] = c.bv;
    float bc[8];
    { const f32x4 b0 = *(const LAS f32x4*)(WL + 128), b1 = *(const LAS f32x4*)(WL + 132);
      bc[0] = b0[0]; bc[1] = b0[1]; bc[2] = b0[2]; bc[3] = b0[3]; bc[4] = b1[0]; bc[5] = b1[1]; bc[6] = b1[2]; bc[7] = b1[3]; }
#pragma unroll
    for (int r4 = 0; r4 < 4; ++r4) { f32x4 wa[4], wb[4];
#pragma unroll
        for (int rr = 0; rr < 4; ++rr) { wa[rr] = *(const LAS f32x4*)(WL + (r4 * 4 + rr) * 8); wb[rr] = *(const LAS f32x4*)(WL + (r4 * 4 + rr) * 8 + 4); }
        asm volatile("" ::: "memory");
#pragma unroll
        for (int rr = 0; rr < 4; ++rr) { const float x = gq[r4][rr];
#pragma unroll
            for (int i = 0; i < 4; ++i) { bc[i] += x * wa[rr][i]; bc[4 + i] += x * wb[rr][i]; } } }
#pragma unroll
    for (int i = 0; i < 8; ++i) bc[i] = logsigmoidf_(bc[i]) * (1.0f / 16.0f);
#pragma unroll
    for (int i = 0; i < 8; ++i) bc[i] = scan_add(bc[i], lane);
#pragma unroll
    for (int i = 0; i < 8; ++i) { BS[lane * 65 + wave * 8 + i] = bc[i];
        if (lane == 63) { BL[wave * 8 + i] = bc[i]; if (scal_unit) scal_unit[wave * 8 + i] = __expf(bc[i]); } }
}
struct GlaLIn { u32x4 kin, vin[2]; GlaCsIn cs; };
__device__ __forceinline__ void gla_L_issue(const Params& p, int j, int b, int h, int ck, GlaLIn& r) {
    const int tid = ltid(), lane = tid & 63, wave = __builtin_amdgcn_readfirstlane(tid >> 6);
    const bf16_t* P = (const bf16_t*)(p.ws + WS_P);
    const int tok0 = b * SEQ + ck * 64; const int t = tid >> 3, seg = tid & 7;
    r.kin = *(const u32x4*)(P + (size_t)(tok0 + t) * NP_CD + CD_KC + h * 64 + seg * 8);
#pragma unroll
    for (int i = 0; i < 2; ++i) { const int idx = tid + 512 * i; r.vin[i] = *(const u32x4*)(P + (size_t)(tok0 + (idx >> 4)) * NP_CD + CD_VC + h * 128 + (idx & 15) * 8); }
    gla_cumsum_issue(p, j, h, tok0, lane, wave, r.cs);
}
__device__ __forceinline__ void gla_L_compute(const Params& p, LAS unsigned char* lds, int j, int b, int h, int ck, const GlaLIn& rg) {
    const int tid = ltid(), lane = tid & 63, wave = __builtin_amdgcn_readfirstlane(tid >> 6), fr = lane & 15, g = lane >> 4;
    LAS unsigned char* KWT = lds; LAS unsigned char* VT = lds + 9216; LAS float* BS = (LAS float*)(lds + 27648); LAS float* BL = (LAS float*)(lds + 44288);
    float* CL = (float*)(p.ws + WS_CL); float* SCAL = (float*)(p.ws + WS_SCAL);
    const int unit = (b * 4 + h) * 64 + ck;
    const int t = tid >> 3, seg = tid & 7;
    const u32x4 kin = rg.kin; const u32x4 (&vin)[2] = rg.vin;
    gla_cumsum(rg.cs, lane, wave, BS, BL, SCAL + (size_t)unit * 64, (LAS float*)(lds + 115712));

    __syncthreads();
#pragma unroll
    for (int e = 0; e < 8; ++e) { const int kk = seg * 8 + e; ((LAS bf16_t*)KWT)[kk * 72 + xcol(kk, t)] = f2bf(bfe(kin, e) * __expf(BL[kk] - BS[t * 65 + kk])); }
#pragma unroll
    for (int i = 0; i < 2; ++i) { const int idx = tid + 512 * i; const int s = idx >> 4, sg = idx & 15;
#pragma unroll
        for (int e = 0; e < 8; ++e) ((LAS bf16_t*)VT)[(sg * 8 + e) * 72 + xcol(sg * 8 + e, s)] = bfr(vin[i], e); }
    __syncthreads();
#pragma unroll
    for (int i = 0; i < 4; ++i) { const int id = wave + 8 * i; const int tk = id >> 3, tv = id & 7; f32x4 acc = (f32x4){0.f, 0.f, 0.f, 0.f};
#pragma unroll
        for (int kk = 0; kk < 2; ++kk) acc = mfma16(ldfrag_x(KWT, tk * 16 + fr, kk, g), ldfrag_x(VT, tv * 16 + fr, kk, g), acc);
#pragma unroll
        for (int r = 0; r < 4; ++r) CL[(size_t)unit * 8192 + (tk * 16 + 4 * g + r) * 128 + tv * 16 + fr] = acc[r]; }
    __syncthreads();
}
__device__ __forceinline__ void phase_scan_gla(const Params& p) {
    const float* CL = (const float*)(p.ws + WS_CL); const float* SCAL = (const float*)(p.ws + WS_SCAL); bf16_t* STG = (bf16_t*)(p.ws + WS_STG);
    for (int e = BID * NTHR + TID; e < 32 * 8192; e += GDIM * NTHR) {
        const int bh = e >> 13, r = e & 8191, dk = r >> 7;
        float S = 0.f;
#pragma unroll 1
        for (int c0 = 0; c0 < 64; c0 += 8) { float v[8], dc[8];
#pragma unroll
            for (int i = 0; i < 8; ++i) { v[i] = CL[(size_t)(bh * 64 + c0 + i) * 8192 + r]; dc[i] = SCAL[(size_t)(bh * 64 + c0 + i) * 64 + dk]; }
#pragma unroll
            for (int i = 0; i < 8; ++i) { STG[(size_t)(bh * 64 + c0 + i) * 8192 + r] = f2bf(S); S = dc[i] * S + v[i]; } }
    }
}
struct GlaOIn { u32x4 qkin[2], vin[2], sin_[2], rin[2]; GlaCsIn cs; };
__device__ __forceinline__ void gla_O_issue(const Params& p, int j, int b, int h, int ck, GlaOIn& r) {
    const int tid = ltid(), lane = tid & 63, wave = __builtin_amdgcn_readfirstlane(tid >> 6);
    const bf16_t* P = (const bf16_t*)(p.ws + WS_P); const bf16_t* STG = (const bf16_t*)(p.ws + WS_STG);
    const int unit = (b * 4 + h) * 64 + ck; const int tok0 = b * SEQ + ck * 64;
    const int sg = tid & 15; const int ch0 = (sg < 8) ? CD_QC + h * 64 + sg * 8 : CD_KC + h * 64 + (sg - 8) * 8;
#pragma unroll
    for (int i = 0; i < 2; ++i) { const int idx = tid + 512 * i; const int tt = idx >> 4;
        r.qkin[i] = *(const u32x4*)(P + (size_t)(tok0 + tt) * NP_CD + ch0);
        r.vin[i] = *(const u32x4*)(P + (size_t)(tok0 + tt) * NP_CD + CD_VC + h * 128 + sg * 8);
        r.rin[i] = *(const u32x4*)(P + (size_t)(tok0 + tt) * NP_CD + CD_RC + h * 128 + sg * 8);
        r.sin_[i] = *(const u32x4*)(STG + (size_t)unit * 8192 + idx * 8); }
    gla_cumsum_issue(p, j, h, tok0, lane, wave, r.cs);
}
__device__ __forceinline__ void gla_O_compute(const Params& p, LAS unsigned char* lds, int j, int b, int h, int ck, const GlaOIn& rg) {
    const int tid = ltid(), lane = tid & 63, wave = __builtin_amdgcn_readfirstlane(tid >> 6), fr = lane & 15, g = lane >> 4;
    LAS unsigned char* QS = lds; LAS unsigned char* KS = lds + 9216; LAS unsigned char* VT = lds + 18432; LAS unsigned char* ST = lds + 36864; LAS unsigned char* PS = lds + 55296;
    LAS float* OS = (LAS float*)(lds + 64512); LAS float* BS = (LAS float*)(lds + 98304); LAS float* BL = (LAS float*)(lds + 114944);
    constexpr int OSS = 132;
    bf16_t* YMIX = (bf16_t*)(p.ws + WS_YMIX);
    const int tok0 = b * SEQ + ck * 64;
    const int sg = tid & 15;
    const u32x4 (&qkin)[2] = rg.qkin; const u32x4 (&vin)[2] = rg.vin; const u32x4 (&sin_)[2] = rg.sin_; const u32x4 (&rin)[2] = rg.rin;

    gla_cumsum(rg.cs, lane, wave, BS, BL, nullptr, (LAS float*)(lds + 115712));

    __syncthreads();

#pragma unroll
    for (int i = 0; i < 2; ++i) { const int idx = tid + 512 * i; const int tt = idx >> 4; float o[8];
#pragma unroll
        for (int e = 0; e < 8; ++e) { const float bb = BS[tt * 65 + (sg & 7) * 8 + e]; o[e] = (sg < 8) ? bfe(qkin[i], e) * 0.125f * __expf(bb) : bfe(qkin[i], e) * __expf(-bb); }
        u32x4 w; w.x = pk2(o[0], o[1]); w.y = pk2(o[2], o[3]); w.z = pk2(o[4], o[5]); w.w = pk2(o[6], o[7]);
        *(LAS u32x4*)(((sg < 8) ? QS : KS) + tt * RS + (sg & 7) * 16) = w;
#pragma unroll
        for (int e = 0; e < 8; ++e) { ((LAS bf16_t*)VT)[(sg * 8 + e) * 72 + xcol(sg * 8 + e, tt)] = bfr(vin[i], e); ((LAS bf16_t*)ST)[(sg * 8 + e) * 72 + xcol(sg * 8 + e, tt)] = bfr(sin_[i], e); } }
    __syncthreads();

    { const int tq = wave >> 1;
#pragma unroll
      for (int u = 0; u < 2; ++u) { const int ts = (wave & 1) * 2 + u; f32x4 acc = (f32x4){0.f, 0.f, 0.f, 0.f};
        if (ts <= tq) {
#pragma unroll
            for (int kk = 0; kk < 2; ++kk) acc = mfma16(ldfrag(QS, tq * 16 + fr, RS, kk, g), ldfrag(KS, ts * 16 + fr, RS, kk, g), acc);
        }
        const int s = ts * 16 + fr;
#pragma unroll
        for (int r = 0; r < 4; ++r) { const int t = tq * 16 + 4 * g + r; const float pv = (ts <= tq && s <= t) ? acc[r] : 0.f; ((LAS bf16_t*)PS)[t * 72 + s] = f2bf(pv); } } }
    __syncthreads();
#pragma unroll
    for (int i = 0; i < 4; ++i) { const int id = wave + 8 * i; const int tq = id >> 3, tv = id & 7; f32x4 acc = (f32x4){0.f, 0.f, 0.f, 0.f};
#pragma unroll
        for (int kk = 0; kk < 2; ++kk) acc = mfma16(ldfrag(QS, tq * 16 + fr, RS, kk, g), ldfrag_x(ST, tv * 16 + fr, kk, g), acc);
#pragma unroll
        for (int kk = 0; kk < 2; ++kk) acc = mfma16(ldfrag(PS, tq * 16 + fr, RS, kk, g), ldfrag_x(VT, tv * 16 + fr, kk, g), acc);
#pragma unroll
        for (int r = 0; r < 4; ++r) OS[(tq * 16 + 4 * g + r) * OSS + tv * 16 + fr] = acc[r]; }
    __syncthreads();

    { const float* hgp = p.in[I_CDHNORM] + j * 512 + h * 128 + sg * 8;
#pragma unroll
      for (int i = 0; i < 2; ++i) { const int tt = (tid + 512 * i) >> 4;
        const f32x4 a0 = *(const LAS f32x4*)(OS + tt * OSS + sg * 8), a1 = *(const LAS f32x4*)(OS + tt * OSS + sg * 8 + 4);
        float hv[8] = {a0[0], a0[1], a0[2], a0[3], a1[0], a1[1], a1[2], a1[3]};
        float ss = 0.f;
#pragma unroll
        for (int e = 0; e < 8; ++e) ss += hv[e] * hv[e];
        ss = row_sum16(ss);
        const float rn = 1.0f / sqrtf(ss * (1.0f / 128.0f) + 1e-6f);
        float y[8];
#pragma unroll
        for (int e = 0; e < 8; ++e) y[e] = hv[e] * rn * hgp[e] * siluf_(bfe(rin[i], e));
        u32x4 w; w.x = pk2(y[0], y[1]); w.y = pk2(y[2], y[3]); w.z = pk2(y[4], y[5]); w.w = pk2(y[6], y[7]);
        *(u32x4*)(YMIX + (size_t)(tok0 + tt) * D + h * 128 + sg * 8) = w; } }
    __syncthreads();

}
__device__ __forceinline__ void unit_gla_O(const Params& p, LAS unsigned char* lds, int j, int b, int h, int ck) { GlaOIn r; gla_O_issue(p, j, b, h, ck, r); gla_O_compute(p, lds, j, b, h, ck, r); }

constexpr int L_BKT8 = 134144, L_RELB = 138240;
__device__ __forceinline__ void load_attn_tables(const Params& p, LAS unsigned char* lds) {
    const int* bkt = (const int*)(p.ws + WS_BKT);
    for (int i = TID; i < 4096; i += NTHR) lds[L_BKT8 + i] = (unsigned char)bkt[i];
    if (TID < 264) ((LAS float*)(lds + L_RELB))[TID] = (TID < 256) ? p.in[I_RELB][TID] * 1.44269504f : -1e30f;
}
__device__ __forceinline__ unsigned keep_lowest(unsigned m, int n) {
    if (n <= 0) return 0u;
    while ((int)__popc(m) > n) m &= ~(1u << (31 - __clz((int)m)));
    return m;
}
__device__ __forceinline__ bf16x4 tr_read(unsigned lds_addr) { bf16x4 r; asm volatile("ds_read_b64_tr_b16 %0, %1\n\ts_waitcnt lgkmcnt(0)" : "=&v"(r) : "v"(lds_addr) : "memory"); return r; }
__device__ __forceinline__ u32x4 ldg16(const void* ptr) { return *(const u32x4*)ptr; }
__device__ __forceinline__ bf16x8 as_bf16x8(const u32x4& v) { return __builtin_bit_cast(bf16x8, v); }
__device__ __forceinline__ void lds_add_u32(unsigned byte_addr, unsigned v) { asm volatile("ds_add_u32 %0, %1" :: "v"(byte_addr), "v"(v) : "memory"); }
__device__ __forceinline__ void lds_or_b32(unsigned byte_addr, unsigned v) { asm volatile("ds_or_b32 %0, %1" :: "v"(byte_addr), "v"(v) : "memory"); }
__device__ __forceinline__ unsigned sortable(float f) { const int u = __float_as_int(f); return (unsigned)u ^ ((unsigned)(u >> 31) | 0x80000000u); }

template <int PASS, bool MASKED, bool RELOAD>
__device__ __forceinline__ void dsa_score_trip(u32x4& x0, u32x4& x1, u32x4& x2, u32x4& x3, const bf16_t* kbase, int kt, int rk, int nkt, int g, int tq, const bf16x8 (&qf)[4][2], const float (&wq)[4],
                                               unsigned pfx, unsigned tau, unsigned hist_a, unsigned gtm_a, unsigned eqm_a) {
    f32x4 a[2][4];
#pragma unroll
    for (int half = 0; half < 2; ++half) { const bf16x8 k0 = as_bf16x8(half ? x2 : x0), k1 = as_bf16x8(half ? x3 : x1);
#pragma unroll
        for (int hh = 0; hh < 4; ++hh) { f32x4 z = (f32x4){0.f, 0.f, 0.f, 0.f}; z = mfma16(k0, qf[hh][0], z); a[half][hh] = mfma16(k1, qf[hh][1], z); } }
    if (RELOAD) { const int ka = rk < nkt ? rk : nkt - 1, kb = rk + 8 < nkt ? rk + 8 : nkt - 1;
        x0 = ldg16(kbase + (size_t)ka * 1024); x1 = ldg16(kbase + (size_t)ka * 1024 + 512); x2 = ldg16(kbase + (size_t)kb * 1024); x3 = ldg16(kbase + (size_t)kb * 1024 + 512);
        asm volatile("" ::: "memory"); }
#pragma unroll
    for (int half = 0; half < 2; ++half) { const int kth = kt + 8 * half; const bool live = !MASKED || kth < nkt;
        f32x2 sc01 = (f32x2){0.f, 0.f}, sc23 = (f32x2){0.f, 0.f};
#pragma unroll
        for (int hh = 0; hh < 4; ++hh) { const f32x4 av = a[half][hh]; const int i0 = __float_as_int(av[0]), i1 = __float_as_int(av[1]), i2 = __float_as_int(av[2]), i3 = __float_as_int(av[3]);
            const f32x2 w2 = (f32x2){wq[hh], wq[hh]};
            sc01 = __builtin_elementwise_fma((f32x2){__int_as_float(i0 > 0 ? i0 : 0), __int_as_float(i1 > 0 ? i1 : 0)}, w2, sc01);
            sc23 = __builtin_elementwise_fma((f32x2){__int_as_float(i2 > 0 ? i2 : 0), __int_as_float(i3 > 0 ? i3 : 0)}, w2, sc23); }
        const f32x4 sc = (f32x4){sc01[0], sc01[1], sc23[0], sc23[1]};
        unsigned gtb = 0u, eqb = 0u;
#pragma unroll
        for (int r = 0; r < 4; ++r) { const int s = kth * 16 + 4 * g + r; const bool valid = !MASKED || (live && s <= tq); const unsigned key = sortable(sc[r]);
            if (PASS == 0) { const unsigned bin = key >> 21, hw = key >> 22; lds_add_u32(hist_a + (hw ^ (hw >> 4)) * 4u, valid ? (1u << ((bin & 1u) * 16u)) : 0u); }
            else if (PASS == 1) { const unsigned bin = (key >> 10) & 2047u, hw = bin >> 1; lds_add_u32(hist_a + (hw ^ (hw >> 4)) * 4u, (valid && (key >> 21) == pfx) ? (1u << ((bin & 1u) * 16u)) : 0u); }
            else { gtb |= (valid && (key >> 10) > tau) ? (1u << r) : 0u; eqb |= (valid && (key >> 10) == tau) ? (1u << r) : 0u; } }
        if (PASS == 2) { const unsigned word = (unsigned)(kth >> 1), sh = (unsigned)((kth & 1) * 16 + 4 * g);
            lds_or_b32(gtm_a + word * 4u, gtb << sh); lds_or_b32(eqm_a + word * 4u, eqb << sh); }
    }
}
template <int PASS>
__device__ __forceinline__ void dsa_score_pass(const bf16_t* KIC, size_t rowb, int nkt, int wave, int fr, int g, int tq, const bf16x8 (&qf)[4][2], const float (&wq)[4],
                                               unsigned pfx, unsigned tau, unsigned hist_a, unsigned gtm_a, unsigned eqm_a, const u32x4 (&first)[8]) {
    const bf16_t* kbase = KIC + rowb * 64 + (g * 16 + fr) * 8;
    u32x4 x0 = first[0], x1 = first[1], x2 = first[2], x3 = first[3], y0 = first[4], y1 = first[5], y2 = first[6], y3 = first[7];
    const int n = (nkt - wave + 15) >> 4;
    int i = 0, kt = wave;
#pragma unroll 1
    for (; i + 2 < n; i += 2, kt += 32) {
        dsa_score_trip<PASS, false, true>(x0, x1, x2, x3, kbase, kt, kt + 32, nkt, g, tq, qf, wq, pfx, tau, hist_a, gtm_a, eqm_a);
        dsa_score_trip<PASS, false, true>(y0, y1, y2, y3, kbase, kt + 16, kt + 48, nkt, g, tq, qf, wq, pfx, tau, hist_a, gtm_a, eqm_a);
    }
    if (i + 1 < n) {
        dsa_score_trip<PASS, false, false>(x0, x1, x2, x3, kbase, kt, 0, nkt, g, tq, qf, wq, pfx, tau, hist_a, gtm_a, eqm_a);
        dsa_score_trip<PASS, true, false>(y0, y1, y2, y3, kbase, kt + 16, 0, nkt, g, tq, qf, wq, pfx, tau, hist_a, gtm_a, eqm_a);
    } else if (i < n) {
        dsa_score_trip<PASS, true, false>(x0, x1, x2, x3, kbase, kt, 0, nkt, g, tq, qf, wq, pfx, tau, hist_a, gtm_a, eqm_a);
    }
}

__device__ __forceinline__ float rows_max(float v) {
    auto a = __builtin_amdgcn_permlane16_swap(__float_as_uint(v), __float_as_uint(v), false, false); v = __builtin_fmaxf(__uint_as_float(a[0]), __uint_as_float(a[1]));
    auto b = __builtin_amdgcn_permlane32_swap(__float_as_uint(v), __float_as_uint(v), false, false); return __builtin_fmaxf(__uint_as_float(b[0]), __uint_as_float(b[1]));
}
__device__ __forceinline__ float rows_sum(float v) {
    auto a = __builtin_amdgcn_permlane16_swap(__float_as_uint(v), __float_as_uint(v), false, false); v = __uint_as_float(a[0]) + __uint_as_float(a[1]);
    auto b = __builtin_amdgcn_permlane32_swap(__float_as_uint(v), __float_as_uint(v), false, false); return __uint_as_float(b[0]) + __uint_as_float(b[1]);
}
__device__ __forceinline__ bf16x4 tr16(const LAS unsigned char* q) { return __builtin_amdgcn_ds_read_tr16_b64_v4i16((LAS bf16x4*)q); }
__device__ __forceinline__ void dsa_gather(u32x4 (&dst)[8], const unsigned char* ckb, unsigned lane_off, const LAS unsigned short* SEL, int qa, int t, int nch0, int T, int g) {
    const int tt = t < T ? t : 0; const bool sec = tt >= nch0; const int qn = qa + (sec ? 1 : 0), cn = sec ? tt - nch0 : tt;
    const u32x4 s8 = *(const LAS u32x4*)(SEL + qn * 256 + cn * 32 + g * 8);
#pragma unroll
    for (int j = 0; j < 8; ++j) { const unsigned w = s8[j >> 1]; const unsigned idx = (j & 1) ? (w >> 16) : (w & 0xffffu);
        dst[j] = ldg16(ckb + (idx * 256u + lane_off)); }
    asm volatile("" ::: "memory");
}
__device__ __forceinline__ void dsa_attn_trip(const u32x4 (&cur)[8], LAS unsigned char* gb, const LAS unsigned char* tra, LAS unsigned char* QAB, const LAS unsigned char* SELB, const LAS float* RELB,
                                              int qa, int t, int nch0, int nch1, int cnt0, int cnt1, int fr, int g, float& m_run, float& l_part, f32x4 (&ao)[8], bf16x8 (&qh)[4]) {
    const bool sec = t >= nch0; const int q = qa + (sec ? 1 : 0), c = sec ? t - nch0 : t, count = sec ? cnt1 : cnt0, nch = sec ? nch1 : nch0;
    if (c == 0) {
#pragma unroll
        for (int kk = 0; kk < 4; ++kk) { const bf16x8 v = *(const LAS bf16x8*)(QAB + ((q * 8 + (fr & 7)) * 128 + kk * 32 + g * 8) * 2); qh[kk] = (fr < 8) ? v : (bf16x8){0, 0, 0, 0, 0, 0, 0, 0}; }
        m_run = -1e30f; l_part = 0.f;
#pragma unroll
        for (int rt = 0; rt < 8; ++rt) ao[rt] = (f32x4){0.f, 0.f, 0.f, 0.f};
    }
#pragma unroll
    for (int j = 0; j < 8; ++j) *(LAS u32x4*)(gb + (g * 8 + j) * 272 + fr * 16) = cur[j];
    bf16x8 af[8];
#pragma unroll
    for (int it = 0; it < 8; ++it) af[it] = *(const LAS bf16x8*)(gb + ((it >> 2) * 16 + fr) * 272 + ((it & 3) * 4 + g) * 16);
    bf16x4 tl[8], th[8];
#pragma unroll
    for (int rt = 0; rt < 8; ++rt) { tl[rt] = tr16(tra + rt * 32); th[rt] = tr16(tra + 16 * 272 + rt * 32); }
    float lg[2][4], bias[2][4];
    {
        const unsigned bka = *(const LAS unsigned*)(SELB + q * 256 + c * 32 + 4 * g), bkb = *(const LAS unsigned*)(SELB + q * 256 + c * 32 + 16 + 4 * g);
#pragma unroll
        for (int r = 0; r < 4; ++r) { bias[0][r] = RELB[((bka >> (8 * r)) & 63u) * 8u + (unsigned)(fr & 7)]; bias[1][r] = RELB[((bkb >> (8 * r)) & 63u) * 8u + (unsigned)(fr & 7)]; }
        asm volatile("" ::: "memory"); }
#pragma unroll
    for (int k2 = 0; k2 < 2; ++k2) { f32x4 a = (f32x4){0.f, 0.f, 0.f, 0.f};
#pragma unroll
        for (int kk = 0; kk < 4; ++kk) a = mfma16(af[k2 * 4 + kk], qh[kk], a);
#pragma unroll
        for (int r = 0; r < 4; ++r) lg[k2][r] = a[r] + bias[k2][r]; }
    float ml = fmaxf(fmaxf(fmaxf(lg[0][0], lg[0][1]), fmaxf(lg[0][2], lg[0][3])), fmaxf(fmaxf(lg[1][0], lg[1][1]), fmaxf(lg[1][2], lg[1][3])));
    ml = rows_max(ml);
    const float m_new = fmaxf(m_run, ml); const float alpha = __builtin_amdgcn_exp2f(m_run - m_new);
    float pr[2][4]; float ps = 0.f;
#pragma unroll
    for (int k2 = 0; k2 < 2; ++k2)
#pragma unroll
        for (int r = 0; r < 4; ++r) { pr[k2][r] = __builtin_amdgcn_exp2f(lg[k2][r] - m_new); ps += pr[k2][r]; }
    l_part = l_part * alpha + ps; m_run = m_new;
    u32x4 pfu; pfu.x = pk2(pr[0][0], pr[0][1]); pfu.y = pk2(pr[0][2], pr[0][3]); pfu.z = pk2(pr[1][0], pr[1][1]); pfu.w = pk2(pr[1][2], pr[1][3]);
    const bf16x8 pf = __builtin_bit_cast(bf16x8, pfu);
#pragma unroll
    for (int rt = 0; rt < 8; ++rt) { ao[rt] = ao[rt] * alpha;
        bf16x8 av; av[0] = tl[rt][0]; av[1] = tl[rt][1]; av[2] = tl[rt][2]; av[3] = tl[rt][3]; av[4] = th[rt][0]; av[5] = th[rt][1]; av[6] = th[rt][2]; av[7] = th[rt][3];
        ao[rt] = mfma16(av, pf, ao[rt]); }
    if (c == nch - 1) {
        const float l = rows_sum(l_part);
        const float inv = 1.0f / l;
        if (fr < 8) {
#pragma unroll
            for (int rt = 0; rt < 8; ++rt) { u32x2 w; w.x = pk2(ao[rt][0] * inv, ao[rt][1] * inv); w.y = pk2(ao[rt][2] * inv, ao[rt][3] * inv);
                *(LAS u32x2*)(QAB + ((q * 8 + fr) * 128 + rt * 16 + 4 * g) * 2) = w; } }
    }
}

__device__ __forceinline__ void unit_dsa(const Params& p, LAS unsigned char* lds, int b, int ti) {
    b = __builtin_amdgcn_readfirstlane(b); ti = __builtin_amdgcn_readfirstlane(ti);
    const int tid = ltid(), lane = tid & 63, wave = __builtin_amdgcn_readfirstlane(tid >> 6), fr = lane & 15, g = lane >> 4;
    LAS unsigned* HIST = (LAS unsigned*)lds; LAS unsigned char* GBUF = lds;
    LAS unsigned* GTM = (LAS unsigned*)(lds + 69632); LAS unsigned* EQM = (LAS unsigned*)(lds + 69632 + 8256);
    LAS unsigned short* SEL = (LAS unsigned short*)(lds + 86272); LAS unsigned char* QAB = lds + 94464;
    LAS int* MISC = (LAS int*)(lds + 127232); LAS unsigned char* SELB = lds + 127488;
    const LAS unsigned char* BKT8 = lds + L_BKT8; const LAS float* RELB = (const LAS float*)(lds + L_RELB);
    const bf16_t* P = (const bf16_t*)(p.ws + WS_P); const float* SP = (const float*)(p.ws + WS_SP); bf16_t* YMIX = (bf16_t*)(p.ws + WS_YMIX);
    const bf16_t* WUK = (const bf16_t*)(p.ws + WS_WUK); const bf16_t* WUV = (const bf16_t*)(p.ws + WS_WUV);
    const bf16_t* KIC = (const bf16_t*)(p.ws + WS_KIC); const bf16_t* CKC = (const bf16_t*)(p.ws + WS_CKC);
    const int t0 = ti * 16; const size_t rowb = (size_t)b * SEQ;

    for (int i = tid; i < 4100; i += NTHR) ((LAS u32x4*)HIST)[i] = (u32x4){0u, 0u, 0u, 0u};
    { const int h = wave; f32x4 acc[8];
#pragma unroll
      for (int rt = 0; rt < 8; ++rt) acc[rt] = (f32x4){0.f, 0.f, 0.f, 0.f};
      bf16x8 bw[16], aq[2];
#pragma unroll
      for (int kk = 0; kk < 2; ++kk) { aq[kk] = *(const bf16x8*)(P + (rowb + t0 + fr) * NP_AB + AB_QB + h * 64 + kk * 32 + g * 8);
#pragma unroll
        for (int rt = 0; rt < 8; ++rt) bw[kk * 8 + rt] = *(const bf16x8*)(WUK + ((size_t)((h * 2 + kk) * 8 + rt) * 64 + lane) * 8); }
      asm volatile("" ::: "memory");
#pragma unroll
      for (int kk = 0; kk < 2; ++kk)
#pragma unroll
        for (int rt = 0; rt < 8; ++rt) acc[rt] = mfma16(bw[kk * 8 + rt], aq[kk], acc[rt]);
#pragma unroll
      for (int rt = 0; rt < 8; ++rt) { constexpr float QS = 0.125f * 1.44269504f;
        u32x2 w; w.x = pk2(acc[rt][0] * QS, acc[rt][1] * QS); w.y = pk2(acc[rt][2] * QS, acc[rt][3] * QS);
        *(LAS u32x2*)(QAB + ((fr * 8 + h) * 128 + rt * 16 + 4 * g) * 2) = w; } }
    bf16x8 qf[4][2];
#pragma unroll
    for (int hh = 0; hh < 4; ++hh)
#pragma unroll
        for (int kk = 0; kk < 2; ++kk) qf[hh][kk] = *(const bf16x8*)(P + (rowb + t0 + fr) * NP_AB + AB_QI + hh * 64 + kk * 32 + g * 8);
    float wq[4];
#pragma unroll
    for (int hh = 0; hh < 4; ++hh) wq[hh] = SP[(rowb + t0 + fr) * 16 + 8 + hh] * 0.5f;
    const int tq = t0 + fr; const int nkt = ti + 1;
    u32x4 kfirst[8];
    { const bf16_t* kbase = KIC + rowb * 64 + (g * 16 + fr) * 8;
#pragma unroll
      for (int q4 = 0; q4 < 4; ++q4) { const int kq = wave + 8 * q4; const int kc = kq < nkt ? kq : nkt - 1; kfirst[2 * q4] = ldg16(kbase + (size_t)kc * 1024); kfirst[2 * q4 + 1] = ldg16(kbase + (size_t)kc * 1024 + 512); } }
    if (tid < 16) { MISC[tid] = 0; MISC[16 + tid] = (t0 + 16 > 256) ? 256 : (1 << 20); MISC[48 + tid] = 0; }
    for (int i = tid; i < 2 * 16 * 129; i += NTHR) GTM[i] = 0u;
    __syncthreads();

    const unsigned hist_a = (unsigned)(unsigned long long)(HIST + fr * 1025), gtm_a = (unsigned)(unsigned long long)(GTM + fr * 129), eqm_a = (unsigned)(unsigned long long)(EQM + fr * 129);
    const bool need_sel = (t0 + 16) > 256;
#pragma unroll 1
    for (int pass = need_sel ? 0 : 2; pass < 3; ++pass) {
        const unsigned pfx = (unsigned)MISC[fr], tau = (unsigned)MISC[48 + fr];

        if (pass == 0) dsa_score_pass<0>(KIC, rowb, nkt, wave, fr, g, tq, qf, wq, pfx, tau, hist_a, gtm_a, eqm_a, kfirst);
        else if (pass == 1) dsa_score_pass<1>(KIC, rowb, nkt, wave, fr, g, tq, qf, wq, pfx, tau, hist_a, gtm_a, eqm_a, kfirst);
        else dsa_score_pass<2>(KIC, rowb, nkt, wave, fr, g, tq, qf, wq, pfx, tau, hist_a, gtm_a, eqm_a, kfirst);
        asm volatile("s_waitcnt lgkmcnt(0)" ::: "memory");
        __syncthreads();

        if (pass < 2) {

#pragma unroll
            for (int qq = 0; qq < 2; ++qq) { const int q = wave * 2 + qq; const int nq = t0 + q + 1;
                if (nq > 256) {
                    const int R = MISC[16 + q]; const int lo = 2016 - 32 * lane;
                    unsigned w[16];
#pragma unroll
                    for (int i = 0; i < 16; ++i) { const unsigned hw = (unsigned)((lo >> 1) + i); w[i] = HIST[q * 1025 + (int)(hw ^ (hw >> 4))]; }
                    asm volatile("" ::: "memory");
                    int sl = 0;
#pragma unroll
                    for (int i = 0; i < 16; ++i) sl += (int)(w[i] & 0xffffu) + (int)(w[i] >> 16);
                    const int cum = scan_add_i(sl, lane);
                    const unsigned long long mk = __ballot(cum >= R);
                    const int Ls = mk ? (int)__ffsll((long long)mk) - 1 : 63;
                    const int c0 = cum - sl; int c = c0, nlt = 0, above = c0;
#pragma unroll
                    for (int i = 15; i >= 0; --i) {
                        c += (int)(w[i] >> 16); nlt += (c < R) ? 1 : 0; above = (c < R) ? c : above;
                        c += (int)(w[i] & 0xffffu); nlt += (c < R) ? 1 : 0; above = (c < R) ? c : above; }
                    const int fbin = lo + 31 - nlt;
                    const int fb = __builtin_amdgcn_readlane(fbin, Ls), ab = __builtin_amdgcn_readlane(above, Ls);
                    if (lane == 0) { const unsigned old = (unsigned)MISC[q];
                        if (pass == 0) MISC[q] = fb; else MISC[48 + q] = (int)((old << 11) | (unsigned)fb);
                        MISC[16 + q] = R - ab; }
                } else if (lane == 0) { MISC[48 + q] = 0; MISC[16 + q] = 1 << 20; }
            }
            __syncthreads();
            if (pass == 0) { for (int i = tid; i < 4100; i += NTHR) ((LAS u32x4*)HIST)[i] = (u32x4){0u, 0u, 0u, 0u}; }
            __syncthreads();

        }
    }

#pragma unroll 1
    for (int qq = 0; qq < 2; ++qq) { const int q = wave * 2 + qq; const int R = MISC[16 + q];
        const unsigned g0 = GTM[q * 129 + 2 * lane], g1 = GTM[q * 129 + 2 * lane + 1], e0 = EQM[q * 129 + 2 * lane], e1 = EQM[q * 129 + 2 * lane + 1];
        const int tc = (int)__popc(e0) + (int)__popc(e1); const int tpre = scan_add_i(tc, lane) - tc;
        const unsigned s0 = g0 | keep_lowest(e0, R - tpre), s1 = g1 | keep_lowest(e1, R - tpre - (int)__popc(e0));
        const int c = (int)__popc(s0) + (int)__popc(s1); const int incl = scan_add_i(c, lane); int pos = incl - c;
        unsigned m = s0; while (m) { const int bit = __ffs((int)m) - 1; m &= m - 1u; if (pos < 256) SEL[q * 256 + pos] = (unsigned short)(lane * 64 + bit); ++pos; }
        m = s1; while (m) { const int bit = __ffs((int)m) - 1; m &= m - 1u; if (pos < 256) SEL[q * 256 + pos] = (unsigned short)(lane * 64 + 32 + bit); ++pos; }
        const int total = __builtin_amdgcn_readlane(incl, 63);
        if (lane == 0) MISC[32 + q] = total < 256 ? total : 256;
        const int cnt = total < 256 ? total : 256; const u32x2 s4 = *(const LAS u32x2*)(SEL + q * 256 + lane * 4);
        unsigned b4 = 0u;
#pragma unroll
        for (int e = 0; e < 4; ++e) { const int ki = (int)((e & 1) ? (s4[e >> 1] >> 16) : (s4[e >> 1] & 0xffffu)); const bool used = lane * 4 + e < cnt;
            b4 |= (used ? (unsigned)BKT8[used ? t0 + q - ki : 0] : 32u) << (8 * e); }
        *(LAS unsigned*)(SELB + q * 256 + lane * 4) = b4;
        if (cnt < 256) {
#pragma unroll
            for (int e = 0; e < 4; ++e) if (lane * 4 + e >= cnt) SEL[q * 256 + lane * 4 + e] = (unsigned short)0; }
    }
    __syncthreads();

    {
        LAS unsigned char* gb = GBUF + wave * 8704;
        const LAS unsigned char* tra = gb + (4 * g + (fr >> 2)) * 272 + (4 * (fr & 3)) * 2;
        const int qa = wave * 2; const int cnt0 = MISC[32 + qa], cnt1 = MISC[33 + qa]; const int nch0 = (cnt0 + 31) >> 5, nch1 = (cnt1 + 31) >> 5, T = nch0 + nch1;
        const unsigned char* ckb = (const unsigned char*)(CKC + rowb * 128); const unsigned lane_off = (unsigned)fr * 16u;
        u32x4 b0[8], b1[8], b2[8];
        float m_run = -1e30f, l_part = 0.f; f32x4 ao[8]; bf16x8 qh[4];
        dsa_gather(b0, ckb, lane_off, SEL, qa, 0, nch0, T, g);
        dsa_gather(b1, ckb, lane_off, SEL, qa, 1, nch0, T, g);
#pragma unroll 1
        for (int t = 0; t < T; t += 3) {
            dsa_gather(b2, ckb, lane_off, SEL, qa, t + 2, nch0, T, g);
            dsa_attn_trip(b0, gb, tra, QAB, SELB, RELB, qa, t, nch0, nch1, cnt0, cnt1, fr, g, m_run, l_part, ao, qh);
            if (t + 1 >= T) break;
            dsa_gather(b0, ckb, lane_off, SEL, qa, t + 3, nch0, T, g);
            dsa_attn_trip(b1, gb, tra, QAB, SELB, RELB, qa, t + 1, nch0, nch1, cnt0, cnt1, fr, g, m_run, l_part, ao, qh);
            if (t + 2 >= T) break;
            dsa_gather(b1, ckb, lane_off, SEL, qa, t + 4, nch0, T, g);
            dsa_attn_trip(b2, gb, tra, QAB, SELB, RELB, qa, t + 2, nch0, nch1, cnt0, cnt1, fr, g, m_run, l_part, ao, qh);
        }
    }
    __syncthreads();

    { const int h = wave; f32x4 acc[4];
#pragma unroll
      for (int nt = 0; nt < 4; ++nt) acc[nt] = (f32x4){0.f, 0.f, 0.f, 0.f};
      bf16x8 bw[16];
#pragma unroll
      for (int kk = 0; kk < 4; ++kk)
#pragma unroll
        for (int nt = 0; nt < 4; ++nt) bw[kk * 4 + nt] = *(const bf16x8*)(WUV + ((size_t)((h * 4 + kk) * 4 + nt) * 64 + lane) * 8);
      asm volatile("" ::: "memory");
#pragma unroll
      for (int kk = 0; kk < 4; ++kk) { const bf16x8 a = *(const LAS bf16x8*)(QAB + ((fr * 8 + h) * 128 + kk * 32 + g * 8) * 2);
#pragma unroll
        for (int nt = 0; nt < 4; ++nt) acc[nt] = mfma16(bw[kk * 4 + nt], a, acc[nt]); }
#pragma unroll
      for (int nt = 0; nt < 4; ++nt) { u32x2 w; w.x = pk2(acc[nt][0], acc[nt][1]); w.y = pk2(acc[nt][2], acc[nt][3]);
        *(u32x2*)(YMIX + (rowb + t0 + fr) * D + 512 + h * 64 + nt * 16 + 4 * g) = w; } }
    __syncthreads();

}

struct DilRegs { u32x4 kv[4], vv[4]; bf16x8 qf[2]; };
__device__ __forceinline__ void dil_issue(const Params& p, int b, int h, int pat, int res, int n, DilRegs& r) {
    const int tid = ltid(), lane = tid & 63, wave = __builtin_amdgcn_readfirstlane(tid >> 6), fr = lane & 15, g = lane >> 4;
    const bf16_t* P = (const bf16_t*)(p.ws + WS_P);
    const int d = (pat == 0) ? 1 : (pat == 1 ? 4 : 16);
    const size_t rowb = (size_t)b * SEQ;
    const int row = tid >> 1, half = tid & 1; const int jsub = 128 * (n - 1) + row; const bool ok = jsub >= 0;
    const size_t tok = rowb + (size_t)(ok ? jsub : 0) * d + res;
#pragma unroll
    for (int q = 0; q < 4; ++q) { r.kv[q] = *(const u32x4*)(P + tok * NP_CD + CD_KD + h * 64 + half * 32 + q * 8); r.vv[q] = *(const u32x4*)(P + tok * NP_CD + CD_VD + h * 64 + half * 32 + q * 8); }
    const int qi = 128 * n + 16 * wave + fr; const size_t qtok = rowb + (size_t)qi * d + res;
#pragma unroll
    for (int kk = 0; kk < 2; ++kk) r.qf[kk] = *(const bf16x8*)(P + qtok * NP_CD + CD_QD + h * 64 + kk * 32 + g * 8);
}
__device__ __forceinline__ void dil_compute(const Params& p, LAS unsigned char* lds, int b, int h, int pat, int res, int n, const DilRegs& rg) {
    const int tid = ltid(), lane = tid & 63, wave = __builtin_amdgcn_readfirstlane(tid >> 6), fr = lane & 15, g = lane >> 4;
    LAS unsigned char* KS2 = lds; LAS unsigned char* VT2 = lds + 36864;
    const LAS unsigned char* BKT8 = lds + L_BKT8; const LAS float* RELB = (const LAS float*)(lds + L_RELB);
    const int d = (pat == 0) ? 1 : (pat == 1 ? 4 : 16);
    const size_t rowb = (size_t)b * SEQ;
    bf16_t* OP = (bf16_t*)(p.ws + (pat == 0 ? WS_HBF : (pat == 1 ? WS_HBF + 32 * MiB : WS_H1)));
    float* LSE = (float*)(p.ws + WS_H1 + 32 * MiB) + (size_t)pat * NTOK * 8;

    { const int row = tid >> 1, half = tid & 1; const bool ok = (128 * (n - 1) + row) >= 0;
#pragma unroll
      for (int q = 0; q < 4; ++q) { const u32x4 kq = ok ? rg.kv[q] : (u32x4){0u, 0u, 0u, 0u}, vq = ok ? rg.vv[q] : (u32x4){0u, 0u, 0u, 0u};
          *(LAS u32x4*)(KS2 + row * 144 + (half * 32 + q * 8) * 2) = kq;
#pragma unroll
          for (int e = 0; e < 4; ++e) { const unsigned w = vq[e]; const int dv = half * 32 + q * 8 + 2 * e;
              ((LAS bf16_t*)VT2)[dv * 264 + row] = (bf16_t)(w & 0xffffu); ((LAS bf16_t*)VT2)[(dv + 1) * 264 + row] = (bf16_t)(w >> 16); } } }

    LAS float* TAPB = (LAS float*)(lds + 70656);
    if (tid < 400) { const int tap = tid - 144; TAPB[tid] = (tap >= 0 && tap <= 128) ? RELB[(int)BKT8[tap * d] * 8 + h] : -1e30f; }
    __syncthreads();

    const int qi = 128 * n + 16 * wave + fr; const size_t qtok = rowb + (size_t)qi * d + res;
    const bf16x8 qf[2] = {rg.qf[0], rg.qf[1]};
    const int ql = 128 + 16 * wave + fr;
    f32x4 ao[4];
#pragma unroll
    for (int vt = 0; vt < 4; ++vt) ao[vt] = (f32x4){0.f, 0.f, 0.f, 0.f};
    float lg[9][4];
#pragma unroll
    for (int ti9 = 0; ti9 < 9; ++ti9) { const int klt = 16 * wave + 16 * ti9; f32x4 a = (f32x4){0.f, 0.f, 0.f, 0.f};
#pragma unroll
        for (int kk = 0; kk < 2; ++kk) a = mfma16(ldfrag(KS2, klt + fr, 144, kk, g), qf[kk], a);
#pragma unroll
        for (int r = 0; r < 4; ++r) { const int kl = klt + 4 * g + r; const int tap = ql - kl;
            float v = fmaf(a[r], 0.125f * 1.44269504f, TAPB[tap + 144]);
            if (n == 0) v = (kl >= 128) ? v : -1e30f;
            lg[ti9][r] = v; } }
    float ml = -1e30f;
#pragma unroll
    for (int ti9 = 0; ti9 < 9; ++ti9) ml = fmaxf(fmaxf(ml, fmaxf(lg[ti9][0], lg[ti9][1])), fmaxf(lg[ti9][2], lg[ti9][3]));
    const float m_run = rows_max(ml);
    float l_part = 0.f; unsigned pw[9][2];
#pragma unroll
    for (int ti9 = 0; ti9 < 9; ++ti9) { float pr[4];
#pragma unroll
        for (int r = 0; r < 4; ++r) { pr[r] = (lg[ti9][r] > -1e29f) ? __builtin_amdgcn_exp2f(lg[ti9][r] - m_run) : 0.f; l_part += pr[r]; }
        pw[ti9][0] = pk2(pr[0], pr[1]); pw[ti9][1] = pk2(pr[2], pr[3]); }
#pragma unroll
    for (int c = 0; c < 5; ++c) { const int kl0 = 16 * wave + 32 * c;
        u32x4 pfu; pfu.x = pw[2 * c][0]; pfu.y = pw[2 * c][1]; pfu.z = (c < 4) ? pw[(c < 4) ? 2 * c + 1 : 0][0] : 0u; pfu.w = (c < 4) ? pw[(c < 4) ? 2 * c + 1 : 0][1] : 0u;
        const bf16x8 pf = __builtin_bit_cast(bf16x8, pfu);
#pragma unroll
        for (int vt = 0; vt < 4; ++vt) {
            const bf16x4 lo = *(const LAS bf16x4*)(VT2 + (vt * 16 + fr) * 528 + (kl0 + 4 * g) * 2);
            bf16x4 hi = (bf16x4){0, 0, 0, 0};
            if (c < 4) hi = *(const LAS bf16x4*)(VT2 + (vt * 16 + fr) * 528 + (kl0 + 16 + 4 * g) * 2);
            bf16x8 af; af[0] = lo[0]; af[1] = lo[1]; af[2] = lo[2]; af[3] = lo[3]; af[4] = hi[0]; af[5] = hi[1]; af[6] = hi[2]; af[7] = hi[3];
            ao[vt] = mfma16(af, pf, ao[vt]); }
    }

    const float l = rows_sum(l_part);
    const float inv = 1.0f / l;
#pragma unroll
    for (int vt = 0; vt < 4; ++vt) { u32x2 w; w.x = pk2(ao[vt][0] * inv, ao[vt][1] * inv); w.y = pk2(ao[vt][2] * inv, ao[vt][3] * inv);
        *(u32x2*)(OP + qtok * 512 + h * 64 + vt * 16 + 4 * g) = w; }
    if (g == 0) LSE[qtok * 8 + h] = (m_run + __log2f(l)) * 0.69314718f;
    __syncthreads();

}

__device__ __forceinline__ void phase_dil_combine(const Params& p) {
    const bf16_t* __restrict__ O0 = (const bf16_t*)(p.ws + WS_HBF); const bf16_t* __restrict__ O1 = (const bf16_t*)(p.ws + WS_HBF + 32 * MiB); const bf16_t* __restrict__ O2 = (const bf16_t*)(p.ws + WS_H1);
    const float* __restrict__ LSE = (const float*)(p.ws + WS_H1 + 32 * MiB); bf16_t* __restrict__ YMIX = (bf16_t*)(p.ws + WS_YMIX);
#pragma unroll 2
    for (int idx = BID * NTHR + TID; idx < NTOK * 64; idx += GDIM * NTHR) {
        const int tok = idx >> 6, h = (idx >> 3) & 7, dg = idx & 7;
        const float l0 = LSE[(size_t)tok * 8 + h], l1 = LSE[(size_t)NTOK * 8 + (size_t)tok * 8 + h], l2 = LSE[(size_t)2 * NTOK * 8 + (size_t)tok * 8 + h];
        const float mx = fmaxf(l0, fmaxf(l1, l2)); const float w0 = __expf(l0 - mx), w1 = __expf(l1 - mx), w2 = __expf(l2 - mx); const float inv = 1.0f / (w0 + w1 + w2);
        const size_t off = (size_t)tok * 512 + h * 64 + dg * 8;
        const u32x4 a = *(const u32x4*)(O0 + off), bq = *(const u32x4*)(O1 + off), c = *(const u32x4*)(O2 + off);
        u32x4 o;
#pragma unroll
        for (int e = 0; e < 4; ++e) {
            const float v0 = (__uint_as_float(a[e] << 16) * w0 + __uint_as_float(bq[e] << 16) * w1 + __uint_as_float(c[e] << 16) * w2) * inv;
            const float v1 = (__uint_as_float(a[e] & 0xffff0000u) * w0 + __uint_as_float(bq[e] & 0xffff0000u) * w1 + __uint_as_float(c[e] & 0xffff0000u) * w2) * inv;
            o[e] = pk2(v0, v1); }
        *(u32x4*)(YMIX + (size_t)tok * D + 512 + h * 64 + dg * 8) = o;
    }
}

__device__ __forceinline__ unsigned grab_issue(unsigned* ctr) { unsigned v = 0u; if (TID == 0) v = __hip_atomic_fetch_add(ctr, 1u, __ATOMIC_RELAXED, __HIP_MEMORY_SCOPE_AGENT); return v; }
__device__ __forceinline__ int grab_finish(unsigned v, LAS int* slot) { __syncthreads(); if (TID == 0) *slot = (int)v; __syncthreads(); return *slot; }
__device__ __forceinline__ int grab_unit(unsigned* ctr, LAS int* slot) {
    __syncthreads();
    if (TID == 0) *slot = (int)__hip_atomic_fetch_add(ctr, 1u, __ATOMIC_RELAXED, __HIP_MEMORY_SCOPE_AGENT);
    __syncthreads();
    return *slot;
}
__device__ __forceinline__ void phase_rec_L(const Params& p, LAS unsigned char* lds, int j, bool is_ab) {
    const int G = GDIM; int u = BID;
    if (is_ab) { MlstmLIn cur, nxt;
        if (u < 2048) mlstm_L_issue(p, (u >> 6) >> 2, (u >> 6) & 3, u & 63, cur);
        for (; u < 2048; u += G) { const int un = u + G;
            if (un < 2048) mlstm_L_issue(p, (un >> 6) >> 2, (un >> 6) & 3, un & 63, nxt);
            mlstm_L_compute(p, lds, j, (u >> 6) >> 2, (u >> 6) & 3, u & 63, cur); cur = nxt; } }
    else { GlaLIn cur, nxt;
        if (u < 2048) gla_L_issue(p, j, (u >> 6) >> 2, (u >> 6) & 3, u & 63, cur);
        for (; u < 2048; u += G) { const int un = u + G;
            if (un < 2048) gla_L_issue(p, j, (un >> 6) >> 2, (un >> 6) & 3, un & 63, nxt);
            gla_L_compute(p, lds, j, (u >> 6) >> 2, (u >> 6) & 3, u & 63, cur); cur = nxt; } }
}
__device__ __forceinline__ void phase_mixer_ab(const Params& p, LAS unsigned char* lds, int j, unsigned* ctr, int nrec = 2048) {
    LAS int* slot = (LAS int*)(lds + LDS_PERS + LP_SLOT);
    load_attn_tables(p, lds);
    { const int nq = GDIM < 8 ? GDIM : 8;
#pragma unroll 1
      for (int bq = BID % nq; bq < 8; bq += nq) { unsigned* cq = ctr + 1 + bq;
          int ub = grab_unit(cq, slot);
          while (ub < 256) { const unsigned pend = grab_issue(cq); unit_dsa(p, lds, bq, 255 - ub); ub = grab_finish(pend, slot); } } }
    int u = 2048 + grab_unit(ctr, slot);
    const int total = 2048 + nrec;
    MlstmOIn cur, nxt;
    if (u < total) { const int k = u - 2048, bh = k >> 6; mlstm_O_issue(p, bh >> 2, bh & 3, k & 63, cur); }
    int un = (u < total) ? 2048 + grab_unit(ctr, slot) : total;
    while (u < total) {
        const unsigned pend = grab_issue(ctr);
        if (un < total) { const int k2 = un - 2048, bh2 = k2 >> 6; mlstm_O_issue(p, bh2 >> 2, bh2 & 3, k2 & 63, nxt); }
        { const int k = u - 2048, bh = k >> 6; mlstm_O_compute(p, lds, j, bh >> 2, bh & 3, k & 63, cur); }
        cur = nxt; u = un; un = 2048 + grab_finish(pend, slot);
    }
}
__device__ __forceinline__ void dil_decode(int k, int& b, int& h, int& pat, int& res, int& n) {
    const int n32 = k & 31, bh = k / 96; pat = (k >> 5) % 3; b = bh >> 3; h = bh & 7;
    if (pat == 0) { res = 0; n = n32; } else if (pat == 1) { res = n32 >> 3; n = n32 & 7; } else { res = n32 >> 1; n = n32 & 1; }
}
__device__ __forceinline__ void phase_mixer_cd(const Params& p, LAS unsigned char* lds, int j, unsigned* ctr, int nrec = 2048) {
    LAS int* slot = (LAS int*)(lds + LDS_PERS + LP_SLOT);
    load_attn_tables(p, lds);
    const int total = 6144 + nrec;
#define DQ_CTR (ctr + 1 + (BID & 7))
#define DQ_K0 ((BID & 7) * 768)
    {
        DilRegs cur, nxt;
        int u = grab_unit(DQ_CTR, slot);
        if (u < 768) { int b, h, pat, res, n; dil_decode(DQ_K0 + u, b, h, pat, res, n); dil_issue(p, b, h, pat, res, n, cur); }
        int un = (u < 768) ? grab_unit(DQ_CTR, slot) : 768;
        while (u < 768) {
            const unsigned pend = grab_issue(DQ_CTR);
            int b, h, pat, res, n; dil_decode(DQ_K0 + u, b, h, pat, res, n);
            if (un < 768) { int b2, h2, pat2, res2, n2; dil_decode(DQ_K0 + un, b2, h2, pat2, res2, n2); dil_issue(p, b2, h2, pat2, res2, n2, nxt); }
            dil_compute(p, lds, b, h, pat, res, n, cur);
            cur = nxt; u = un; un = grab_finish(pend, slot);
        }
    }
#undef DQ_CTR
#undef DQ_K0
    {
        int u = 6144 + grab_unit(ctr, slot);
        int un = (u < total) ? 6144 + grab_unit(ctr, slot) : total;
        GlaOIn gc, gn;
        if (u < total) { const int k = u - 6144, bh = k >> 6; gla_O_issue(p, j, bh >> 2, bh & 3, k & 63, gc); }
        while (u < total) {
            const unsigned pend = grab_issue(ctr);
            if (un < total) { const int k2 = un - 6144, bh2 = k2 >> 6; gla_O_issue(p, j, bh2 >> 2, bh2 & 3, k2 & 63, gn); }
            { const int k = u - 6144, bh = k >> 6; gla_O_compute(p, lds, j, bh >> 2, bh & 3, k & 63, gc); }
            gc = gn; u = un; un = 6144 + grab_finish(pend, slot);
        }
    }
}
typedef const __attribute__((address_space(4))) Params* KernargP;
__device__ __forceinline__ const Params& lparams() { KernargP k = (KernargP)__builtin_amdgcn_kernarg_segment_ptr(); asm volatile("" : "+s"(k)); return *(const Params*)k; }
#define PP (lparams())
__device__ __forceinline__ LAS unsigned char* llds(LAS unsigned char* q) { asm volatile("" : "+s"(q)); return q; }
#define LL (llds(lds))
__global__ void __launch_bounds__(NTHR, 2) hybrid_fwd(Params p) {
    extern __shared__ __attribute__((aligned(16))) unsigned char lds_raw[];
    LAS unsigned char* lds = (LAS unsigned char*)lds_raw;
    const int tid = TID, G = GDIM;
    for (int i = tid; i < (LDS_TOTAL - LDS_PERS) / 4; i += NTHR) ((LAS unsigned*)(lds + LDS_PERS))[i] = 0u;
    __syncthreads();
    unsigned* ctl = (unsigned*)(PP.ws + WS_CTL);
    XcdBarrier bar = xcd_barrier_post(ctl + CW_BAR, (volatile LAS unsigned*)(lds + LDS_PERS));
    LAS int* tbase = (LAS int*)(lds + LDS_PERS + LP_TBASE);

    { p0_prologue(PP, LL); }
    __syncthreads();
#pragma unroll 1
    for (int l = 0; l < DEPTH; ++l) {
        const bool is_ab = (l & 1) == 0; const int j = l >> 1;
        prep_layer(PP, LL, l);
        if (l == 0) xcd_barrier(bar);
        __syncthreads();
        { phase_norm1(PP, LL, l); }
        { xcd_barrier(bar); }
        {
            const int N = is_ab ? NP_AB : NP_CD;
            pg8::Gemm gm{(const bf16_t*)(PP.ws + WS_HBF), (const bf16_t*)(PP.ws + WS_WIN), NTOK, N, D};
            pg8::StaticOrder S; S.init(NTOK, N, G, BID);
            pg8::EpiBf16<false> E{(bf16_t*)(PP.ws + WS_P), N, is_ab ? (bf16_t*)(PP.ws + WS_KIC) : nullptr, is_ab ? (bf16_t*)(PP.ws + WS_CKC) : nullptr, LL + LDS_EPI};
            pg8::gemm_phase(LL, gm, S, E);
        }
        xcd_barrier(bar);
        phase_rec_L(PP, LL, j, is_ab);
        xcd_barrier(bar);
        if (is_ab) phase_scan_mlstm(PP); else phase_scan_gla(PP);
        xcd_barrier(bar);
        if (is_ab) { phase_mixer_ab(PP, LL, j, ctl + CW_WQ + 64 * l);
        } else { phase_mixer_cd(PP, LL, j, ctl + CW_WQ + 64 * l); xcd_barrier(bar); phase_dil_combine(PP);
        }
        xcd_barrier(bar);
        {
            pg8::Gemm gm{(const bf16_t*)(PP.ws + WS_YMIX), (const bf16_t*)(PP.ws + WS_WOUT), NTOK, D, D};
            pg8::StaticOrder S; S.init(NTOK, D, G, BID);
            pg8::EpiOutRes E{(float*)(PP.ws + WS_X), (const float*)(PP.ws + WS_MOD) + (size_t)l * 8 * 6 * D + 2 * D, LL + LDS_EPI};
            { pg8::gemm_phase(LL, gm, S, E); }
        }
        xcd_barrier(bar);
        phase_norm2(PP, LL, l);
        xcd_barrier(bar);
        phase_dispatch(PP, LL, tbase);
        xcd_barrier(bar);
        {
            pg8::Gemm gm{(const bf16_t*)(PP.ws + WS_HBF), (const bf16_t*)(PP.ws + WS_WGU), MOE_ROWS, 16 * 1024, D, (const int*)(PP.ws + WS_ROWTOK)};
            pg8::MoeOrder S{tbase, G, (G % 8 == 0) ? (BID % 8) * (G / 8) + BID / 8 : BID};
            pg8::EpiMoe1 E{(bf16_t*)(PP.ws + WS_H1), LL + LDS_EPI};
            pg8::gemm_phase<pg8::EpiMoe1, pg8::MoeOrder, true>(LL, gm, S, E);
        }
        xcd_barrier(bar);
        {
            pg8::Gemm gm{(const bf16_t*)(PP.ws + WS_H1), (const bf16_t*)(PP.ws + WS_WDN), MOE_ROWS, 16 * 1024, 512};
            pg8::MoeOrder S{tbase, G, (G % 8 == 0) ? (BID % 8) * (G / 8) + BID / 8 : BID};
            pg8::EpiBf16<true> E{(bf16_t*)(PP.ws + WS_P), D, nullptr, nullptr, LL + LDS_EPI};
            pg8::gemm_phase(LL, gm, S, E);
        }
        xcd_barrier(bar);
    }
    { phase_final(PP, LL); }
}

extern "C" void kernel_launch(void* const* d_in, const int* in_sizes, int n_in, void* d_out, int out_size, void* d_ws, size_t ws_size, hipStream_t stream) {
    static int grid = 0;
    if (grid == 0) {
        if (n_in != 28 || ws_size < WS_END2) { fprintf(stderr, "kernel_launch: unexpected n_in %d / ws_size %zu (need %zu)\n", n_in, ws_size, (size_t)WS_END2); grid = -1; return; }
        int dev = 0, cus = 0, per_cu = 0;
        if (hipGetDevice(&dev) != hipSuccess || hipDeviceGetAttribute(&cus, hipDeviceAttributeMultiprocessorCount, dev) != hipSuccess) { grid = -1; return; }
        if (hipFuncSetAttribute((const void*)hybrid_fwd, hipFuncAttributeMaxDynamicSharedMemorySize, LDS_TOTAL) != hipSuccess) { fprintf(stderr, "kernel_launch: hipFuncSetAttribute failed\n"); grid = -1; return; }
        if (hipOccupancyMaxActiveBlocksPerMultiprocessor(&per_cu, (const void*)hybrid_fwd, NTHR, LDS_TOTAL) != hipSuccess || per_cu < 1) { fprintf(stderr, "kernel_launch: occupancy query says %d\n", per_cu); }
        (void)hipGetLastError();
        if (cus < 8) { fprintf(stderr, "kernel_launch: %d compute units (the dilated-attention queues need 8 workgroups)\n", cus); grid = -1; return; }
        grid = cus;
    }
    if (grid < 0) return;
    if (hipMemsetAsync((char*)d_ws + WS_CTL, 0, CTL_BYTES, stream) != hipSuccess) return;
    Params p{};
    for (int i = 0; i < 28; ++i) p.in[i] = (const float*)d_in[i];
    p.out = (float*)d_out; p.ws = (unsigned char*)d_ws;
    hipLaunchKernelGGL(hybrid_fwd, dim3(grid), dim3(NTHR), LDS_TOTAL, stream, p);
}
```
